# Optimizing an MI355X kernel written in HIP

```python
import math
import jax
import jax.numpy as jnp
from jax import lax
import numpy as np

D_MODEL = 1024
BATCH = 4
SEQ = 8192
DEPTH = 1

DILATED_GROUPS = ((128, 1), (512, 4), (2048, 16))
N_GROUPS_A = len(DILATED_GROUPS)
HEADS_PER_GROUP_A = 4
HEAD_DIM_A = 128
N_HEADS_A = N_GROUPS_A * HEADS_PER_GROUP_A
WIDTH_A = HEADS_PER_GROUP_A * HEAD_DIM_A
NUM_BUCKETS = 32
MAX_DISTANCE = 2048
HGRN_HEAD_DIM = 128
N_HEADS_B = D_MODEL // HGRN_HEAD_DIM
WIDTH_B = N_HEADS_B * HGRN_HEAD_DIM
CHUNK_B = 64
MEM_LEN = 256
N_HEADS_C = 4
HEAD_DIM_C = 128
WIDTH_C = N_HEADS_C * HEAD_DIM_C
N_BRANCHES = 3
COLS_A = N_GROUPS_A * 3 * WIDTH_A
COLS_B = 4 * WIDTH_B
COLS_C = WIDTH_C
COLS_GATE = N_BRANCHES * D_MODEL
N_IN = COLS_A + COLS_B + COLS_C + COLS_GATE
N_EXPERT_GROUPS = 4
EXPERTS_PER_GROUP = 8
N_EXPERTS = N_EXPERT_GROUPS * EXPERTS_PER_GROUP
TOP_K_INNER = 2
D_EXPERT = D_MODEL // 4
MOE_BLOCK = 128
DN_ALPHA = (2 * DEPTH) ** 0.25
DN_BETA = (8 * DEPTH) ** -0.25
LN_EPS = 1e-5
RMS_EPS = 1e-6

kernel_name = 'hybrid_dilated_hgrn2_mem_hmoe_block'


def _layer_norm(x, g, b):
    xf = x.astype(jnp.float32)
    mu = jnp.mean(xf, axis=-1, keepdims=True)
    var = jnp.mean(jnp.square(xf - mu), axis=-1, keepdims=True)
    return ((xf - mu) * lax.rsqrt(var + LN_EPS) * g.astype(jnp.float32) + b.astype(jnp.float32)).astype(x.dtype)


def _t5_bucket_np(dist):
    dist = np.asarray(dist, np.int32)
    max_exact = NUM_BUCKETS // 2
    d = np.maximum(dist, 1).astype(np.float32)
    large = max_exact + (np.log(d / max_exact) / math.log(MAX_DISTANCE / max_exact) * (NUM_BUCKETS - max_exact)).astype(np.int32)
    large = np.minimum(large, NUM_BUCKETS - 1)
    return np.where(dist < max_exact, dist, large).astype(np.int32)


def _dilated_band_attention(q, k, v, bias_tab, window, dilation):
    B, S, H, Dh = q.shape
    band = window // dilation
    L = S // dilation
    nb = -(-L // band)
    Lp = nb * band

    def to_blocks(t):
        t = t.reshape(B, L, dilation, H, Dh).transpose(0, 2, 1, 3, 4)
        t = jnp.pad(t, ((0, 0), (0, 0), (0, Lp - L), (0, 0), (0, 0)))
        return t.reshape(B, dilation, nb, band, H, Dh)

    def with_prev(t):
        prev = jnp.pad(t, ((0, 0), (0, 0), (1, 0), (0, 0), (0, 0), (0, 0)))[:, :, :-1]
        return jnp.concatenate([prev, t], axis=3)

    qb = to_blocks(q)
    kc = with_prev(to_blocks(k))
    vc = with_prev(to_blocks(v))

    i = np.arange(band)[:, None]
    j = np.arange(2 * band)[None, :]
    u = i + band - j
    in_band = (u >= 0) & (u <= band)
    first_block = (np.arange(nb)[:, None, None] == 0) & (j[None] < band)
    valid = in_band[None] & ~first_block
    bucket = _t5_bucket_np(np.clip(u, 0, band) * dilation)
    bias = jnp.take(bias_tab, jnp.asarray(bucket), axis=0).astype(jnp.float32).transpose(2, 0, 1)

    s = jnp.einsum('bcnihd,bcnjhd->bcnhij', qb, kc).astype(jnp.float32) * (Dh ** -0.5)
    s = jnp.where(valid[None, None, :, None], s + bias[None, None, None], -jnp.inf)
    m = jnp.max(s, axis=-1, keepdims=True)
    p = jnp.exp(s - m)
    l = jnp.sum(p, axis=-1, keepdims=True)
    o = jnp.einsum('bcnhij,bcnjhd->bcnihd', p, vc.astype(jnp.float32))
    o = o / l.transpose(0, 1, 2, 4, 3, 5)
    lse = (m + jnp.log(l))[..., 0].transpose(0, 1, 2, 4, 3)

    def from_blocks(t):
        t = t.reshape((B, dilation, Lp) + t.shape[4:])[:, :, :L]
        t = jnp.swapaxes(t, 1, 2)
        return t.reshape((B, S) + t.shape[3:])

    return from_blocks(o), from_blocks(lse)


def _hgrn2(q, f_raw, i_in, g, lb, norm_g):
    B, S, H, Dk = q.shape
    n_chunks = S // CHUNK_B
    qf = jax.nn.silu(q.astype(jnp.float32))
    f = lb + (1.0 - lb) * jax.nn.sigmoid(f_raw.astype(jnp.float32))
    logf = jnp.log(f)
    kf = 1.0 - f
    vf = i_in.astype(jnp.float32)

    def chunks(t):
        return t.reshape(B, n_chunks, CHUNK_B, H, t.shape[-1]).transpose(1, 0, 3, 2, 4)

    qc, kc, vc, lc = chunks(qf), chunks(kf), chunks(vf), chunks(logf)
    bc = jnp.cumsum(lc, axis=3)
    causal = np.tril(np.ones((CHUNK_B, CHUNK_B), dtype=bool))

    def step(state, inp):
        qt, kt, vt, bt = inp
        o_inter = jnp.einsum('bhtk,bhkv->bhtv', qt * jnp.exp(bt), state)
        diff = jnp.where(causal[:, :, None], bt[:, :, :, None, :] - bt[:, :, None, :, :], -jnp.inf)
        att = jnp.einsum('bhtk,bhsk,bhtsk->bhts', qt, kt, jnp.exp(diff))
        o_intra = jnp.einsum('bhts,bhsv->bhtv', att, vt)
        b_last = bt[:, :, -1:, :]
        new_state = jnp.exp(b_last[:, :, 0, :, None]) * state + jnp.einsum('bhsk,bhsv->bhkv', kt * jnp.exp(b_last - bt), vt)
        return new_state, o_inter + o_intra

    s0 = jnp.zeros((B, H, Dk, vf.shape[-1]), jnp.float32)
    _, o = lax.scan(step, s0, (qc, kc, vc, bc))
    o = o.transpose(1, 0, 3, 2, 4).reshape(B, S, H, -1)
    o = o * lax.rsqrt(jnp.mean(o * o, axis=-1, keepdims=True) + RMS_EPS)
    o = o.reshape(B, S, -1) * norm_g.astype(jnp.float32) * jax.nn.silu(g.reshape(B, S, -1).astype(jnp.float32))
    return o.astype(q.dtype)


def _memory_attention(q, mem, w_kv):
    B, S = q.shape[0], q.shape[1]
    M = mem.shape[1]
    kv = (mem @ w_kv).reshape(B, M, 2, N_HEADS_C, HEAD_DIM_C)
    k, v = kv[:, :, 0], kv[:, :, 1]
    s = jnp.einsum('bshd,bmhd->bhsm', q, k).astype(jnp.float32) * (HEAD_DIM_C ** -0.5)
    p = jax.nn.softmax(s, axis=-1)
    o = jnp.einsum('bhsm,bmhd->bshd', p, v.astype(jnp.float32))
    return o.reshape(B, S, WIDTH_C).astype(q.dtype)


def _hier_moe(h, w_rg, b_rg, w_re, b_re, w_gate, w_up, w_down):
    B, S, D = h.shape
    T = B * S
    ht = h.reshape(T, D)
    glog = (ht @ w_rg).astype(jnp.float32) + b_rg.astype(jnp.float32)
    gprob = jax.nn.softmax(glog, axis=-1)
    gsel = jnp.argmax(glog, axis=-1)
    elog = ((ht @ w_re).astype(jnp.float32) + b_re.astype(jnp.float32)).reshape(T, N_EXPERT_GROUPS, EXPERTS_PER_GROUP)
    elog_sel = elog[jnp.arange(T), gsel]
    top_v, top_i = lax.top_k(elog_sel, TOP_K_INNER)
    weights = jax.nn.softmax(top_v, axis=-1) * jnp.take_along_axis(gprob, gsel[:, None], axis=1)
    eid = gsel[:, None] * EXPERTS_PER_GROUP + top_i

    M = T * TOP_K_INNER
    e_flat = eid.reshape(M)
    w_flat = weights.reshape(M)
    tok = jnp.arange(M) // TOP_K_INNER
    order = jnp.argsort(e_flat)
    e_s, tok_s, w_s = e_flat[order], tok[order], w_flat[order]
    counts = jnp.bincount(e_flat, length=N_EXPERTS)
    starts = jnp.cumsum(counts) - counts
    pcounts = (counts + MOE_BLOCK - 1) // MOE_BLOCK * MOE_BLOCK
    pends = jnp.cumsum(pcounts)
    pstarts = pends - pcounts
    dest = pstarts[e_s] + (jnp.arange(M) - starts[e_s])
    n_blocks = (M + N_EXPERTS * (MOE_BLOCK - 1) + MOE_BLOCK - 1) // MOE_BLOCK
    P = n_blocks * MOE_BLOCK
    xbuf = jnp.zeros((P, D), h.dtype).at[dest].set(ht[tok_s])
    block_e = jnp.minimum(jnp.searchsorted(pends, jnp.arange(n_blocks) * MOE_BLOCK, side='right'), N_EXPERTS - 1)

    def expert_block(args):
        xb, e = args
        return (jax.nn.silu(xb @ w_gate[e]) * (xb @ w_up[e])) @ w_down[e]

    ybuf = lax.map(expert_block, (xbuf.reshape(n_blocks, MOE_BLOCK, D), block_e)).reshape(P, D)
    y = jnp.zeros((T, D), h.dtype).at[tok_s].add(w_s[:, None].astype(h.dtype) * ybuf[dest])
    return y.reshape(B, S, D)


def setup_inputs(seed: int = 0) -> dict:
    key = jax.random.key(seed)
    ks = jax.random.split(key, 24)

    def nrm(k, shape, scale):
        return jax.random.normal(k, shape, jnp.float32) * scale

    scale_a = np.ones((N_GROUPS_A, 3, WIDTH_A), np.float32)
    scale_a[:, 2] = DN_BETA
    scale_b = np.ones((4, WIDTH_B), np.float32)
    scale_b[2] = DN_BETA
    col_scale = jnp.asarray(np.concatenate([scale_a.ravel(), scale_b.ravel(), np.ones(COLS_C + COLS_GATE, np.float32)]))
    kv_scale = jnp.asarray(np.concatenate([np.ones(WIDTH_C, np.float32), np.full(WIDTH_C, DN_BETA, np.float32)]))
    return {
        'x': nrm(ks[0], (BATCH, SEQ, D_MODEL), 1.0),
        'mem': nrm(ks[1], (BATCH, MEM_LEN, D_MODEL), 1.0),
        'rel_bias': nrm(ks[2], (NUM_BUCKETS, N_HEADS_A), 0.2),
        'hgrn_lb_logits': nrm(ks[3], (DEPTH + 1, WIDTH_B), 1.0),
        'w_in': nrm(ks[4], (DEPTH, D_MODEL, N_IN), D_MODEL ** -0.5) * col_scale,
        'w_mem_kv': nrm(ks[5], (DEPTH, D_MODEL, 2 * WIDTH_C), D_MODEL ** -0.5) * kv_scale,
        'hgrn_norm_g': 1.0 + nrm(ks[6], (DEPTH, WIDTH_B), 0.02),
        'w_branch_a': nrm(ks[7], (DEPTH, WIDTH_A, D_MODEL), WIDTH_A ** -0.5 * DN_BETA),
        'w_branch_b': nrm(ks[8], (DEPTH, WIDTH_B, D_MODEL), WIDTH_B ** -0.5 * DN_BETA),
        'w_branch_c': nrm(ks[9], (DEPTH, WIDTH_C, D_MODEL), WIDTH_C ** -0.5 * DN_BETA),
        'w_out': nrm(ks[10], (DEPTH, D_MODEL, D_MODEL), D_MODEL ** -0.5 * DN_BETA),
        'ln1_g': 1.0 + nrm(ks[11], (DEPTH, D_MODEL), 0.02),
        'ln1_b': nrm(ks[12], (DEPTH, D_MODEL), 0.02),
        'w_router_group': nrm(ks[13], (DEPTH, D_MODEL, N_EXPERT_GROUPS), D_MODEL ** -0.5),
        'b_router_group': nrm(ks[14], (DEPTH, N_EXPERT_GROUPS), 0.01),
        'w_router_expert': nrm(ks[15], (DEPTH, D_MODEL, N_EXPERTS), D_MODEL ** -0.5),
        'b_router_expert': nrm(ks[16], (DEPTH, N_EXPERTS), 0.01),
        'w_exp_gate': nrm(ks[17], (DEPTH, N_EXPERTS, D_MODEL, D_EXPERT), D_MODEL ** -0.5 * DN_BETA),
        'w_exp_up': nrm(ks[18], (DEPTH, N_EXPERTS, D_MODEL, D_EXPERT), D_MODEL ** -0.5 * DN_BETA),
        'w_exp_down': nrm(ks[19], (DEPTH, N_EXPERTS, D_EXPERT, D_MODEL), D_EXPERT ** -0.5 * DN_BETA),
        'ln2_g': 1.0 + nrm(ks[20], (DEPTH, D_MODEL), 0.02),
        'ln2_b': nrm(ks[21], (DEPTH, D_MODEL), 0.02),
    }


def reference(x, mem, rel_bias, hgrn_lb_logits, w_in, w_mem_kv, hgrn_norm_g, w_branch_a, w_branch_b, w_branch_c, w_out, ln1_g, ln1_b, w_router_group, b_router_group, w_router_expert, b_router_expert, w_exp_gate, w_exp_up, w_exp_down, ln2_g, ln2_b):
    B, S, D = x.shape
    lower_bounds = jnp.cumsum(jax.nn.softmax(hgrn_lb_logits.astype(jnp.float32), axis=0), axis=0)
    for l in range(DEPTH):
        proj = x @ w_in[l]
        pa = proj[..., :COLS_A].reshape(B, S, N_GROUPS_A, 3, HEADS_PER_GROUP_A, HEAD_DIM_A)
        pb = proj[..., COLS_A:COLS_A + COLS_B].reshape(B, S, 4, N_HEADS_B, HGRN_HEAD_DIM)
        pc = proj[..., COLS_A + COLS_B:COLS_A + COLS_B + COLS_C].reshape(B, S, N_HEADS_C, HEAD_DIM_C)
        pg = proj[..., COLS_A + COLS_B + COLS_C:].reshape(B, S, N_BRANCHES, D)

        outs, lses = [], []
        for g, (window, dilation) in enumerate(DILATED_GROUPS):
            o_g, lse_g = _dilated_band_attention(pa[:, :, g, 0], pa[:, :, g, 1], pa[:, :, g, 2], rel_bias[:, g * HEADS_PER_GROUP_A:(g + 1) * HEADS_PER_GROUP_A], window, dilation)
            outs.append(o_g)
            lses.append(lse_g)
        mix_w = jax.nn.softmax(jnp.stack(lses), axis=0)[..., None]
        o_a = jnp.sum(mix_w * jnp.stack(outs), axis=0).reshape(B, S, WIDTH_A).astype(x.dtype)

        o_b = _hgrn2(pb[:, :, 0], pb[:, :, 1], pb[:, :, 2], pb[:, :, 3], lower_bounds[l].reshape(N_HEADS_B, HGRN_HEAD_DIM), hgrn_norm_g[l])

        o_c = _memory_attention(pc, mem, w_mem_kv[l])

        gates = jax.nn.sigmoid(pg.astype(jnp.float32)).astype(x.dtype)
        merged = gates[:, :, 0] * (o_a @ w_branch_a[l]) + gates[:, :, 1] * (o_b @ w_branch_b[l]) + gates[:, :, 2] * (o_c @ w_branch_c[l])
        x = _layer_norm(DN_ALPHA * x + merged @ w_out[l], ln1_g[l], ln1_b[l])

        y = _hier_moe(x, w_router_group[l], b_router_group[l], w_router_expert[l], b_router_expert[l], w_exp_gate[l], w_exp_up[l], w_exp_down[l])
        x = _layer_norm(DN_ALPHA * x + y, ln2_g[l], ln2_b[l])
    return x
```

```cpp
#ifdef HOST_TEST
#include <cmath>
#include <cstdint>
#include <cstdio>
#include <cstring>
#define HD
#define GLOBAL
#else
#include <hip/hip_runtime.h>
#include <cstdint>
#include <cstdio>
#include <cstring>
#include <cmath>
#define HD __host__ __device__ __forceinline__
#endif

#ifndef CFG_D
#define CFG_D 1024
#define CFG_B 4
#define CFG_S 8192
#endif
typedef unsigned short bf16_t;
constexpr int D = CFG_D, NBATCH = CFG_B, S = CFG_S, T = NBATCH * S;
constexpr int NHALF = 2, TH = T / NHALF, BH = NBATCH / NHALF;
constexpr int WA = 512, HB = D / 128, WB = D, WC = 512;
constexpr int COLS_A = 4608, COLS_B = 4 * WB, COLS_C = 512, COLS_G = 3 * D;
constexpr int NP = COLS_A + COLS_B + COLS_C, N_IN = NP + COLS_G;
constexpr int OW = WA + WB + WC;
constexpr int DE = D / 4, NE = 32, HBK = DE < 128 ? DE : 128;
constexpr int MEM = 256, NSEG = S / 256;
constexpr int MAXROWS = 2 * T + NE * 256;
constexpr float DN_ALPHA = 1.189207115002721f;
constexpr float LN_EPS = 1e-5f, RMS_EPS = 1e-6f;
constexpr float QK_SCALE = 0.08838834764831845f;

constexpr size_t MiB = 1u << 20;
constexpr size_t al(size_t x) { return (x + 4095) & ~(size_t)4095; }
constexpr size_t OFF_CTL = 0;
constexpr size_t OFF_SMALL = 1 * MiB;
constexpr size_t OFF_WT = 2 * MiB;
constexpr size_t WT_IN = OFF_WT, WT_KV = WT_IN + al((size_t)N_IN * D * 2), WT_A = WT_KV + al((size_t)1024 * D * 2),
                 WT_B = WT_A + al((size_t)D * WA * 2), WT_C = WT_B + al((size_t)D * WB * 2), WT_OUT = WT_C + al((size_t)D * WC * 2),
                 OFF_MEMB = WT_OUT + al((size_t)D * D * 2), OFF_MEMKV = OFF_MEMB + al((size_t)NBATCH * MEM * D * 2),
                 OFF_LIST = OFF_MEMKV + al((size_t)NBATCH * MEM * 1024 * 2), OFF_RW = OFF_LIST + al((size_t)NE * T * 4),
                 OFF_XB = OFF_RW + al((size_t)T * 2 * 4), OFF_P = OFF_XB + al((size_t)T * D * 2),
                 OFF_PART = OFF_P + al((size_t)TH * NP * 2), OFF_LSE = OFF_PART + al((size_t)3 * TH * WA * 2),
                 OFF_HG = OFF_LSE + al((size_t)3 * TH * 4 * 4), OFF_DSEG = OFF_HG + al((size_t)BH * HB * NSEG * 128 * 128 * 4),
                 WS_END = OFF_DSEG + al((size_t)BH * HB * NSEG * 128 * 4);
constexpr size_t OFF_GATES = OFF_P, OFF_H1 = OFF_P, OFF_X1B = OFF_P + al((size_t)T * D * 4),
                 OFF_WTGU = OFF_P + al((size_t)T * 3 * D * 2), OFF_WTDN = OFF_WTGU + al((size_t)NE * 2 * DE * D * 2),
                 OFF_HBUF = OFF_WTDN + al((size_t)NE * D * DE * 2), OFF_PEND = OFF_HBUF + al((size_t)MAXROWS * DE * 2);
constexpr size_t OFF_MERGED = OFF_XB, OFF_Y0 = OFF_XB, OFF_Y1 = OFF_PART;
static_assert(OFF_X1B + (size_t)T * D * 2 <= OFF_WTGU, "x1b inside dead gates region");
static_assert(OFF_PEND <= OFF_PART, "P-region overlays fit");
static_assert(OFF_Y1 + (size_t)T * D * 2 <= WS_END, "y1 fits in part+hg region");
constexpr int CW_CNT = 0;
constexpr int SM_BIAS = 0, SM_LB = 2048, SM_BLK = 2048 + 4096;

HD float bf2f(bf16_t v) { union { unsigned u; float f; } c; c.u = (unsigned)v << 16; return c.f; }
HD bf16_t f2bf(float f) { union { unsigned u; float f; } c; c.f = f; unsigned u = c.u; return (bf16_t)((u + 0x7fffu + ((u >> 16) & 1u)) >> 16); }
HD float sigmoidf_(float x) { return 1.0f / (1.0f + expf(-x)); }
HD float siluf_(float x) { return x / (1.0f + expf(-x)); }
HD int dil_of(int g) { return g == 0 ? 1 : (g == 1 ? 4 : 16); }
HD int perm_row(int tl, int g) { const int r = dil_of(g), bl = tl / S, s = tl % S; return bl * S + (s % r) * (S / r) + s / r; }

struct Ctx {
    const float *x, *mem, *rel_bias, *lb_logits, *w_in, *w_kv, *norm_g, *w_a, *w_b, *w_c, *w_out, *ln1_g, *ln1_b, *w_rg, *b_rg, *w_re, *b_re, *w_eg, *w_eu, *w_ed, *ln2_g, *ln2_b;
    float* out; unsigned char* ws;
    unsigned char bucket[3][132];
    int half, pad0;
};
template <class Tp> HD Tp* wsp(const Ctx& c, size_t off) { return (Tp*)(c.ws + off); }

#ifdef HOST_TEST
static inline unsigned atomic_inc_u32(unsigned* p) { unsigned r;
#pragma omp atomic capture
    { r = *p; *p += 1; }
    return r; }
#else
__device__ __forceinline__ unsigned atomic_inc_u32(unsigned* p) { return atomicAdd(p, 1u); }
#endif

struct S0_xb { Ctx c; static constexpr long n = (long)T * D;
    HD void operator()(long i) const { wsp<bf16_t>(c, OFF_XB)[i] = f2bf(c.x[i]); } };
struct S0_memb { Ctx c; static constexpr long n = (long)NBATCH * MEM * D;
    HD void operator()(long i) const { wsp<bf16_t>(c, OFF_MEMB)[i] = f2bf(c.mem[i]); } };
struct S0_tr { const float* W; bf16_t* Wt; int K, N; long n;
    HD void operator()(long i) const { const int k = (int)(i % K); const long nn = i / K; Wt[i] = f2bf(W[(size_t)k * N + nn]); } };
struct S0_gu { Ctx c; static constexpr long n = (long)NE * 2 * DE * D;
    HD void operator()(long i) const { const int k = (int)(i % D); const long r = i / D; const int j = (int)(r % (2 * DE)), e = (int)(r / (2 * DE));
        const int u = j / (2 * HBK), w = j % (2 * HBK), hid = u * HBK + w % HBK, up = w / HBK;
        const float* src = up ? c.w_eu : c.w_eg; wsp<bf16_t>(c, OFF_WTGU)[i] = f2bf(src[((size_t)e * D + k) * DE + hid]); } };
struct S0_dn { Ctx c; static constexpr long n = (long)NE * D * DE;
    HD void operator()(long i) const { const int k = (int)(i % DE); const long r = i / DE; const int col = (int)(r % D), e = (int)(r / D);
        wsp<bf16_t>(c, OFF_WTDN)[i] = f2bf(c.w_ed[((size_t)e * DE + k) * D + col]); } };
struct S0_small { Ctx c; static constexpr long n = 12 * 129 + WB + 64;
    HD void operator()(long i) const { float* sm = wsp<float>(c, OFF_SMALL);
        if (i < 12 * 129) { const int gh = (int)(i / 129), u = (int)(i % 129), g = gh / 4; sm[SM_BIAS + i] = c.rel_bias[c.bucket[g][u] * 12 + gh]; }
        else if (i < 12 * 129 + WB) { const int ch = (int)(i - 12 * 129); sm[SM_LB + ch] = sigmoidf_(c.lb_logits[ch] - c.lb_logits[WB + ch]); }
        else { const int j = (int)(i - 12 * 129 - WB); wsp<unsigned>(c, OFF_CTL)[j] = 0u; } } };

struct G_proj { Ctx c; static constexpr int N = NP, NSEGS = 1, NBP = 1;
    HD int M() const { return TH; } HD int K(int) const { return D; }
    HD const bf16_t* arow(int, int row) const { return wsp<bf16_t>(c, OFF_XB) + ((size_t)c.half * TH + row) * D; }
    HD const bf16_t* brow(int, int, int col, int) const { return wsp<bf16_t>(c, WT_IN) + (size_t)col * D; }
    HD void between(int, int, int, float&, float&) const {}
    HD void store(int row, int col, float a, float) const { const int pr = col < COLS_A ? perm_row(row, col / 1536) : row; wsp<bf16_t>(c, OFF_P)[(size_t)pr * NP + col] = f2bf(a); } };
struct G_memkv { Ctx c; static constexpr int N = 1024, NSEGS = 1, NBP = 1;
    HD int M() const { return NBATCH * MEM; } HD int K(int) const { return D; }
    HD const bf16_t* arow(int, int row) const { return wsp<bf16_t>(c, OFF_MEMB) + (size_t)row * D; }
    HD const bf16_t* brow(int, int, int col, int) const { return wsp<bf16_t>(c, WT_KV) + (size_t)col * D; }
    HD void between(int, int, int, float&, float&) const {}
    HD void store(int row, int col, float a, float) const { wsp<bf16_t>(c, OFF_MEMKV)[(size_t)row * 1024 + col] = f2bf(a); } };
struct G_gates { Ctx c; static constexpr int N = 3 * D, NSEGS = 1, NBP = 1;
    HD int M() const { return T; } HD int K(int) const { return D; }
    HD const bf16_t* arow(int, int row) const { return wsp<bf16_t>(c, OFF_XB) + (size_t)row * D; }
    HD const bf16_t* brow(int, int, int col, int) const { return wsp<bf16_t>(c, WT_IN) + (size_t)(NP + col) * D; }
    HD void between(int, int, int, float&, float&) const {}
    HD void store(int row, int col, float a, float) const { wsp<bf16_t>(c, OFF_GATES)[(size_t)row * 3 * D + col] = f2bf(sigmoidf_(a)); } };
struct G_merge { Ctx c; static constexpr int N = D, NSEGS = 3, NBP = 1;
    HD int M() const { return T; } HD int K(int s) const { return s == 1 ? WB : 512; }
    HD const bf16_t* arow(int s, int row) const { return (const bf16_t*)c.out + (size_t)row * OW + (s == 0 ? 0 : (s == 1 ? WA : WA + WB)); }
    HD const bf16_t* brow(int s, int, int col, int) const { return s == 0 ? wsp<bf16_t>(c, WT_A) + (size_t)col * WA : (s == 1 ? wsp<bf16_t>(c, WT_B) + (size_t)col * WB : wsp<bf16_t>(c, WT_C) + (size_t)col * WC); }
    HD void between(int s, int row, int col, float& acc, float& carry) const { carry += bf2f(wsp<bf16_t>(c, OFF_GATES)[(size_t)row * 3 * D + s * D + col]) * acc; acc = 0.f; }
    HD void store(int row, int col, float, float carry) const { wsp<bf16_t>(c, OFF_MERGED)[(size_t)row * D + col] = f2bf(carry); } };
struct G_wout { Ctx c; static constexpr int N = D, NSEGS = 1, NBP = 1;
    HD int M() const { return T; } HD int K(int) const { return D; }
    HD const bf16_t* arow(int, int row) const { return wsp<bf16_t>(c, OFF_MERGED) + (size_t)row * D; }
    HD const bf16_t* brow(int, int, int col, int) const { return wsp<bf16_t>(c, WT_OUT) + (size_t)col * D; }
    HD void between(int, int, int, float&, float&) const {}
    HD void store(int row, int col, float a, float) const { wsp<float>(c, OFF_H1)[(size_t)row * D + col] = DN_ALPHA * c.x[(size_t)row * D + col] + a; } };
struct MoeRow { int e, pos, valid, entry; };
HD MoeRow moe_row(const Ctx& c, int row) {
    const int* blk = wsp<int>(c, OFF_SMALL) + SM_BLK; const unsigned* cnt = wsp<unsigned>(c, OFF_CTL) + CW_CNT;
    MoeRow r; const int rb = row >> 8; r.e = blk[64 + rb]; r.pos = ((rb - blk[r.e]) << 8) + (row & 255); r.valid = r.pos < (int)cnt[r.e];
    r.entry = wsp<int>(c, OFF_LIST)[(size_t)r.e * T + (r.valid ? r.pos : 0)]; return r; }
HD int moe_rows_total(const Ctx& c) { return (wsp<int>(c, OFF_SMALL) + SM_BLK)[32] << 8; }
struct G_moe1 { Ctx c; static constexpr int N = DE, NSEGS = 1, NBP = 2;
    HD int M() const { return moe_rows_total(c); } HD int K(int) const { return D; }
    HD const bf16_t* arow(int, int row) const { const MoeRow r = moe_row(c, row); return wsp<bf16_t>(c, OFF_X1B) + (size_t)(r.entry >> 1) * D; }
    HD const bf16_t* brow(int, int row0, int col, int which) const { const int e = (wsp<int>(c, OFF_SMALL) + SM_BLK)[64 + (row0 >> 8)];
        return wsp<bf16_t>(c, OFF_WTGU) + ((size_t)e * 2 * DE + (col / HBK) * 2 * HBK + which * HBK + col % HBK) * D; }
    HD void between(int, int, int, float&, float&) const {}
    HD void store(int row, int col, float g, float u) const { wsp<bf16_t>(c, OFF_HBUF)[(size_t)row * DE + col] = f2bf(siluf_(g) * u); } };
struct G_moe2 { Ctx c; static constexpr int N = D, NSEGS = 1, NBP = 1;
    HD int M() const { return moe_rows_total(c); } HD int K(int) const { return DE; }
    HD const bf16_t* arow(int, int row) const { return wsp<bf16_t>(c, OFF_HBUF) + (size_t)row * DE; }
    HD const bf16_t* brow(int, int row0, int col, int) const { const int e = (wsp<int>(c, OFF_SMALL) + SM_BLK)[64 + (row0 >> 8)]; return wsp<bf16_t>(c, OFF_WTDN) + ((size_t)e * D + col) * DE; }
    HD void between(int, int, int, float&, float&) const {}
    HD void store(int row, int col, float a, float) const { const MoeRow r = moe_row(c, row); if (!r.valid) return;
        wsp<bf16_t>(c, (r.entry & 1) ? OFF_Y1 : OFF_Y0)[(size_t)(r.entry >> 1) * D + col] = f2bf(a); } };

struct u32x4_t { unsigned x, y, z, w; };
HD float bflo(unsigned u) { union { unsigned u; float f; } c; c.u = u << 16; return c.f; }
HD float bfhi(unsigned u) { union { unsigned u; float f; } c; c.u = u & 0xffff0000u; return c.f; }
HD float dot128(const bf16_t* a, const bf16_t* b) { float s = 0.f; const u32x4_t* pa = (const u32x4_t*)a; const u32x4_t* pb = (const u32x4_t*)b;
#ifndef HOST_TEST
#pragma unroll 4
#endif
    for (int d = 0; d < 16; ++d) { const u32x4_t ua = pa[d], ub = pb[d];
        s += bflo(ua.x) * bflo(ub.x) + bfhi(ua.x) * bfhi(ub.x) + bflo(ua.y) * bflo(ub.y) + bfhi(ua.y) * bfhi(ub.y) + bflo(ua.z) * bflo(ub.z) + bfhi(ua.z) * bfhi(ub.z) + bflo(ua.w) * bflo(ub.w) + bfhi(ua.w) * bfhi(ub.w); }
    return s; }
struct E_attnA { Ctx c; static constexpr long n = (long)TH * 3 * 4 * 8;
    HD void operator()(long idx) const {
        const int p = (int)(idx & 7), h = (int)((idx >> 3) & 3); const long rest = idx >> 5; const int g = (int)(rest % 3), tl = (int)(rest / 3);
        const int r = dil_of(g), bl = tl / S, s = tl % S, cc = s % r, nq = s / r, L = S / r, base = bl * S + cc * L;
        const bf16_t* P = wsp<bf16_t>(c, OFF_P); const float* bias = wsp<float>(c, OFF_SMALL) + SM_BIAS + (g * 4 + h) * 129;
        const bf16_t* q = P + (size_t)(base + nq) * NP + g * 1536 + h * 128;
        float m = -INFINITY, l = 0.f, o[16];
#ifndef HOST_TEST
#pragma unroll
#endif
        for (int j = 0; j < 16; ++j) o[j] = 0.f;
        const int umax = nq < 128 ? nq : 128;
        for (int u = 0; u <= umax; ++u) {
            const bf16_t* kr = P + (size_t)(base + nq - u) * NP + g * 1536 + 512 + h * 128; const bf16_t* vr = kr + 512 + p * 16;
            const float sc = dot128(q, kr) * QK_SCALE + bias[u];
            const float mn = fmaxf(m, sc), a = expf(m - mn), pw = expf(sc - mn); l = l * a + pw; m = mn;
#ifndef HOST_TEST
#pragma unroll
#endif
            for (int j = 0; j < 16; ++j) o[j] = o[j] * a + pw * bf2f(vr[j]);
        }
        bf16_t* op = wsp<bf16_t>(c, OFF_PART) + ((size_t)g * TH + tl) * WA + h * 128 + p * 16; const float il = 1.f / l;
#ifndef HOST_TEST
#pragma unroll
#endif
        for (int j = 0; j < 16; ++j) op[j] = f2bf(o[j] * il);
        if (p == 0) wsp<float>(c, OFF_LSE)[((size_t)g * TH + tl) * 4 + h] = m + logf(l);
    } };
struct E_combA { Ctx c; static constexpr long n = (long)TH * WA;
    HD void operator()(long idx) const { const int col = (int)(idx % WA), tl = (int)(idx / WA), h = col >> 7;
        const float* lse = wsp<float>(c, OFF_LSE); const bf16_t* part = wsp<bf16_t>(c, OFF_PART);
        const float l0 = lse[((size_t)0 * TH + tl) * 4 + h], l1 = lse[((size_t)1 * TH + tl) * 4 + h], l2 = lse[((size_t)2 * TH + tl) * 4 + h];
        const float mx = fmaxf(l0, fmaxf(l1, l2)), e0 = expf(l0 - mx), e1 = expf(l1 - mx), e2 = expf(l2 - mx), inv = 1.f / (e0 + e1 + e2);
        const float v = (e0 * bf2f(part[((size_t)0 * TH + tl) * WA + col]) + e1 * bf2f(part[((size_t)1 * TH + tl) * WA + col]) + e2 * bf2f(part[((size_t)2 * TH + tl) * WA + col])) * inv;
        ((bf16_t*)c.out)[((size_t)c.half * TH + tl) * OW + col] = f2bf(v); } };
struct E_attnC { Ctx c; static constexpr long n = (long)TH * 4 * 8;
    HD void operator()(long idx) const { const int p = (int)(idx & 7), h = (int)((idx >> 3) & 3), tl = (int)(idx >> 5), b = c.half * BH + tl / S;
        const bf16_t* q = wsp<bf16_t>(c, OFF_P) + (size_t)tl * NP + COLS_A + COLS_B + h * 128; const bf16_t* kv = wsp<bf16_t>(c, OFF_MEMKV) + (size_t)b * MEM * 1024;
        float m = -INFINITY, l = 0.f, o[16];
#ifndef HOST_TEST
#pragma unroll
#endif
        for (int j = 0; j < 16; ++j) o[j] = 0.f;
        for (int k = 0; k < MEM; ++k) { const bf16_t* kr = kv + (size_t)k * 1024 + h * 128; const bf16_t* vr = kr + 512 + p * 16;
            const float sc = dot128(q, kr) * QK_SCALE; const float mn = fmaxf(m, sc), a = expf(m - mn), pw = expf(sc - mn); l = l * a + pw; m = mn;
#ifndef HOST_TEST
#pragma unroll
#endif
            for (int j = 0; j < 16; ++j) o[j] = o[j] * a + pw * bf2f(vr[j]); }
        bf16_t* op = (bf16_t*)c.out + ((size_t)c.half * TH + tl) * OW + WA + WB + h * 128 + p * 16; const float il = 1.f / l;
#ifndef HOST_TEST
#pragma unroll
#endif
        for (int j = 0; j < 16; ++j) op[j] = f2bf(o[j] * il); } };

HD float hg_f(const Ctx& c, const bf16_t* prow, int ch) { const float lb = wsp<float>(c, OFF_SMALL)[SM_LB + ch]; return lb + (1.f - lb) * sigmoidf_(bf2f(prow[COLS_A + WB + ch])); }
struct E_hg1 { Ctx c; static constexpr long n = (long)BH * HB * NSEG * 128 * 128;
    HD void operator()(long idx) const { const int v = (int)(idx & 127), k = (int)((idx >> 7) & 127); const long r = idx >> 14; const int seg = (int)(r % NSEG), bhl = (int)(r / NSEG), h = bhl % HB, bl = bhl / HB;
        const bf16_t* P = wsp<bf16_t>(c, OFF_P); const int ch = h * 128 + k; float st = 0.f, dsum = 0.f;
        for (int s = 0; s < 256; ++s) { const bf16_t* pr = P + (size_t)(bl * S + seg * 256 + s) * NP; const float f = hg_f(c, pr, ch); st = f * st + (1.f - f) * bf2f(pr[COLS_A + 2 * WB + h * 128 + v]); dsum += logf(f); }
        wsp<float>(c, OFF_HG)[idx] = st; if (v == 0) wsp<float>(c, OFF_DSEG)[((size_t)bhl * NSEG + seg) * 128 + k] = dsum; } };
struct E_hg2 { Ctx c; static constexpr long n = (long)BH * HB * 128 * 128;
    HD void operator()(long idx) const { const int v = (int)(idx & 127), k = (int)((idx >> 7) & 127), bhl = (int)(idx >> 14); float run = 0.f;
        for (int seg = 0; seg < NSEG; ++seg) { float* p = wsp<float>(c, OFF_HG) + (((size_t)bhl * NSEG + seg) * 128 + k) * 128 + v; const float tmp = *p; *p = run;
            run = expf(wsp<float>(c, OFF_DSEG)[((size_t)bhl * NSEG + seg) * 128 + k]) * run + tmp; } } };
struct E_hg3 { Ctx c; static constexpr long n = (long)BH * HB * NSEG * 128;
    HD void operator()(long idx) const { const int v = (int)(idx & 127); const long r = idx >> 7; const int seg = (int)(r % NSEG), bhl = (int)(r / NSEG), h = bhl % HB, bl = bhl / HB;
        const bf16_t* P = wsp<bf16_t>(c, OFF_P); float st[128];
#ifndef HOST_TEST
#pragma unroll
#endif
        for (int k = 0; k < 128; ++k) st[k] = wsp<float>(c, OFF_HG)[(((size_t)bhl * NSEG + seg) * 128 + k) * 128 + v];
        for (int s = 0; s < 256; ++s) { const int tl = bl * S + seg * 256 + s; const bf16_t* pr = P + (size_t)tl * NP; const float iv = bf2f(pr[COLS_A + 2 * WB + h * 128 + v]); float o = 0.f;
#ifndef HOST_TEST
#pragma unroll
#endif
            for (int k = 0; k < 128; ++k) { const float f = hg_f(c, pr, h * 128 + k); st[k] = f * st[k] + (1.f - f) * iv; o += siluf_(bf2f(pr[COLS_A + h * 128 + k])) * st[k]; }
            ((bf16_t*)c.out)[((size_t)c.half * TH + tl) * OW + WA + h * 128 + v] = f2bf(o); } } };
struct E_hgnorm { Ctx c; static constexpr long n = (long)TH * HB;
    HD void operator()(long idx) const { const int h = (int)(idx % HB), tl = (int)(idx / HB); bf16_t* o = (bf16_t*)c.out + ((size_t)c.half * TH + tl) * OW + WA + h * 128;
        const bf16_t* pr = wsp<bf16_t>(c, OFF_P) + (size_t)tl * NP + COLS_A + 3 * WB + h * 128; float ss = 0.f;
        for (int v = 0; v < 128; ++v) { const float x = bf2f(o[v]); ss += x * x; }
        const float rs = 1.f / sqrtf(ss * (1.f / 128.f) + RMS_EPS);
        for (int v = 0; v < 128; ++v) o[v] = f2bf(bf2f(o[v]) * rs * c.norm_g[h * 128 + v] * siluf_(bf2f(pr[v]))); } };

struct E_ln1 { Ctx c; static constexpr long n = T;
    HD void operator()(long row) const { float* h1 = wsp<float>(c, OFF_H1) + (size_t)row * D; bf16_t* xb1 = wsp<bf16_t>(c, OFF_X1B) + (size_t)row * D;
        float mu = 0.f; for (int i = 0; i < D; ++i) mu += h1[i]; mu *= (1.f / D);
        float var = 0.f; for (int i = 0; i < D; ++i) { const float d = h1[i] - mu; var += d * d; } var *= (1.f / D); const float rs = 1.f / sqrtf(var + LN_EPS);
        float gl0 = c.b_rg[0], gl1 = c.b_rg[1], gl2 = c.b_rg[2], gl3 = c.b_rg[3];
        for (int i = 0; i < D; ++i) { const float v = (h1[i] - mu) * rs * c.ln1_g[i] + c.ln1_b[i]; h1[i] = v; xb1[i] = f2bf(v);
            gl0 += v * c.w_rg[i * 4 + 0]; gl1 += v * c.w_rg[i * 4 + 1]; gl2 += v * c.w_rg[i * 4 + 2]; gl3 += v * c.w_rg[i * 4 + 3]; }
        int gs = 0; float gm = gl0; if (gl1 > gm) { gm = gl1; gs = 1; } if (gl2 > gm) { gm = gl2; gs = 2; } if (gl3 > gm) { gm = gl3; gs = 3; }
        const float gp = 1.f / (expf(gl0 - gm) + expf(gl1 - gm) + expf(gl2 - gm) + expf(gl3 - gm));
        float v0 = -INFINITY, v1 = -INFINITY; int i0 = 0, i1 = 0;
        for (int j = 0; j < 8; ++j) { float el = c.b_re[gs * 8 + j]; for (int i = 0; i < D; ++i) el += h1[i] * c.w_re[i * 32 + gs * 8 + j];
            if (el > v0) { v1 = v0; i1 = i0; v0 = el; i0 = j; } else if (el > v1) { v1 = el; i1 = j; } }
        const float e1 = expf(v1 - v0), w0 = gp / (1.f + e1), w1 = gp * e1 / (1.f + e1);
        unsigned* cnt = wsp<unsigned>(c, OFF_CTL) + CW_CNT; int* list = wsp<int>(c, OFF_LIST); float* rw = wsp<float>(c, OFF_RW);
        const int ea = gs * 8 + i0, eb = gs * 8 + i1;
        list[(size_t)ea * T + atomic_inc_u32(cnt + ea)] = (int)row * 2 + 0; list[(size_t)eb * T + atomic_inc_u32(cnt + eb)] = (int)row * 2 + 1;
        rw[row * 2 + 0] = w0; rw[row * 2 + 1] = w1; } };
struct E_blk { Ctx c; static constexpr long n = 1;
    HD void operator()(long) const { int* blk = wsp<int>(c, OFF_SMALL) + SM_BLK; const unsigned* cnt = wsp<unsigned>(c, OFF_CTL) + CW_CNT; int acc = 0;
        for (int e = 0; e < NE; ++e) { blk[e] = acc; const int nb = ((int)cnt[e] + 255) >> 8; for (int j = 0; j < nb; ++j) blk[64 + acc + j] = e; acc += nb; } blk[32] = acc; } };
struct E_ln2 { Ctx c; static constexpr long n = T;
    HD void operator()(long row) const { const float* x1 = wsp<float>(c, OFF_H1) + (size_t)row * D; const bf16_t* y0 = wsp<bf16_t>(c, OFF_Y0) + (size_t)row * D; const bf16_t* y1 = wsp<bf16_t>(c, OFF_Y1) + (size_t)row * D;
        const float w0 = wsp<float>(c, OFF_RW)[row * 2], w1 = wsp<float>(c, OFF_RW)[row * 2 + 1]; float* o = c.out + (size_t)row * D;
        float mu = 0.f; for (int i = 0; i < D; ++i) { const float v = DN_ALPHA * x1[i] + w0 * bf2f(y0[i]) + w1 * bf2f(y1[i]); mu += v; } mu *= (1.f / D);
        float var = 0.f; for (int i = 0; i < D; ++i) { const float v = DN_ALPHA * x1[i] + w0 * bf2f(y0[i]) + w1 * bf2f(y1[i]) - mu; var += v * v; } var *= (1.f / D); const float rs = 1.f / sqrtf(var + LN_EPS);
        for (int i = 0; i < D; ++i) { const float v = DN_ALPHA * x1[i] + w0 * bf2f(y0[i]) + w1 * bf2f(y1[i]); o[i] = (v - mu) * rs * c.ln2_g[i] + c.ln2_b[i]; } } };
typedef short bf16x8 __attribute__((ext_vector_type(8)));
typedef float f32x4 __attribute__((ext_vector_type(4)));

template <class F> __global__ void __launch_bounds__(256) k_elems(F f, long n) {
    for (long i = (long)blockIdx.x * 256 + threadIdx.x; i < n; i += (long)gridDim.x * 256) f(i);
}
template <class F> __global__ void __launch_bounds__(64) k_elems64(F f, long n) {
    for (long i = (long)blockIdx.x * 64 + threadIdx.x; i < n; i += (long)gridDim.x * 64) f(i);
}
template <class G> __global__ void __launch_bounds__(256) k_sgemm(G g) {
    const int M = g.M(); const int lane = threadIdx.x & 63, wid = threadIdx.x >> 6; constexpr int ntn = G::N / 64;
    const long ntiles = (long)(M / 64) * ntn;
    for (long tile = blockIdx.x; tile < ntiles; tile += gridDim.x) {
        const int tm = (int)(tile / ntn), tn = (int)(tile % ntn), r0 = tm * 64 + wid * 16, c0 = tn * 64;
        f32x4 acc[G::NBP][4], carry[4];
#pragma unroll
        for (int j = 0; j < 4; ++j) { carry[j] = (f32x4){0.f, 0.f, 0.f, 0.f};
#pragma unroll
            for (int w = 0; w < G::NBP; ++w) acc[w][j] = (f32x4){0.f, 0.f, 0.f, 0.f}; }
#pragma unroll
        for (int seg = 0; seg < G::NSEGS; ++seg) {
            const bf16_t* ar = g.arow(seg, r0 + (lane & 15)) + 8 * (lane >> 4); const bf16_t* br[G::NBP][4];
#pragma unroll
            for (int w = 0; w < G::NBP; ++w)
#pragma unroll
                for (int j = 0; j < 4; ++j) br[w][j] = g.brow(seg, r0, c0 + 16 * j + (lane & 15), w) + 8 * (lane >> 4);
            const int K = g.K(seg);
            for (int k0 = 0; k0 < K; k0 += 32) { const bf16x8 a = *(const bf16x8*)(ar + k0);
#pragma unroll
                for (int w = 0; w < G::NBP; ++w)
#pragma unroll
                    for (int j = 0; j < 4; ++j) { const bf16x8 b = *(const bf16x8*)(br[w][j] + k0); acc[w][j] = __builtin_amdgcn_mfma_f32_16x16x32_bf16(a, b, acc[w][j], 0, 0, 0); } }
#pragma unroll
            for (int j = 0; j < 4; ++j)
#pragma unroll
                for (int i = 0; i < 4; ++i) { float a = acc[0][j][i], cr = carry[j][i]; g.between(seg, r0 + (lane >> 4) * 4 + i, c0 + 16 * j + (lane & 15), a, cr); acc[0][j][i] = a; carry[j][i] = cr; }
        }
#pragma unroll
        for (int j = 0; j < 4; ++j)
#pragma unroll
            for (int i = 0; i < 4; ++i) g.store(r0 + (lane >> 4) * 4 + i, c0 + 16 * j + (lane & 15), acc[0][j][i], G::NBP == 2 ? acc[G::NBP - 1][j][i] : carry[j][i]);
    }
}
template <class F> static void launch_elems(const F& f, long n, hipStream_t st) { long nb = (n + 255) / 256; if (nb > 32768) nb = 32768; if (nb < 1) nb = 1; hipLaunchKernelGGL(k_elems<F>, dim3((unsigned)nb), dim3(256), 0, st, f, n); }
template <class F> static void launch_elems64(const F& f, long n, hipStream_t st) { long nb = (n + 63) / 64; if (nb > 65536) nb = 65536; hipLaunchKernelGGL(k_elems64<F>, dim3((unsigned)nb), dim3(64), 0, st, f, n); }
template <class G> static void launch_sgemm(const G& g, hipStream_t st) { hipLaunchKernelGGL(k_sgemm<G>, dim3(4096), dim3(256), 0, st, g); }

static void fill_bucket(Ctx& c) {
    for (int g = 0; g < 3; ++g) for (int u = 0; u <= 128; ++u) { const int dist = u * dil_of(g); int b;
        if (dist < 16) b = dist; else { const float d = (float)dist; int large = 16 + (int)(logf(d / 16.f) / (float)log(2048.0 / 16.0) * 16.f); if (large > 31) large = 31; b = large; }
        c.bucket[g][u] = (unsigned char)b; }
}
static Ctx make_ctx(void* const* d_in, void* d_out, void* d_ws) {
    Ctx c; memset(&c, 0, sizeof(c)); const float** ip = (const float**)&c; for (int i = 0; i < 22; ++i) ip[i] = (const float*)d_in[i];
    c.out = (float*)d_out; c.ws = (unsigned char*)d_ws; fill_bucket(c); return c;
}
static void v1_stage0(Ctx c, hipStream_t st) {
    launch_elems(S0_xb{c}, S0_xb::n, st); launch_elems(S0_memb{c}, S0_memb::n, st); launch_elems(S0_small{c}, S0_small::n, st);
    launch_elems(S0_tr{c.w_in, wsp<bf16_t>(c, WT_IN), D, N_IN, (long)D * N_IN}, (long)D * N_IN, st);
    launch_elems(S0_tr{c.w_kv, wsp<bf16_t>(c, WT_KV), D, 1024, (long)D * 1024}, (long)D * 1024, st);
    launch_elems(S0_tr{c.w_a, wsp<bf16_t>(c, WT_A), WA, D, (long)D * WA}, (long)D * WA, st);
    launch_elems(S0_tr{c.w_b, wsp<bf16_t>(c, WT_B), WB, D, (long)D * WB}, (long)D * WB, st);
    launch_elems(S0_tr{c.w_c, wsp<bf16_t>(c, WT_C), WC, D, (long)D * WC}, (long)D * WC, st);
    launch_elems(S0_tr{c.w_out, wsp<bf16_t>(c, WT_OUT), D, D, (long)D * D}, (long)D * D, st);
}
static void v1_proj(Ctx c, hipStream_t st) { if (c.half == 0) launch_sgemm(G_memkv{c}, st); launch_sgemm(G_proj{c}, st); }
static void v1_mixers(Ctx c, hipStream_t st) {
    launch_elems(E_hg1{c}, E_hg1::n, st); launch_elems(E_hg2{c}, E_hg2::n, st);
    launch_elems(E_attnA{c}, E_attnA::n, st); launch_elems(E_attnC{c}, E_attnC::n, st);
    launch_elems64(E_hg3{c}, E_hg3::n, st); launch_elems(E_hgnorm{c}, E_hgnorm::n, st); launch_elems(E_combA{c}, E_combA::n, st);
}
static void v1_expw(Ctx c, hipStream_t st) { launch_elems(S0_gu{c}, S0_gu::n, st); launch_elems(S0_dn{c}, S0_dn::n, st); }
static void v1_gates(Ctx c, hipStream_t st) { launch_sgemm(G_gates{c}, st); }
static void v1_merge(Ctx c, hipStream_t st) { launch_sgemm(G_merge{c}, st); }
static void v1_wout(Ctx c, hipStream_t st) { launch_sgemm(G_wout{c}, st); }
static void v1_ln1(Ctx c, hipStream_t st) { launch_elems(E_ln1{c}, E_ln1::n, st); launch_elems(E_blk{c}, 1, st); }
static void v1_moe1(Ctx c, hipStream_t st) { launch_sgemm(G_moe1{c}, st); }
static void v1_moe2(Ctx c, hipStream_t st) { launch_sgemm(G_moe2{c}, st); }
static void v1_ln2(Ctx c, hipStream_t st) { launch_elems(E_ln2{c}, E_ln2::n, st); }
extern "C" void kernel_launch(void* const* d_in, const int* in_sizes, int n_in, void* d_out, int out_size, void* d_ws, size_t ws_size, hipStream_t stream) {
    if (n_in != 22 || in_sizes[0] != T * D || out_size != T * D || ws_size < WS_END) { fprintf(stderr, "kernel_launch: unexpected shapes / workspace (%zu < %zu)\n", ws_size, (size_t)WS_END); return; }
    Ctx c = make_ctx(d_in, d_out, d_ws);
    v1_stage0(c, stream);
    for (int half = 0; half < NHALF; ++half) { c.half = half; v1_proj(c, stream); v1_mixers(c, stream); }
    c.half = 0;
    v1_expw(c, stream); v1_gates(c, stream); v1_merge(c, stream); v1_wout(c, stream); v1_ln1(c, stream); v1_moe1(c, stream); v1_moe2(c, stream); v1_ln2(c, stream);
}
```

```cpp
#ifdef HOST_TEST
#include <cmath>
#include <cstdint>
#include <cstdio>
#include <cstring>
#define HD
#define GLOBAL
#else
#include <hip/hip_runtime.h>
#include <cstdint>
#include <cstdio>
#include <cstring>
#include <cmath>
#define HD __host__ __device__ __forceinline__
#endif

#ifndef CFG_D
#define CFG_D 1024
#define CFG_B 4
#define CFG_S 8192
#endif
typedef unsigned short bf16_t;
constexpr int D = CFG_D, NBATCH = CFG_B, S = CFG_S, T = NBATCH * S;
constexpr int NHALF = 2, TH = T / NHALF, BH = NBATCH / NHALF;
constexpr int WA = 512, HB = D / 128, WB = D, WC = 512;
constexpr int COLS_A = 4608, COLS_B = 4 * WB, COLS_C = 512, COLS_G = 3 * D;
constexpr int NP = COLS_A + COLS_B + COLS_C, N_IN = NP + COLS_G;
constexpr int OW = WA + WB + WC;
constexpr int DE = D / 4, NE = 32, HBK = DE < 128 ? DE : 128;
constexpr int MEM = 256, NSEG = S / 256;
constexpr int MAXROWS = 2 * T + NE * 256;
constexpr float DN_ALPHA = 1.189207115002721f;
constexpr float LN_EPS = 1e-5f, RMS_EPS = 1e-6f;
constexpr float QK_SCALE = 0.08838834764831845f;

constexpr size_t MiB = 1u << 20;
constexpr size_t al(size_t x) { return (x + 4095) & ~(size_t)4095; }
constexpr size_t OFF_CTL = 0;
constexpr size_t OFF_SMALL = 1 * MiB;
constexpr size_t OFF_WT = 2 * MiB;
constexpr size_t WT_IN = OFF_WT, WT_KV = WT_IN + al((size_t)N_IN * D * 2), WT_A = WT_KV + al((size_t)1024 * D * 2),
                 WT_B = WT_A + al((size_t)D * WA * 2), WT_C = WT_B + al((size_t)D * WB * 2), WT_OUT = WT_C + al((size_t)D * WC * 2),
                 OFF_MEMB = WT_OUT + al((size_t)D * D * 2), OFF_MEMKV = OFF_MEMB + al((size_t)NBATCH * MEM * D * 2),
                 OFF_LIST = OFF_MEMKV + al((size_t)NBATCH * MEM * 1024 * 2), OFF_RW = OFF_LIST + al((size_t)NE * T * 4),
                 OFF_XB = OFF_RW + al((size_t)T * 2 * 4), OFF_P = OFF_XB + al((size_t)T * D * 2),
                 OFF_PART = OFF_P + al((size_t)TH * NP * 2), OFF_LSE = OFF_PART + al((size_t)3 * TH * WA * 2),
                 OFF_HG = OFF_LSE + al((size_t)3 * TH * 4 * 4), OFF_DSEG = OFF_HG + al((size_t)BH * HB * NSEG * 128 * 128 * 4),
                 WS_END = OFF_DSEG + al((size_t)BH * HB * NSEG * 128 * 4);
constexpr size_t OFF_GATES = OFF_P, OFF_H1 = OFF_P, OFF_X1B = OFF_P + al((size_t)T * D * 4),
                 OFF_WTGU = OFF_P + al((size_t)T * 3 * D * 2), OFF_WTDN = OFF_WTGU + al((size_t)NE * 2 * DE * D * 2),
                 OFF_HBUF = OFF_WTDN + al((size_t)NE * D * DE * 2), OFF_PEND = OFF_HBUF + al((size_t)MAXROWS * DE * 2);
constexpr size_t OFF_MERGED = OFF_XB, OFF_Y0 = OFF_XB, OFF_Y1 = OFF_PART;
static_assert(OFF_X1B + (size_t)T * D * 2 <= OFF_WTGU, "x1b inside dead gates region");
static_assert(OFF_PEND <= OFF_PART, "P-region overlays fit");
static_assert(OFF_Y1 + (size_t)T * D * 2 <= WS_END, "y1 fits in part+hg region");
constexpr int CW_CNT = 0;
constexpr int SM_BIAS = 0, SM_LB = 2048, SM_BLK = 2048 + 4096;

HD float bf2f(bf16_t v) { union { unsigned u; float f; } c; c.u = (unsigned)v << 16; return c.f; }
HD bf16_t f2bf(float f) { union { unsigned u; float f; } c; c.f = f; unsigned u = c.u; return (bf16_t)((u + 0x7fffu + ((u >> 16) & 1u)) >> 16); }
HD float sigmoidf_(float x) { return 1.0f / (1.0f + expf(-x)); }
HD float siluf_(float x) { return x / (1.0f + expf(-x)); }
HD int dil_of(int g) { return g == 0 ? 1 : (g == 1 ? 4 : 16); }
HD int perm_row(int tl, int g) { const int r = dil_of(g), bl = tl / S, s = tl % S; return bl * S + (s % r) * (S / r) + s / r; }

struct Ctx {
    const float *x, *mem, *rel_bias, *lb_logits, *w_in, *w_kv, *norm_g, *w_a, *w_b, *w_c, *w_out, *ln1_g, *ln1_b, *w_rg, *b_rg, *w_re, *b_re, *w_eg, *w_eu, *w_ed, *ln2_g, *ln2_b;
    float* out; unsigned char* ws;
};
#ifdef HOST_TEST
static const unsigned char T5_BUCKET[3][129] = {
#else
__device__ const unsigned char T5_BUCKET[3][129] = {
#endif
{0,1,2,3,4,5,6,7,8,9,10,11,12,13,14,15,16,16,16,16,16,16,17,17,17,17,17,17,17,17,18,18,18,18,18,18,18,18,18,18,19,19,19,19,19,19,19,19,19,19,19,19,19,19,20,20,20,20,20,20,20,20,20,20,20,20,20,20,20,20,20,20,20,21,21,21,21,21,21,21,21,21,21,21,21,21,21,21,21,21,21,21,21,21,21,21,21,21,21,22,22,22,22,22,22,22,22,22,22,22,22,22,22,22,22,22,22,22,22,22,22,22,22,22,22,22,22,22,22},
{0,4,8,12,16,16,17,17,18,18,19,19,19,19,20,20,20,20,20,21,21,21,21,21,21,22,22,22,22,22,22,22,22,22,23,23,23,23,23,23,23,23,23,23,23,23,24,24,24,24,24,24,24,24,24,24,24,24,24,24,24,24,25,25,25,25,25,25,25,25,25,25,25,25,25,25,25,25,25,25,25,25,25,26,26,26,26,26,26,26,26,26,26,26,26,26,26,26,26,26,26,26,26,26,26,26,26,26,26,26,26,26,26,27,27,27,27,27,27,27,27,27,27,27,27,27,27,27,27},
{0,16,18,19,20,21,21,22,22,23,23,23,24,24,24,24,25,25,25,25,25,26,26,26,26,26,26,26,26,27,27,27,27,27,27,27,27,27,27,28,28,28,28,28,28,28,28,28,28,28,28,28,29,29,29,29,29,29,29,29,29,29,29,29,29,29,29,29,29,29,30,30,30,30,30,30,30,30,30,30,30,30,30,30,30,30,30,30,30,30,30,30,30,30,30,31,31,31,31,31,31,31,31,31,31,31,31,31,31,31,31,31,31,31,31,31,31,31,31,31,31,31,31,31,31,31,31,31,31}};
template <class Tp> HD Tp* wsp(const Ctx& c, size_t off) { return (Tp*)(c.ws + off); }

#ifdef HOST_TEST
static inline unsigned atomic_inc_u32(unsigned* p) { unsigned r;
#pragma omp atomic capture
    { r = *p; *p += 1; }
    return r; }
#else
__device__ __forceinline__ unsigned atomic_inc_u32(unsigned* p) { return atomicAdd(p, 1u); }
#endif

struct S0_xb { Ctx c; static constexpr long n = (long)T * D;
    HD void operator()(long i) const { wsp<bf16_t>(c, OFF_XB)[i] = f2bf(c.x[i]); } };
struct S0_memb { Ctx c; static constexpr long n = (long)NBATCH * MEM * D;
    HD void operator()(long i) const { wsp<bf16_t>(c, OFF_MEMB)[i] = f2bf(c.mem[i]); } };
struct S0_tr { const float* W; bf16_t* Wt; int K, N; long n;
    HD void operator()(long i) const { const int k = (int)(i % K); const long nn = i / K; Wt[i] = f2bf(W[(size_t)k * N + nn]); } };
struct S0_gu { Ctx c; static constexpr long n = (long)NE * 2 * DE * D;
    HD void operator()(long i) const { const int k = (int)(i % D); const long r = i / D; const int j = (int)(r % (2 * DE)), e = (int)(r / (2 * DE));
        const int u = j / (2 * HBK), w = j % (2 * HBK), hid = u * HBK + w % HBK, up = w / HBK;
        const float* src = up ? c.w_eu : c.w_eg; wsp<bf16_t>(c, OFF_WTGU)[i] = f2bf(src[((size_t)e * D + k) * DE + hid]); } };
struct S0_dn { Ctx c; static constexpr long n = (long)NE * D * DE;
    HD void operator()(long i) const { const int k = (int)(i % DE); const long r = i / DE; const int col = (int)(r % D), e = (int)(r / D);
        wsp<bf16_t>(c, OFF_WTDN)[i] = f2bf(c.w_ed[((size_t)e * DE + k) * D + col]); } };
struct S0_small { Ctx c; static constexpr long n = 12 * 129 + WB + 64;
    HD void operator()(long i) const { float* sm = wsp<float>(c, OFF_SMALL);
        if (i < 12 * 129) { const int gh = (int)(i / 129), u = (int)(i % 129), g = gh / 4; sm[SM_BIAS + i] = c.rel_bias[T5_BUCKET[g][u] * 12 + gh]; }
        else if (i < 12 * 129 + WB) { const int ch = (int)(i - 12 * 129); sm[SM_LB + ch] = sigmoidf_(c.lb_logits[ch] - c.lb_logits[WB + ch]); }
        else { const int j = (int)(i - 12 * 129 - WB); wsp<unsigned>(c, OFF_CTL)[j] = 0u; } } };

struct G_proj { Ctx c; int half; static constexpr int N = NP, NSEGS = 1, NBP = 1;
    HD int M() const { return TH; } HD int K(int) const { return D; }
    HD const bf16_t* arow(int, int row) const { return wsp<bf16_t>(c, OFF_XB) + ((size_t)half * TH + row) * D; }
    HD const bf16_t* brow(int, int, int col, int) const { return wsp<bf16_t>(c, WT_IN) + (size_t)col * D; }
    HD void between(int, int, int, float&, float&) const {}
    HD void store(int row, int col, float a, float) const { const int pr = col < COLS_A ? perm_row(row, col / 1536) : row; wsp<bf16_t>(c, OFF_P)[(size_t)pr * NP + col] = f2bf(a); } };
struct G_memkv { Ctx c; static constexpr int N = 1024, NSEGS = 1, NBP = 1;
    HD int M() const { return NBATCH * MEM; } HD int K(int) const { return D; }
    HD const bf16_t* arow(int, int row) const { return wsp<bf16_t>(c, OFF_MEMB) + (size_t)row * D; }
    HD const bf16_t* brow(int, int, int col, int) const { return wsp<bf16_t>(c, WT_KV) + (size_t)col * D; }
    HD void between(int, int, int, float&, float&) const {}
    HD void store(int row, int col, float a, float) const { wsp<bf16_t>(c, OFF_MEMKV)[(size_t)row * 1024 + col] = f2bf(a); } };
struct G_gates { Ctx c; static constexpr int N = 3 * D, NSEGS = 1, NBP = 1;
    HD int M() const { return T; } HD int K(int) const { return D; }
    HD const bf16_t* arow(int, int row) const { return wsp<bf16_t>(c, OFF_XB) + (size_t)row * D; }
    HD const bf16_t* brow(int, int, int col, int) const { return wsp<bf16_t>(c, WT_IN) + (size_t)(NP + col) * D; }
    HD void between(int, int, int, float&, float&) const {}
    HD void store(int row, int col, float a, float) const { wsp<bf16_t>(c, OFF_GATES)[(size_t)row * 3 * D + col] = f2bf(sigmoidf_(a)); } };
struct G_merge { Ctx c; static constexpr int N = D, NSEGS = 3, NBP = 1;
    HD int M() const { return T; } HD int K(int s) const { return s == 1 ? WB : 512; }
    HD const bf16_t* arow(int s, int row) const { return (const bf16_t*)c.out + (size_t)row * OW + (s == 0 ? 0 : (s == 1 ? WA : WA + WB)); }
    HD const bf16_t* brow(int s, int, int col, int) const { return s == 0 ? wsp<bf16_t>(c, WT_A) + (size_t)col * WA : (s == 1 ? wsp<bf16_t>(c, WT_B) + (size_t)col * WB : wsp<bf16_t>(c, WT_C) + (size_t)col * WC); }
    HD void between(int s, int row, int col, float& acc, float& carry) const { carry += bf2f(wsp<bf16_t>(c, OFF_GATES)[(size_t)row * 3 * D + s * D + col]) * acc; acc = 0.f; }
    HD void store(int row, int col, float, float carry) const { wsp<bf16_t>(c, OFF_MERGED)[(size_t)row * D + col] = f2bf(carry); } };
struct G_wout { Ctx c; static constexpr int N = D, NSEGS = 1, NBP = 1;
    HD int M() const { return T; } HD int K(int) const { return D; }
    HD const bf16_t* arow(int, int row) const { return wsp<bf16_t>(c, OFF_MERGED) + (size_t)row * D; }
    HD const bf16_t* brow(int, int, int col, int) const { return wsp<bf16_t>(c, WT_OUT) + (size_t)col * D; }
    HD void between(int, int, int, float&, float&) const {}
    HD void store(int row, int col, float a, float) const { wsp<float>(c, OFF_H1)[(size_t)row * D + col] = DN_ALPHA * c.x[(size_t)row * D + col] + a; } };
struct MoeRow { int e, pos, valid, entry; };
HD MoeRow moe_row(const Ctx& c, int row) {
    const int* blk = wsp<int>(c, OFF_SMALL) + SM_BLK; const unsigned* cnt = wsp<unsigned>(c, OFF_CTL) + CW_CNT;
    MoeRow r; const int rb = row >> 8; r.e = blk[64 + rb]; r.pos = ((rb - blk[r.e]) << 8) + (row & 255); r.valid = r.pos < (int)cnt[r.e];
    r.entry = wsp<int>(c, OFF_LIST)[(size_t)r.e * T + (r.valid ? r.pos : 0)]; return r; }
HD int moe_rows_total(const Ctx& c) { return (wsp<int>(c, OFF_SMALL) + SM_BLK)[32] << 8; }
struct G_moe1 { Ctx c; static constexpr int N = DE, NSEGS = 1, NBP = 2;
    HD int M() const { return moe_rows_total(c); } HD int K(int) const { return D; }
    HD const bf16_t* arow(int, int row) const { const MoeRow r = moe_row(c, row); return wsp<bf16_t>(c, OFF_X1B) + (size_t)(r.entry >> 1) * D; }
    HD const bf16_t* brow(int, int row0, int col, int which) const { const int e = (wsp<int>(c, OFF_SMALL) + SM_BLK)[64 + (row0 >> 8)];
        return wsp<bf16_t>(c, OFF_WTGU) + ((size_t)e * 2 * DE + (col / HBK) * 2 * HBK + which * HBK + col % HBK) * D; }
    HD void between(int, int, int, float&, float&) const {}
    HD void store(int row, int col, float g, float u) const { wsp<bf16_t>(c, OFF_HBUF)[(size_t)row * DE + col] = f2bf(siluf_(g) * u); } };
struct G_moe2 { Ctx c; static constexpr int N = D, NSEGS = 1, NBP = 1;
    HD int M() const { return moe_rows_total(c); } HD int K(int) const { return DE; }
    HD const bf16_t* arow(int, int row) const { return wsp<bf16_t>(c, OFF_HBUF) + (size_t)row * DE; }
    HD const bf16_t* brow(int, int row0, int col, int) const { const int e = (wsp<int>(c, OFF_SMALL) + SM_BLK)[64 + (row0 >> 8)]; return wsp<bf16_t>(c, OFF_WTDN) + ((size_t)e * D + col) * DE; }
    HD void between(int, int, int, float&, float&) const {}
    HD void store(int row, int col, float a, float) const { const MoeRow r = moe_row(c, row); if (!r.valid) return;
        wsp<bf16_t>(c, (r.entry & 1) ? OFF_Y1 : OFF_Y0)[(size_t)(r.entry >> 1) * D + col] = f2bf(a); } };

struct u32x4_t { unsigned x, y, z, w; };
HD float bflo(unsigned u) { union { unsigned u; float f; } c; c.u = u << 16; return c.f; }
HD float bfhi(unsigned u) { union { unsigned u; float f; } c; c.u = u & 0xffff0000u; return c.f; }
HD float dot128(const bf16_t* a, const bf16_t* b) { float s = 0.f; const u32x4_t* pa = (const u32x4_t*)a; const u32x4_t* pb = (const u32x4_t*)b;
#ifndef HOST_TEST
#pragma unroll 4
#endif
    for (int d = 0; d < 16; ++d) { const u32x4_t ua = pa[d], ub = pb[d];
        s += bflo(ua.x) * bflo(ub.x) + bfhi(ua.x) * bfhi(ub.x) + bflo(ua.y) * bflo(ub.y) + bfhi(ua.y) * bfhi(ub.y) + bflo(ua.z) * bflo(ub.z) + bfhi(ua.z) * bfhi(ub.z) + bflo(ua.w) * bflo(ub.w) + bfhi(ua.w) * bfhi(ub.w); }
    return s; }
struct E_attnA { Ctx c; int half; static constexpr long n = (long)TH * 3 * 4 * 8;
    HD void operator()(long idx) const {
        const int p = (int)(idx & 7), h = (int)((idx >> 3) & 3); const long rest = idx >> 5; const int g = (int)(rest % 3), tl = (int)(rest / 3);
        const int r = dil_of(g), bl = tl / S, s = tl % S, cc = s % r, nq = s / r, L = S / r, base = bl * S + cc * L;
        const bf16_t* P = wsp<bf16_t>(c, OFF_P); const float* bias = wsp<float>(c, OFF_SMALL) + SM_BIAS + (g * 4 + h) * 129;
        const bf16_t* q = P + (size_t)(base + nq) * NP + g * 1536 + h * 128;
        float m = -INFINITY, l = 0.f, o[16];
#ifndef HOST_TEST
#pragma unroll
#endif
        for (int j = 0; j < 16; ++j) o[j] = 0.f;
        const int umax = nq < 128 ? nq : 128;
        for (int u = 0; u <= umax; ++u) {
            const bf16_t* kr = P + (size_t)(base + nq - u) * NP + g * 1536 + 512 + h * 128; const bf16_t* vr = kr + 512 + p * 16;
            const float sc = dot128(q, kr) * QK_SCALE + bias[u];
            const float mn = fmaxf(m, sc), a = expf(m - mn), pw = expf(sc - mn); l = l * a + pw; m = mn;
#ifndef HOST_TEST
#pragma unroll
#endif
            for (int j = 0; j < 16; ++j) o[j] = o[j] * a + pw * bf2f(vr[j]);
        }
        bf16_t* op = wsp<bf16_t>(c, OFF_PART) + ((size_t)g * TH + tl) * WA + h * 128 + p * 16; const float il = 1.f / l;
#ifndef HOST_TEST
#pragma unroll
#endif
        for (int j = 0; j < 16; ++j) op[j] = f2bf(o[j] * il);
        if (p == 0) wsp<float>(c, OFF_LSE)[((size_t)g * TH + tl) * 4 + h] = m + logf(l);
    } };
struct E_combA { Ctx c; int half; static constexpr long n = (long)TH * WA;
    HD void operator()(long idx) const { const int col = (int)(idx % WA), tl = (int)(idx / WA), h = col >> 7;
        const float* lse = wsp<float>(c, OFF_LSE); const bf16_t* part = wsp<bf16_t>(c, OFF_PART);
        const float l0 = lse[((size_t)0 * TH + tl) * 4 + h], l1 = lse[((size_t)1 * TH + tl) * 4 + h], l2 = lse[((size_t)2 * TH + tl) * 4 + h];
        const float mx = fmaxf(l0, fmaxf(l1, l2)), e0 = expf(l0 - mx), e1 = expf(l1 - mx), e2 = expf(l2 - mx), inv = 1.f / (e0 + e1 + e2);
        const float v = (e0 * bf2f(part[((size_t)0 * TH + tl) * WA + col]) + e1 * bf2f(part[((size_t)1 * TH + tl) * WA + col]) + e2 * bf2f(part[((size_t)2 * TH + tl) * WA + col])) * inv;
        ((bf16_t*)c.out)[((size_t)half * TH + tl) * OW + col] = f2bf(v); } };
struct E_attnC { Ctx c; int half; static constexpr long n = (long)TH * 4 * 8;
    HD void operator()(long idx) const { const int p = (int)(idx & 7), h = (int)((idx >> 3) & 3), tl = (int)(idx >> 5), b = half * BH + tl / S;
        const bf16_t* q = wsp<bf16_t>(c, OFF_P) + (size_t)tl * NP + COLS_A + COLS_B + h * 128; const bf16_t* kv = wsp<bf16_t>(c, OFF_MEMKV) + (size_t)b * MEM * 1024;
        float m = -INFINITY, l = 0.f, o[16];
#ifndef HOST_TEST
#pragma unroll
#endif
        for (int j = 0; j < 16; ++j) o[j] = 0.f;
        for (int k = 0; k < MEM; ++k) { const bf16_t* kr = kv + (size_t)k * 1024 + h * 128; const bf16_t* vr = kr + 512 + p * 16;
            const float sc = dot128(q, kr) * QK_SCALE; const float mn = fmaxf(m, sc), a = expf(m - mn), pw = expf(sc - mn); l = l * a + pw; m = mn;
#ifndef HOST_TEST
#pragma unroll
#endif
            for (int j = 0; j < 16; ++j) o[j] = o[j] * a + pw * bf2f(vr[j]); }
        bf16_t* op = (bf16_t*)c.out + ((size_t)half * TH + tl) * OW + WA + WB + h * 128 + p * 16; const float il = 1.f / l;
#ifndef HOST_TEST
#pragma unroll
#endif
        for (int j = 0; j < 16; ++j) op[j] = f2bf(o[j] * il); } };

HD float hg_f(const Ctx& c, const bf16_t* prow, int ch) { const float lb = wsp<float>(c, OFF_SMALL)[SM_LB + ch]; return lb + (1.f - lb) * sigmoidf_(bf2f(prow[COLS_A + WB + ch])); }
struct E_hg1 { Ctx c; int half; static constexpr long n = (long)BH * HB * NSEG * 128 * 128;
    HD void operator()(long idx) const { const int v = (int)(idx & 127), k = (int)((idx >> 7) & 127); const long r = idx >> 14; const int seg = (int)(r % NSEG), bhl = (int)(r / NSEG), h = bhl % HB, bl = bhl / HB;
        const bf16_t* P = wsp<bf16_t>(c, OFF_P); const int ch = h * 128 + k; float st = 0.f, dsum = 0.f;
        for (int s = 0; s < 256; ++s) { const bf16_t* pr = P + (size_t)(bl * S + seg * 256 + s) * NP; const float f = hg_f(c, pr, ch); st = f * st + (1.f - f) * bf2f(pr[COLS_A + 2 * WB + h * 128 + v]); dsum += logf(f); }
        wsp<float>(c, OFF_HG)[idx] = st; if (v == 0) wsp<float>(c, OFF_DSEG)[((size_t)bhl * NSEG + seg) * 128 + k] = dsum; } };
struct E_hg2 { Ctx c; static constexpr long n = (long)BH * HB * 128 * 128;
    HD void operator()(long idx) const { const int v = (int)(idx & 127), k = (int)((idx >> 7) & 127), bhl = (int)(idx >> 14); float run = 0.f;
        for (int seg = 0; seg < NSEG; ++seg) { float* p = wsp<float>(c, OFF_HG) + (((size_t)bhl * NSEG + seg) * 128 + k) * 128 + v; const float tmp = *p; *p = run;
            run = expf(wsp<float>(c, OFF_DSEG)[((size_t)bhl * NSEG + seg) * 128 + k]) * run + tmp; } } };
struct E_hg3 { Ctx c; int half; static constexpr long n = (long)BH * HB * NSEG * 128;
    HD void operator()(long idx) const { const int v = (int)(idx & 127); const long r = idx >> 7; const int seg = (int)(r % NSEG), bhl = (int)(r / NSEG), h = bhl % HB, bl = bhl / HB;
        const bf16_t* P = wsp<bf16_t>(c, OFF_P); float st[128];
#ifndef HOST_TEST
#pragma unroll
#endif
        for (int k = 0; k < 128; ++k) st[k] = wsp<float>(c, OFF_HG)[(((size_t)bhl * NSEG + seg) * 128 + k) * 128 + v];
        for (int s = 0; s < 256; ++s) { const int tl = bl * S + seg * 256 + s; const bf16_t* pr = P + (size_t)tl * NP; const float iv = bf2f(pr[COLS_A + 2 * WB + h * 128 + v]); float o = 0.f;
#ifndef HOST_TEST
#pragma unroll
#endif
            for (int k = 0; k < 128; ++k) { const float f = hg_f(c, pr, h * 128 + k); st[k] = f * st[k] + (1.f - f) * iv; o += siluf_(bf2f(pr[COLS_A + h * 128 + k])) * st[k]; }
            ((bf16_t*)c.out)[((size_t)half * TH + tl) * OW + WA + h * 128 + v] = f2bf(o); } } };
struct E_hgnorm { Ctx c; int half; static constexpr long n = (long)TH * HB;
    HD void operator()(long idx) const { const int h = (int)(idx % HB), tl = (int)(idx / HB); bf16_t* o = (bf16_t*)c.out + ((size_t)half * TH + tl) * OW + WA + h * 128;
        const bf16_t* pr = wsp<bf16_t>(c, OFF_P) + (size_t)tl * NP + COLS_A + 3 * WB + h * 128; float ss = 0.f;
        for (int v = 0; v < 128; ++v) { const float x = bf2f(o[v]); ss += x * x; }
        const float rs = 1.f / sqrtf(ss * (1.f / 128.f) + RMS_EPS);
        for (int v = 0; v < 128; ++v) o[v] = f2bf(bf2f(o[v]) * rs * c.norm_g[h * 128 + v] * siluf_(bf2f(pr[v]))); } };

struct E_ln1 { Ctx c; static constexpr long n = T;
    HD void operator()(long row) const { float* h1 = wsp<float>(c, OFF_H1) + (size_t)row * D; bf16_t* xb1 = wsp<bf16_t>(c, OFF_X1B) + (size_t)row * D;
        float mu = 0.f; for (int i = 0; i < D; ++i) mu += h1[i]; mu *= (1.f / D);
        float var = 0.f; for (int i = 0; i < D; ++i) { const float d = h1[i] - mu; var += d * d; } var *= (1.f / D); const float rs = 1.f / sqrtf(var + LN_EPS);
        float gl0 = c.b_rg[0], gl1 = c.b_rg[1], gl2 = c.b_rg[2], gl3 = c.b_rg[3];
        for (int i = 0; i < D; ++i) { const float v = (h1[i] - mu) * rs * c.ln1_g[i] + c.ln1_b[i]; h1[i] = v; xb1[i] = f2bf(v);
            gl0 += v * c.w_rg[i * 4 + 0]; gl1 += v * c.w_rg[i * 4 + 1]; gl2 += v * c.w_rg[i * 4 + 2]; gl3 += v * c.w_rg[i * 4 + 3]; }
        int gs = 0; float gm = gl0; if (gl1 > gm) { gm = gl1; gs = 1; } if (gl2 > gm) { gm = gl2; gs = 2; } if (gl3 > gm) { gm = gl3; gs = 3; }
        const float gp = 1.f / (expf(gl0 - gm) + expf(gl1 - gm) + expf(gl2 - gm) + expf(gl3 - gm));
        float v0 = -INFINITY, v1 = -INFINITY; int i0 = 0, i1 = 0;
        for (int j = 0; j < 8; ++j) { float el = c.b_re[gs * 8 + j]; for (int i = 0; i < D; ++i) el += h1[i] * c.w_re[i * 32 + gs * 8 + j];
            if (el > v0) { v1 = v0; i1 = i0; v0 = el; i0 = j; } else if (el > v1) { v1 = el; i1 = j; } }
        const float e1 = expf(v1 - v0), w0 = gp / (1.f + e1), w1 = gp * e1 / (1.f + e1);
        unsigned* cnt = wsp<unsigned>(c, OFF_CTL) + CW_CNT; int* list = wsp<int>(c, OFF_LIST); float* rw = wsp<float>(c, OFF_RW);
        const int ea = gs * 8 + i0, eb = gs * 8 + i1;
        list[(size_t)ea * T + atomic_inc_u32(cnt + ea)] = (int)row * 2 + 0; list[(size_t)eb * T + atomic_inc_u32(cnt + eb)] = (int)row * 2 + 1;
        rw[row * 2 + 0] = w0; rw[row * 2 + 1] = w1; } };
struct E_blk { Ctx c; static constexpr long n = 1;
    HD void operator()(long) const { int* blk = wsp<int>(c, OFF_SMALL) + SM_BLK; const unsigned* cnt = wsp<unsigned>(c, OFF_CTL) + CW_CNT; int acc = 0;
        for (int e = 0; e < NE; ++e) { blk[e] = acc; const int nb = ((int)cnt[e] + 255) >> 8; for (int j = 0; j < nb; ++j) blk[64 + acc + j] = e; acc += nb; } blk[32] = acc; } };
struct E_ln2 { Ctx c; static constexpr long n = T;
    HD void operator()(long row) const { const float* x1 = wsp<float>(c, OFF_H1) + (size_t)row * D; const bf16_t* y0 = wsp<bf16_t>(c, OFF_Y0) + (size_t)row * D; const bf16_t* y1 = wsp<bf16_t>(c, OFF_Y1) + (size_t)row * D;
        const float w0 = wsp<float>(c, OFF_RW)[row * 2], w1 = wsp<float>(c, OFF_RW)[row * 2 + 1]; float* o = c.out + (size_t)row * D;
        float mu = 0.f; for (int i = 0; i < D; ++i) { const float v = DN_ALPHA * x1[i] + w0 * bf2f(y0[i]) + w1 * bf2f(y1[i]); mu += v; } mu *= (1.f / D);
        float var = 0.f; for (int i = 0; i < D; ++i) { const float v = DN_ALPHA * x1[i] + w0 * bf2f(y0[i]) + w1 * bf2f(y1[i]) - mu; var += v * v; } var *= (1.f / D); const float rs = 1.f / sqrtf(var + LN_EPS);
        for (int i = 0; i < D; ++i) { const float v = DN_ALPHA * x1[i] + w0 * bf2f(y0[i]) + w1 * bf2f(y1[i]); o[i] = (v - mu) * rs * c.ln2_g[i] + c.ln2_b[i]; } } };
typedef short bf16x8 __attribute__((ext_vector_type(8)));
typedef float f32x4 __attribute__((ext_vector_type(4)));

template <class F> __global__ void __launch_bounds__(256) k_elems(F f, long n) {
    for (long i = (long)blockIdx.x * 256 + threadIdx.x; i < n; i += (long)gridDim.x * 256) f(i);
}
template <class F> __global__ void __launch_bounds__(64) k_elems64(F f, long n) {
    for (long i = (long)blockIdx.x * 64 + threadIdx.x; i < n; i += (long)gridDim.x * 64) f(i);
}
template <class G> __global__ void __launch_bounds__(256) k_sgemm(G g) {
    const int M = g.M(); const int lane = threadIdx.x & 63, wid = threadIdx.x >> 6; constexpr int ntn = G::N / 64;
    const long ntiles = (long)(M / 64) * ntn;
    for (long tile = blockIdx.x; tile < ntiles; tile += gridDim.x) {
        const int tm = (int)(tile / ntn), tn = (int)(tile % ntn), r0 = tm * 64 + wid * 16, c0 = tn * 64;
        f32x4 acc[G::NBP][4], carry[4];
#pragma unroll
        for (int j = 0; j < 4; ++j) { carry[j] = (f32x4){0.f, 0.f, 0.f, 0.f};
#pragma unroll
            for (int w = 0; w < G::NBP; ++w) acc[w][j] = (f32x4){0.f, 0.f, 0.f, 0.f}; }
#pragma unroll
        for (int seg = 0; seg < G::NSEGS; ++seg) {
            const bf16_t* ar = g.arow(seg, r0 + (lane & 15)) + 8 * (lane >> 4); const bf16_t* br[G::NBP][4];
#pragma unroll
            for (int w = 0; w < G::NBP; ++w)
#pragma unroll
                for (int j = 0; j < 4; ++j) br[w][j] = g.brow(seg, r0, c0 + 16 * j + (lane & 15), w) + 8 * (lane >> 4);
            const int K = g.K(seg);
            for (int k0 = 0; k0 < K; k0 += 32) { const bf16x8 a = *(const bf16x8*)(ar + k0);
#pragma unroll
                for (int w = 0; w < G::NBP; ++w)
#pragma unroll
                    for (int j = 0; j < 4; ++j) { const bf16x8 b = *(const bf16x8*)(br[w][j] + k0); acc[w][j] = __builtin_amdgcn_mfma_f32_16x16x32_bf16(a, b, acc[w][j], 0, 0, 0); } }
#pragma unroll
            for (int j = 0; j < 4; ++j)
#pragma unroll
                for (int i = 0; i < 4; ++i) { float a = acc[0][j][i], cr = carry[j][i]; g.between(seg, r0 + (lane >> 4) * 4 + i, c0 + 16 * j + (lane & 15), a, cr); acc[0][j][i] = a; carry[j][i] = cr; }
        }
#pragma unroll
        for (int j = 0; j < 4; ++j)
#pragma unroll
            for (int i = 0; i < 4; ++i) g.store(r0 + (lane >> 4) * 4 + i, c0 + 16 * j + (lane & 15), acc[0][j][i], G::NBP == 2 ? acc[G::NBP - 1][j][i] : carry[j][i]);
    }
}
template <class F> static void launch_elems(const F& f, long n, hipStream_t st) { long nb = (n + 255) / 256; if (nb > 32768) nb = 32768; if (nb < 1) nb = 1; hipLaunchKernelGGL(k_elems<F>, dim3((unsigned)nb), dim3(256), 0, st, f, n); }
template <class F> static void launch_elems64(const F& f, long n, hipStream_t st) { long nb = (n + 63) / 64; if (nb > 65536) nb = 65536; hipLaunchKernelGGL(k_elems64<F>, dim3((unsigned)nb), dim3(64), 0, st, f, n); }
template <class G> static void launch_sgemm(const G& g, hipStream_t st) { hipLaunchKernelGGL(k_sgemm<G>, dim3(4096), dim3(256), 0, st, g); }

static Ctx make_ctx(void* const* d_in, void* d_out, void* d_ws) {
    Ctx c; memset(&c, 0, sizeof(c)); const float** ip = (const float**)&c; for (int i = 0; i < 22; ++i) ip[i] = (const float*)d_in[i];
    c.out = (float*)d_out; c.ws = (unsigned char*)d_ws; return c;
}
static void v1_stage0(Ctx c, hipStream_t st) {
    launch_elems(S0_xb{c}, S0_xb::n, st); launch_elems(S0_memb{c}, S0_memb::n, st); launch_elems(S0_small{c}, S0_small::n, st);
    launch_elems(S0_tr{c.w_in, wsp<bf16_t>(c, WT_IN), D, N_IN, (long)D * N_IN}, (long)D * N_IN, st);
    launch_elems(S0_tr{c.w_kv, wsp<bf16_t>(c, WT_KV), D, 1024, (long)D * 1024}, (long)D * 1024, st);
    launch_elems(S0_tr{c.w_a, wsp<bf16_t>(c, WT_A), WA, D, (long)D * WA}, (long)D * WA, st);
    launch_elems(S0_tr{c.w_b, wsp<bf16_t>(c, WT_B), WB, D, (long)D * WB}, (long)D * WB, st);
    launch_elems(S0_tr{c.w_c, wsp<bf16_t>(c, WT_C), WC, D, (long)D * WC}, (long)D * WC, st);
    launch_elems(S0_tr{c.w_out, wsp<bf16_t>(c, WT_OUT), D, D, (long)D * D}, (long)D * D, st);
}
static void v1_proj(Ctx c, int half, hipStream_t st) { if (half == 0) launch_sgemm(G_memkv{c}, st); launch_sgemm(G_proj{c, half}, st); }
static void v1_mixers(Ctx c, int half, hipStream_t st) {
    launch_elems(E_hg1{c, half}, E_hg1::n, st); launch_elems(E_hg2{c}, E_hg2::n, st);
    launch_elems(E_attnA{c, half}, E_attnA::n, st); launch_elems(E_attnC{c, half}, E_attnC::n, st);
    launch_elems64(E_hg3{c, half}, E_hg3::n, st); launch_elems(E_hgnorm{c, half}, E_hgnorm::n, st); launch_elems(E_combA{c, half}, E_combA::n, st);
}
static void v1_expw(Ctx c, hipStream_t st) { launch_elems(S0_gu{c}, S0_gu::n, st); launch_elems(S0_dn{c}, S0_dn::n, st); }
static void v1_gates(Ctx c, hipStream_t st) { launch_sgemm(G_gates{c}, st); }
static void v1_merge(Ctx c, hipStream_t st) { launch_sgemm(G_merge{c}, st); }
static void v1_wout(Ctx c, hipStream_t st) { launch_sgemm(G_wout{c}, st); }
static void v1_ln1(Ctx c, hipStream_t st) { launch_elems(E_ln1{c}, E_ln1::n, st); launch_elems(E_blk{c}, 1, st); }
static void v1_moe1(Ctx c, hipStream_t st) { launch_sgemm(G_moe1{c}, st); }
static void v1_moe2(Ctx c, hipStream_t st) { launch_sgemm(G_moe2{c}, st); }
static void v1_ln2(Ctx c, hipStream_t st) { launch_elems(E_ln2{c}, E_ln2::n, st); }
#include <hip/hip_cooperative_groups.h>
namespace cg = cooperative_groups;
constexpr int NTHR = 512, LDS_BYTES = 147456;

template <class F> __device__ __forceinline__ void dev_elems(const F& f, long n) {
    for (long i = (long)blockIdx.x * NTHR + threadIdx.x; i < n; i += (long)gridDim.x * NTHR) f(i);
}
template <class G> __device__ __forceinline__ void dev_sgemm(const G& g) {
    const int M = g.M(); const int lane = threadIdx.x & 63, wid = threadIdx.x >> 6; constexpr int ntn = G::N / 64;
    const long ntiles = (long)(M / 16) * ntn;
    for (long tile = (long)blockIdx.x * 8 + wid; tile < ntiles; tile += (long)gridDim.x * 8) {
        const int tm = (int)(tile / ntn), tn = (int)(tile % ntn), r0 = tm * 16, c0 = tn * 64;
        f32x4 acc[G::NBP][4], carry[4];
#pragma unroll
        for (int j = 0; j < 4; ++j) { carry[j] = (f32x4){0.f, 0.f, 0.f, 0.f};
#pragma unroll
            for (int w = 0; w < G::NBP; ++w) acc[w][j] = (f32x4){0.f, 0.f, 0.f, 0.f}; }
#pragma unroll
        for (int seg = 0; seg < G::NSEGS; ++seg) {
            const bf16_t* ar = g.arow(seg, r0 + (lane & 15)) + 8 * (lane >> 4); const bf16_t* br[G::NBP][4];
#pragma unroll
            for (int w = 0; w < G::NBP; ++w)
#pragma unroll
                for (int j = 0; j < 4; ++j) br[w][j] = g.brow(seg, r0, c0 + 16 * j + (lane & 15), w) + 8 * (lane >> 4);
            const int K = g.K(seg);
            for (int k0 = 0; k0 < K; k0 += 32) { const bf16x8 a = *(const bf16x8*)(ar + k0);
#pragma unroll
                for (int w = 0; w < G::NBP; ++w)
#pragma unroll
                    for (int j = 0; j < 4; ++j) { const bf16x8 b = *(const bf16x8*)(br[w][j] + k0); acc[w][j] = __builtin_amdgcn_mfma_f32_16x16x32_bf16(a, b, acc[w][j], 0, 0, 0); } }
#pragma unroll
            for (int j = 0; j < 4; ++j)
#pragma unroll
                for (int i = 0; i < 4; ++i) { float a = acc[0][j][i], cr = carry[j][i]; g.between(seg, r0 + (lane >> 4) * 4 + i, c0 + 16 * j + (lane & 15), a, cr); acc[0][j][i] = a; carry[j][i] = cr; }
        }
#pragma unroll
        for (int j = 0; j < 4; ++j)
#pragma unroll
            for (int i = 0; i < 4; ++i) g.store(r0 + (lane >> 4) * 4 + i, c0 + 16 * j + (lane & 15), acc[0][j][i], G::NBP == 2 ? acc[G::NBP - 1][j][i] : carry[j][i]);
    }
}

struct E_hg3q { Ctx c; int half; static constexpr long n = (long)BH * HB * NSEG * 128 * 4;
    __device__ __forceinline__ void operator()(long idx) const { const int kq = (int)(idx & 3), v = (int)((idx >> 2) & 127); const long r = idx >> 9; const int seg = (int)(r % NSEG), bhl = (int)(r / NSEG), h = bhl % HB, bl = bhl / HB;
        const bf16_t* P = wsp<bf16_t>(c, OFF_P); float st[32];
#pragma unroll
        for (int k = 0; k < 32; ++k) st[k] = wsp<float>(c, OFF_HG)[(((size_t)bhl * NSEG + seg) * 128 + kq * 32 + k) * 128 + v];
        for (int s = 0; s < 256; ++s) { const int tl = bl * S + seg * 256 + s; const bf16_t* pr = P + (size_t)tl * NP; const float iv = bf2f(pr[COLS_A + 2 * WB + h * 128 + v]); float o = 0.f;
#pragma unroll
            for (int k = 0; k < 32; ++k) { const int kk = kq * 32 + k; const float f = hg_f(c, pr, h * 128 + kk); st[k] = f * st[k] + (1.f - f) * iv; o += siluf_(bf2f(pr[COLS_A + h * 128 + kk])) * st[k]; }
            o += __shfl_xor(o, 1); o += __shfl_xor(o, 2);
            if (kq == 0) ((bf16_t*)c.out)[((size_t)half * TH + tl) * OW + WA + h * 128 + v] = f2bf(o); } } };

__global__ void __launch_bounds__(NTHR) mega(Ctx c) {
    extern __shared__ __attribute__((aligned(16))) unsigned char lds[];
    cg::grid_group grid = cg::this_grid();
    dev_elems(S0_xb{c}, S0_xb::n); dev_elems(S0_memb{c}, S0_memb::n); dev_elems(S0_small{c}, S0_small::n);
    dev_elems(S0_tr{c.w_in, wsp<bf16_t>(c, WT_IN), D, N_IN, (long)D * N_IN}, (long)D * N_IN);
    dev_elems(S0_tr{c.w_kv, wsp<bf16_t>(c, WT_KV), D, 1024, (long)D * 1024}, (long)D * 1024);
    dev_elems(S0_tr{c.w_a, wsp<bf16_t>(c, WT_A), WA, D, (long)D * WA}, (long)D * WA);
    dev_elems(S0_tr{c.w_b, wsp<bf16_t>(c, WT_B), WB, D, (long)D * WB}, (long)D * WB);
    dev_elems(S0_tr{c.w_c, wsp<bf16_t>(c, WT_C), WC, D, (long)D * WC}, (long)D * WC);
    dev_elems(S0_tr{c.w_out, wsp<bf16_t>(c, WT_OUT), D, D, (long)D * D}, (long)D * D);
    grid.sync();
    for (int half = 0; half < NHALF; ++half) {
        if (half == 0) dev_sgemm(G_memkv{c});
        dev_sgemm(G_proj{c, half});
        grid.sync();
        dev_elems(E_hg1{c, half}, E_hg1::n); dev_elems(E_attnA{c, half}, E_attnA::n); dev_elems(E_attnC{c, half}, E_attnC::n);
        grid.sync();
        dev_elems(E_hg2{c}, E_hg2::n); dev_elems(E_combA{c, half}, E_combA::n);
        grid.sync();
        dev_elems(E_hg3q{c, half}, E_hg3q::n);
        grid.sync();
        dev_elems(E_hgnorm{c, half}, E_hgnorm::n);
        grid.sync();
    }
    dev_elems(S0_gu{c}, S0_gu::n); dev_elems(S0_dn{c}, S0_dn::n); dev_sgemm(G_gates{c});
    grid.sync();
    dev_sgemm(G_merge{c});
    grid.sync();
    dev_sgemm(G_wout{c});
    grid.sync();
    dev_elems(E_ln1{c}, E_ln1::n);
    grid.sync();
    dev_elems(E_blk{c}, 1);
    grid.sync();
    dev_sgemm(G_moe1{c});
    grid.sync();
    dev_sgemm(G_moe2{c});
    grid.sync();
    dev_elems(E_ln2{c}, E_ln2::n);
}

extern "C" void kernel_launch(void* const* d_in, const int* in_sizes, int n_in, void* d_out, int out_size, void* d_ws, size_t ws_size, hipStream_t stream) {
    if (n_in != 22 || in_sizes[0] != T * D || out_size != T * D || ws_size < WS_END) { fprintf(stderr, "kernel_launch: unexpected shapes / workspace (%zu < %zu)\n", ws_size, (size_t)WS_END); return; }
    static int grid_blocks = 0;
    if (!grid_blocks) {
        int dev = 0, cus = 0, per_cu = 0;
        hipGetDevice(&dev); hipDeviceGetAttribute(&cus, hipDeviceAttributeMultiprocessorCount, dev);
        hipFuncSetAttribute((const void*)mega, hipFuncAttributeMaxDynamicSharedMemorySize, LDS_BYTES);
        hipOccupancyMaxActiveBlocksPerMultiprocessor(&per_cu, (const void*)mega, NTHR, LDS_BYTES);
        if (per_cu < 1) { fprintf(stderr, "kernel_launch: occupancy query says %d blocks/CU\n", per_cu); per_cu = 1; }
        if (per_cu > 1) per_cu = 1;
        grid_blocks = cus * per_cu;
    }
    Ctx c = make_ctx(d_in, d_out, d_ws);
    void* args[] = {&c};
    hipError_t e = hipLaunchCooperativeKernel((const void*)mega, dim3(grid_blocks), dim3(NTHR), args, LDS_BYTES, stream);
    if (e != hipSuccess) fprintf(stderr, "cooperative launch failed: %s (grid %d)\n", hipGetErrorString(e), grid_blocks);
}
```

```cpp
#ifdef HOST_TEST
#include <cmath>
#include <cstdint>
#include <cstdio>
#include <cstring>
#define HD
#define GLOBAL
#else
#include <hip/hip_runtime.h>
#include <cstdint>
#include <cstdio>
#include <cstring>
#include <cmath>
#define HD __host__ __device__ __forceinline__
#endif

#ifndef CFG_D
#define CFG_D 1024
#define CFG_B 4
#define CFG_S 8192
#endif
typedef unsigned short bf16_t;
constexpr int D = CFG_D, NBATCH = CFG_B, S = CFG_S, T = NBATCH * S;
constexpr int NHALF = 2, TH = T / NHALF, BH = NBATCH / NHALF;
constexpr int WA = 512, HB = D / 128, WB = D, WC = 512;
constexpr int COLS_A = 4608, COLS_B = 4 * WB, COLS_C = 512, COLS_G = 3 * D;
constexpr int NP = COLS_A + COLS_B + COLS_C, N_IN = NP + COLS_G;
constexpr int OW = WA + WB + WC;
constexpr int DE = D / 4, NE = 32, HBK = DE < 128 ? DE : 128;
constexpr int MEM = 256, NSEG = S / 256;
constexpr int MAXROWS = 2 * T + NE * 256;
constexpr float DN_ALPHA = 1.189207115002721f;
constexpr float LN_EPS = 1e-5f, RMS_EPS = 1e-6f;
constexpr float QK_SCALE = 0.08838834764831845f;

constexpr size_t MiB = 1u << 20;
constexpr size_t al(size_t x) { return (x + 4095) & ~(size_t)4095; }
constexpr size_t OFF_CTL = 0;
constexpr size_t OFF_SMALL = 1 * MiB;
constexpr size_t OFF_WT = 2 * MiB;
constexpr size_t WT_IN = OFF_WT, WT_KV = WT_IN + al((size_t)N_IN * D * 2), WT_A = WT_KV + al((size_t)1024 * D * 2),
                 WT_B = WT_A + al((size_t)D * WA * 2), WT_C = WT_B + al((size_t)D * WB * 2), WT_OUT = WT_C + al((size_t)D * WC * 2),
                 OFF_MEMB = WT_OUT + al((size_t)D * D * 2), OFF_MEMKV = OFF_MEMB + al((size_t)NBATCH * MEM * D * 2),
                 OFF_LIST = OFF_MEMKV + al((size_t)NBATCH * MEM * 1024 * 2), OFF_RW = OFF_LIST + al((size_t)NE * T * 4),
                 OFF_XB = OFF_RW + al((size_t)T * 2 * 4), OFF_P = OFF_XB + al((size_t)T * D * 2),
                 OFF_PART = OFF_P + al((size_t)TH * NP * 2), OFF_LSE = OFF_PART + al((size_t)3 * TH * WA * 2),
                 OFF_HG = OFF_LSE + al((size_t)3 * TH * 4 * 4), OFF_DSEG = OFF_HG + al((size_t)BH * HB * NSEG * 128 * 128 * 4),
                 WS_END = OFF_DSEG + al((size_t)BH * HB * NSEG * 128 * 4);
constexpr size_t OFF_GATES = OFF_P, OFF_H1 = OFF_P, OFF_X1B = OFF_P + al((size_t)T * D * 4),
                 OFF_WTGU = OFF_P + al((size_t)T * 3 * D * 2), OFF_WTDN = OFF_WTGU + al((size_t)NE * 2 * DE * D * 2),
                 OFF_HBUF = OFF_WTDN + al((size_t)NE * D * DE * 2), OFF_PEND = OFF_HBUF + al((size_t)MAXROWS * DE * 2);
constexpr size_t OFF_MERGED = OFF_XB, OFF_Y0 = OFF_XB, OFF_Y1 = OFF_PART;
static_assert(OFF_X1B + (size_t)T * D * 2 <= OFF_WTGU, "x1b inside dead gates region");
static_assert(OFF_PEND <= OFF_PART, "P-region overlays fit");
static_assert(OFF_Y1 + (size_t)T * D * 2 <= WS_END, "y1 fits in part+hg region");
constexpr int CW_CNT = 0;
constexpr int SM_BIAS = 0, SM_LB = 2048, SM_BLK = 2048 + 4096;

HD float bf2f(bf16_t v) { union { unsigned u; float f; } c; c.u = (unsigned)v << 16; return c.f; }
HD bf16_t f2bf(float f) { union { unsigned u; float f; } c; c.f = f; unsigned u = c.u; return (bf16_t)((u + 0x7fffu + ((u >> 16) & 1u)) >> 16); }
HD float sigmoidf_(float x) { return 1.0f / (1.0f + expf(-x)); }
HD float siluf_(float x) { return x / (1.0f + expf(-x)); }
HD int dil_of(int g) { return g == 0 ? 1 : (g == 1 ? 4 : 16); }
HD int perm_row(int tl, int g) { const int r = dil_of(g), bl = tl / S, s = tl % S; return bl * S + (s % r) * (S / r) + s / r; }

struct Ctx {
    const float *x, *mem, *rel_bias, *lb_logits, *w_in, *w_kv, *norm_g, *w_a, *w_b, *w_c, *w_out, *ln1_g, *ln1_b, *w_rg, *b_rg, *w_re, *b_re, *w_eg, *w_eu, *w_ed, *ln2_g, *ln2_b;
    float* out; unsigned char* ws;
};
#ifdef HOST_TEST
static const unsigned char T5_BUCKET[3][129] = {
#else
__device__ const unsigned char T5_BUCKET[3][129] = {
#endif
{0,1,2,3,4,5,6,7,8,9,10,11,12,13,14,15,16,16,16,16,16,16,17,17,17,17,17,17,17,17,18,18,18,18,18,18,18,18,18,18,19,19,19,19,19,19,19,19,19,19,19,19,19,19,20,20,20,20,20,20,20,20,20,20,20,20,20,20,20,20,20,20,20,21,21,21,21,21,21,21,21,21,21,21,21,21,21,21,21,21,21,21,21,21,21,21,21,21,21,22,22,22,22,22,22,22,22,22,22,22,22,22,22,22,22,22,22,22,22,22,22,22,22,22,22,22,22,22,22},
{0,4,8,12,16,16,17,17,18,18,19,19,19,19,20,20,20,20,20,21,21,21,21,21,21,22,22,22,22,22,22,22,22,22,23,23,23,23,23,23,23,23,23,23,23,23,24,24,24,24,24,24,24,24,24,24,24,24,24,24,24,24,25,25,25,25,25,25,25,25,25,25,25,25,25,25,25,25,25,25,25,25,25,26,26,26,26,26,26,26,26,26,26,26,26,26,26,26,26,26,26,26,26,26,26,26,26,26,26,26,26,26,26,27,27,27,27,27,27,27,27,27,27,27,27,27,27,27,27},
{0,16,18,19,20,21,21,22,22,23,23,23,24,24,24,24,25,25,25,25,25,26,26,26,26,26,26,26,26,27,27,27,27,27,27,27,27,27,27,28,28,28,28,28,28,28,28,28,28,28,28,28,29,29,29,29,29,29,29,29,29,29,29,29,29,29,29,29,29,29,30,30,30,30,30,30,30,30,30,30,30,30,30,30,30,30,30,30,30,30,30,30,30,30,30,31,31,31,31,31,31,31,31,31,31,31,31,31,31,31,31,31,31,31,31,31,31,31,31,31,31,31,31,31,31,31,31,31,31}};
template <class Tp> HD Tp* wsp(const Ctx& c, size_t off) { return (Tp*)(c.ws + off); }

#ifdef HOST_TEST
static inline unsigned atomic_inc_u32(unsigned* p) { unsigned r;
#pragma omp atomic capture
    { r = *p; *p += 1; }
    return r; }
#else
__device__ __forceinline__ unsigned atomic_inc_u32(unsigned* p) { return atomicAdd(p, 1u); }
#endif

struct S0_xb { Ctx c; static constexpr long n = (long)T * D;
    HD void operator()(long i) const { wsp<bf16_t>(c, OFF_XB)[i] = f2bf(c.x[i]); } };
struct S0_memb { Ctx c; static constexpr long n = (long)NBATCH * MEM * D;
    HD void operator()(long i) const { wsp<bf16_t>(c, OFF_MEMB)[i] = f2bf(c.mem[i]); } };
struct S0_tr { const float* W; bf16_t* Wt; int K, N; long n; int ldo;
    HD void operator()(long i) const { const int k = (int)(i % K); const long nn = i / K; Wt[(size_t)nn * ldo + k] = f2bf(W[(size_t)k * N + nn]); } };
struct S0_gu { Ctx c; static constexpr long n = (long)NE * 2 * DE * D;
    HD void operator()(long i) const { const int k = (int)(i % D); const long r = i / D; const int j = (int)(r % (2 * DE)), e = (int)(r / (2 * DE));
        const int u = j / (2 * HBK), w = j % (2 * HBK), hid = u * HBK + w % HBK, up = w / HBK;
        const float* src = up ? c.w_eu : c.w_eg; wsp<bf16_t>(c, OFF_WTGU)[i] = f2bf(src[((size_t)e * D + k) * DE + hid]); } };
struct S0_dn { Ctx c; static constexpr long n = (long)NE * D * DE;
    HD void operator()(long i) const { const int k = (int)(i % DE); const long r = i / DE; const int col = (int)(r % D), e = (int)(r / D);
        wsp<bf16_t>(c, OFF_WTDN)[i] = f2bf(c.w_ed[((size_t)e * DE + k) * D + col]); } };
struct S0_small { Ctx c; static constexpr long n = 12 * 129 + WB + 64;
    HD void operator()(long i) const { float* sm = wsp<float>(c, OFF_SMALL);
        if (i < 12 * 129) { const int gh = (int)(i / 129), u = (int)(i % 129), g = gh / 4; sm[SM_BIAS + i] = c.rel_bias[T5_BUCKET[g][u] * 12 + gh]; }
        else if (i < 12 * 129 + WB) { const int ch = (int)(i - 12 * 129); sm[SM_LB + ch] = sigmoidf_(c.lb_logits[ch] - c.lb_logits[WB + ch]); }
        else { const int j = (int)(i - 12 * 129 - WB); wsp<unsigned>(c, OFF_CTL)[j] = 0u; } } };

struct G_proj { Ctx c; int half; static constexpr int N = NP, NSEGS = 1, NBP = 1;
    HD int M() const { return TH; } HD int K(int) const { return D; }
    HD const bf16_t* arow(int, int row) const { return wsp<bf16_t>(c, OFF_XB) + ((size_t)half * TH + row) * D; }
    HD const bf16_t* brow(int, int, int col, int) const { return wsp<bf16_t>(c, WT_IN) + (size_t)col * D; }
    HD void between(int, int, int, float&, float&) const {}
    HD void store(int row, int col, float a, float) const { const int pr = col < COLS_A ? perm_row(row, col / 1536) : row; wsp<bf16_t>(c, OFF_P)[(size_t)pr * NP + col] = f2bf(a); } };
struct G_memkv { Ctx c; static constexpr int N = 1024, NSEGS = 1, NBP = 1;
    HD int M() const { return NBATCH * MEM; } HD int K(int) const { return D; }
    HD const bf16_t* arow(int, int row) const { return wsp<bf16_t>(c, OFF_MEMB) + (size_t)row * D; }
    HD const bf16_t* brow(int, int, int col, int) const { return wsp<bf16_t>(c, WT_KV) + (size_t)col * D; }
    HD void between(int, int, int, float&, float&) const {}
    HD void store(int row, int col, float a, float) const { wsp<bf16_t>(c, OFF_MEMKV)[(size_t)row * 1024 + col] = f2bf(a); } };
struct G_gates { Ctx c; static constexpr int N = 3 * D, NSEGS = 1, NBP = 1;
    HD int M() const { return T; } HD int K(int) const { return D; }
    HD const bf16_t* arow(int, int row) const { return wsp<bf16_t>(c, OFF_XB) + (size_t)row * D; }
    HD const bf16_t* brow(int, int, int col, int) const { return wsp<bf16_t>(c, WT_IN) + (size_t)(NP + col) * D; }
    HD void between(int, int, int, float&, float&) const {}
    HD void store(int row, int col, float a, float) const { wsp<bf16_t>(c, OFF_GATES)[((size_t)(col / D) * T + row) * D + col % D] = f2bf(sigmoidf_(a)); } };
struct G_merge { Ctx c; static constexpr int N = D, NSEGS = 3, NBP = 1;
    HD int M() const { return T; } HD int K(int s) const { return s == 1 ? WB : 512; }
    HD const bf16_t* arow(int s, int row) const { return (const bf16_t*)c.out + (size_t)row * OW + (s == 0 ? 0 : (s == 1 ? WA : WA + WB)); }
    HD const bf16_t* brow(int s, int, int col, int) const { return wsp<bf16_t>(c, WT_A) + (size_t)col * OW + (s == 0 ? 0 : (s == 1 ? WA : WA + WB)); }
    HD void between(int s, int row, int col, float& acc, float& carry) const { carry += bf2f(wsp<bf16_t>(c, OFF_GATES)[((size_t)s * T + row) * D + col]) * acc; acc = 0.f; }
    HD void store(int row, int col, float, float carry) const { wsp<bf16_t>(c, OFF_MERGED)[(size_t)row * D + col] = f2bf(carry); } };
struct G_wout { Ctx c; static constexpr int N = D, NSEGS = 1, NBP = 1;
    HD int M() const { return T; } HD int K(int) const { return D; }
    HD const bf16_t* arow(int, int row) const { return wsp<bf16_t>(c, OFF_MERGED) + (size_t)row * D; }
    HD const bf16_t* brow(int, int, int col, int) const { return wsp<bf16_t>(c, WT_OUT) + (size_t)col * D; }
    HD void between(int, int, int, float&, float&) const {}
    HD void store(int row, int col, float a, float) const { wsp<float>(c, OFF_H1)[(size_t)row * D + col] = DN_ALPHA * c.x[(size_t)row * D + col] + a; } };
struct MoeRow { int e, pos, valid, entry; };
HD MoeRow moe_row(const Ctx& c, int row) {
    const int* blk = wsp<int>(c, OFF_SMALL) + SM_BLK; const unsigned* cnt = wsp<unsigned>(c, OFF_CTL) + CW_CNT;
    MoeRow r; const int rb = row >> 8; r.e = blk[64 + rb]; r.pos = ((rb - blk[r.e]) << 8) + (row & 255); r.valid = r.pos < (int)cnt[r.e];
    r.entry = wsp<int>(c, OFF_LIST)[(size_t)r.e * T + (r.valid ? r.pos : 0)]; return r; }
HD int moe_rows_total(const Ctx& c) { return (wsp<int>(c, OFF_SMALL) + SM_BLK)[32] << 8; }
struct G_moe1 { Ctx c; static constexpr int N = DE, NSEGS = 1, NBP = 2;
    HD int M() const { return moe_rows_total(c); } HD int K(int) const { return D; }
    HD const bf16_t* arow(int, int row) const { const MoeRow r = moe_row(c, row); return wsp<bf16_t>(c, OFF_X1B) + (size_t)(r.entry >> 1) * D; }
    HD const bf16_t* brow(int, int row0, int col, int which) const { const int e = (wsp<int>(c, OFF_SMALL) + SM_BLK)[64 + (row0 >> 8)];
        return wsp<bf16_t>(c, OFF_WTGU) + ((size_t)e * 2 * DE + (col / HBK) * 2 * HBK + which * HBK + col % HBK) * D; }
    HD void between(int, int, int, float&, float&) const {}
    HD void store(int row, int col, float g, float u) const { wsp<bf16_t>(c, OFF_HBUF)[(size_t)row * DE + col] = f2bf(siluf_(g) * u); } };
struct G_moe2 { Ctx c; static constexpr int N = D, NSEGS = 1, NBP = 1;
    HD int M() const { return moe_rows_total(c); } HD int K(int) const { return DE; }
    HD const bf16_t* arow(int, int row) const { return wsp<bf16_t>(c, OFF_HBUF) + (size_t)row * DE; }
    HD const bf16_t* brow(int, int row0, int col, int) const { const int e = (wsp<int>(c, OFF_SMALL) + SM_BLK)[64 + (row0 >> 8)]; return wsp<bf16_t>(c, OFF_WTDN) + ((size_t)e * D + col) * DE; }
    HD void between(int, int, int, float&, float&) const {}
    HD void store(int row, int col, float a, float) const { const MoeRow r = moe_row(c, row); if (!r.valid) return;
        wsp<bf16_t>(c, (r.entry & 1) ? OFF_Y1 : OFF_Y0)[(size_t)(r.entry >> 1) * D + col] = f2bf(a); } };

struct u32x4_t { unsigned x, y, z, w; };
HD float bflo(unsigned u) { union { unsigned u; float f; } c; c.u = u << 16; return c.f; }
HD float bfhi(unsigned u) { union { unsigned u; float f; } c; c.u = u & 0xffff0000u; return c.f; }
HD float dot128(const bf16_t* a, const bf16_t* b) { float s = 0.f; const u32x4_t* pa = (const u32x4_t*)a; const u32x4_t* pb = (const u32x4_t*)b;
#ifndef HOST_TEST
#pragma unroll 4
#endif
    for (int d = 0; d < 16; ++d) { const u32x4_t ua = pa[d], ub = pb[d];
        s += bflo(ua.x) * bflo(ub.x) + bfhi(ua.x) * bfhi(ub.x) + bflo(ua.y) * bflo(ub.y) + bfhi(ua.y) * bfhi(ub.y) + bflo(ua.z) * bflo(ub.z) + bfhi(ua.z) * bfhi(ub.z) + bflo(ua.w) * bflo(ub.w) + bfhi(ua.w) * bfhi(ub.w); }
    return s; }
struct E_attnA { Ctx c; int half; static constexpr long n = (long)TH * 3 * 4 * 8;
    HD void operator()(long idx) const {
        const int p = (int)(idx & 7), h = (int)((idx >> 3) & 3); const long rest = idx >> 5; const int g = (int)(rest % 3), tl = (int)(rest / 3);
        const int r = dil_of(g), bl = tl / S, s = tl % S, cc = s % r, nq = s / r, L = S / r, base = bl * S + cc * L;
        const bf16_t* P = wsp<bf16_t>(c, OFF_P); const float* bias = wsp<float>(c, OFF_SMALL) + SM_BIAS + (g * 4 + h) * 129;
        const bf16_t* q = P + (size_t)(base + nq) * NP + g * 1536 + h * 128;
        float m = -INFINITY, l = 0.f, o[16];
#ifndef HOST_TEST
#pragma unroll
#endif
        for (int j = 0; j < 16; ++j) o[j] = 0.f;
        const int umax = nq < 128 ? nq : 128;
        for (int u = 0; u <= umax; ++u) {
            const bf16_t* kr = P + (size_t)(base + nq - u) * NP + g * 1536 + 512 + h * 128; const bf16_t* vr = kr + 512 + p * 16;
            const float sc = dot128(q, kr) * QK_SCALE + bias[u];
            const float mn = fmaxf(m, sc), a = expf(m - mn), pw = expf(sc - mn); l = l * a + pw; m = mn;
#ifndef HOST_TEST
#pragma unroll
#endif
            for (int j = 0; j < 16; ++j) o[j] = o[j] * a + pw * bf2f(vr[j]);
        }
        bf16_t* op = wsp<bf16_t>(c, OFF_PART) + ((size_t)g * TH + tl) * WA + h * 128 + p * 16; const float il = 1.f / l;
#ifndef HOST_TEST
#pragma unroll
#endif
        for (int j = 0; j < 16; ++j) op[j] = f2bf(o[j] * il);
        if (p == 0) wsp<float>(c, OFF_LSE)[((size_t)g * TH + tl) * 4 + h] = m + logf(l);
    } };
struct E_combA { Ctx c; int half; static constexpr long n = (long)TH * WA;
    HD void operator()(long idx) const { const int col = (int)(idx % WA), tl = (int)(idx / WA), h = col >> 7;
        const float* lse = wsp<float>(c, OFF_LSE); const bf16_t* part = wsp<bf16_t>(c, OFF_PART);
        const float l0 = lse[((size_t)0 * TH + tl) * 4 + h], l1 = lse[((size_t)1 * TH + tl) * 4 + h], l2 = lse[((size_t)2 * TH + tl) * 4 + h];
        const float mx = fmaxf(l0, fmaxf(l1, l2)), e0 = expf(l0 - mx), e1 = expf(l1 - mx), e2 = expf(l2 - mx), inv = 1.f / (e0 + e1 + e2);
        const float v = (e0 * bf2f(part[((size_t)0 * TH + tl) * WA + col]) + e1 * bf2f(part[((size_t)1 * TH + tl) * WA + col]) + e2 * bf2f(part[((size_t)2 * TH + tl) * WA + col])) * inv;
        ((bf16_t*)c.out)[((size_t)half * TH + tl) * OW + col] = f2bf(v); } };
struct E_attnC { Ctx c; int half; static constexpr long n = (long)TH * 4 * 8;
    HD void operator()(long idx) const { const int p = (int)(idx & 7), h = (int)((idx >> 3) & 3), tl = (int)(idx >> 5), b = half * BH + tl / S;
        const bf16_t* q = wsp<bf16_t>(c, OFF_P) + (size_t)tl * NP + COLS_A + COLS_B + h * 128; const bf16_t* kv = wsp<bf16_t>(c, OFF_MEMKV) + (size_t)b * MEM * 1024;
        float m = -INFINITY, l = 0.f, o[16];
#ifndef HOST_TEST
#pragma unroll
#endif
        for (int j = 0; j < 16; ++j) o[j] = 0.f;
        for (int k = 0; k < MEM; ++k) { const bf16_t* kr = kv + (size_t)k * 1024 + h * 128; const bf16_t* vr = kr + 512 + p * 16;
            const float sc = dot128(q, kr) * QK_SCALE; const float mn = fmaxf(m, sc), a = expf(m - mn), pw = expf(sc - mn); l = l * a + pw; m = mn;
#ifndef HOST_TEST
#pragma unroll
#endif
            for (int j = 0; j < 16; ++j) o[j] = o[j] * a + pw * bf2f(vr[j]); }
        bf16_t* op = (bf16_t*)c.out + ((size_t)half * TH + tl) * OW + WA + WB + h * 128 + p * 16; const float il = 1.f / l;
#ifndef HOST_TEST
#pragma unroll
#endif
        for (int j = 0; j < 16; ++j) op[j] = f2bf(o[j] * il); } };

HD float hg_f(const Ctx& c, const bf16_t* prow, int ch) { const float lb = wsp<float>(c, OFF_SMALL)[SM_LB + ch]; return lb + (1.f - lb) * sigmoidf_(bf2f(prow[COLS_A + WB + ch])); }
struct E_hg1 { Ctx c; int half; static constexpr long n = (long)BH * HB * NSEG * 128 * 128;
    HD void operator()(long idx) const { const int v = (int)(idx & 127), k = (int)((idx >> 7) & 127); const long r = idx >> 14; const int seg = (int)(r % NSEG), bhl = (int)(r / NSEG), h = bhl % HB, bl = bhl / HB;
        const bf16_t* P = wsp<bf16_t>(c, OFF_P); const int ch = h * 128 + k; float st = 0.f, dsum = 0.f;
        for (int s = 0; s < 256; ++s) { const bf16_t* pr = P + (size_t)(bl * S + seg * 256 + s) * NP; const float f = hg_f(c, pr, ch); st = f * st + (1.f - f) * bf2f(pr[COLS_A + 2 * WB + h * 128 + v]); dsum += logf(f); }
        wsp<float>(c, OFF_HG)[idx] = st; if (v == 0) wsp<float>(c, OFF_DSEG)[((size_t)bhl * NSEG + seg) * 128 + k] = dsum; } };
struct E_hg2 { Ctx c; static constexpr long n = (long)BH * HB * 128 * 128;
    HD void operator()(long idx) const { const int v = (int)(idx & 127), k = (int)((idx >> 7) & 127), bhl = (int)(idx >> 14); float run = 0.f;
        for (int seg = 0; seg < NSEG; ++seg) { float* p = wsp<float>(c, OFF_HG) + (((size_t)bhl * NSEG + seg) * 128 + k) * 128 + v; const float tmp = *p; *p = run;
            run = expf(wsp<float>(c, OFF_DSEG)[((size_t)bhl * NSEG + seg) * 128 + k]) * run + tmp; } } };
struct E_hg3 { Ctx c; int half; static constexpr long n = (long)BH * HB * NSEG * 128;
    HD void operator()(long idx) const { const int v = (int)(idx & 127); const long r = idx >> 7; const int seg = (int)(r % NSEG), bhl = (int)(r / NSEG), h = bhl % HB, bl = bhl / HB;
        const bf16_t* P = wsp<bf16_t>(c, OFF_P); float st[128];
#ifndef HOST_TEST
#pragma unroll
#endif
        for (int k = 0; k < 128; ++k) st[k] = wsp<float>(c, OFF_HG)[(((size_t)bhl * NSEG + seg) * 128 + k) * 128 + v];
        for (int s = 0; s < 256; ++s) { const int tl = bl * S + seg * 256 + s; const bf16_t* pr = P + (size_t)tl * NP; const float iv = bf2f(pr[COLS_A + 2 * WB + h * 128 + v]); float o = 0.f;
#ifndef HOST_TEST
#pragma unroll
#endif
            for (int k = 0; k < 128; ++k) { const float f = hg_f(c, pr, h * 128 + k); st[k] = f * st[k] + (1.f - f) * iv; o += siluf_(bf2f(pr[COLS_A + h * 128 + k])) * st[k]; }
            ((bf16_t*)c.out)[((size_t)half * TH + tl) * OW + WA + h * 128 + v] = f2bf(o); } } };
struct E_hgnorm { Ctx c; int half; static constexpr long n = (long)TH * HB;
    HD void operator()(long idx) const { const int h = (int)(idx % HB), tl = (int)(idx / HB); bf16_t* o = (bf16_t*)c.out + ((size_t)half * TH + tl) * OW + WA + h * 128;
        const bf16_t* pr = wsp<bf16_t>(c, OFF_P) + (size_t)tl * NP + COLS_A + 3 * WB + h * 128; float ss = 0.f;
        for (int v = 0; v < 128; ++v) { const float x = bf2f(o[v]); ss += x * x; }
        const float rs = 1.f / sqrtf(ss * (1.f / 128.f) + RMS_EPS);
        for (int v = 0; v < 128; ++v) o[v] = f2bf(bf2f(o[v]) * rs * c.norm_g[h * 128 + v] * siluf_(bf2f(pr[v]))); } };

struct E_ln1 { Ctx c; static constexpr long n = T;
    HD void operator()(long row) const { float* h1 = wsp<float>(c, OFF_H1) + (size_t)row * D; bf16_t* xb1 = wsp<bf16_t>(c, OFF_X1B) + (size_t)row * D;
        float mu = 0.f; for (int i = 0; i < D; ++i) mu += h1[i]; mu *= (1.f / D);
        float var = 0.f; for (int i = 0; i < D; ++i) { const float d = h1[i] - mu; var += d * d; } var *= (1.f / D); const float rs = 1.f / sqrtf(var + LN_EPS);
        float gl0 = c.b_rg[0], gl1 = c.b_rg[1], gl2 = c.b_rg[2], gl3 = c.b_rg[3];
        for (int i = 0; i < D; ++i) { const float v = (h1[i] - mu) * rs * c.ln1_g[i] + c.ln1_b[i]; h1[i] = v; xb1[i] = f2bf(v);
            gl0 += v * c.w_rg[i * 4 + 0]; gl1 += v * c.w_rg[i * 4 + 1]; gl2 += v * c.w_rg[i * 4 + 2]; gl3 += v * c.w_rg[i * 4 + 3]; }
        int gs = 0; float gm = gl0; if (gl1 > gm) { gm = gl1; gs = 1; } if (gl2 > gm) { gm = gl2; gs = 2; } if (gl3 > gm) { gm = gl3; gs = 3; }
        const float gp = 1.f / (expf(gl0 - gm) + expf(gl1 - gm) + expf(gl2 - gm) + expf(gl3 - gm));
        float v0 = -INFINITY, v1 = -INFINITY; int i0 = 0, i1 = 0;
        for (int j = 0; j < 8; ++j) { float el = c.b_re[gs * 8 + j]; for (int i = 0; i < D; ++i) el += h1[i] * c.w_re[i * 32 + gs * 8 + j];
            if (el > v0) { v1 = v0; i1 = i0; v0 = el; i0 = j; } else if (el > v1) { v1 = el; i1 = j; } }
        const float e1 = expf(v1 - v0), w0 = gp / (1.f + e1), w1 = gp * e1 / (1.f + e1);
        unsigned* cnt = wsp<unsigned>(c, OFF_CTL) + CW_CNT; int* list = wsp<int>(c, OFF_LIST); float* rw = wsp<float>(c, OFF_RW);
        const int ea = gs * 8 + i0, eb = gs * 8 + i1;
        list[(size_t)ea * T + atomic_inc_u32(cnt + ea)] = (int)row * 2 + 0; list[(size_t)eb * T + atomic_inc_u32(cnt + eb)] = (int)row * 2 + 1;
        rw[row * 2 + 0] = w0; rw[row * 2 + 1] = w1; } };
struct E_blk { Ctx c; static constexpr long n = 1;
    HD void operator()(long) const { int* blk = wsp<int>(c, OFF_SMALL) + SM_BLK; const unsigned* cnt = wsp<unsigned>(c, OFF_CTL) + CW_CNT; int acc = 0;
        for (int e = 0; e < NE; ++e) { blk[e] = acc; const int nb = ((int)cnt[e] + 255) >> 8; for (int j = 0; j < nb; ++j) blk[64 + acc + j] = e; acc += nb; } blk[32] = acc; } };
struct E_ln2 { Ctx c; static constexpr long n = T;
    HD void operator()(long row) const { const float* x1 = wsp<float>(c, OFF_H1) + (size_t)row * D; const bf16_t* y0 = wsp<bf16_t>(c, OFF_Y0) + (size_t)row * D; const bf16_t* y1 = wsp<bf16_t>(c, OFF_Y1) + (size_t)row * D;
        const float w0 = wsp<float>(c, OFF_RW)[row * 2], w1 = wsp<float>(c, OFF_RW)[row * 2 + 1]; float* o = c.out + (size_t)row * D;
        float mu = 0.f; for (int i = 0; i < D; ++i) { const float v = DN_ALPHA * x1[i] + w0 * bf2f(y0[i]) + w1 * bf2f(y1[i]); mu += v; } mu *= (1.f / D);
        float var = 0.f; for (int i = 0; i < D; ++i) { const float v = DN_ALPHA * x1[i] + w0 * bf2f(y0[i]) + w1 * bf2f(y1[i]) - mu; var += v * v; } var *= (1.f / D); const float rs = 1.f / sqrtf(var + LN_EPS);
        for (int i = 0; i < D; ++i) { const float v = DN_ALPHA * x1[i] + w0 * bf2f(y0[i]) + w1 * bf2f(y1[i]); o[i] = (v - mu) * rs * c.ln2_g[i] + c.ln2_b[i]; } } };
typedef short bf16x8 __attribute__((ext_vector_type(8)));
typedef float f32x4 __attribute__((ext_vector_type(4)));

template <class F> __global__ void __launch_bounds__(256) k_elems(F f, long n) {
    for (long i = (long)blockIdx.x * 256 + threadIdx.x; i < n; i += (long)gridDim.x * 256) f(i);
}
template <class F> __global__ void __launch_bounds__(64) k_elems64(F f, long n) {
    for (long i = (long)blockIdx.x * 64 + threadIdx.x; i < n; i += (long)gridDim.x * 64) f(i);
}
template <class G> __global__ void __launch_bounds__(256) k_sgemm(G g) {
    const int M = g.M(); const int lane = threadIdx.x & 63, wid = threadIdx.x >> 6; constexpr int ntn = G::N / 64;
    const long ntiles = (long)(M / 64) * ntn;
    for (long tile = blockIdx.x; tile < ntiles; tile += gridDim.x) {
        const int tm = (int)(tile / ntn), tn = (int)(tile % ntn), r0 = tm * 64 + wid * 16, c0 = tn * 64;
        f32x4 acc[G::NBP][4], carry[4];
#pragma unroll
        for (int j = 0; j < 4; ++j) { carry[j] = (f32x4){0.f, 0.f, 0.f, 0.f};
#pragma unroll
            for (int w = 0; w < G::NBP; ++w) acc[w][j] = (f32x4){0.f, 0.f, 0.f, 0.f}; }
#pragma unroll
        for (int seg = 0; seg < G::NSEGS; ++seg) {
            const bf16_t* ar = g.arow(seg, r0 + (lane & 15)) + 8 * (lane >> 4); const bf16_t* br[G::NBP][4];
#pragma unroll
            for (int w = 0; w < G::NBP; ++w)
#pragma unroll
                for (int j = 0; j < 4; ++j) br[w][j] = g.brow(seg, r0, c0 + 16 * j + (lane & 15), w) + 8 * (lane >> 4);
            const int K = g.K(seg);
            for (int k0 = 0; k0 < K; k0 += 32) { const bf16x8 a = *(const bf16x8*)(ar + k0);
#pragma unroll
                for (int w = 0; w < G::NBP; ++w)
#pragma unroll
                    for (int j = 0; j < 4; ++j) { const bf16x8 b = *(const bf16x8*)(br[w][j] + k0); acc[w][j] = __builtin_amdgcn_mfma_f32_16x16x32_bf16(a, b, acc[w][j], 0, 0, 0); } }
#pragma unroll
            for (int j = 0; j < 4; ++j)
#pragma unroll
                for (int i = 0; i < 4; ++i) { float a = acc[0][j][i], cr = carry[j][i]; g.between(seg, r0 + (lane >> 4) * 4 + i, c0 + 16 * j + (lane & 15), a, cr); acc[0][j][i] = a; carry[j][i] = cr; }
        }
#pragma unroll
        for (int j = 0; j < 4; ++j)
#pragma unroll
            for (int i = 0; i < 4; ++i) g.store(r0 + (lane >> 4) * 4 + i, c0 + 16 * j + (lane & 15), acc[0][j][i], G::NBP == 2 ? acc[G::NBP - 1][j][i] : carry[j][i]);
    }
}
template <class F> static void launch_elems(const F& f, long n, hipStream_t st) { long nb = (n + 255) / 256; if (nb > 32768) nb = 32768; if (nb < 1) nb = 1; hipLaunchKernelGGL(k_elems<F>, dim3((unsigned)nb), dim3(256), 0, st, f, n); }
template <class F> static void launch_elems64(const F& f, long n, hipStream_t st) { long nb = (n + 63) / 64; if (nb > 65536) nb = 65536; hipLaunchKernelGGL(k_elems64<F>, dim3((unsigned)nb), dim3(64), 0, st, f, n); }
template <class G> static void launch_sgemm(const G& g, hipStream_t st) { hipLaunchKernelGGL(k_sgemm<G>, dim3(4096), dim3(256), 0, st, g); }

static Ctx make_ctx(void* const* d_in, void* d_out, void* d_ws) {
    Ctx c; memset(&c, 0, sizeof(c)); const float** ip = (const float**)&c; for (int i = 0; i < 22; ++i) ip[i] = (const float*)d_in[i];
    c.out = (float*)d_out; c.ws = (unsigned char*)d_ws; return c;
}
static void v1_stage0(Ctx c, hipStream_t st) {
    launch_elems(S0_xb{c}, S0_xb::n, st); launch_elems(S0_memb{c}, S0_memb::n, st); launch_elems(S0_small{c}, S0_small::n, st);
    launch_elems(S0_tr{c.w_in, wsp<bf16_t>(c, WT_IN), D, N_IN, (long)D * N_IN, D}, (long)D * N_IN, st);
    launch_elems(S0_tr{c.w_kv, wsp<bf16_t>(c, WT_KV), D, 1024, (long)D * 1024, D}, (long)D * 1024, st);
    launch_elems(S0_tr{c.w_a, wsp<bf16_t>(c, WT_A), WA, D, (long)D * WA, OW}, (long)D * WA, st);
    launch_elems(S0_tr{c.w_b, wsp<bf16_t>(c, WT_A) + WA, WB, D, (long)D * WB, OW}, (long)D * WB, st);
    launch_elems(S0_tr{c.w_c, wsp<bf16_t>(c, WT_A) + WA + WB, WC, D, (long)D * WC, OW}, (long)D * WC, st);
    launch_elems(S0_tr{c.w_out, wsp<bf16_t>(c, WT_OUT), D, D, (long)D * D, D}, (long)D * D, st);
}
static void v1_proj(Ctx c, int half, hipStream_t st) { if (half == 0) launch_sgemm(G_memkv{c}, st); launch_sgemm(G_proj{c, half}, st); }
static void v1_mixers(Ctx c, int half, hipStream_t st) {
    launch_elems(E_hg1{c, half}, E_hg1::n, st); launch_elems(E_hg2{c}, E_hg2::n, st);
    launch_elems(E_attnA{c, half}, E_attnA::n, st); launch_elems(E_attnC{c, half}, E_attnC::n, st);
    launch_elems64(E_hg3{c, half}, E_hg3::n, st); launch_elems(E_hgnorm{c, half}, E_hgnorm::n, st); launch_elems(E_combA{c, half}, E_combA::n, st);
}
static void v1_expw(Ctx c, hipStream_t st) { launch_elems(S0_gu{c}, S0_gu::n, st); launch_elems(S0_dn{c}, S0_dn::n, st); }
static void v1_gates(Ctx c, hipStream_t st) { launch_sgemm(G_gates{c}, st); }
static void v1_merge(Ctx c, hipStream_t st) { launch_sgemm(G_merge{c}, st); }
static void v1_wout(Ctx c, hipStream_t st) { launch_sgemm(G_wout{c}, st); }
static void v1_ln1(Ctx c, hipStream_t st) { launch_elems(E_ln1{c}, E_ln1::n, st); launch_elems(E_blk{c}, 1, st); }
static void v1_moe1(Ctx c, hipStream_t st) { launch_sgemm(G_moe1{c}, st); }
static void v1_moe2(Ctx c, hipStream_t st) { launch_sgemm(G_moe2{c}, st); }
static void v1_ln2(Ctx c, hipStream_t st) { launch_elems(E_ln2{c}, E_ln2::n, st); }
namespace pg8 {
#define PG8_LAS __attribute__((address_space(3)))
typedef unsigned u32x4 __attribute__((ext_vector_type(4)));
constexpr int BM = 256, BK = 64, HALF = 128, HTB = HALF * BK * 2, STAGE_BYTES = 8 * HTB, NXCD = 8, WGM = 8;
__host__ __device__ __forceinline__ int lds_byte(int r, int c) { const int st = (r >> 4) * 2 + (c >> 5), rr = r & 15, cc = c & 31, ob = rr * 64 + cc * 2; return st * 1024 + (ob ^ (((ob >> 9) & 1) << 5)); }
__host__ __device__ __forceinline__ void stage_rc(int b, int& R, int& C) { const int st = b / 1024, sb = b % 1024, swz = sb ^ (((sb >> 9) & 1) << 5); R = (st >> 1) * 16 + swz / 64; C = (st & 1) * 32 + (swz % 64) / 2; }
__host__ __device__ __forceinline__ int perm32(int rho) { const int n = rho >> 4, i = rho & 15; return 8 * (i >> 2) + 4 * n + (i & 3); }
__device__ __forceinline__ unsigned cvt_pk_bf16(float lo, float hi) { unsigned r; asm volatile("v_cvt_pk_bf16_f32 %0, %1, %2" : "=v"(r) : "v"(lo), "v"(hi)); return r; }

__device__ __forceinline__ int lane_id_opaque() { int l; asm volatile("v_mbcnt_lo_u32_b32 %0, -1, 0\n\tv_mbcnt_hi_u32_b32 %0, -1, %0" : "=v"(l)); return l; }
struct Unit { const char* A; const char* B; int nt, pm, pn, tag; };
__device__ __forceinline__ void tile_of(int L, int nM, int nN, int& pm, int& pn) {
    const int nwg = nM * nN; int wgid = L; { const int q = nwg / NXCD, r = nwg % NXCD, xcd = wgid % NXCD, off = wgid / NXCD; wgid = (xcd < r ? xcd * (q + 1) : r * (q + 1) + (xcd - r) * q) + off; }
    const int nig = WGM * nN, gid = wgid / nig, fm = gid * WGM, gsz = (nM - fm) < WGM ? (nM - fm) : WGM;
    pm = fm + ((wgid % nig) % gsz); pn = (wgid % nig) / gsz;
}
template <class Epi, class Sched>
__device__ __forceinline__ void gemm_phase(PG8_LAS unsigned char* lds, const Sched& S, const Epi& E, int tid) {
    constexpr bool GA = Sched::GATHER;
    asm volatile("" : "+v"(tid));
    const int wid = __builtin_amdgcn_readfirstlane(tid >> 6), lane = tid & 63, wr = wid >> 2, wc = wid & 3, fr = lane & 15, fq = lane >> 4;
    const unsigned lda = S.lda, ldb = S.ldb;
    int sR[2]; unsigned voffA[2], voffB[2];
#pragma unroll
    for (int i = 0; i < 2; ++i) { int R, C; stage_rc(tid * 16 + i * 8192, R, C); sR[i] = R; const int Rb = Epi::PERM ? ((R & ~31) + perm32(R & 31)) : R;
        voffA[i] = (GA ? 0u : (unsigned)R * lda) + (unsigned)C * 2u; voffB[i] = (unsigned)Rb * ldb + (unsigned)C * 2u; }
    const size_t kstep = (size_t)(BK * 2), hstepA = (size_t)HALF * lda, hstepB = (size_t)HALF * ldb;
    const unsigned ldsw = (unsigned)wid * 1024u;
    const int aoff = lds_byte(wr * 64 + fr, fq * 8), boff = lds_byte(wc * 32 + fr, fq * 8);
#define PG8_SA(b, h) (((b) * 2 + (h)) * HTB)
#define PG8_SB(b, h) ((4 + (b) * 2 + (h)) * HTB)
#define PG8_STAGE(bufoff, gbase, voff) do { _Pragma("unroll") for (int _i = 0; _i < 2; ++_i) \
        __builtin_amdgcn_global_load_lds((const unsigned*)((const char*)(gbase) + (voff)[_i]), (PG8_LAS unsigned*)(lds + (bufoff) + ldsw + _i * 8192), 16, 0, 0); } while (0)
#define PG8_STAGE_A(bufoff, gbase, h, tk) do { if constexpr (GA) { unsigned _o[2]; _Pragma("unroll") for (int _i = 0; _i < 2; ++_i) _o[_i] = (((tk)[_i] >> (16 * (h))) & 0xffffu) * lda + voffA[_i]; PG8_STAGE(bufoff, gbase, _o); } \
        else { PG8_STAGE(bufoff, (gbase) + (h) * hstepA, voffA); } } while (0)
#define PG8_LDA(dst, b, h) do { _Pragma("unroll") for (int m = 0; m < 4; ++m) _Pragma("unroll") for (int k = 0; k < 2; ++k) dst[m][k] = *(const PG8_LAS bf16x8*)(lds + PG8_SA(b, h) + aoff + m * 2048 + k * 1024); } while (0)
#define PG8_LDB(dst, b, h) do { _Pragma("unroll") for (int n = 0; n < 2; ++n) _Pragma("unroll") for (int k = 0; k < 2; ++k) dst[n][k] = *(const PG8_LAS bf16x8*)(lds + PG8_SB(b, h) + boff + n * 2048 + k * 1024); } while (0)
#define PG8_MMA(ai, bj, At, Bt) do { __builtin_amdgcn_s_setprio(1); _Pragma("unroll") for (int m = 0; m < 4; ++m) _Pragma("unroll") for (int n = 0; n < 2; ++n) _Pragma("unroll") for (int k = 0; k < 2; ++k) \
        acc[ai][bj][m][n] = __builtin_amdgcn_mfma_f32_16x16x32_bf16(Bt[n][k], At[m][k], acc[ai][bj][m][n], 0, 0, 0); __builtin_amdgcn_s_setprio(0); } while (0)
#define PG8_WAIT_V(n) asm volatile("s_waitcnt vmcnt(" #n ")" ::: "memory")
#define PG8_WAIT_L(n) asm volatile("s_waitcnt lgkmcnt(" #n ")" ::: "memory")
#define PG8_BAR __builtin_amdgcn_s_barrier()
#define PG8_SCHED __builtin_amdgcn_sched_barrier(0)
#define PG8_TOKS(u, tk) do { if constexpr (GA) { _Pragma("unroll") for (int _i = 0; _i < 2; ++_i) tk[_i] = S.a_row(u, sR[_i]) | (S.a_row(u, sR[_i] + HALF) << 16); } } while (0)
    Unit cur, nxt; int ui = 0;
    if (!S.next(0, cur)) return;
    f32x4 acc[2][2][4][2];
#pragma unroll
    for (int a = 0; a < 2; ++a)
#pragma unroll
        for (int b = 0; b < 2; ++b)
#pragma unroll
            for (int m = 0; m < 4; ++m)
#pragma unroll
                for (int n = 0; n < 2; ++n) acc[a][b][m][n] = (f32x4){0.f, 0.f, 0.f, 0.f};
    bf16x8 At[4][2], B0[2][2], B1[2][2];
    unsigned ctk[2] = {0u, 0u}, ntk[2] = {0u, 0u};
    PG8_TOKS(cur, ctk);
    const char* cA = cur.A; const char* cB = cur.B;
    PG8_STAGE(PG8_SB(0, 0), cB, voffB); PG8_STAGE(PG8_SB(0, 1), cB + hstepB, voffB); PG8_STAGE_A(PG8_SA(0, 0), cA, 0, ctk); PG8_STAGE_A(PG8_SA(0, 1), cA, 1, ctk);
    if (wr == 1) PG8_BAR;
    PG8_WAIT_V(2); PG8_BAR;
    PG8_STAGE(PG8_SB(1, 0), cB + kstep, voffB); PG8_STAGE_A(PG8_SA(1, 0), cA + kstep, 0, ctk); PG8_STAGE(PG8_SB(1, 1), cB + hstepB + kstep, voffB);
    PG8_WAIT_V(6); PG8_BAR;
    for (;;) {
        const bool has_next = S.next(ui + 1, nxt);
        const char* nA = cA; const char* nB = cB;
        if constexpr (GA) { ntk[0] = ctk[0]; ntk[1] = ctk[1]; }
        if (has_next) { nA = nxt.A; nB = nxt.B; PG8_TOKS(nxt, ntk); }
        const int nt = cur.nt;
#define PG8_TRIP(a1, a2, b2, tk2) do { const char* a3 = (a2) + kstep; const char* b3 = (b2) + kstep; \
            PG8_LDB(B0, 0, 0); PG8_LDB(B1, 0, 1); PG8_SCHED; PG8_LDA(At, 0, 0); PG8_STAGE_A(PG8_SA(1, 1), a1, 1, ctk); \
            PG8_WAIT_V(8); PG8_WAIT_L(0); PG8_BAR; PG8_MMA(0, 0, At, B0); PG8_MMA(0, 1, At, B1); PG8_BAR; PG8_SCHED; \
            PG8_LDA(At, 0, 1); PG8_STAGE(PG8_SB(0, 0), b2, voffB); PG8_STAGE(PG8_SB(0, 1), (b2) + hstepB, voffB); PG8_STAGE_A(PG8_SA(0, 0), a2, 0, tk2); \
            PG8_WAIT_V(8); PG8_WAIT_L(0); PG8_BAR; PG8_MMA(1, 0, At, B0); PG8_MMA(1, 1, At, B1); PG8_BAR; PG8_SCHED; \
            PG8_LDB(B0, 1, 0); PG8_LDB(B1, 1, 1); PG8_SCHED; PG8_LDA(At, 1, 0); PG8_STAGE_A(PG8_SA(0, 1), a2, 1, tk2); \
            PG8_WAIT_V(8); PG8_WAIT_L(0); PG8_BAR; PG8_MMA(0, 0, At, B0); PG8_MMA(0, 1, At, B1); PG8_BAR; PG8_SCHED; \
            PG8_LDA(At, 1, 1); PG8_STAGE(PG8_SB(1, 0), b3, voffB); PG8_STAGE(PG8_SB(1, 1), b3 + hstepB, voffB); PG8_STAGE_A(PG8_SA(1, 0), a3, 0, tk2); \
            PG8_WAIT_V(8); PG8_WAIT_L(0); PG8_BAR; PG8_MMA(1, 0, At, B0); PG8_MMA(1, 1, At, B1); PG8_BAR; PG8_SCHED; } while (0)
        for (int t = 0; t < nt - 2; t += 2) { const char* a1 = cA + (size_t)(t + 1) * kstep; const char* a2 = cA + (size_t)(t + 2) * kstep; const char* b2 = cB + (size_t)(t + 2) * kstep;
            PG8_TRIP(a1, a2, b2, ctk); }
        { const char* a1 = cA + (size_t)(nt - 1) * kstep; PG8_TRIP(a1, nA, nB, ntk); }
#undef PG8_TRIP
        if (wr == 0) PG8_BAR;
        { const int el = lane_id_opaque(); E(acc, cur, wr, wc, el & 15, el >> 4); }
        if (!has_next) break;
        cur = nxt; cA = nA; cB = nB;
        if constexpr (GA) { ctk[0] = ntk[0]; ctk[1] = ntk[1]; }
        ++ui;
        if (wr == 1) PG8_BAR;
    }
    PG8_WAIT_V(0);
    PG8_BAR;
#undef PG8_SA
#undef PG8_SB
#undef PG8_STAGE
#undef PG8_STAGE_A
#undef PG8_LDA
#undef PG8_LDB
#undef PG8_MMA
#undef PG8_WAIT_V
#undef PG8_WAIT_L
#undef PG8_BAR
#undef PG8_SCHED
#undef PG8_TOKS
}
}
namespace pg8 {
#define ZERO_ACC() do { _Pragma("unroll") for (int a_ = 0; a_ < 2; ++a_) _Pragma("unroll") for (int b_ = 0; b_ < 2; ++b_) _Pragma("unroll") for (int m_ = 0; m_ < 4; ++m_) _Pragma("unroll") for (int n_ = 0; n_ < 2; ++n_) acc[a_][b_][m_][n_] = (f32x4){0.f, 0.f, 0.f, 0.f}; } while (0)
typedef f32x4 (&AccRef)[2][2][4][2];
__device__ __forceinline__ u32x4 pack8(f32x4 v0, f32x4 v1) { u32x4 w; w.x = cvt_pk_bf16(v0[0], v0[1]); w.y = cvt_pk_bf16(v0[2], v0[3]); w.z = cvt_pk_bf16(v1[0], v1[1]); w.w = cvt_pk_bf16(v1[2], v1[3]); return w; }
__device__ __forceinline__ void unpack8(u32x4 w, f32x4& v0, f32x4& v1) { v0 = (f32x4){bflo(w.x), bfhi(w.x), bflo(w.y), bfhi(w.y)}; v1 = (f32x4){bflo(w.z), bfhi(w.z), bflo(w.w), bfhi(w.w)}; }
__device__ __forceinline__ float fsigmoid(float x) { return __builtin_amdgcn_rcpf(1.f + __expf(-x)); }

struct SchedGrid {
    static constexpr bool GATHER = false; unsigned lda, ldb;
    int nM, nN, G, c, nt; const char *A0, *B0;
    __device__ __forceinline__ bool next(int i, Unit& u) const { const long L = (long)i * G + c; if (L >= (long)nM * nN) return false;
        int pm, pn; tile_of((int)L, nM, nN, pm, pn); u.pm = pm; u.pn = pn; u.tag = 0; u.nt = nt;
        u.A = A0 + (size_t)pm * BM * lda; u.B = B0 + (size_t)pn * BM * ldb; return true; }
};
struct SchedMerge {
    static constexpr bool GATHER = false; unsigned lda, ldb;
    int nM, nN, G, c; const char *A0, *B0;
    __device__ __forceinline__ bool next(int i, Unit& u) const { const int r = i / 3, s = i - r * 3; const long L = (long)r * G + c; if (L >= (long)nM * nN) return false;
        int pm, pn; tile_of((int)L, nM, nN, pm, pn); u.pm = pm; u.pn = pn; u.tag = s; u.nt = (s == 1 ? WB : WA) / BK;
        const size_t so = (size_t)((s > 0 ? WA : 0) + (s > 1 ? WB : 0)) * 2;
        u.A = A0 + (size_t)pm * BM * lda + so; u.B = B0 + (size_t)pn * BM * ldb + so; return true; }
};
#define ROWS_BEGIN(off0) { unsigned ro_ = (off0); _Pragma("unroll") for (int ai = 0; ai < 2; ++ai) { _Pragma("unroll") for (int m = 0; m < 4; ++m) {
#define ROWS_END(step16) ro_ += (m == 3 ? 5u : 1u) * (step16); asm volatile("" : "+v"(ro_) :: "memory"); } } }
struct EpiProj { static constexpr bool PERM = true; bf16_t* P;
    __device__ __forceinline__ void operator()(AccRef acc, const Unit& u, int wr, int wc, int fr, int fq) const {
        const int g = u.pn < 18 ? u.pn / 6 : -1; const int col0 = u.pn * BM + wc * 32 + 8 * fq; const int r0 = u.pm * BM + wr * 64 + fr;
        const int pr0 = g >= 0 ? perm_row(r0, g) : r0; const unsigned step16 = (unsigned)(16 >> (g <= 0 ? 0 : 2 * g)) * (NP * 2);
        char* base = (char*)P;
        ROWS_BEGIN((unsigned)pr0 * (NP * 2) + (unsigned)col0 * 2)
#pragma unroll
            for (int bj = 0; bj < 2; ++bj) *(u32x4*)(base + ro_ + bj * (HALF * 2)) = pack8(acc[ai][bj][m][0], acc[ai][bj][m][1]);
        ROWS_END(step16)
        ZERO_ACC(); } };
struct EpiGates { static constexpr bool PERM = true; bf16_t* Gt;
    __device__ __forceinline__ void operator()(AccRef acc, const Unit& u, int wr, int wc, int fr, int fq) const {
        const int pl = u.pn / (D / BM), col0 = (u.pn % (D / BM)) * BM + wc * 32 + 8 * fq, r0 = u.pm * BM + wr * 64 + fr; char* base = (char*)Gt + (size_t)pl * T * D * 2;
        ROWS_BEGIN((unsigned)r0 * (D * 2) + (unsigned)col0 * 2)
#pragma unroll
            for (int bj = 0; bj < 2; ++bj) { f32x4 v0 = acc[ai][bj][m][0], v1 = acc[ai][bj][m][1];
#pragma unroll
                for (int e = 0; e < 4; ++e) { v0[e] = fsigmoid(v0[e]); v1[e] = fsigmoid(v1[e]); }
                *(u32x4*)(base + ro_ + bj * (HALF * 2)) = pack8(v0, v1); }
        ROWS_END(16u * D * 2)
        ZERO_ACC(); } };
struct EpiMerge { static constexpr bool PERM = true; const bf16_t* Gt; bf16_t* Mg;
    __device__ __forceinline__ void operator()(AccRef acc, const Unit& u, int wr, int wc, int fr, int fq) const {
        const int s = u.tag; const int col0 = u.pn * BM + wc * 32 + 8 * fq, r0 = u.pm * BM + wr * 64 + fr; const char* gbase = (const char*)Gt + (size_t)s * T * D * 2; char* mbase = (char*)Mg;
        ROWS_BEGIN((unsigned)r0 * (D * 2) + (unsigned)col0 * 2)
#pragma unroll
            for (int bj = 0; bj < 2; ++bj) { f32x4 g0, g1; unpack8(*(const u32x4*)(gbase + ro_ + bj * (HALF * 2)), g0, g1);
                if (s < 2) { f32x4 h0, h1; unpack8(*(const u32x4*)(gbase + (size_t)T * D * 2 + ro_ + bj * (HALF * 2)), h0, h1);
#pragma unroll
                    for (int e = 0; e < 4; ++e) { g0[e] *= __builtin_amdgcn_rcpf(fmaxf(h0[e], 1e-20f)); g1[e] *= __builtin_amdgcn_rcpf(fmaxf(h1[e], 1e-20f)); } }
                acc[ai][bj][m][0] *= g0; acc[ai][bj][m][1] *= g1;
                if (s == 2) *(u32x4*)(mbase + ro_ + bj * (HALF * 2)) = pack8(acc[ai][bj][m][0], acc[ai][bj][m][1]); }
        ROWS_END(16u * D * 2)
        if (s == 2) ZERO_ACC(); } };
struct EpiWout { static constexpr bool PERM = false; const float* X; float* H1;
    __device__ __forceinline__ void operator()(AccRef acc, const Unit& u, int wr, int wc, int fr, int fq) const {
        const int col0 = u.pn * BM + wc * 32 + 4 * fq, r0 = u.pm * BM + wr * 64 + fr; const char* xb_ = (const char*)X; char* hb_ = (char*)H1;
        ROWS_BEGIN((unsigned)r0 * (D * 4) + (unsigned)col0 * 4)
#pragma unroll
            for (int bj = 0; bj < 2; ++bj)
#pragma unroll
                for (int n = 0; n < 2; ++n) { const f32x4 xv = *(const f32x4*)(xb_ + ro_ + (bj * HALF + n * 16) * 4); *(f32x4*)(hb_ + ro_ + (bj * HALF + n * 16) * 4) = xv * DN_ALPHA + acc[ai][bj][m][n]; }
        ROWS_END(16u * D * 4)
        ZERO_ACC(); } };
template <bool GA> struct SchedMoe {
    static constexpr bool GATHER = GA; unsigned lda, ldb;
    int G, c, ncol, nt; const int* blk; const int* list; const unsigned* cnt; const char* A; const char* B; size_t b_estride, b_pnstride;
    __device__ __forceinline__ bool next(int i, Unit& u) const { const long L = (long)i * G + c; const int nblk = __builtin_amdgcn_readfirstlane(blk[32]); if (L >= (long)nblk * ncol) return false;
        const int rb = (int)(L / ncol), pn = (int)(L % ncol), e = __builtin_amdgcn_readfirstlane(blk[64 + rb]); u.pm = rb; u.pn = pn; u.tag = e; u.nt = nt;
        u.A = GA ? A : A + (size_t)rb * BM * lda; u.B = B + (size_t)e * b_estride + (size_t)pn * b_pnstride; return true; }
    __device__ __forceinline__ unsigned a_row(const Unit& u, int row) const {
        const int e = u.tag, pos = ((u.pm - __builtin_amdgcn_readfirstlane(blk[e])) << 8) + row; const int entry = list[(size_t)e * T + (pos < __builtin_amdgcn_readfirstlane((int)cnt[e]) ? pos : 0)]; return (unsigned)(entry >> 1); }
};
struct EpiMoe1 { static constexpr bool PERM = true; bf16_t* Hb;
    __device__ __forceinline__ void operator()(AccRef acc, const Unit& u, int wr, int wc, int fr, int fq) const {
        const int col0 = u.pn * HALF + wc * 32 + 8 * fq, r0 = u.pm * BM + wr * 64 + fr; char* base = (char*)Hb;
        ROWS_BEGIN((unsigned)r0 * (DE * 2) + (unsigned)col0 * 2)
            f32x4 v0 = acc[ai][0][m][0], v1 = acc[ai][0][m][1];
#pragma unroll
            for (int e = 0; e < 4; ++e) { v0[e] = v0[e] * fsigmoid(v0[e]) * acc[ai][1][m][0][e]; v1[e] = v1[e] * fsigmoid(v1[e]) * acc[ai][1][m][1][e]; }
            *(u32x4*)(base + ro_) = pack8(v0, v1);
        ROWS_END(16u * DE * 2)
        ZERO_ACC(); } };
struct EpiMoe2 { static constexpr bool PERM = true; const int* blk; const int* list; const unsigned* cnt; bf16_t* Y0; bf16_t* Y1;
    __device__ __forceinline__ void operator()(AccRef acc, const Unit& u, int wr, int wc, int fr, int fq) const {
        const int e = u.tag, col0 = u.pn * BM + wc * 32 + 8 * fq, pbase = ((u.pm - __builtin_amdgcn_readfirstlane(blk[e])) << 8) + wr * 64 + fr, n_e = __builtin_amdgcn_readfirstlane((int)cnt[e]); const int* le = list + (size_t)e * T;
        ROWS_BEGIN((unsigned)pbase)
            const int pos = (int)ro_;
            if (pos < n_e) { const int entry = le[pos]; bf16_t* rowp = ((entry & 1) ? Y1 : Y0) + (size_t)(entry >> 1) * D + col0;
#pragma unroll
                for (int bj = 0; bj < 2; ++bj) *(u32x4*)(rowp + bj * HALF) = pack8(acc[ai][bj][m][0], acc[ai][bj][m][1]); }
        ROWS_END(16u)
        ZERO_ACC(); } };
#undef ROWS_BEGIN
#undef ROWS_END
#undef ZERO_ACC
}

__device__ __forceinline__ void fast_proj(const Ctx& c, int half, PG8_LAS unsigned char* lds, int tid) {
    pg8::SchedGrid S; S.nM = TH / 256; S.nN = NP / 256; S.G = gridDim.x; S.c = blockIdx.x; S.nt = D / 64; S.lda = D * 2; S.ldb = D * 2;
    S.A0 = (const char*)(wsp<bf16_t>(c, OFF_XB) + (size_t)half * TH * D); S.B0 = (const char*)wsp<bf16_t>(c, WT_IN);
    pg8::EpiProj E{wsp<bf16_t>(c, OFF_P)}; pg8::gemm_phase(lds, S, E, tid);
}
__device__ __forceinline__ void fast_gates(const Ctx& c, PG8_LAS unsigned char* lds, int tid) {
    pg8::SchedGrid S; S.nM = T / 256; S.nN = 3 * D / 256; S.G = gridDim.x; S.c = blockIdx.x; S.nt = D / 64; S.lda = D * 2; S.ldb = D * 2;
    S.A0 = (const char*)wsp<bf16_t>(c, OFF_XB); S.B0 = (const char*)(wsp<bf16_t>(c, WT_IN) + (size_t)NP * D);
    pg8::EpiGates E{wsp<bf16_t>(c, OFF_GATES)}; pg8::gemm_phase(lds, S, E, tid);
}
__device__ __forceinline__ void fast_merge(const Ctx& c, PG8_LAS unsigned char* lds, int tid) {
    pg8::SchedMerge S; S.nM = T / 256; S.nN = D / 256; S.G = gridDim.x; S.c = blockIdx.x; S.lda = OW * 2; S.ldb = OW * 2;
    S.A0 = (const char*)c.out; S.B0 = (const char*)wsp<bf16_t>(c, WT_A);
    pg8::EpiMerge E{wsp<bf16_t>(c, OFF_GATES), wsp<bf16_t>(c, OFF_MERGED)}; pg8::gemm_phase(lds, S, E, tid);
}
__device__ __forceinline__ void fast_wout(const Ctx& c, PG8_LAS unsigned char* lds, int tid) {
    pg8::SchedGrid S; S.nM = T / 256; S.nN = D / 256; S.G = gridDim.x; S.c = blockIdx.x; S.nt = D / 64; S.lda = D * 2; S.ldb = D * 2;
    S.A0 = (const char*)wsp<bf16_t>(c, OFF_MERGED); S.B0 = (const char*)wsp<bf16_t>(c, WT_OUT);
    pg8::EpiWout E{c.x, wsp<float>(c, OFF_H1)}; pg8::gemm_phase(lds, S, E, tid);
}
__device__ __forceinline__ void fast_moe1(const Ctx& c, PG8_LAS unsigned char* lds, int tid) {
    pg8::SchedMoe<true> S; S.G = gridDim.x; S.c = blockIdx.x; S.ncol = 2; S.nt = D / 64; S.blk = wsp<int>(c, OFF_SMALL) + SM_BLK; S.list = wsp<int>(c, OFF_LIST); S.cnt = wsp<unsigned>(c, OFF_CTL) + CW_CNT;
    S.A = (const char*)wsp<bf16_t>(c, OFF_X1B); S.B = (const char*)wsp<bf16_t>(c, OFF_WTGU); S.b_estride = (size_t)2 * DE * D * 2; S.b_pnstride = (size_t)256 * D * 2; S.lda = D * 2; S.ldb = D * 2;
    pg8::EpiMoe1 E{wsp<bf16_t>(c, OFF_HBUF)}; pg8::gemm_phase(lds, S, E, tid);
}
__device__ __forceinline__ void fast_moe2(const Ctx& c, PG8_LAS unsigned char* lds, int tid) {
    pg8::SchedMoe<false> S; S.G = gridDim.x; S.c = blockIdx.x; S.ncol = D / 256; S.nt = DE / 64; S.blk = wsp<int>(c, OFF_SMALL) + SM_BLK; S.list = wsp<int>(c, OFF_LIST); S.cnt = wsp<unsigned>(c, OFF_CTL) + CW_CNT;
    S.A = (const char*)wsp<bf16_t>(c, OFF_HBUF); S.B = (const char*)wsp<bf16_t>(c, OFF_WTDN); S.b_estride = (size_t)D * DE * 2; S.b_pnstride = (size_t)256 * DE * 2; S.lda = DE * 2; S.ldb = DE * 2;
    pg8::EpiMoe2 E{S.blk, S.list, S.cnt, wsp<bf16_t>(c, OFF_Y0), wsp<bf16_t>(c, OFF_Y1)}; pg8::gemm_phase(lds, S, E, tid);
}
#include <hip/hip_cooperative_groups.h>
namespace cg = cooperative_groups;
constexpr int NTHR = 512, LDS_BYTES = 147456;

template <class F> __device__ __forceinline__ void dev_elems_(const F& f, long n, int tid) {
    asm volatile("" : "+v"(tid));
    for (long i = (long)blockIdx.x * NTHR + tid; i < n; i += (long)gridDim.x * NTHR) f(i);
}
template <class G> __device__ __forceinline__ void dev_sgemm_(const G& g, int tid) {
    asm volatile("" : "+v"(tid));
    const int M = g.M(); const int lane = tid & 63, wid = tid >> 6; constexpr int ntn = G::N / 64;
    const long ntiles = (long)(M / 16) * ntn;
    for (long tile = (long)blockIdx.x * 8 + wid; tile < ntiles; tile += (long)gridDim.x * 8) {
        const int tm = (int)(tile / ntn), tn = (int)(tile % ntn), r0 = tm * 16, c0 = tn * 64;
        f32x4 acc[G::NBP][4], carry[4];
#pragma unroll
        for (int j = 0; j < 4; ++j) { carry[j] = (f32x4){0.f, 0.f, 0.f, 0.f};
#pragma unroll
            for (int w = 0; w < G::NBP; ++w) acc[w][j] = (f32x4){0.f, 0.f, 0.f, 0.f}; }
#pragma unroll
        for (int seg = 0; seg < G::NSEGS; ++seg) {
            const bf16_t* ar = g.arow(seg, r0 + (lane & 15)) + 8 * (lane >> 4); const bf16_t* br[G::NBP][4];
#pragma unroll
            for (int w = 0; w < G::NBP; ++w)
#pragma unroll
                for (int j = 0; j < 4; ++j) br[w][j] = g.brow(seg, r0, c0 + 16 * j + (lane & 15), w) + 8 * (lane >> 4);
            const int K = g.K(seg);
            for (int k0 = 0; k0 < K; k0 += 32) { const bf16x8 a = *(const bf16x8*)(ar + k0);
#pragma unroll
                for (int w = 0; w < G::NBP; ++w)
#pragma unroll
                    for (int j = 0; j < 4; ++j) { const bf16x8 b = *(const bf16x8*)(br[w][j] + k0); acc[w][j] = __builtin_amdgcn_mfma_f32_16x16x32_bf16(a, b, acc[w][j], 0, 0, 0); } }
#pragma unroll
            for (int j = 0; j < 4; ++j)
#pragma unroll
                for (int i = 0; i < 4; ++i) { float a = acc[0][j][i], cr = carry[j][i]; g.between(seg, r0 + (lane >> 4) * 4 + i, c0 + 16 * j + (lane & 15), a, cr); acc[0][j][i] = a; carry[j][i] = cr; }
        }
#pragma unroll
        for (int j = 0; j < 4; ++j)
#pragma unroll
            for (int i = 0; i < 4; ++i) g.store(r0 + (lane >> 4) * 4 + i, c0 + 16 * j + (lane & 15), acc[0][j][i], G::NBP == 2 ? acc[G::NBP - 1][j][i] : carry[j][i]);
    }
}

struct E_hg3q { Ctx c; int half; static constexpr long n = (long)BH * HB * NSEG * 128 * 4;
    __device__ __forceinline__ void operator()(long idx) const { const int kq = (int)(idx & 3), v = (int)((idx >> 2) & 127); const long r = idx >> 9; const int seg = (int)(r % NSEG), bhl = (int)(r / NSEG), h = bhl % HB, bl = bhl / HB;
        const bf16_t* P = wsp<bf16_t>(c, OFF_P); float st[32];
#pragma unroll
        for (int k = 0; k < 32; ++k) st[k] = wsp<float>(c, OFF_HG)[(((size_t)bhl * NSEG + seg) * 128 + kq * 32 + k) * 128 + v];
        for (int s = 0; s < 256; ++s) { const int tl = bl * S + seg * 256 + s; const bf16_t* pr = P + (size_t)tl * NP; const float iv = bf2f(pr[COLS_A + 2 * WB + h * 128 + v]); float o = 0.f;
#pragma unroll
            for (int k = 0; k < 32; ++k) { const int kk = kq * 32 + k; const float f = hg_f(c, pr, h * 128 + kk); st[k] = f * st[k] + (1.f - f) * iv; o += siluf_(bf2f(pr[COLS_A + h * 128 + kk])) * st[k]; }
            o += __shfl_xor(o, 1); o += __shfl_xor(o, 2);
            if (kq == 0) ((bf16_t*)c.out)[((size_t)half * TH + tl) * OW + WA + h * 128 + v] = f2bf(o); } } };

typedef const __attribute__((address_space(4))) Ctx* CtxK;
#if defined(__HIP_DEVICE_COMPILE__)
__device__ __forceinline__ Ctx load_ctx() { CtxK p = (CtxK)__builtin_amdgcn_kernarg_segment_ptr(); asm volatile("" : "+s"(p)); return *p; }
#else
__device__ inline Ctx load_ctx() { return Ctx(); }
#endif
#define PH_BEGIN { const Ctx c = load_ctx(); const int tid = wid_s * 64 + pg8::lane_id_opaque();
#define dev_elems(...) dev_elems_(__VA_ARGS__, tid)
#define dev_sgemm(...) dev_sgemm_(__VA_ARGS__, tid)
#define PH_END }

__global__ void __launch_bounds__(NTHR) mega(Ctx c_arg) {
    extern __shared__ __attribute__((aligned(16))) unsigned char lds_raw[];
    PG8_LAS unsigned char* lds = (PG8_LAS unsigned char*)lds_raw;
    cg::grid_group grid = cg::this_grid();
    const int wid_s = __builtin_amdgcn_readfirstlane((int)threadIdx.x >> 6);
    PH_BEGIN
    dev_elems(S0_xb{c}, S0_xb::n); dev_elems(S0_memb{c}, S0_memb::n); dev_elems(S0_small{c}, S0_small::n);
    dev_elems(S0_tr{c.w_in, wsp<bf16_t>(c, WT_IN), D, N_IN, (long)D * N_IN, D}, (long)D * N_IN);
    dev_elems(S0_tr{c.w_kv, wsp<bf16_t>(c, WT_KV), D, 1024, (long)D * 1024, D}, (long)D * 1024);
    dev_elems(S0_tr{c.w_a, wsp<bf16_t>(c, WT_A), WA, D, (long)D * WA, OW}, (long)D * WA);
    dev_elems(S0_tr{c.w_b, wsp<bf16_t>(c, WT_A) + WA, WB, D, (long)D * WB, OW}, (long)D * WB);
    dev_elems(S0_tr{c.w_c, wsp<bf16_t>(c, WT_A) + WA + WB, WC, D, (long)D * WC, OW}, (long)D * WC);
    dev_elems(S0_tr{c.w_out, wsp<bf16_t>(c, WT_OUT), D, D, (long)D * D, D}, (long)D * D);
    PH_END
    grid.sync();
#pragma unroll
    for (int half = 0; half < NHALF; ++half) {
        PH_BEGIN
        if (half == 0) dev_sgemm(G_memkv{c});
        fast_proj(c, half, lds, tid);
        PH_END
        grid.sync();
        PH_BEGIN
        dev_elems(E_hg1{c, half}, E_hg1::n); dev_elems(E_attnA{c, half}, E_attnA::n); dev_elems(E_attnC{c, half}, E_attnC::n);
        PH_END
        grid.sync();
        PH_BEGIN
        dev_elems(E_hg2{c}, E_hg2::n); dev_elems(E_combA{c, half}, E_combA::n);
        PH_END
        grid.sync();
        PH_BEGIN
        dev_elems(E_hg3q{c, half}, E_hg3q::n);
        PH_END
        grid.sync();
        PH_BEGIN
        dev_elems(E_hgnorm{c, half}, E_hgnorm::n);
        PH_END
        grid.sync();
    }
    PH_BEGIN
    dev_elems(S0_gu{c}, S0_gu::n); dev_elems(S0_dn{c}, S0_dn::n); fast_gates(c, lds, tid);
    PH_END
    grid.sync();
    PH_BEGIN
    fast_merge(c, lds, tid);
    PH_END
    grid.sync();
    PH_BEGIN
    fast_wout(c, lds, tid);
    PH_END
    grid.sync();
    PH_BEGIN
    dev_elems(E_ln1{c}, E_ln1::n);
    PH_END
    grid.sync();
    PH_BEGIN
    dev_elems(E_blk{c}, 1);
    PH_END
    grid.sync();
    PH_BEGIN
    fast_moe1(c, lds, tid);
    PH_END
    grid.sync();
    PH_BEGIN
    fast_moe2(c, lds, tid);
    PH_END
    grid.sync();
    PH_BEGIN
    dev_elems(E_ln2{c}, E_ln2::n);
    PH_END
}

extern "C" void kernel_launch(void* const* d_in, const int* in_sizes, int n_in, void* d_out, int out_size, void* d_ws, size_t ws_size, hipStream_t stream) {
    if (n_in != 22 || in_sizes[0] != T * D || out_size != T * D || ws_size < WS_END) { fprintf(stderr, "kernel_launch: unexpected shapes / workspace (%zu < %zu)\n", ws_size, (size_t)WS_END); return; }
    static int grid_blocks = 0;
    if (!grid_blocks) {
        int dev = 0, cus = 0, per_cu = 0;
        hipGetDevice(&dev); hipDeviceGetAttribute(&cus, hipDeviceAttributeMultiprocessorCount, dev);
        hipFuncSetAttribute((const void*)mega, hipFuncAttributeMaxDynamicSharedMemorySize, LDS_BYTES);
        hipOccupancyMaxActiveBlocksPerMultiprocessor(&per_cu, (const void*)mega, NTHR, LDS_BYTES);
        if (per_cu < 1) { fprintf(stderr, "kernel_launch: occupancy query says %d blocks/CU\n", per_cu); per_cu = 1; }
        if (per_cu > 1) per_cu = 1;
        grid_blocks = cus * per_cu;
    }
    Ctx c = make_ctx(d_in, d_out, d_ws);
    void* args[] = {&c};
    hipError_t e = hipLaunchCooperativeKernel((const void*)mega, dim3(grid_blocks), dim3(NTHR), args, LDS_BYTES, stream);
    if (e != hipSuccess) fprintf(stderr, "cooperative launch failed: %s (grid %d)\n", hipGetErrorString(e), grid_blocks);
}
```

```cpp
#ifdef HOST_TEST
#include <cmath>
#include <cstdint>
#include <cstdio>
#include <cstring>
#define HD
#define GLOBAL
#else
#include <hip/hip_runtime.h>
#include <cstdint>
#include <cstdio>
#include <cstring>
#include <cmath>
#define HD __host__ __device__ __forceinline__
#endif

#ifndef CFG_D
#define CFG_D 1024
#define CFG_B 4
#define CFG_S 8192
#endif
typedef unsigned short bf16_t;
constexpr int D = CFG_D, NBATCH = CFG_B, S = CFG_S, T = NBATCH * S;
constexpr int NHALF = 2, TH = T / NHALF, BH = NBATCH / NHALF;
constexpr int WA = 512, HB = D / 128, WB = D, WC = 512;
constexpr int COLS_A = 4608, COLS_B = 4 * WB, COLS_C = 512, COLS_G = 3 * D;
constexpr int NP = COLS_A + COLS_B + COLS_C, N_IN = NP + COLS_G;
constexpr int OW = WA + WB + WC;
constexpr int DE = D / 4, NE = 32, HBK = DE < 128 ? DE : 128;
constexpr int MEM = 256, NSEG = S / 256;
constexpr int MAXROWS = 2 * T + NE * 256;
constexpr float DN_ALPHA = 1.189207115002721f;
constexpr float LN_EPS = 1e-5f, RMS_EPS = 1e-6f;
constexpr float QK_SCALE = 0.08838834764831845f;

constexpr size_t MiB = 1u << 20;
constexpr size_t al(size_t x) { return (x + 4095) & ~(size_t)4095; }
constexpr size_t OFF_CTL = 0;
constexpr size_t OFF_SMALL = 1 * MiB;
constexpr size_t OFF_WT = 2 * MiB;
constexpr size_t WT_IN = OFF_WT, WT_KV = WT_IN + al((size_t)N_IN * D * 2), WT_A = WT_KV + al((size_t)1024 * D * 2),
                 WT_B = WT_A + al((size_t)D * WA * 2), WT_C = WT_B + al((size_t)D * WB * 2), WT_OUT = WT_C + al((size_t)D * WC * 2),
                 OFF_MEMB = WT_OUT + al((size_t)D * D * 2), OFF_MEMKV = OFF_MEMB + al((size_t)NBATCH * MEM * D * 2),
                 OFF_LIST = OFF_MEMKV + al((size_t)NBATCH * MEM * 1024 * 2), OFF_RW = OFF_LIST + al((size_t)NE * T * 4),
                 OFF_XB = OFF_RW + al((size_t)T * 2 * 4), OFF_P = OFF_XB + al((size_t)T * D * 2),
                 OFF_PART = OFF_P + al((size_t)TH * NP * 2), OFF_LSE = OFF_PART + al((size_t)3 * TH * WA * 2),
                 OFF_HG = OFF_LSE + al((size_t)3 * TH * 4 * 4), OFF_DSEG = OFF_HG + al((size_t)BH * HB * NSEG * 128 * 128 * 4),
                 WS_END = OFF_DSEG + al((size_t)BH * HB * NSEG * 128 * 4);
constexpr size_t OFF_GATES = OFF_P, OFF_H1 = OFF_P, OFF_X1B = OFF_P + al((size_t)T * D * 4),
                 OFF_WTGU = OFF_P + al((size_t)T * 3 * D * 2), OFF_WTDN = OFF_WTGU + al((size_t)NE * 2 * DE * D * 2),
                 OFF_HBUF = OFF_WTDN + al((size_t)NE * D * DE * 2), OFF_PEND = OFF_HBUF + al((size_t)MAXROWS * DE * 2);
constexpr size_t OFF_MERGED = OFF_XB, OFF_Y0 = OFF_XB, OFF_Y1 = OFF_PART;
static_assert(OFF_X1B + (size_t)T * D * 2 <= OFF_WTGU, "x1b inside dead gates region");
static_assert(OFF_PEND <= OFF_PART, "P-region overlays fit");
static_assert(OFF_Y1 + (size_t)T * D * 2 <= WS_END, "y1 fits in part+hg region");
constexpr int CW_CNT = 0;
constexpr int SM_BIAS = 0, SM_LB = 2048, SM_BLK = 2048 + 4096;

HD float bf2f(bf16_t v) { union { unsigned u; float f; } c; c.u = (unsigned)v << 16; return c.f; }
HD bf16_t f2bf(float f) { union { unsigned u; float f; } c; c.f = f; unsigned u = c.u; return (bf16_t)((u + 0x7fffu + ((u >> 16) & 1u)) >> 16); }
HD float sigmoidf_(float x) { return 1.0f / (1.0f + expf(-x)); }
HD float siluf_(float x) { return x / (1.0f + expf(-x)); }
HD int dil_of(int g) { return g == 0 ? 1 : (g == 1 ? 4 : 16); }
HD int perm_row(int tl, int g) { const int r = dil_of(g), bl = tl / S, s = tl % S; return bl * S + (s % r) * (S / r) + s / r; }

struct Ctx {
    const float *x, *mem, *rel_bias, *lb_logits, *w_in, *w_kv, *norm_g, *w_a, *w_b, *w_c, *w_out, *ln1_g, *ln1_b, *w_rg, *b_rg, *w_re, *b_re, *w_eg, *w_eu, *w_ed, *ln2_g, *ln2_b;
    float* out; unsigned char* ws;
};
#ifdef HOST_TEST
static const unsigned char T5_BUCKET[3][129] = {
#else
__device__ const unsigned char T5_BUCKET[3][129] = {
#endif
{0,1,2,3,4,5,6,7,8,9,10,11,12,13,14,15,16,16,16,16,16,16,17,17,17,17,17,17,17,17,18,18,18,18,18,18,18,18,18,18,19,19,19,19,19,19,19,19,19,19,19,19,19,19,20,20,20,20,20,20,20,20,20,20,20,20,20,20,20,20,20,20,20,21,21,21,21,21,21,21,21,21,21,21,21,21,21,21,21,21,21,21,21,21,21,21,21,21,21,22,22,22,22,22,22,22,22,22,22,22,22,22,22,22,22,22,22,22,22,22,22,22,22,22,22,22,22,22,22},
{0,4,8,12,16,16,17,17,18,18,19,19,19,19,20,20,20,20,20,21,21,21,21,21,21,22,22,22,22,22,22,22,22,22,23,23,23,23,23,23,23,23,23,23,23,23,24,24,24,24,24,24,24,24,24,24,24,24,24,24,24,24,25,25,25,25,25,25,25,25,25,25,25,25,25,25,25,25,25,25,25,25,25,26,26,26,26,26,26,26,26,26,26,26,26,26,26,26,26,26,26,26,26,26,26,26,26,26,26,26,26,26,26,27,27,27,27,27,27,27,27,27,27,27,27,27,27,27,27},
{0,16,18,19,20,21,21,22,22,23,23,23,24,24,24,24,25,25,25,25,25,26,26,26,26,26,26,26,26,27,27,27,27,27,27,27,27,27,27,28,28,28,28,28,28,28,28,28,28,28,28,28,29,29,29,29,29,29,29,29,29,29,29,29,29,29,29,29,29,29,30,30,30,30,30,30,30,30,30,30,30,30,30,30,30,30,30,30,30,30,30,30,30,30,30,31,31,31,31,31,31,31,31,31,31,31,31,31,31,31,31,31,31,31,31,31,31,31,31,31,31,31,31,31,31,31,31,31,31}};
template <class Tp> HD Tp* wsp(const Ctx& c, size_t off) { return (Tp*)(c.ws + off); }

#ifdef HOST_TEST
static inline unsigned atomic_inc_u32(unsigned* p) { unsigned r;
#pragma omp atomic capture
    { r = *p; *p += 1; }
    return r; }
#else
__device__ __forceinline__ unsigned atomic_inc_u32(unsigned* p) { return atomicAdd(p, 1u); }
#endif

struct S0_xb { Ctx c; static constexpr long n = (long)T * D;
    HD void operator()(long i) const { wsp<bf16_t>(c, OFF_XB)[i] = f2bf(c.x[i]); } };
struct S0_memb { Ctx c; static constexpr long n = (long)NBATCH * MEM * D;
    HD void operator()(long i) const { wsp<bf16_t>(c, OFF_MEMB)[i] = f2bf(c.mem[i]); } };
struct S0_tr { const float* W; bf16_t* Wt; int K, N; long n; int ldo;
    HD void operator()(long i) const { const int k = (int)(i % K); const long nn = i / K; Wt[(size_t)nn * ldo + k] = f2bf(W[(size_t)k * N + nn]); } };
struct S0_gu { Ctx c; static constexpr long n = (long)NE * 2 * DE * D;
    HD void operator()(long i) const { const int k = (int)(i % D); const long r = i / D; const int j = (int)(r % (2 * DE)), e = (int)(r / (2 * DE));
        const int u = j / (2 * HBK), w = j % (2 * HBK), hid = u * HBK + w % HBK, up = w / HBK;
        const float* src = up ? c.w_eu : c.w_eg; wsp<bf16_t>(c, OFF_WTGU)[i] = f2bf(src[((size_t)e * D + k) * DE + hid]); } };
struct S0_dn { Ctx c; static constexpr long n = (long)NE * D * DE;
    HD void operator()(long i) const { const int k = (int)(i % DE); const long r = i / DE; const int col = (int)(r % D), e = (int)(r / D);
        wsp<bf16_t>(c, OFF_WTDN)[i] = f2bf(c.w_ed[((size_t)e * DE + k) * D + col]); } };
struct S0_small { Ctx c; static constexpr long n = 12 * 129 + WB + 64;
    HD void operator()(long i) const { float* sm = wsp<float>(c, OFF_SMALL);
        if (i < 12 * 129) { const int gh = (int)(i / 129), u = (int)(i % 129), g = gh / 4; sm[SM_BIAS + i] = c.rel_bias[T5_BUCKET[g][u] * 12 + gh]; }
        else if (i < 12 * 129 + WB) { const int ch = (int)(i - 12 * 129); sm[SM_LB + ch] = sigmoidf_(c.lb_logits[ch] - c.lb_logits[WB + ch]); }
        else { const int j = (int)(i - 12 * 129 - WB); wsp<unsigned>(c, OFF_CTL)[j] = 0u; } } };

struct G_proj { Ctx c; int half; static constexpr int N = NP, NSEGS = 1, NBP = 1;
    HD int M() const { return TH; } HD int K(int) const { return D; }
    HD const bf16_t* arow(int, int row) const { return wsp<bf16_t>(c, OFF_XB) + ((size_t)half * TH + row) * D; }
    HD const bf16_t* brow(int, int, int col, int) const { return wsp<bf16_t>(c, WT_IN) + (size_t)col * D; }
    HD void between(int, int, int, float&, float&) const {}
    HD void store(int row, int col, float a, float) const { const int pr = col < COLS_A ? perm_row(row, col / 1536) : row; wsp<bf16_t>(c, OFF_P)[(size_t)pr * NP + col] = f2bf(a); } };
struct G_memkv { Ctx c; static constexpr int N = 1024, NSEGS = 1, NBP = 1;
    HD int M() const { return NBATCH * MEM; } HD int K(int) const { return D; }
    HD const bf16_t* arow(int, int row) const { return wsp<bf16_t>(c, OFF_MEMB) + (size_t)row * D; }
    HD const bf16_t* brow(int, int, int col, int) const { return wsp<bf16_t>(c, WT_KV) + (size_t)col * D; }
    HD void between(int, int, int, float&, float&) const {}
    HD void store(int row, int col, float a, float) const { wsp<bf16_t>(c, OFF_MEMKV)[(size_t)row * 1024 + col] = f2bf(a); } };
struct G_gates { Ctx c; static constexpr int N = 3 * D, NSEGS = 1, NBP = 1;
    HD int M() const { return T; } HD int K(int) const { return D; }
    HD const bf16_t* arow(int, int row) const { return wsp<bf16_t>(c, OFF_XB) + (size_t)row * D; }
    HD const bf16_t* brow(int, int, int col, int) const { return wsp<bf16_t>(c, WT_IN) + (size_t)(NP + col) * D; }
    HD void between(int, int, int, float&, float&) const {}
    HD void store(int row, int col, float a, float) const { wsp<bf16_t>(c, OFF_GATES)[((size_t)(col / D) * T + row) * D + col % D] = f2bf(sigmoidf_(a)); } };
struct G_merge { Ctx c; static constexpr int N = D, NSEGS = 3, NBP = 1;
    HD int M() const { return T; } HD int K(int s) const { return s == 1 ? WB : 512; }
    HD const bf16_t* arow(int s, int row) const { return (const bf16_t*)c.out + (size_t)row * OW + (s == 0 ? 0 : (s == 1 ? WA : WA + WB)); }
    HD const bf16_t* brow(int s, int, int col, int) const { return wsp<bf16_t>(c, WT_A) + (size_t)col * OW + (s == 0 ? 0 : (s == 1 ? WA : WA + WB)); }
    HD void between(int s, int row, int col, float& acc, float& carry) const { carry += bf2f(wsp<bf16_t>(c, OFF_GATES)[((size_t)s * T + row) * D + col]) * acc; acc = 0.f; }
    HD void store(int row, int col, float, float carry) const { wsp<bf16_t>(c, OFF_MERGED)[(size_t)row * D + col] = f2bf(carry); } };
struct G_wout { Ctx c; static constexpr int N = D, NSEGS = 1, NBP = 1;
    HD int M() const { return T; } HD int K(int) const { return D; }
    HD const bf16_t* arow(int, int row) const { return wsp<bf16_t>(c, OFF_MERGED) + (size_t)row * D; }
    HD const bf16_t* brow(int, int, int col, int) const { return wsp<bf16_t>(c, WT_OUT) + (size_t)col * D; }
    HD void between(int, int, int, float&, float&) const {}
    HD void store(int row, int col, float a, float) const { wsp<float>(c, OFF_H1)[(size_t)row * D + col] = DN_ALPHA * c.x[(size_t)row * D + col] + a; } };
struct MoeRow { int e, pos, valid, entry; };
HD MoeRow moe_row(const Ctx& c, int row) {
    const int* blk = wsp<int>(c, OFF_SMALL) + SM_BLK; const unsigned* cnt = wsp<unsigned>(c, OFF_CTL) + CW_CNT;
    MoeRow r; const int rb = row >> 8; r.e = blk[64 + rb]; r.pos = ((rb - blk[r.e]) << 8) + (row & 255); r.valid = r.pos < (int)cnt[r.e];
    r.entry = wsp<int>(c, OFF_LIST)[(size_t)r.e * T + (r.valid ? r.pos : 0)]; return r; }
HD int moe_rows_total(const Ctx& c) { return (wsp<int>(c, OFF_SMALL) + SM_BLK)[32] << 8; }
struct G_moe1 { Ctx c; static constexpr int N = DE, NSEGS = 1, NBP = 2;
    HD int M() const { return moe_rows_total(c); } HD int K(int) const { return D; }
    HD const bf16_t* arow(int, int row) const { const MoeRow r = moe_row(c, row); return wsp<bf16_t>(c, OFF_X1B) + (size_t)(r.entry >> 1) * D; }
    HD const bf16_t* brow(int, int row0, int col, int which) const { const int e = (wsp<int>(c, OFF_SMALL) + SM_BLK)[64 + (row0 >> 8)];
        return wsp<bf16_t>(c, OFF_WTGU) + ((size_t)e * 2 * DE + (col / HBK) * 2 * HBK + which * HBK + col % HBK) * D; }
    HD void between(int, int, int, float&, float&) const {}
    HD void store(int row, int col, float g, float u) const { wsp<bf16_t>(c, OFF_HBUF)[(size_t)row * DE + col] = f2bf(siluf_(g) * u); } };
struct G_moe2 { Ctx c; static constexpr int N = D, NSEGS = 1, NBP = 1;
    HD int M() const { return moe_rows_total(c); } HD int K(int) const { return DE; }
    HD const bf16_t* arow(int, int row) const { return wsp<bf16_t>(c, OFF_HBUF) + (size_t)row * DE; }
    HD const bf16_t* brow(int, int row0, int col, int) const { const int e = (wsp<int>(c, OFF_SMALL) + SM_BLK)[64 + (row0 >> 8)]; return wsp<bf16_t>(c, OFF_WTDN) + ((size_t)e * D + col) * DE; }
    HD void between(int, int, int, float&, float&) const {}
    HD void store(int row, int col, float a, float) const { const MoeRow r = moe_row(c, row); if (!r.valid) return;
        wsp<bf16_t>(c, (r.entry & 1) ? OFF_Y1 : OFF_Y0)[(size_t)(r.entry >> 1) * D + col] = f2bf(a); } };

struct u32x4_t { unsigned x, y, z, w; };
HD float bflo(unsigned u) { union { unsigned u; float f; } c; c.u = u << 16; return c.f; }
HD float bfhi(unsigned u) { union { unsigned u; float f; } c; c.u = u & 0xffff0000u; return c.f; }
HD float dot128(const bf16_t* a, const bf16_t* b) { float s = 0.f; const u32x4_t* pa = (const u32x4_t*)a; const u32x4_t* pb = (const u32x4_t*)b;
#ifndef HOST_TEST
#pragma unroll 4
#endif
    for (int d = 0; d < 16; ++d) { const u32x4_t ua = pa[d], ub = pb[d];
        s += bflo(ua.x) * bflo(ub.x) + bfhi(ua.x) * bfhi(ub.x) + bflo(ua.y) * bflo(ub.y) + bfhi(ua.y) * bfhi(ub.y) + bflo(ua.z) * bflo(ub.z) + bfhi(ua.z) * bfhi(ub.z) + bflo(ua.w) * bflo(ub.w) + bfhi(ua.w) * bfhi(ub.w); }
    return s; }
struct E_attnA { Ctx c; int half; static constexpr long n = (long)TH * 3 * 4 * 8;
    HD void operator()(long idx) const {
        const int p = (int)(idx & 7), h = (int)((idx >> 3) & 3); const long rest = idx >> 5; const int g = (int)(rest % 3), tl = (int)(rest / 3);
        const int r = dil_of(g), bl = tl / S, s = tl % S, cc = s % r, nq = s / r, L = S / r, base = bl * S + cc * L;
        const bf16_t* P = wsp<bf16_t>(c, OFF_P); const float* bias = wsp<float>(c, OFF_SMALL) + SM_BIAS + (g * 4 + h) * 129;
        const bf16_t* q = P + (size_t)(base + nq) * NP + g * 1536 + h * 128;
        float m = -INFINITY, l = 0.f, o[16];
#ifndef HOST_TEST
#pragma unroll
#endif
        for (int j = 0; j < 16; ++j) o[j] = 0.f;
        const int umax = nq < 128 ? nq : 128;
        for (int u = 0; u <= umax; ++u) {
            const bf16_t* kr = P + (size_t)(base + nq - u) * NP + g * 1536 + 512 + h * 128; const bf16_t* vr = kr + 512 + p * 16;
            const float sc = dot128(q, kr) * QK_SCALE + bias[u];
            const float mn = fmaxf(m, sc), a = expf(m - mn), pw = expf(sc - mn); l = l * a + pw; m = mn;
#ifndef HOST_TEST
#pragma unroll
#endif
            for (int j = 0; j < 16; ++j) o[j] = o[j] * a + pw * bf2f(vr[j]);
        }
        bf16_t* op = wsp<bf16_t>(c, OFF_PART) + ((size_t)g * TH + tl) * WA + h * 128 + p * 16; const float il = 1.f / l;
#ifndef HOST_TEST
#pragma unroll
#endif
        for (int j = 0; j < 16; ++j) op[j] = f2bf(o[j] * il);
        if (p == 0) wsp<float>(c, OFF_LSE)[((size_t)g * TH + tl) * 4 + h] = m + logf(l);
    } };
struct E_combA { Ctx c; int half; static constexpr long n = (long)TH * WA;
    HD void operator()(long idx) const { const int col = (int)(idx % WA), tl = (int)(idx / WA), h = col >> 7;
        const float* lse = wsp<float>(c, OFF_LSE); const bf16_t* part = wsp<bf16_t>(c, OFF_PART);
        const float l0 = lse[((size_t)0 * TH + tl) * 4 + h], l1 = lse[((size_t)1 * TH + tl) * 4 + h], l2 = lse[((size_t)2 * TH + tl) * 4 + h];
        const float mx = fmaxf(l0, fmaxf(l1, l2)), e0 = expf(l0 - mx), e1 = expf(l1 - mx), e2 = expf(l2 - mx), inv = 1.f / (e0 + e1 + e2);
        const float v = (e0 * bf2f(part[((size_t)0 * TH + tl) * WA + col]) + e1 * bf2f(part[((size_t)1 * TH + tl) * WA + col]) + e2 * bf2f(part[((size_t)2 * TH + tl) * WA + col])) * inv;
        ((bf16_t*)c.out)[((size_t)half * TH + tl) * OW + col] = f2bf(v); } };
struct E_attnC { Ctx c; int half; static constexpr long n = (long)TH * 4 * 8;
    HD void operator()(long idx) const { const int p = (int)(idx & 7), h = (int)((idx >> 3) & 3), tl = (int)(idx >> 5), b = half * BH + tl / S;
        const bf16_t* q = wsp<bf16_t>(c, OFF_P) + (size_t)tl * NP + COLS_A + COLS_B + h * 128; const bf16_t* kv = wsp<bf16_t>(c, OFF_MEMKV) + (size_t)b * MEM * 1024;
        float m = -INFINITY, l = 0.f, o[16];
#ifndef HOST_TEST
#pragma unroll
#endif
        for (int j = 0; j < 16; ++j) o[j] = 0.f;
        for (int k = 0; k < MEM; ++k) { const bf16_t* kr = kv + (size_t)k * 1024 + h * 128; const bf16_t* vr = kr + 512 + p * 16;
            const float sc = dot128(q, kr) * QK_SCALE; const float mn = fmaxf(m, sc), a = expf(m - mn), pw = expf(sc - mn); l = l * a + pw; m = mn;
#ifndef HOST_TEST
#pragma unroll
#endif
            for (int j = 0; j < 16; ++j) o[j] = o[j] * a + pw * bf2f(vr[j]); }
        bf16_t* op = (bf16_t*)c.out + ((size_t)half * TH + tl) * OW + WA + WB + h * 128 + p * 16; const float il = 1.f / l;
#ifndef HOST_TEST
#pragma unroll
#endif
        for (int j = 0; j < 16; ++j) op[j] = f2bf(o[j] * il); } };

HD float hg_f(const Ctx& c, const bf16_t* prow, int ch) { const float lb = wsp<float>(c, OFF_SMALL)[SM_LB + ch]; return lb + (1.f - lb) * sigmoidf_(bf2f(prow[COLS_A + WB + ch])); }
struct E_hg1 { Ctx c; int half; static constexpr long n = (long)BH * HB * NSEG * 128 * 128;
    HD void operator()(long idx) const { const int v = (int)(idx & 127), k = (int)((idx >> 7) & 127); const long r = idx >> 14; const int seg = (int)(r % NSEG), bhl = (int)(r / NSEG), h = bhl % HB, bl = bhl / HB;
        const bf16_t* P = wsp<bf16_t>(c, OFF_P); const int ch = h * 128 + k; float st = 0.f, dsum = 0.f;
        for (int s = 0; s < 256; ++s) { const bf16_t* pr = P + (size_t)(bl * S + seg * 256 + s) * NP; const float f = hg_f(c, pr, ch); st = f * st + (1.f - f) * bf2f(pr[COLS_A + 2 * WB + h * 128 + v]); dsum += logf(f); }
        wsp<float>(c, OFF_HG)[idx] = st; if (v == 0) wsp<float>(c, OFF_DSEG)[((size_t)bhl * NSEG + seg) * 128 + k] = dsum; } };
struct E_hg2 { Ctx c; static constexpr long n = (long)BH * HB * 128 * 128;
    HD void operator()(long idx) const { const int v = (int)(idx & 127), k = (int)((idx >> 7) & 127), bhl = (int)(idx >> 14); float run = 0.f;
        for (int seg = 0; seg < NSEG; ++seg) { float* p = wsp<float>(c, OFF_HG) + (((size_t)bhl * NSEG + seg) * 128 + k) * 128 + v; const float tmp = *p; *p = run;
            run = expf(wsp<float>(c, OFF_DSEG)[((size_t)bhl * NSEG + seg) * 128 + k]) * run + tmp; } } };
struct E_hg3 { Ctx c; int half; static constexpr long n = (long)BH * HB * NSEG * 128;
    HD void operator()(long idx) const { const int v = (int)(idx & 127); const long r = idx >> 7; const int seg = (int)(r % NSEG), bhl = (int)(r / NSEG), h = bhl % HB, bl = bhl / HB;
        const bf16_t* P = wsp<bf16_t>(c, OFF_P); float st[128];
#ifndef HOST_TEST
#pragma unroll
#endif
        for (int k = 0; k < 128; ++k) st[k] = wsp<float>(c, OFF_HG)[(((size_t)bhl * NSEG + seg) * 128 + k) * 128 + v];
        for (int s = 0; s < 256; ++s) { const int tl = bl * S + seg * 256 + s; const bf16_t* pr = P + (size_t)tl * NP; const float iv = bf2f(pr[COLS_A + 2 * WB + h * 128 + v]); float o = 0.f;
#ifndef HOST_TEST
#pragma unroll
#endif
            for (int k = 0; k < 128; ++k) { const float f = hg_f(c, pr, h * 128 + k); st[k] = f * st[k] + (1.f - f) * iv; o += siluf_(bf2f(pr[COLS_A + h * 128 + k])) * st[k]; }
            ((bf16_t*)c.out)[((size_t)half * TH + tl) * OW + WA + h * 128 + v] = f2bf(o); } } };
struct E_hgnorm { Ctx c; int half; static constexpr long n = (long)TH * HB;
    HD void operator()(long idx) const { const int h = (int)(idx % HB), tl = (int)(idx / HB); bf16_t* o = (bf16_t*)c.out + ((size_t)half * TH + tl) * OW + WA + h * 128;
        const bf16_t* pr = wsp<bf16_t>(c, OFF_P) + (size_t)tl * NP + COLS_A + 3 * WB + h * 128; float ss = 0.f;
        for (int v = 0; v < 128; ++v) { const float x = bf2f(o[v]); ss += x * x; }
        const float rs = 1.f / sqrtf(ss * (1.f / 128.f) + RMS_EPS);
        for (int v = 0; v < 128; ++v) o[v] = f2bf(bf2f(o[v]) * rs * c.norm_g[h * 128 + v] * siluf_(bf2f(pr[v]))); } };

struct E_ln1 { Ctx c; static constexpr long n = T;
    HD void operator()(long row) const { float* h1 = wsp<float>(c, OFF_H1) + (size_t)row * D; bf16_t* xb1 = wsp<bf16_t>(c, OFF_X1B) + (size_t)row * D;
        float mu = 0.f; for (int i = 0; i < D; ++i) mu += h1[i]; mu *= (1.f / D);
        float var = 0.f; for (int i = 0; i < D; ++i) { const float d = h1[i] - mu; var += d * d; } var *= (1.f / D); const float rs = 1.f / sqrtf(var + LN_EPS);
        float gl0 = c.b_rg[0], gl1 = c.b_rg[1], gl2 = c.b_rg[2], gl3 = c.b_rg[3];
        for (int i = 0; i < D; ++i) { const float v = (h1[i] - mu) * rs * c.ln1_g[i] + c.ln1_b[i]; h1[i] = v; xb1[i] = f2bf(v);
            gl0 += v * c.w_rg[i * 4 + 0]; gl1 += v * c.w_rg[i * 4 + 1]; gl2 += v * c.w_rg[i * 4 + 2]; gl3 += v * c.w_rg[i * 4 + 3]; }
        int gs = 0; float gm = gl0; if (gl1 > gm) { gm = gl1; gs = 1; } if (gl2 > gm) { gm = gl2; gs = 2; } if (gl3 > gm) { gm = gl3; gs = 3; }
        const float gp = 1.f / (expf(gl0 - gm) + expf(gl1 - gm) + expf(gl2 - gm) + expf(gl3 - gm));
        float v0 = -INFINITY, v1 = -INFINITY; int i0 = 0, i1 = 0;
        for (int j = 0; j < 8; ++j) { float el = c.b_re[gs * 8 + j]; for (int i = 0; i < D; ++i) el += h1[i] * c.w_re[i * 32 + gs * 8 + j];
            if (el > v0) { v1 = v0; i1 = i0; v0 = el; i0 = j; } else if (el > v1) { v1 = el; i1 = j; } }
        const float e1 = expf(v1 - v0), w0 = gp / (1.f + e1), w1 = gp * e1 / (1.f + e1);
        unsigned* cnt = wsp<unsigned>(c, OFF_CTL) + CW_CNT; int* list = wsp<int>(c, OFF_LIST); float* rw = wsp<float>(c, OFF_RW);
        const int ea = gs * 8 + i0, eb = gs * 8 + i1;
        list[(size_t)ea * T + atomic_inc_u32(cnt + ea)] = (int)row * 2 + 0; list[(size_t)eb * T + atomic_inc_u32(cnt + eb)] = (int)row * 2 + 1;
        rw[row * 2 + 0] = w0; rw[row * 2 + 1] = w1; } };
struct E_blk { Ctx c; static constexpr long n = 1;
    HD void operator()(long) const { int* blk = wsp<int>(c, OFF_SMALL) + SM_BLK; const unsigned* cnt = wsp<unsigned>(c, OFF_CTL) + CW_CNT; int acc = 0;
        for (int e = 0; e < NE; ++e) { blk[e] = acc; const int nb = ((int)cnt[e] + 255) >> 8; for (int j = 0; j < nb; ++j) blk[64 + acc + j] = e; acc += nb; } blk[32] = acc; } };
struct E_ln2 { Ctx c; static constexpr long n = T;
    HD void operator()(long row) const { const float* x1 = wsp<float>(c, OFF_H1) + (size_t)row * D; const bf16_t* y0 = wsp<bf16_t>(c, OFF_Y0) + (size_t)row * D; const bf16_t* y1 = wsp<bf16_t>(c, OFF_Y1) + (size_t)row * D;
        const float w0 = wsp<float>(c, OFF_RW)[row * 2], w1 = wsp<float>(c, OFF_RW)[row * 2 + 1]; float* o = c.out + (size_t)row * D;
        float mu = 0.f; for (int i = 0; i < D; ++i) { const float v = DN_ALPHA * x1[i] + w0 * bf2f(y0[i]) + w1 * bf2f(y1[i]); mu += v; } mu *= (1.f / D);
        float var = 0.f; for (int i = 0; i < D; ++i) { const float v = DN_ALPHA * x1[i] + w0 * bf2f(y0[i]) + w1 * bf2f(y1[i]) - mu; var += v * v; } var *= (1.f / D); const float rs = 1.f / sqrtf(var + LN_EPS);
        for (int i = 0; i < D; ++i) { const float v = DN_ALPHA * x1[i] + w0 * bf2f(y0[i]) + w1 * bf2f(y1[i]); o[i] = (v - mu) * rs * c.ln2_g[i] + c.ln2_b[i]; } } };
typedef short bf16x8 __attribute__((ext_vector_type(8)));
typedef float f32x4 __attribute__((ext_vector_type(4)));

template <class F> __global__ void __launch_bounds__(256) k_elems(F f, long n) {
    for (long i = (long)blockIdx.x * 256 + threadIdx.x; i < n; i += (long)gridDim.x * 256) f(i);
}
template <class F> __global__ void __launch_bounds__(64) k_elems64(F f, long n) {
    for (long i = (long)blockIdx.x * 64 + threadIdx.x; i < n; i += (long)gridDim.x * 64) f(i);
}
template <class G> __global__ void __launch_bounds__(256) k_sgemm(G g) {
    const int M = g.M(); const int lane = threadIdx.x & 63, wid = threadIdx.x >> 6; constexpr int ntn = G::N / 64;
    const long ntiles = (long)(M / 64) * ntn;
    for (long tile = blockIdx.x; tile < ntiles; tile += gridDim.x) {
        const int tm = (int)(tile / ntn), tn = (int)(tile % ntn), r0 = tm * 64 + wid * 16, c0 = tn * 64;
        f32x4 acc[G::NBP][4], carry[4];
#pragma unroll
        for (int j = 0; j < 4; ++j) { carry[j] = (f32x4){0.f, 0.f, 0.f, 0.f};
#pragma unroll
            for (int w = 0; w < G::NBP; ++w) acc[w][j] = (f32x4){0.f, 0.f, 0.f, 0.f}; }
#pragma unroll
        for (int seg = 0; seg < G::NSEGS; ++seg) {
            const bf16_t* ar = g.arow(seg, r0 + (lane & 15)) + 8 * (lane >> 4); const bf16_t* br[G::NBP][4];
#pragma unroll
            for (int w = 0; w < G::NBP; ++w)
#pragma unroll
                for (int j = 0; j < 4; ++j) br[w][j] = g.brow(seg, r0, c0 + 16 * j + (lane & 15), w) + 8 * (lane >> 4);
            const int K = g.K(seg);
            for (int k0 = 0; k0 < K; k0 += 32) { const bf16x8 a = *(const bf16x8*)(ar + k0);
#pragma unroll
                for (int w = 0; w < G::NBP; ++w)
#pragma unroll
                    for (int j = 0; j < 4; ++j) { const bf16x8 b = *(const bf16x8*)(br[w][j] + k0); acc[w][j] = __builtin_amdgcn_mfma_f32_16x16x32_bf16(a, b, acc[w][j], 0, 0, 0); } }
#pragma unroll
            for (int j = 0; j < 4; ++j)
#pragma unroll
                for (int i = 0; i < 4; ++i) { float a = acc[0][j][i], cr = carry[j][i]; g.between(seg, r0 + (lane >> 4) * 4 + i, c0 + 16 * j + (lane & 15), a, cr); acc[0][j][i] = a; carry[j][i] = cr; }
        }
#pragma unroll
        for (int j = 0; j < 4; ++j)
#pragma unroll
            for (int i = 0; i < 4; ++i) g.store(r0 + (lane >> 4) * 4 + i, c0 + 16 * j + (lane & 15), acc[0][j][i], G::NBP == 2 ? acc[G::NBP - 1][j][i] : carry[j][i]);
    }
}
template <class F> static void launch_elems(const F& f, long n, hipStream_t st) { long nb = (n + 255) / 256; if (nb > 32768) nb = 32768; if (nb < 1) nb = 1; hipLaunchKernelGGL(k_elems<F>, dim3((unsigned)nb), dim3(256), 0, st, f, n); }
template <class F> static void launch_elems64(const F& f, long n, hipStream_t st) { long nb = (n + 63) / 64; if (nb > 65536) nb = 65536; hipLaunchKernelGGL(k_elems64<F>, dim3((unsigned)nb), dim3(64), 0, st, f, n); }
template <class G> static void launch_sgemm(const G& g, hipStream_t st) { hipLaunchKernelGGL(k_sgemm<G>, dim3(4096), dim3(256), 0, st, g); }

static Ctx make_ctx(void* const* d_in, void* d_out, void* d_ws) {
    Ctx c; memset(&c, 0, sizeof(c)); const float** ip = (const float**)&c; for (int i = 0; i < 22; ++i) ip[i] = (const float*)d_in[i];
    c.out = (float*)d_out; c.ws = (unsigned char*)d_ws; return c;
}
static void v1_stage0(Ctx c, hipStream_t st) {
    launch_elems(S0_xb{c}, S0_xb::n, st); launch_elems(S0_memb{c}, S0_memb::n, st); launch_elems(S0_small{c}, S0_small::n, st);
    launch_elems(S0_tr{c.w_in, wsp<bf16_t>(c, WT_IN), D, N_IN, (long)D * N_IN, D}, (long)D * N_IN, st);
    launch_elems(S0_tr{c.w_kv, wsp<bf16_t>(c, WT_KV), D, 1024, (long)D * 1024, D}, (long)D * 1024, st);
    launch_elems(S0_tr{c.w_a, wsp<bf16_t>(c, WT_A), WA, D, (long)D * WA, OW}, (long)D * WA, st);
    launch_elems(S0_tr{c.w_b, wsp<bf16_t>(c, WT_A) + WA, WB, D, (long)D * WB, OW}, (long)D * WB, st);
    launch_elems(S0_tr{c.w_c, wsp<bf16_t>(c, WT_A) + WA + WB, WC, D, (long)D * WC, OW}, (long)D * WC, st);
    launch_elems(S0_tr{c.w_out, wsp<bf16_t>(c, WT_OUT), D, D, (long)D * D, D}, (long)D * D, st);
}
static void v1_proj(Ctx c, int half, hipStream_t st) { if (half == 0) launch_sgemm(G_memkv{c}, st); launch_sgemm(G_proj{c, half}, st); }
static void v1_mixers(Ctx c, int half, hipStream_t st) {
    launch_elems(E_hg1{c, half}, E_hg1::n, st); launch_elems(E_hg2{c}, E_hg2::n, st);
    launch_elems(E_attnA{c, half}, E_attnA::n, st); launch_elems(E_attnC{c, half}, E_attnC::n, st);
    launch_elems64(E_hg3{c, half}, E_hg3::n, st); launch_elems(E_hgnorm{c, half}, E_hgnorm::n, st); launch_elems(E_combA{c, half}, E_combA::n, st);
}
static void v1_expw(Ctx c, hipStream_t st) { launch_elems(S0_gu{c}, S0_gu::n, st); launch_elems(S0_dn{c}, S0_dn::n, st); }
static void v1_gates(Ctx c, hipStream_t st) { launch_sgemm(G_gates{c}, st); }
static void v1_merge(Ctx c, hipStream_t st) { launch_sgemm(G_merge{c}, st); }
static void v1_wout(Ctx c, hipStream_t st) { launch_sgemm(G_wout{c}, st); }
static void v1_ln1(Ctx c, hipStream_t st) { launch_elems(E_ln1{c}, E_ln1::n, st); launch_elems(E_blk{c}, 1, st); }
static void v1_moe1(Ctx c, hipStream_t st) { launch_sgemm(G_moe1{c}, st); }
static void v1_moe2(Ctx c, hipStream_t st) { launch_sgemm(G_moe2{c}, st); }
static void v1_ln2(Ctx c, hipStream_t st) { launch_elems(E_ln2{c}, E_ln2::n, st); }
namespace pg8 {
#define PG8_LAS __attribute__((address_space(3)))
typedef unsigned u32x4 __attribute__((ext_vector_type(4)));
constexpr int BM = 256, BK = 64, HALF = 128, HTB = HALF * BK * 2, STAGE_BYTES = 8 * HTB, NXCD = 8, WGM = 8;
__host__ __device__ __forceinline__ int lds_byte(int r, int c) { const int st = (r >> 4) * 2 + (c >> 5), rr = r & 15, cc = c & 31, ob = rr * 64 + cc * 2; return st * 1024 + (ob ^ (((ob >> 9) & 1) << 5)); }
__host__ __device__ __forceinline__ void stage_rc(int b, int& R, int& C) { const int st = b / 1024, sb = b % 1024, swz = sb ^ (((sb >> 9) & 1) << 5); R = (st >> 1) * 16 + swz / 64; C = (st & 1) * 32 + (swz % 64) / 2; }
__host__ __device__ __forceinline__ int perm32(int rho) { const int n = rho >> 4, i = rho & 15; return 8 * (i >> 2) + 4 * n + (i & 3); }
__device__ __forceinline__ unsigned cvt_pk_bf16(float lo, float hi) { unsigned r; asm volatile("v_cvt_pk_bf16_f32 %0, %1, %2" : "=v"(r) : "v"(lo), "v"(hi)); return r; }

__device__ __forceinline__ int lane_id_opaque() { int l; asm volatile("v_mbcnt_lo_u32_b32 %0, -1, 0\n\tv_mbcnt_hi_u32_b32 %0, -1, %0" : "=v"(l)); return l; }
struct Unit { const char* A; const char* B; int nt, pm, pn, tag; };
__device__ __forceinline__ void tile_of(int L, int nM, int nN, int& pm, int& pn) {
    const int nwg = nM * nN; int wgid = L; { const int q = nwg / NXCD, r = nwg % NXCD, xcd = wgid % NXCD, off = wgid / NXCD; wgid = (xcd < r ? xcd * (q + 1) : r * (q + 1) + (xcd - r) * q) + off; }
    const int nig = WGM * nN, gid = wgid / nig, fm = gid * WGM, gsz = (nM - fm) < WGM ? (nM - fm) : WGM;
    pm = fm + ((wgid % nig) % gsz); pn = (wgid % nig) / gsz;
}
template <class Epi, class Sched>
__device__ __forceinline__ void gemm_phase(PG8_LAS unsigned char* lds, const Sched& S, const Epi& E, int tid) {
    constexpr bool GA = Sched::GATHER;
    asm volatile("" : "+v"(tid));
    const int wid = __builtin_amdgcn_readfirstlane(tid >> 6), lane = tid & 63, wr = wid >> 2, wc = wid & 3, fr = lane & 15, fq = lane >> 4;
    const unsigned lda = S.lda, ldb = S.ldb;
    int sR[2]; unsigned voffA[2], voffB[2];
#pragma unroll
    for (int i = 0; i < 2; ++i) { int R, C; stage_rc(tid * 16 + i * 8192, R, C); sR[i] = R; const int Rb = Epi::PERM ? ((R & ~31) + perm32(R & 31)) : R;
        voffA[i] = (GA ? 0u : (unsigned)R * lda) + (unsigned)C * 2u; voffB[i] = (unsigned)Rb * ldb + (unsigned)C * 2u; }
    const size_t kstep = (size_t)(BK * 2), hstepA = (size_t)HALF * lda, hstepB = (size_t)HALF * ldb;
    const unsigned ldsw = (unsigned)wid * 1024u;
    const int aoff = lds_byte(wr * 64 + fr, fq * 8), boff = lds_byte(wc * 32 + fr, fq * 8);
#define PG8_SA(b, h) (((b) * 2 + (h)) * HTB)
#define PG8_SB(b, h) ((4 + (b) * 2 + (h)) * HTB)
#define PG8_STAGE(bufoff, gbase, voff) do { _Pragma("unroll") for (int _i = 0; _i < 2; ++_i) \
        __builtin_amdgcn_global_load_lds((const unsigned*)((const char*)(gbase) + (voff)[_i]), (PG8_LAS unsigned*)(lds + (bufoff) + ldsw + _i * 8192), 16, 0, 0); } while (0)
#define PG8_STAGE_A(bufoff, gbase, h, tk) do { if constexpr (GA) { unsigned _o[2]; _Pragma("unroll") for (int _i = 0; _i < 2; ++_i) _o[_i] = (((tk)[_i] >> (16 * (h))) & 0xffffu) * lda + voffA[_i]; PG8_STAGE(bufoff, gbase, _o); } \
        else { PG8_STAGE(bufoff, (gbase) + (h) * hstepA, voffA); } } while (0)
#define PG8_LDA(dst, b, h) do { _Pragma("unroll") for (int m = 0; m < 4; ++m) _Pragma("unroll") for (int k = 0; k < 2; ++k) dst[m][k] = *(const PG8_LAS bf16x8*)(lds + PG8_SA(b, h) + aoff + m * 2048 + k * 1024); } while (0)
#define PG8_LDB(dst, b, h) do { _Pragma("unroll") for (int n = 0; n < 2; ++n) _Pragma("unroll") for (int k = 0; k < 2; ++k) dst[n][k] = *(const PG8_LAS bf16x8*)(lds + PG8_SB(b, h) + boff + n * 2048 + k * 1024); } while (0)
#define PG8_MMA(ai, bj, At, Bt) do { __builtin_amdgcn_s_setprio(1); _Pragma("unroll") for (int m = 0; m < 4; ++m) _Pragma("unroll") for (int n = 0; n < 2; ++n) _Pragma("unroll") for (int k = 0; k < 2; ++k) \
        acc[ai][bj][m][n] = __builtin_amdgcn_mfma_f32_16x16x32_bf16(Bt[n][k], At[m][k], acc[ai][bj][m][n], 0, 0, 0); __builtin_amdgcn_s_setprio(0); } while (0)
#define PG8_WAIT_V(n) asm volatile("s_waitcnt vmcnt(" #n ")" ::: "memory")
#define PG8_WAIT_L(n) asm volatile("s_waitcnt lgkmcnt(" #n ")" ::: "memory")
#define PG8_BAR __builtin_amdgcn_s_barrier()
#define PG8_SCHED __builtin_amdgcn_sched_barrier(0)
#define PG8_TOKS(u, tk) do { if constexpr (GA) { _Pragma("unroll") for (int _i = 0; _i < 2; ++_i) tk[_i] = S.a_row(u, sR[_i]) | (S.a_row(u, sR[_i] + HALF) << 16); } } while (0)
    Unit cur, nxt; int ui = 0;
    if (!S.next(0, cur)) return;
    f32x4 acc[2][2][4][2];
#pragma unroll
    for (int a = 0; a < 2; ++a)
#pragma unroll
        for (int b = 0; b < 2; ++b)
#pragma unroll
            for (int m = 0; m < 4; ++m)
#pragma unroll
                for (int n = 0; n < 2; ++n) acc[a][b][m][n] = (f32x4){0.f, 0.f, 0.f, 0.f};
    bf16x8 At[4][2], B0[2][2], B1[2][2];
    unsigned ctk[2] = {0u, 0u}, ntk[2] = {0u, 0u};
    PG8_TOKS(cur, ctk);
    const char* cA = cur.A; const char* cB = cur.B;
    PG8_STAGE(PG8_SB(0, 0), cB, voffB); PG8_STAGE(PG8_SB(0, 1), cB + hstepB, voffB); PG8_STAGE_A(PG8_SA(0, 0), cA, 0, ctk); PG8_STAGE_A(PG8_SA(0, 1), cA, 1, ctk);
    if (wr == 1) PG8_BAR;
    PG8_WAIT_V(2); PG8_BAR;
    PG8_STAGE(PG8_SB(1, 0), cB + kstep, voffB); PG8_STAGE_A(PG8_SA(1, 0), cA + kstep, 0, ctk); PG8_STAGE(PG8_SB(1, 1), cB + hstepB + kstep, voffB);
    PG8_WAIT_V(6); PG8_BAR;
    for (;;) {
        const bool has_next = S.next(ui + 1, nxt);
        const char* nA = cA; const char* nB = cB;
        if constexpr (GA) { ntk[0] = ctk[0]; ntk[1] = ctk[1]; }
        if (has_next) { nA = nxt.A; nB = nxt.B; PG8_TOKS(nxt, ntk); }
        const int nt = cur.nt;
#define PG8_TRIP(a1, a2, b2, tk2) do { const char* a3 = (a2) + kstep; const char* b3 = (b2) + kstep; \
            PG8_LDB(B0, 0, 0); PG8_LDB(B1, 0, 1); PG8_SCHED; PG8_LDA(At, 0, 0); PG8_STAGE_A(PG8_SA(1, 1), a1, 1, ctk); \
            PG8_WAIT_V(8); PG8_WAIT_L(0); PG8_BAR; PG8_MMA(0, 0, At, B0); PG8_MMA(0, 1, At, B1); PG8_BAR; PG8_SCHED; \
            PG8_LDA(At, 0, 1); PG8_STAGE(PG8_SB(0, 0), b2, voffB); PG8_STAGE(PG8_SB(0, 1), (b2) + hstepB, voffB); PG8_STAGE_A(PG8_SA(0, 0), a2, 0, tk2); \
            PG8_WAIT_V(8); PG8_WAIT_L(0); PG8_BAR; PG8_MMA(1, 0, At, B0); PG8_MMA(1, 1, At, B1); PG8_BAR; PG8_SCHED; \
            PG8_LDB(B0, 1, 0); PG8_LDB(B1, 1, 1); PG8_SCHED; PG8_LDA(At, 1, 0); PG8_STAGE_A(PG8_SA(0, 1), a2, 1, tk2); \
            PG8_WAIT_V(8); PG8_WAIT_L(0); PG8_BAR; PG8_MMA(0, 0, At, B0); PG8_MMA(0, 1, At, B1); PG8_BAR; PG8_SCHED; \
            PG8_LDA(At, 1, 1); PG8_STAGE(PG8_SB(1, 0), b3, voffB); PG8_STAGE(PG8_SB(1, 1), b3 + hstepB, voffB); PG8_STAGE_A(PG8_SA(1, 0), a3, 0, tk2); \
            PG8_WAIT_V(8); PG8_WAIT_L(0); PG8_BAR; PG8_MMA(1, 0, At, B0); PG8_MMA(1, 1, At, B1); PG8_BAR; PG8_SCHED; } while (0)
        for (int t = 0; t < nt - 2; t += 2) { const char* a1 = cA + (size_t)(t + 1) * kstep; const char* a2 = cA + (size_t)(t + 2) * kstep; const char* b2 = cB + (size_t)(t + 2) * kstep;
            PG8_TRIP(a1, a2, b2, ctk); }
        { const char* a1 = cA + (size_t)(nt - 1) * kstep; PG8_TRIP(a1, nA, nB, ntk); }
#undef PG8_TRIP
        if (wr == 0) PG8_BAR;
        { const int el = lane_id_opaque(); E(acc, cur, wr, wc, el & 15, el >> 4); }
        if (!has_next) break;
        cur = nxt; cA = nA; cB = nB;
        if constexpr (GA) { ctk[0] = ntk[0]; ctk[1] = ntk[1]; }
        ++ui;
        if (wr == 1) PG8_BAR;
    }
    PG8_WAIT_V(0);
    PG8_BAR;
#undef PG8_SA
#undef PG8_SB
#undef PG8_STAGE
#undef PG8_STAGE_A
#undef PG8_LDA
#undef PG8_LDB
#undef PG8_MMA
#undef PG8_WAIT_V
#undef PG8_WAIT_L
#undef PG8_BAR
#undef PG8_SCHED
#undef PG8_TOKS
}
}
namespace pg8 {
#define ZERO_ACC() do { _Pragma("unroll") for (int a_ = 0; a_ < 2; ++a_) _Pragma("unroll") for (int b_ = 0; b_ < 2; ++b_) _Pragma("unroll") for (int m_ = 0; m_ < 4; ++m_) _Pragma("unroll") for (int n_ = 0; n_ < 2; ++n_) acc[a_][b_][m_][n_] = (f32x4){0.f, 0.f, 0.f, 0.f}; } while (0)
typedef f32x4 (&AccRef)[2][2][4][2];
__device__ __forceinline__ u32x4 pack8(f32x4 v0, f32x4 v1) { u32x4 w; w.x = cvt_pk_bf16(v0[0], v0[1]); w.y = cvt_pk_bf16(v0[2], v0[3]); w.z = cvt_pk_bf16(v1[0], v1[1]); w.w = cvt_pk_bf16(v1[2], v1[3]); return w; }
__device__ __forceinline__ void unpack8(u32x4 w, f32x4& v0, f32x4& v1) { v0 = (f32x4){bflo(w.x), bfhi(w.x), bflo(w.y), bfhi(w.y)}; v1 = (f32x4){bflo(w.z), bfhi(w.z), bflo(w.w), bfhi(w.w)}; }
__device__ __forceinline__ float fsigmoid(float x) { return __builtin_amdgcn_rcpf(1.f + __expf(-x)); }

struct SchedGrid {
    static constexpr bool GATHER = false; unsigned lda, ldb;
    int nM, nN, G, c, nt; const char *A0, *B0;
    __device__ __forceinline__ bool next(int i, Unit& u) const { const long L = (long)i * G + c; if (L >= (long)nM * nN) return false;
        int pm, pn; tile_of((int)L, nM, nN, pm, pn); u.pm = pm; u.pn = pn; u.tag = 0; u.nt = nt;
        u.A = A0 + (size_t)pm * BM * lda; u.B = B0 + (size_t)pn * BM * ldb; return true; }
};
struct SchedMerge {
    static constexpr bool GATHER = false; unsigned lda, ldb;
    int nM, nN, G, c; const char *A0, *B0;
    __device__ __forceinline__ bool next(int i, Unit& u) const { const int r = i / 3, s = i - r * 3; const long L = (long)r * G + c; if (L >= (long)nM * nN) return false;
        int pm, pn; tile_of((int)L, nM, nN, pm, pn); u.pm = pm; u.pn = pn; u.tag = s; u.nt = (s == 1 ? WB : WA) / BK;
        const size_t so = (size_t)((s > 0 ? WA : 0) + (s > 1 ? WB : 0)) * 2;
        u.A = A0 + (size_t)pm * BM * lda + so; u.B = B0 + (size_t)pn * BM * ldb + so; return true; }
};
#define ROWS_BEGIN(off0) { unsigned ro_ = (off0); _Pragma("unroll") for (int ai = 0; ai < 2; ++ai) { _Pragma("unroll") for (int m = 0; m < 4; ++m) {
#define ROWS_END(step16) ro_ += (m == 3 ? 5u : 1u) * (step16); asm volatile("" : "+v"(ro_) :: "memory"); } } }
struct EpiProj { static constexpr bool PERM = true; bf16_t* P;
    __device__ __forceinline__ void operator()(AccRef acc, const Unit& u, int wr, int wc, int fr, int fq) const {
        const int g = u.pn < 18 ? u.pn / 6 : -1; const int col0 = u.pn * BM + wc * 32 + 8 * fq; const int r0 = u.pm * BM + wr * 64 + fr;
        const int pr0 = g >= 0 ? perm_row(r0, g) : r0; const unsigned step16 = (unsigned)(16 >> (g <= 0 ? 0 : 2 * g)) * (NP * 2);
        char* base = (char*)P;
        ROWS_BEGIN((unsigned)pr0 * (NP * 2) + (unsigned)col0 * 2)
#pragma unroll
            for (int bj = 0; bj < 2; ++bj) *(u32x4*)(base + ro_ + bj * (HALF * 2)) = pack8(acc[ai][bj][m][0], acc[ai][bj][m][1]);
        ROWS_END(step16)
        ZERO_ACC(); } };
struct EpiGates { static constexpr bool PERM = true; bf16_t* Gt;
    __device__ __forceinline__ void operator()(AccRef acc, const Unit& u, int wr, int wc, int fr, int fq) const {
        const int pl = u.pn / (D / BM), col0 = (u.pn % (D / BM)) * BM + wc * 32 + 8 * fq, r0 = u.pm * BM + wr * 64 + fr; char* base = (char*)Gt + (size_t)pl * T * D * 2;
        ROWS_BEGIN((unsigned)r0 * (D * 2) + (unsigned)col0 * 2)
#pragma unroll
            for (int bj = 0; bj < 2; ++bj) { f32x4 v0 = acc[ai][bj][m][0], v1 = acc[ai][bj][m][1];
#pragma unroll
                for (int e = 0; e < 4; ++e) { v0[e] = fsigmoid(v0[e]); v1[e] = fsigmoid(v1[e]); }
                *(u32x4*)(base + ro_ + bj * (HALF * 2)) = pack8(v0, v1); }
        ROWS_END(16u * D * 2)
        ZERO_ACC(); } };
struct EpiMerge { static constexpr bool PERM = true; const bf16_t* Gt; bf16_t* Mg;
    __device__ __forceinline__ void operator()(AccRef acc, const Unit& u, int wr, int wc, int fr, int fq) const {
        const int s = u.tag; const int col0 = u.pn * BM + wc * 32 + 8 * fq, r0 = u.pm * BM + wr * 64 + fr; const char* gbase = (const char*)Gt + (size_t)s * T * D * 2; char* mbase = (char*)Mg;
        ROWS_BEGIN((unsigned)r0 * (D * 2) + (unsigned)col0 * 2)
#pragma unroll
            for (int bj = 0; bj < 2; ++bj) { f32x4 g0, g1; unpack8(*(const u32x4*)(gbase + ro_ + bj * (HALF * 2)), g0, g1);
                if (s < 2) { f32x4 h0, h1; unpack8(*(const u32x4*)(gbase + (size_t)T * D * 2 + ro_ + bj * (HALF * 2)), h0, h1);
#pragma unroll
                    for (int e = 0; e < 4; ++e) { g0[e] *= __builtin_amdgcn_rcpf(fmaxf(h0[e], 1e-20f)); g1[e] *= __builtin_amdgcn_rcpf(fmaxf(h1[e], 1e-20f)); } }
                acc[ai][bj][m][0] *= g0; acc[ai][bj][m][1] *= g1;
                if (s == 2) *(u32x4*)(mbase + ro_ + bj * (HALF * 2)) = pack8(acc[ai][bj][m][0], acc[ai][bj][m][1]); }
        ROWS_END(16u * D * 2)
        if (s == 2) ZERO_ACC(); } };
struct EpiWout { static constexpr bool PERM = false; const float* X; float* H1;
    __device__ __forceinline__ void operator()(AccRef acc, const Unit& u, int wr, int wc, int fr, int fq) const {
        const int col0 = u.pn * BM + wc * 32 + 4 * fq, r0 = u.pm * BM + wr * 64 + fr; const char* xb_ = (const char*)X; char* hb_ = (char*)H1;
        ROWS_BEGIN((unsigned)r0 * (D * 4) + (unsigned)col0 * 4)
#pragma unroll
            for (int bj = 0; bj < 2; ++bj)
#pragma unroll
                for (int n = 0; n < 2; ++n) { const f32x4 xv = *(const f32x4*)(xb_ + ro_ + (bj * HALF + n * 16) * 4); *(f32x4*)(hb_ + ro_ + (bj * HALF + n * 16) * 4) = xv * DN_ALPHA + acc[ai][bj][m][n]; }
        ROWS_END(16u * D * 4)
        ZERO_ACC(); } };
template <bool GA> struct SchedMoe {
    static constexpr bool GATHER = GA; unsigned lda, ldb;
    int G, c, ncol, nt; const int* blk; const int* list; const unsigned* cnt; const char* A; const char* B; size_t b_estride, b_pnstride;
    __device__ __forceinline__ bool next(int i, Unit& u) const { const long L = (long)i * G + c; const int nblk = __builtin_amdgcn_readfirstlane(blk[32]); if (L >= (long)nblk * ncol) return false;
        const int rb = (int)(L / ncol), pn = (int)(L % ncol), e = __builtin_amdgcn_readfirstlane(blk[64 + rb]); u.pm = rb; u.pn = pn; u.tag = e; u.nt = nt;
        u.A = GA ? A : A + (size_t)rb * BM * lda; u.B = B + (size_t)e * b_estride + (size_t)pn * b_pnstride; return true; }
    __device__ __forceinline__ unsigned a_row(const Unit& u, int row) const {
        const int e = u.tag, pos = ((u.pm - __builtin_amdgcn_readfirstlane(blk[e])) << 8) + row; const int entry = list[(size_t)e * T + (pos < __builtin_amdgcn_readfirstlane((int)cnt[e]) ? pos : 0)]; return (unsigned)(entry >> 1); }
};
struct EpiMoe1 { static constexpr bool PERM = true; bf16_t* Hb;
    __device__ __forceinline__ void operator()(AccRef acc, const Unit& u, int wr, int wc, int fr, int fq) const {
        const int col0 = u.pn * HALF + wc * 32 + 8 * fq, r0 = u.pm * BM + wr * 64 + fr; char* base = (char*)Hb;
        ROWS_BEGIN((unsigned)r0 * (DE * 2) + (unsigned)col0 * 2)
            f32x4 v0 = acc[ai][0][m][0], v1 = acc[ai][0][m][1];
#pragma unroll
            for (int e = 0; e < 4; ++e) { v0[e] = v0[e] * fsigmoid(v0[e]) * acc[ai][1][m][0][e]; v1[e] = v1[e] * fsigmoid(v1[e]) * acc[ai][1][m][1][e]; }
            *(u32x4*)(base + ro_) = pack8(v0, v1);
        ROWS_END(16u * DE * 2)
        ZERO_ACC(); } };
struct EpiMoe2 { static constexpr bool PERM = true; const int* blk; const int* list; const unsigned* cnt; bf16_t* Y0; bf16_t* Y1;
    __device__ __forceinline__ void operator()(AccRef acc, const Unit& u, int wr, int wc, int fr, int fq) const {
        const int e = u.tag, col0 = u.pn * BM + wc * 32 + 8 * fq, pbase = ((u.pm - __builtin_amdgcn_readfirstlane(blk[e])) << 8) + wr * 64 + fr, n_e = __builtin_amdgcn_readfirstlane((int)cnt[e]); const int* le = list + (size_t)e * T;
        ROWS_BEGIN((unsigned)pbase)
            const int pos = (int)ro_;
            if (pos < n_e) { const int entry = le[pos]; bf16_t* rowp = ((entry & 1) ? Y1 : Y0) + (size_t)(entry >> 1) * D + col0;
#pragma unroll
                for (int bj = 0; bj < 2; ++bj) *(u32x4*)(rowp + bj * HALF) = pack8(acc[ai][bj][m][0], acc[ai][bj][m][1]); }
        ROWS_END(16u)
        ZERO_ACC(); } };
#undef ROWS_BEGIN
#undef ROWS_END
#undef ZERO_ACC
}

__device__ __forceinline__ void fast_proj(const Ctx& c, int half, PG8_LAS unsigned char* lds, int tid) {
    pg8::SchedGrid S; S.nM = TH / 256; S.nN = NP / 256; S.G = gridDim.x; S.c = blockIdx.x; S.nt = D / 64; S.lda = D * 2; S.ldb = D * 2;
    S.A0 = (const char*)(wsp<bf16_t>(c, OFF_XB) + (size_t)half * TH * D); S.B0 = (const char*)wsp<bf16_t>(c, WT_IN);
    pg8::EpiProj E{wsp<bf16_t>(c, OFF_P)}; pg8::gemm_phase(lds, S, E, tid);
}
__device__ __forceinline__ void fast_gates(const Ctx& c, PG8_LAS unsigned char* lds, int tid) {
    pg8::SchedGrid S; S.nM = T / 256; S.nN = 3 * D / 256; S.G = gridDim.x; S.c = blockIdx.x; S.nt = D / 64; S.lda = D * 2; S.ldb = D * 2;
    S.A0 = (const char*)wsp<bf16_t>(c, OFF_XB); S.B0 = (const char*)(wsp<bf16_t>(c, WT_IN) + (size_t)NP * D);
    pg8::EpiGates E{wsp<bf16_t>(c, OFF_GATES)}; pg8::gemm_phase(lds, S, E, tid);
}
__device__ __forceinline__ void fast_merge(const Ctx& c, PG8_LAS unsigned char* lds, int tid) {
    pg8::SchedMerge S; S.nM = T / 256; S.nN = D / 256; S.G = gridDim.x; S.c = blockIdx.x; S.lda = OW * 2; S.ldb = OW * 2;
    S.A0 = (const char*)c.out; S.B0 = (const char*)wsp<bf16_t>(c, WT_A);
    pg8::EpiMerge E{wsp<bf16_t>(c, OFF_GATES), wsp<bf16_t>(c, OFF_MERGED)}; pg8::gemm_phase(lds, S, E, tid);
}
__device__ __forceinline__ void fast_wout(const Ctx& c, PG8_LAS unsigned char* lds, int tid) {
    pg8::SchedGrid S; S.nM = T / 256; S.nN = D / 256; S.G = gridDim.x; S.c = blockIdx.x; S.nt = D / 64; S.lda = D * 2; S.ldb = D * 2;
    S.A0 = (const char*)wsp<bf16_t>(c, OFF_MERGED); S.B0 = (const char*)wsp<bf16_t>(c, WT_OUT);
    pg8::EpiWout E{c.x, wsp<float>(c, OFF_H1)}; pg8::gemm_phase(lds, S, E, tid);
}
__device__ __forceinline__ void fast_moe1(const Ctx& c, PG8_LAS unsigned char* lds, int tid) {
    pg8::SchedMoe<true> S; S.G = gridDim.x; S.c = blockIdx.x; S.ncol = 2; S.nt = D / 64; S.blk = wsp<int>(c, OFF_SMALL) + SM_BLK; S.list = wsp<int>(c, OFF_LIST); S.cnt = wsp<unsigned>(c, OFF_CTL) + CW_CNT;
    S.A = (const char*)wsp<bf16_t>(c, OFF_X1B); S.B = (const char*)wsp<bf16_t>(c, OFF_WTGU); S.b_estride = (size_t)2 * DE * D * 2; S.b_pnstride = (size_t)256 * D * 2; S.lda = D * 2; S.ldb = D * 2;
    pg8::EpiMoe1 E{wsp<bf16_t>(c, OFF_HBUF)}; pg8::gemm_phase(lds, S, E, tid);
}
__device__ __forceinline__ void fast_moe2(const Ctx& c, PG8_LAS unsigned char* lds, int tid) {
    pg8::SchedMoe<false> S; S.G = gridDim.x; S.c = blockIdx.x; S.ncol = D / 256; S.nt = DE / 64; S.blk = wsp<int>(c, OFF_SMALL) + SM_BLK; S.list = wsp<int>(c, OFF_LIST); S.cnt = wsp<unsigned>(c, OFF_CTL) + CW_CNT;
    S.A = (const char*)wsp<bf16_t>(c, OFF_HBUF); S.B = (const char*)wsp<bf16_t>(c, OFF_WTDN); S.b_estride = (size_t)D * DE * 2; S.b_pnstride = (size_t)256 * DE * 2; S.lda = DE * 2; S.ldb = DE * 2;
    pg8::EpiMoe2 E{S.blk, S.list, S.cnt, wsp<bf16_t>(c, OFF_Y0), wsp<bf16_t>(c, OFF_Y1)}; pg8::gemm_phase(lds, S, E, tid);
}
namespace attn {
typedef short s16x4 __attribute__((ext_vector_type(4)));
typedef float f32x16 __attribute__((ext_vector_type(16)));
typedef unsigned u32x4 __attribute__((ext_vector_type(4)));
constexpr int KVBLK = 64, DH = 128, SHM_V = KVBLK * DH * 2, SHM_K = KVBLK * DH * 2;
constexpr int LDS_V = 0, LDS_K = 2 * SHM_V, LDS_WS = LDS_K + 2 * SHM_K, LDS_BIAS = LDS_WS + 8 * 64 * 4, BIAS_PAD = 96, BIAS_N = 129 + 2 * BIAS_PAD, LDS_END = LDS_BIAS + ((BIAS_N * 4 + 15) & ~15);
constexpr float LOG2E = 1.4426950408889634f, C2 = LOG2E * QK_SCALE, LN2 = 0.6931471805599453f;
#define KSWZ(row, colB) ((row) * 256 + ((colB) ^ (((row) & 7) << 4)))
#define SBAR() __builtin_amdgcn_sched_barrier(0)
__device__ __forceinline__ int v_st(int k, int c) { const int kk = (k & ~0xC) | ((k & 4) << 1) | ((k & 8) >> 1); return ((kk >> 3) * 4 + (c >> 5)) * 512 + ((kk & 7) * 32 + (c & 31)) * 2; }
__device__ __forceinline__ int v_rd_base(int lane) { return ((lane & 3) << 3) | (((lane >> 2) & 3) << 6) | (((lane >> 4) & 1) << 5) | (((lane >> 5) & 1) << 8); }
constexpr int v_rd_off(int d0, int ks, int half) { return d0 * 512 + ks * 4096 + half * 2048; }
__device__ __forceinline__ int crow(int r, int hi) { return (r & 3) + 8 * (r >> 2) + 4 * hi; }
__device__ __forceinline__ unsigned cvtpk(float lo, float hi) { unsigned r; asm volatile("v_cvt_pk_bf16_f32 %0, %1, %2" : "=v"(r) : "v"(lo), "v"(hi)); return r; }
__device__ __forceinline__ void qkt(f32x16& p0, f32x16& p1, const PG8_LAS char* kbuf, int r32, int hi, const bf16x8* qr) {
    p0 = f32x16{}; p1 = f32x16{};
    const PG8_LAS char* kb[4];
#pragma unroll
    for (int dd = 0; dd < 4; ++dd) kb[dd] = kbuf + KSWZ(r32, (dd * 16 + hi * 8) * 2);
#pragma unroll
    for (int d0 = 0; d0 < 8; ++d0) { const PG8_LAS char* a = kb[d0 & 3] + (d0 >> 2) * 128;
        const bf16x8 b0 = *(const PG8_LAS bf16x8*)(a);
        const bf16x8 b1 = *(const PG8_LAS bf16x8*)(a + 32 * 256);
        p0 = __builtin_amdgcn_mfma_f32_32x32x16_bf16(b0, qr[d0], p0, 0, 0, 0);
        p1 = __builtin_amdgcn_mfma_f32_32x32x16_bf16(b1, qr[d0], p1, 0, 0, 0); }
}
__device__ __forceinline__ void pv_tile(f32x16* o, int vb0, bf16x8 pa0, bf16x8 pa1, bf16x8 pa2, bf16x8 pa3) {
#define TRRD(dst, off) asm volatile("ds_read_b64_tr_b16 %0, %1 offset:%2" : "=&v"(dst) : "v"(vb0), "i"(off) : "memory")
#define PV_D0(d0) do { s16x4 l0, l1, l2, l3, h0, h1, h2, h3; constexpr int b_ = v_rd_off(d0, 0, 0); \
        TRRD(l0, b_); TRRD(h0, b_ + 2048); TRRD(l1, b_ + 4096); TRRD(h1, b_ + 6144); TRRD(l2, b_ + 8192); TRRD(h2, b_ + 10240); TRRD(l3, b_ + 12288); TRRD(h3, b_ + 14336); \
        asm volatile("s_waitcnt lgkmcnt(0)" ::: "memory"); SBAR(); \
        o[d0] = __builtin_amdgcn_mfma_f32_32x32x16_bf16(pa0, (bf16x8){l0[0], l0[1], l0[2], l0[3], h0[0], h0[1], h0[2], h0[3]}, o[d0], 0, 0, 0); \
        o[d0] = __builtin_amdgcn_mfma_f32_32x32x16_bf16(pa1, (bf16x8){l1[0], l1[1], l1[2], l1[3], h1[0], h1[1], h1[2], h1[3]}, o[d0], 0, 0, 0); \
        o[d0] = __builtin_amdgcn_mfma_f32_32x32x16_bf16(pa2, (bf16x8){l2[0], l2[1], l2[2], l2[3], h2[0], h2[1], h2[2], h2[3]}, o[d0], 0, 0, 0); \
        o[d0] = __builtin_amdgcn_mfma_f32_32x32x16_bf16(pa3, (bf16x8){l3[0], l3[1], l3[2], l3[3], h3[0], h3[1], h3[2], h3[3]}, o[d0], 0, 0, 0); } while (0)
    PV_D0(0); PV_D0(1); PV_D0(2); PV_D0(3);
#undef PV_D0
#undef TRRD
}
template <bool BAND>
__device__ __forceinline__ void attn_unit(PG8_LAS char* lds, const bf16_t* Q, size_t qs, const bf16_t* K, const bf16_t* V, size_t ks, int NT, int qpos0, int kpos0,
                                          bf16_t* Ob, size_t ostride, float* lse, int obase, int omul, int tid) {
    const int wid = __builtin_amdgcn_readfirstlane(tid >> 6), lane = tid & 63, r32 = lane & 31, hi = lane >> 5;
    PG8_LAS char* V_lds = lds + LDS_V; PG8_LAS char* K_lds = lds + LDS_K;
    PG8_LAS float* wsf = (PG8_LAS float*)(lds + LDS_WS) + wid * 64; const PG8_LAS float* bias = (const PG8_LAS float*)(lds + LDS_BIAS);
    const int sr = tid >> 4, sc = (tid & 15) * 8, vst0 = v_st(sr, sc), vst1 = v_st(32 + sr, sc), kws = KSWZ(sr, sc * 2);
    const int vbl = (int)(uintptr_t)V_lds + v_rd_base(lane);
    bf16x8 qr[8];
    { const bf16_t* qp = Q + (size_t)(wid * 32 + r32) * qs + hi * 8;
#pragma unroll
      for (int d0 = 0; d0 < 8; ++d0) qr[d0] = *(const bf16x8*)(qp + d0 * 16); }
    bf16x8 st_k0, st_k1, st_v0, st_v1;
#define SLOAD(t) do { const size_t ro_ = (size_t)((t) * KVBLK + sr) * ks + sc; st_k0 = *(const bf16x8*)(K + ro_); st_k1 = *(const bf16x8*)(K + ro_ + 32 * ks); st_v0 = *(const bf16x8*)(V + ro_); st_v1 = *(const bf16x8*)(V + ro_ + 32 * ks); } while (0)
#define SWRITE(bf) do { *(PG8_LAS bf16x8*)(K_lds + (bf) * SHM_K + kws) = st_k0; *(PG8_LAS bf16x8*)(K_lds + (bf) * SHM_K + kws + 32 * 256) = st_k1; \
                        *(PG8_LAS bf16x8*)(V_lds + (bf) * SHM_V + vst0) = st_v0; *(PG8_LAS bf16x8*)(V_lds + (bf) * SHM_V + vst1) = st_v1; } while (0)
    SLOAD(0); SWRITE(0);
    __syncthreads();
    float m_run = -1e30f, l_run = 0.f; f32x16 o[4] = {};
    const int qlo = qpos0 + wid * 32;
    for (int t = 0; t < NT; ++t) {
        const int buf = t & 1;
        if (t + 1 < NT) SLOAD(t + 1);
        const int kb = kpos0 + t * KVBLK;
        const bool act = !BAND || (kb <= qlo + 31 && kb + KVBLK - 1 >= qlo - 128);
        if (act) {
            f32x16 p0, p1;
            qkt(p0, p1, K_lds + buf * SHM_K, r32, hi, qr);
            if (BAND) {
                const int dq = qlo + r32 - kb - 4 * hi;
                const PG8_LAS float* bp = bias + (dq + BIAS_PAD - 59);
#pragma unroll
                for (int r = 0; r < 16; ++r) { const int cr = (r & 3) + 8 * (r >> 2);
                    const float b0 = bp[59 - cr], b1 = bp[59 - cr - 32];
                    p0[r] = ((unsigned)(dq - cr) <= 128u) ? fmaf(p0[r], C2, b0) : -INFINITY;
                    p1[r] = ((unsigned)(dq - cr - 32) <= 128u) ? fmaf(p1[r], C2, b1) : -INFINITY; }
            } else {
#pragma unroll
                for (int r = 0; r < 16; ++r) { p0[r] *= C2; p1[r] *= C2; }
            }
            float pmax = p0[0];
#pragma unroll
            for (int r = 1; r < 16; ++r) pmax = fmaxf(pmax, p0[r]);
#pragma unroll
            for (int r = 0; r < 16; ++r) pmax = fmaxf(pmax, p1[r]);
            { auto rr = __builtin_amdgcn_permlane32_swap(__float_as_uint(pmax), __float_as_uint(pmax), false, false); pmax = fmaxf(__uint_as_float(rr[0]), __uint_as_float(rr[1])); }
            const float mn = fmaxf(m_run, pmax), alpha = __builtin_amdgcn_exp2f(m_run - mn); m_run = mn;
            float ps = 0.f;
#pragma unroll
            for (int r = 0; r < 16; ++r) { p0[r] = __builtin_amdgcn_exp2f(p0[r] - mn); p1[r] = __builtin_amdgcn_exp2f(p1[r] - mn); ps += p0[r] + p1[r]; }
            { auto rr = __builtin_amdgcn_permlane32_swap(__float_as_uint(ps), __float_as_uint(ps), false, false); ps = __uint_as_float(rr[0]) + __uint_as_float(rr[1]); }
            l_run = l_run * alpha + ps;
            if (__any(alpha < 1.f)) { if (hi == 0) wsf[r32] = alpha; asm volatile("s_waitcnt lgkmcnt(0)" ::: "memory");
#pragma unroll
                for (int r = 0; r < 16; ++r) { const float a = wsf[crow(r, hi)];
#pragma unroll
                    for (int d_ = 0; d_ < 4; ++d_) o[d_][r] *= a; }
                asm volatile("s_waitcnt lgkmcnt(0)" ::: "memory"); }
            bf16x8 pa0, pa1, pa2, pa3;
#define PK4(P, B_, OUT) do { unsigned a0 = cvtpk(P[B_ + 0], P[B_ + 1]), a1 = cvtpk(P[B_ + 2], P[B_ + 3]); unsigned b0 = cvtpk(P[B_ + 4], P[B_ + 5]), b1 = cvtpk(P[B_ + 6], P[B_ + 7]); \
        auto r0 = __builtin_amdgcn_permlane32_swap(a0, b0, false, false); auto r1 = __builtin_amdgcn_permlane32_swap(a1, b1, false, false); \
        u32x4 w = {r0[0], r1[0], r0[1], r1[1]}; OUT = *reinterpret_cast<bf16x8*>(&w); } while (0)
            PK4(p0, 0, pa0); PK4(p0, 8, pa1); PK4(p1, 0, pa2); PK4(p1, 8, pa3);
#undef PK4
            SBAR();
            pv_tile(o, vbl + buf * SHM_V, pa0, pa1, pa2, pa3);
        }
        if (t + 1 < NT) SWRITE(buf ^ 1);
        __syncthreads();
    }
#undef SLOAD
#undef SWRITE
    if (hi == 0) wsf[r32] = l_run; asm volatile("s_waitcnt lgkmcnt(0)" ::: "memory");
    float rli[16];
#pragma unroll
    for (int r = 0; r < 16; ++r) rli[r] = __builtin_amdgcn_rcpf(wsf[crow(r, hi)]);
#pragma unroll
    for (int r = 0; r < 16; ++r) { const int row = wid * 32 + crow(r, hi); bf16_t* op = Ob + (size_t)(obase + row * omul) * ostride;
#pragma unroll
        for (int d0 = 0; d0 < 4; ++d0) { const float v = o[d0][r] * rli[r]; const float vn = __shfl_xor(v, 1);
            if ((r32 & 1) == 0) *(unsigned*)(op + d0 * 32 + r32) = cvtpk(v, vn); } }
    if (BAND) { if (hi == 0) lse[(size_t)(obase + (wid * 32 + r32) * omul) * 4] = (m_run + __log2f(l_run)) * LN2; }
    __syncthreads();
}
#undef KSWZ
#undef SBAR

__device__ __forceinline__ void attn_phase(const Ctx& c, int half, PG8_LAS unsigned char* lds_u, int tid) {
    asm volatile("" : "+v"(tid));
    PG8_LAS char* lds = (PG8_LAS char*)lds_u;
    constexpr int QB = S / 256, NUA = BH * 3 * 4 * QB, NUC = BH * 4 * QB, NU = NUA + NUC;
    const bf16_t* P = wsp<bf16_t>(c, OFF_P);
    for (int u = blockIdx.x; u < NU; u += gridDim.x) {
        if (u < NUA) {
            const int j = u % QB, h = (u / QB) & 3, g = (u / (QB * 4)) % 3, bl = u / (QB * 12);
            const int r = dil_of(g), L = S / r, nqb = L / 256, cc = j / nqb, qb = j % nqb, q0 = qb * 256, base = bl * S + cc * L;
            { PG8_LAS float* bt = (PG8_LAS float*)(lds + LDS_BIAS); const float* bsrc = wsp<float>(c, OFF_SMALL) + SM_BIAS + (g * 4 + h) * 129;
              for (int i = tid; i < BIAS_N; i += 512) { const int uu = i - BIAS_PAD; bt[i] = (uu >= 0 && uu <= 128) ? bsrc[uu] * LOG2E : 0.f; } }
            const int klo = q0 >= 128 ? q0 - 128 : 0, NT = (q0 + 256 - klo) / 64;
            const bf16_t* Qp = P + (size_t)(base + q0) * NP + g * 1536 + h * 128; const bf16_t* Kp = P + (size_t)(base + klo) * NP + g * 1536 + 512 + h * 128;
            attn_unit<true>(lds, Qp, NP, Kp, Kp + 512, NP, NT, q0, klo, wsp<bf16_t>(c, OFF_PART) + (size_t)g * TH * WA + h * 128, WA, wsp<float>(c, OFF_LSE) + (size_t)g * TH * 4 + h,
                            bl * S + q0 * r + cc, r, tid);
        } else {
            const int v = u - NUA, j = v % QB, h = (v / QB) & 3, bl = v / (QB * 4), b = half * BH + bl, tl0 = bl * S + j * 256;
            const bf16_t* Qp = P + (size_t)tl0 * NP + COLS_A + COLS_B + h * 128; const bf16_t* Kp = wsp<bf16_t>(c, OFF_MEMKV) + (size_t)b * MEM * 1024 + h * 128;
            attn_unit<false>(lds, Qp, NP, Kp, Kp + 512, 1024, MEM / 64, 0, 0, (bf16_t*)c.out + (size_t)half * TH * OW + WA + WB + h * 128, OW, nullptr, tl0, 1, tid);
        }
    }
}
}
namespace rowops {
typedef float f32x4 __attribute__((ext_vector_type(4)));
typedef unsigned u32x2 __attribute__((ext_vector_type(2)));
typedef unsigned u32x4 __attribute__((ext_vector_type(4)));
__device__ __forceinline__ float wave_sum(float v) {
#pragma unroll
    for (int o = 1; o < 64; o <<= 1) v += __shfl_xor(v, o);
    return v;
}
__device__ __forceinline__ unsigned pk2(float lo, float hi) { return pg8::cvt_pk_bf16(lo, hi); }

__device__ __forceinline__ void ln1_router_phase(const Ctx& c, int tid) {
    asm volatile("" : "+v"(tid));
    const int lane = tid & 63, wid = tid >> 6, gw = blockIdx.x * 8 + wid, NGW = gridDim.x * 8;
    float* H1 = wsp<float>(c, OFF_H1); bf16_t* X1B = wsp<bf16_t>(c, OFF_X1B);
    unsigned* cnt = wsp<unsigned>(c, OFF_CTL) + CW_CNT; int* list = wsp<int>(c, OFF_LIST); float* rw = wsp<float>(c, OFF_RW);
    f32x4 gv[4], bv[4];
#pragma unroll
    for (int j = 0; j < 4; ++j) { gv[j] = *(const f32x4*)(c.ln1_g + 4 * lane + 256 * j); bv[j] = *(const f32x4*)(c.ln1_b + 4 * lane + 256 * j); }
    for (int row = gw; row < T; row += NGW) {
        f32x4* hp = (f32x4*)(H1 + (size_t)row * D) + lane; f32x4 v[4]; float s = 0.f;
#pragma unroll
        for (int j = 0; j < 4; ++j) { v[j] = hp[64 * j]; s += (v[j][0] + v[j][1]) + (v[j][2] + v[j][3]); }
        const float mean = wave_sum(s) * (1.f / D); float s2 = 0.f;
#pragma unroll
        for (int j = 0; j < 4; ++j) { v[j] = v[j] - mean; s2 += (v[j][0] * v[j][0] + v[j][1] * v[j][1]) + (v[j][2] * v[j][2] + v[j][3] * v[j][3]); }
        const float rstd = 1.f / sqrtf(wave_sum(s2) * (1.f / D) + LN_EPS);
        float gl[4] = {0.f, 0.f, 0.f, 0.f};
#pragma unroll
        for (int j = 0; j < 4; ++j) { v[j] = v[j] * rstd * gv[j] + bv[j]; hp[64 * j] = v[j];
            u32x2 w; w.x = pk2(v[j][0], v[j][1]); w.y = pk2(v[j][2], v[j][3]); *((u32x2*)(X1B + (size_t)row * D) + lane + 64 * j) = w;
#pragma unroll
            for (int e = 0; e < 4; ++e) { const f32x4 wg = *(const f32x4*)(c.w_rg + (size_t)(4 * lane + 256 * j + e) * 4); gl[0] += v[j][e] * wg[0]; gl[1] += v[j][e] * wg[1]; gl[2] += v[j][e] * wg[2]; gl[3] += v[j][e] * wg[3]; } }
#pragma unroll
        for (int g = 0; g < 4; ++g) gl[g] = wave_sum(gl[g]) + c.b_rg[g];
        int gs = 0; float gm = gl[0];
#pragma unroll
        for (int g = 1; g < 4; ++g) if (gl[g] > gm) { gm = gl[g]; gs = g; }
        const float gp = 1.f / (__expf(gl[0] - gm) + __expf(gl[1] - gm) + __expf(gl[2] - gm) + __expf(gl[3] - gm));
        float el[8] = {0.f, 0.f, 0.f, 0.f, 0.f, 0.f, 0.f, 0.f};
#pragma unroll
        for (int j = 0; j < 4; ++j)
#pragma unroll
            for (int e = 0; e < 4; ++e) { const float* wp = c.w_re + (size_t)(4 * lane + 256 * j + e) * 32 + gs * 8; const f32x4 wa = *(const f32x4*)wp, wb = *(const f32x4*)(wp + 4);
                el[0] += v[j][e] * wa[0]; el[1] += v[j][e] * wa[1]; el[2] += v[j][e] * wa[2]; el[3] += v[j][e] * wa[3]; el[4] += v[j][e] * wb[0]; el[5] += v[j][e] * wb[1]; el[6] += v[j][e] * wb[2]; el[7] += v[j][e] * wb[3]; }
        float v0 = -INFINITY, v1 = -INFINITY; int i0 = 0, i1 = 0;
#pragma unroll
        for (int j = 0; j < 8; ++j) { const float x = wave_sum(el[j]) + c.b_re[gs * 8 + j];
            if (x > v0) { v1 = v0; i1 = i0; v0 = x; i0 = j; } else if (x > v1) { v1 = x; i1 = j; } }
        if (lane == 0) { const float e1 = __expf(v1 - v0), w0 = gp / (1.f + e1), w1 = gp * e1 / (1.f + e1); const int ea = gs * 8 + i0, eb = gs * 8 + i1;
            list[(size_t)ea * T + atomicAdd(cnt + ea, 1u)] = row * 2; list[(size_t)eb * T + atomicAdd(cnt + eb, 1u)] = row * 2 + 1;
            rw[row * 2] = w0; rw[row * 2 + 1] = w1; }
    }
}
__device__ __forceinline__ void ln2_phase(const Ctx& c, int tid) {
    asm volatile("" : "+v"(tid));
    const int lane = tid & 63, wid = tid >> 6, gw = blockIdx.x * 8 + wid, NGW = gridDim.x * 8;
    const float* X1 = wsp<float>(c, OFF_H1); const bf16_t* Y0 = wsp<bf16_t>(c, OFF_Y0); const bf16_t* Y1 = wsp<bf16_t>(c, OFF_Y1); const float* rw = wsp<float>(c, OFF_RW);
    f32x4 gv[4], bv[4];
#pragma unroll
    for (int j = 0; j < 4; ++j) { gv[j] = *(const f32x4*)(c.ln2_g + 4 * lane + 256 * j); bv[j] = *(const f32x4*)(c.ln2_b + 4 * lane + 256 * j); }
    for (int row = gw; row < T; row += NGW) {
        const f32x4* xp = (const f32x4*)(X1 + (size_t)row * D) + lane; const u32x2* y0p = (const u32x2*)(Y0 + (size_t)row * D) + lane; const u32x2* y1p = (const u32x2*)(Y1 + (size_t)row * D) + lane;
        const float w0 = rw[row * 2], w1 = rw[row * 2 + 1]; f32x4 v[4]; float s = 0.f;
#pragma unroll
        for (int j = 0; j < 4; ++j) { const f32x4 x = xp[64 * j]; const u32x2 a = y0p[64 * j], b = y1p[64 * j];
            v[j][0] = DN_ALPHA * x[0] + w0 * bflo(a.x) + w1 * bflo(b.x); v[j][1] = DN_ALPHA * x[1] + w0 * bfhi(a.x) + w1 * bfhi(b.x);
            v[j][2] = DN_ALPHA * x[2] + w0 * bflo(a.y) + w1 * bflo(b.y); v[j][3] = DN_ALPHA * x[3] + w0 * bfhi(a.y) + w1 * bfhi(b.y);
            s += (v[j][0] + v[j][1]) + (v[j][2] + v[j][3]); }
        const float mean = wave_sum(s) * (1.f / D); float s2 = 0.f;
#pragma unroll
        for (int j = 0; j < 4; ++j) { v[j] = v[j] - mean; s2 += (v[j][0] * v[j][0] + v[j][1] * v[j][1]) + (v[j][2] * v[j][2] + v[j][3] * v[j][3]); }
        const float rstd = 1.f / sqrtf(wave_sum(s2) * (1.f / D) + LN_EPS);
        f32x4* op = (f32x4*)(c.out + (size_t)row * D) + lane;
#pragma unroll
        for (int j = 0; j < 4; ++j) op[64 * j] = v[j] * rstd * gv[j] + bv[j];
    }
}
__device__ __forceinline__ void transpose_item(const float* W, int N, bf16_t* Wt, size_t ldo, PG8_LAS float* scr, int k0, int n0, int lane) {
#pragma unroll 8
    for (int i = 0; i < 32; ++i) { const int kk = 2 * i + (lane >> 5); scr[kk * 33 + (lane & 31)] = W[(size_t)(k0 + kk) * N + n0 + (lane & 31)]; }
    asm volatile("s_waitcnt lgkmcnt(0)" ::: "memory");
    const int ch = lane & 7;
#pragma unroll
    for (int j = 0; j < 4; ++j) { const int n = (lane >> 3) + 8 * j; const PG8_LAS float* s = scr + (8 * ch) * 33 + n;
        u32x4 o; o.x = pk2(s[0 * 33], s[1 * 33]); o.y = pk2(s[2 * 33], s[3 * 33]); o.z = pk2(s[4 * 33], s[5 * 33]); o.w = pk2(s[6 * 33], s[7 * 33]);
        *(u32x4*)(Wt + (size_t)n * ldo + k0 + 8 * ch) = o; }
    asm volatile("s_waitcnt lgkmcnt(0)" ::: "memory");
}
__device__ __forceinline__ void cvt_copy(const float* src, bf16_t* dst, long n, int tid) {
    const long n8 = n / 8;
    for (long i = (long)blockIdx.x * 512 + tid; i < n8; i += (long)gridDim.x * 512) { const f32x4 a = *(const f32x4*)(src + i * 8), b = *(const f32x4*)(src + i * 8 + 4);
        u32x4 o; o.x = pk2(a[0], a[1]); o.y = pk2(a[2], a[3]); o.z = pk2(b[0], b[1]); o.w = pk2(b[2], b[3]); *(u32x4*)(dst + i * 8) = o; }
}
__device__ __forceinline__ void prologue_phase(const Ctx& c, PG8_LAS unsigned char* lds, int tid) {
    asm volatile("" : "+v"(tid));
    const int lane = tid & 63, wid = tid >> 6, gw = blockIdx.x * 8 + wid, NGW = gridDim.x * 8;
    PG8_LAS float* scr = (PG8_LAS float*)(lds + wid * 16384);
    constexpr int I_IN = (D / 64) * (N_IN / 32), I_KV = (D / 64) * (1024 / 32), I_A = (WA / 64) * (D / 32), I_B = (WB / 64) * (D / 32), I_C = (WC / 64) * (D / 32), I_O = (D / 64) * (D / 32);
    constexpr int NIT = I_IN + I_KV + I_A + I_B + I_C + I_O;
    for (int it = gw; it < NIT; it += NGW) { int r = it;
        if (r < I_IN) { const int nb = N_IN / 32; transpose_item(c.w_in, N_IN, wsp<bf16_t>(c, WT_IN) + (size_t)(r % nb) * 32 * D, D, scr, (r / nb) * 64, (r % nb) * 32, lane); continue; } r -= I_IN;
        if (r < I_KV) { const int nb = 1024 / 32; transpose_item(c.w_kv, 1024, wsp<bf16_t>(c, WT_KV) + (size_t)(r % nb) * 32 * D, D, scr, (r / nb) * 64, (r % nb) * 32, lane); continue; } r -= I_KV;
        if (r < I_A) { const int nb = D / 32; transpose_item(c.w_a, D, wsp<bf16_t>(c, WT_A) + (size_t)(r % nb) * 32 * OW, OW, scr, (r / nb) * 64, (r % nb) * 32, lane); continue; } r -= I_A;
        if (r < I_B) { const int nb = D / 32; transpose_item(c.w_b, D, wsp<bf16_t>(c, WT_A) + WA + (size_t)(r % nb) * 32 * OW, OW, scr, (r / nb) * 64, (r % nb) * 32, lane); continue; } r -= I_B;
        if (r < I_C) { const int nb = D / 32; transpose_item(c.w_c, D, wsp<bf16_t>(c, WT_A) + WA + WB + (size_t)(r % nb) * 32 * OW, OW, scr, (r / nb) * 64, (r % nb) * 32, lane); continue; } r -= I_C;
        { const int nb = D / 32; transpose_item(c.w_out, D, wsp<bf16_t>(c, WT_OUT) + (size_t)(r % nb) * 32 * D, D, scr, (r / nb) * 64, (r % nb) * 32, lane); }
    }
    cvt_copy(c.x, wsp<bf16_t>(c, OFF_XB), (long)T * D, tid);
    cvt_copy(c.mem, wsp<bf16_t>(c, OFF_MEMB), (long)NBATCH * MEM * D, tid);
}
__device__ __forceinline__ void expert_weights_phase(const Ctx& c, PG8_LAS unsigned char* lds, int tid) {
    asm volatile("" : "+v"(tid));
    const int lane = tid & 63, wid = tid >> 6, gw = blockIdx.x * 8 + wid, NGW = gridDim.x * 8;
    PG8_LAS float* scr = (PG8_LAS float*)(lds + wid * 16384);
    constexpr int I_G = (D / 64) * (DE / 32), I_D = (DE / 64) * (D / 32), PER_E = 2 * I_G + I_D;
    for (int it = gw; it < NE * PER_E; it += NGW) { const int e = it / PER_E; int r = it % PER_E;
        if (r < 2 * I_G) { const int up = r / I_G; r %= I_G; const int nb = DE / 32, n0 = (r % nb) * 32, k0 = (r / nb) * 64; const float* src = (up ? c.w_eu : c.w_eg) + (size_t)e * D * DE;
            transpose_item(src, DE, wsp<bf16_t>(c, OFF_WTGU) + ((size_t)e * 2 * DE + (n0 / 128) * 256 + up * 128 + n0 % 128) * D, D, scr, k0, n0, lane); }
        else { r -= 2 * I_G; const int nb = D / 32, n0 = (r % nb) * 32, k0 = (r / nb) * 64;
            transpose_item(c.w_ed + (size_t)e * DE * D, D, wsp<bf16_t>(c, OFF_WTDN) + ((size_t)e * D + n0) * DE, DE, scr, k0, n0, lane); }
    }
}
}
#include <hip/hip_cooperative_groups.h>
namespace cg = cooperative_groups;
constexpr int NTHR = 512, LDS_BYTES = 147456;

template <class F> __device__ __forceinline__ void dev_elems_(const F& f, long n, int tid) {
    asm volatile("" : "+v"(tid));
    for (long i = (long)blockIdx.x * NTHR + tid; i < n; i += (long)gridDim.x * NTHR) f(i);
}
template <class G> __device__ __forceinline__ void dev_sgemm_(const G& g, int tid) {
    asm volatile("" : "+v"(tid));
    const int M = g.M(); const int lane = tid & 63, wid = tid >> 6; constexpr int ntn = G::N / 64;
    const long ntiles = (long)(M / 16) * ntn;
    for (long tile = (long)blockIdx.x * 8 + wid; tile < ntiles; tile += (long)gridDim.x * 8) {
        const int tm = (int)(tile / ntn), tn = (int)(tile % ntn), r0 = tm * 16, c0 = tn * 64;
        f32x4 acc[G::NBP][4], carry[4];
#pragma unroll
        for (int j = 0; j < 4; ++j) { carry[j] = (f32x4){0.f, 0.f, 0.f, 0.f};
#pragma unroll
            for (int w = 0; w < G::NBP; ++w) acc[w][j] = (f32x4){0.f, 0.f, 0.f, 0.f}; }
#pragma unroll
        for (int seg = 0; seg < G::NSEGS; ++seg) {
            const bf16_t* ar = g.arow(seg, r0 + (lane & 15)) + 8 * (lane >> 4); const bf16_t* br[G::NBP][4];
#pragma unroll
            for (int w = 0; w < G::NBP; ++w)
#pragma unroll
                for (int j = 0; j < 4; ++j) br[w][j] = g.brow(seg, r0, c0 + 16 * j + (lane & 15), w) + 8 * (lane >> 4);
            const int K = g.K(seg);
            for (int k0 = 0; k0 < K; k0 += 32) { const bf16x8 a = *(const bf16x8*)(ar + k0);
#pragma unroll
                for (int w = 0; w < G::NBP; ++w)
#pragma unroll
                    for (int j = 0; j < 4; ++j) { const bf16x8 b = *(const bf16x8*)(br[w][j] + k0); acc[w][j] = __builtin_amdgcn_mfma_f32_16x16x32_bf16(a, b, acc[w][j], 0, 0, 0); } }
#pragma unroll
            for (int j = 0; j < 4; ++j)
#pragma unroll
                for (int i = 0; i < 4; ++i) { float a = acc[0][j][i], cr = carry[j][i]; g.between(seg, r0 + (lane >> 4) * 4 + i, c0 + 16 * j + (lane & 15), a, cr); acc[0][j][i] = a; carry[j][i] = cr; }
        }
#pragma unroll
        for (int j = 0; j < 4; ++j)
#pragma unroll
            for (int i = 0; i < 4; ++i) g.store(r0 + (lane >> 4) * 4 + i, c0 + 16 * j + (lane & 15), acc[0][j][i], G::NBP == 2 ? acc[G::NBP - 1][j][i] : carry[j][i]);
    }
}

struct E_hg3q { Ctx c; int half; static constexpr long n = (long)BH * HB * NSEG * 128 * 4;
    __device__ __forceinline__ void operator()(long idx) const { const int kq = (int)(idx & 3), v = (int)((idx >> 2) & 127); const long r = idx >> 9; const int seg = (int)(r % NSEG), bhl = (int)(r / NSEG), h = bhl % HB, bl = bhl / HB;
        const bf16_t* P = wsp<bf16_t>(c, OFF_P); float st[32];
#pragma unroll
        for (int k = 0; k < 32; ++k) st[k] = wsp<float>(c, OFF_HG)[(((size_t)bhl * NSEG + seg) * 128 + kq * 32 + k) * 128 + v];
        for (int s = 0; s < 256; ++s) { const int tl = bl * S + seg * 256 + s; const bf16_t* pr = P + (size_t)tl * NP; const float iv = bf2f(pr[COLS_A + 2 * WB + h * 128 + v]); float o = 0.f;
#pragma unroll
            for (int k = 0; k < 32; ++k) { const int kk = kq * 32 + k; const float f = hg_f(c, pr, h * 128 + kk); st[k] = f * st[k] + (1.f - f) * iv; o += siluf_(bf2f(pr[COLS_A + h * 128 + kk])) * st[k]; }
            o += __shfl_xor(o, 1); o += __shfl_xor(o, 2);
            if (kq == 0) ((bf16_t*)c.out)[((size_t)half * TH + tl) * OW + WA + h * 128 + v] = f2bf(o); } } };

typedef const __attribute__((address_space(4))) Ctx* CtxK;
#if defined(__HIP_DEVICE_COMPILE__)
__device__ __forceinline__ Ctx load_ctx() { CtxK p = (CtxK)__builtin_amdgcn_kernarg_segment_ptr(); asm volatile("" : "+s"(p)); return *p; }
#else
__device__ inline Ctx load_ctx() { return Ctx(); }
#endif
#define PH_BEGIN { const Ctx c = load_ctx(); const int tid = wid_s * 64 + pg8::lane_id_opaque();
#define dev_elems(...) dev_elems_(__VA_ARGS__, tid)
#define dev_sgemm(...) dev_sgemm_(__VA_ARGS__, tid)
#define PH_END }

__global__ void __launch_bounds__(NTHR) mega(Ctx c_arg) {
    extern __shared__ __attribute__((aligned(16))) unsigned char lds_raw[];
    PG8_LAS unsigned char* lds = (PG8_LAS unsigned char*)lds_raw;
    cg::grid_group grid = cg::this_grid();
    const int wid_s = __builtin_amdgcn_readfirstlane((int)threadIdx.x >> 6);
    PH_BEGIN
    dev_elems(S0_small{c}, S0_small::n); rowops::prologue_phase(c, lds, tid);
    PH_END
    grid.sync();
#pragma unroll
    for (int half = 0; half < NHALF; ++half) {
        PH_BEGIN
        if (half == 0) dev_sgemm(G_memkv{c});
        fast_proj(c, half, lds, tid);
        PH_END
        grid.sync();
        PH_BEGIN
        dev_elems(E_hg1{c, half}, E_hg1::n); attn::attn_phase(c, half, lds, tid);
        PH_END
        grid.sync();
        PH_BEGIN
        dev_elems(E_hg2{c}, E_hg2::n); dev_elems(E_combA{c, half}, E_combA::n);
        PH_END
        grid.sync();
        PH_BEGIN
        dev_elems(E_hg3q{c, half}, E_hg3q::n);
        PH_END
        grid.sync();
        PH_BEGIN
        dev_elems(E_hgnorm{c, half}, E_hgnorm::n);
        PH_END
        grid.sync();
    }
    PH_BEGIN
    rowops::expert_weights_phase(c, lds, tid); __syncthreads(); fast_gates(c, lds, tid);
    PH_END
    grid.sync();
    PH_BEGIN
    fast_merge(c, lds, tid);
    PH_END
    grid.sync();
    PH_BEGIN
    fast_wout(c, lds, tid);
    PH_END
    grid.sync();
    PH_BEGIN
    rowops::ln1_router_phase(c, tid);
    PH_END
    grid.sync();
    PH_BEGIN
    dev_elems(E_blk{c}, 1);
    PH_END
    grid.sync();
    PH_BEGIN
    fast_moe1(c, lds, tid);
    PH_END
    grid.sync();
    PH_BEGIN
    fast_moe2(c, lds, tid);
    PH_END
    grid.sync();
    PH_BEGIN
    rowops::ln2_phase(c, tid);
    PH_END
}

extern "C" void kernel_launch(void* const* d_in, const int* in_sizes, int n_in, void* d_out, int out_size, void* d_ws, size_t ws_size, hipStream_t stream) {
    if (n_in != 22 || in_sizes[0] != T * D || out_size != T * D || ws_size < WS_END) { fprintf(stderr, "kernel_launch: unexpected shapes / workspace (%zu < %zu)\n", ws_size, (size_t)WS_END); return; }
    static int grid_blocks = 0;
    if (!grid_blocks) {
        int dev = 0, cus = 0, per_cu = 0;
        hipGetDevice(&dev); hipDeviceGetAttribute(&cus, hipDeviceAttributeMultiprocessorCount, dev);
        hipFuncSetAttribute((const void*)mega, hipFuncAttributeMaxDynamicSharedMemorySize, LDS_BYTES);
        hipOccupancyMaxActiveBlocksPerMultiprocessor(&per_cu, (const void*)mega, NTHR, LDS_BYTES);
        if (per_cu < 1) { fprintf(stderr, "kernel_launch: occupancy query says %d blocks/CU\n", per_cu); per_cu = 1; }
        if (per_cu > 1) per_cu = 1;
        grid_blocks = cus * per_cu;
    }
    Ctx c = make_ctx(d_in, d_out, d_ws);
    void* args[] = {&c};
    hipError_t e = hipLaunchCooperativeKernel((const void*)mega, dim3(grid_blocks), dim3(NTHR), args, LDS_BYTES, stream);
    if (e != hipSuccess) fprintf(stderr, "cooperative launch failed: %s (grid %d)\n", hipGetErrorString(e), grid_blocks);
}
```

```cpp
#ifdef HOST_TEST
#include <cmath>
#include <cstdint>
#include <cstdio>
#include <cstring>
#define HD
#define GLOBAL
#else
#include <hip/hip_runtime.h>
#include <cstdint>
#include <cstdio>
#include <cstring>
#include <cmath>
#define HD __host__ __device__ __forceinline__
#endif

#ifndef CFG_D
#define CFG_D 1024
#define CFG_B 4
#define CFG_S 8192
#endif
typedef unsigned short bf16_t;
constexpr int D = CFG_D, NBATCH = CFG_B, S = CFG_S, T = NBATCH * S;
constexpr int NHALF = 2, TH = T / NHALF, BH = NBATCH / NHALF;
constexpr int WA = 512, HB = D / 128, WB = D, WC = 512;
constexpr int COLS_A = 4608, COLS_B = 4 * WB, COLS_C = 512, COLS_G = 3 * D;
constexpr int NP = COLS_A + COLS_B + COLS_C, N_IN = NP + COLS_G;
constexpr int OW = WA + WB + WC;
constexpr int DE = D / 4, NE = 32, HBK = DE < 128 ? DE : 128;
constexpr int MEM = 256, NSEG = S / 256;
constexpr int MAXROWS = 2 * T + NE * 256;
constexpr float DN_ALPHA = 1.189207115002721f;
constexpr float LN_EPS = 1e-5f, RMS_EPS = 1e-6f;
constexpr float QK_SCALE = 0.08838834764831845f;

constexpr size_t MiB = 1u << 20;
constexpr size_t al(size_t x) { return (x + 4095) & ~(size_t)4095; }
constexpr size_t OFF_CTL = 0;
constexpr size_t OFF_SMALL = 1 * MiB;
constexpr size_t OFF_WT = 2 * MiB;
constexpr size_t WT_IN = OFF_WT, WT_KV = WT_IN + al((size_t)N_IN * D * 2), WT_A = WT_KV + al((size_t)1024 * D * 2),
                 WT_B = WT_A + al((size_t)D * WA * 2), WT_C = WT_B + al((size_t)D * WB * 2), WT_OUT = WT_C + al((size_t)D * WC * 2),
                 OFF_MEMB = WT_OUT + al((size_t)D * D * 2), OFF_MEMKV = OFF_MEMB + al((size_t)NBATCH * MEM * D * 2),
                 OFF_LIST = OFF_MEMKV + al((size_t)NBATCH * MEM * 1024 * 2), OFF_RW = OFF_LIST + al((size_t)NE * T * 4),
                 OFF_XB = OFF_RW + al((size_t)T * 2 * 4), OFF_P = OFF_XB + al((size_t)T * D * 2),
                 OFF_PART = OFF_P + al((size_t)TH * NP * 2), OFF_LSE = OFF_PART + al((size_t)3 * TH * WA * 2),
                 OFF_HG = OFF_LSE + al((size_t)3 * TH * 4 * 4), OFF_DSEG = OFF_HG + al((size_t)BH * HB * NSEG * 128 * 128 * 4),
                 WS_END = OFF_DSEG + al((size_t)BH * HB * NSEG * 128 * 4);
constexpr size_t OFF_GATES = OFF_P, OFF_H1 = OFF_P, OFF_X1B = OFF_P + al((size_t)T * D * 4),
                 OFF_WTGU = OFF_P + al((size_t)T * 3 * D * 2), OFF_WTDN = OFF_WTGU + al((size_t)NE * 2 * DE * D * 2),
                 OFF_HBUF = OFF_WTDN + al((size_t)NE * D * DE * 2), OFF_PEND = OFF_HBUF + al((size_t)MAXROWS * DE * 2);
constexpr size_t OFF_MERGED = OFF_XB, OFF_Y0 = OFF_XB, OFF_Y1 = OFF_PART;
static_assert(OFF_X1B + (size_t)T * D * 2 <= OFF_WTGU, "x1b inside dead gates region");
static_assert(OFF_PEND <= OFF_PART, "P-region overlays fit");
static_assert(OFF_Y1 + (size_t)T * D * 2 <= WS_END, "y1 fits in part+hg region");
constexpr int CW_CNT = 0;
constexpr int SM_BIAS = 0, SM_LB = 2048, SM_BLK = 2048 + 4096;

HD float bf2f(bf16_t v) { union { unsigned u; float f; } c; c.u = (unsigned)v << 16; return c.f; }
HD bf16_t f2bf(float f) { union { unsigned u; float f; } c; c.f = f; unsigned u = c.u; return (bf16_t)((u + 0x7fffu + ((u >> 16) & 1u)) >> 16); }
HD float sigmoidf_(float x) { return 1.0f / (1.0f + expf(-x)); }
HD float siluf_(float x) { return x / (1.0f + expf(-x)); }
HD int dil_of(int g) { return g == 0 ? 1 : (g == 1 ? 4 : 16); }
HD int perm_row(int tl, int g) { const int r = dil_of(g), bl = tl / S, s = tl % S; return bl * S + (s % r) * (S / r) + s / r; }

struct Ctx {
    const float *x, *mem, *rel_bias, *lb_logits, *w_in, *w_kv, *norm_g, *w_a, *w_b, *w_c, *w_out, *ln1_g, *ln1_b, *w_rg, *b_rg, *w_re, *b_re, *w_eg, *w_eu, *w_ed, *ln2_g, *ln2_b;
    float* out; unsigned char* ws;
};
#ifdef HOST_TEST
static const unsigned char T5_BUCKET[3][129] = {
#else
__device__ const unsigned char T5_BUCKET[3][129] = {
#endif
{0,1,2,3,4,5,6,7,8,9,10,11,12,13,14,15,16,16,16,16,16,16,17,17,17,17,17,17,17,17,18,18,18,18,18,18,18,18,18,18,19,19,19,19,19,19,19,19,19,19,19,19,19,19,20,20,20,20,20,20,20,20,20,20,20,20,20,20,20,20,20,20,20,21,21,21,21,21,21,21,21,21,21,21,21,21,21,21,21,21,21,21,21,21,21,21,21,21,21,22,22,22,22,22,22,22,22,22,22,22,22,22,22,22,22,22,22,22,22,22,22,22,22,22,22,22,22,22,22},
{0,4,8,12,16,16,17,17,18,18,19,19,19,19,20,20,20,20,20,21,21,21,21,21,21,22,22,22,22,22,22,22,22,22,23,23,23,23,23,23,23,23,23,23,23,23,24,24,24,24,24,24,24,24,24,24,24,24,24,24,24,24,25,25,25,25,25,25,25,25,25,25,25,25,25,25,25,25,25,25,25,25,25,26,26,26,26,26,26,26,26,26,26,26,26,26,26,26,26,26,26,26,26,26,26,26,26,26,26,26,26,26,26,27,27,27,27,27,27,27,27,27,27,27,27,27,27,27,27},
{0,16,18,19,20,21,21,22,22,23,23,23,24,24,24,24,25,25,25,25,25,26,26,26,26,26,26,26,26,27,27,27,27,27,27,27,27,27,27,28,28,28,28,28,28,28,28,28,28,28,28,28,29,29,29,29,29,29,29,29,29,29,29,29,29,29,29,29,29,29,30,30,30,30,30,30,30,30,30,30,30,30,30,30,30,30,30,30,30,30,30,30,30,30,30,31,31,31,31,31,31,31,31,31,31,31,31,31,31,31,31,31,31,31,31,31,31,31,31,31,31,31,31,31,31,31,31,31,31}};
template <class Tp> HD Tp* wsp(const Ctx& c, size_t off) { return (Tp*)(c.ws + off); }

#ifdef HOST_TEST
static inline unsigned atomic_inc_u32(unsigned* p) { unsigned r;
#pragma omp atomic capture
    { r = *p; *p += 1; }
    return r; }
#else
__device__ __forceinline__ unsigned atomic_inc_u32(unsigned* p) { return atomicAdd(p, 1u); }
#endif

struct S0_xb { Ctx c; static constexpr long n = (long)T * D;
    HD void operator()(long i) const { wsp<bf16_t>(c, OFF_XB)[i] = f2bf(c.x[i]); } };
struct S0_memb { Ctx c; static constexpr long n = (long)NBATCH * MEM * D;
    HD void operator()(long i) const { wsp<bf16_t>(c, OFF_MEMB)[i] = f2bf(c.mem[i]); } };
struct S0_tr { const float* W; bf16_t* Wt; int K, N; long n; int ldo;
    HD void operator()(long i) const { const int k = (int)(i % K); const long nn = i / K; Wt[(size_t)nn * ldo + k] = f2bf(W[(size_t)k * N + nn]); } };
struct S0_gu { Ctx c; static constexpr long n = (long)NE * 2 * DE * D;
    HD void operator()(long i) const { const int k = (int)(i % D); const long r = i / D; const int j = (int)(r % (2 * DE)), e = (int)(r / (2 * DE));
        const int u = j / (2 * HBK), w = j % (2 * HBK), hid = u * HBK + w % HBK, up = w / HBK;
        const float* src = up ? c.w_eu : c.w_eg; wsp<bf16_t>(c, OFF_WTGU)[i] = f2bf(src[((size_t)e * D + k) * DE + hid]); } };
struct S0_dn { Ctx c; static constexpr long n = (long)NE * D * DE;
    HD void operator()(long i) const { const int k = (int)(i % DE); const long r = i / DE; const int col = (int)(r % D), e = (int)(r / D);
        wsp<bf16_t>(c, OFF_WTDN)[i] = f2bf(c.w_ed[((size_t)e * DE + k) * D + col]); } };
struct S0_small { Ctx c; static constexpr long n = 12 * 129 + WB + 64;
    HD void operator()(long i) const { float* sm = wsp<float>(c, OFF_SMALL);
        if (i < 12 * 129) { const int gh = (int)(i / 129), u = (int)(i % 129), g = gh / 4; sm[SM_BIAS + i] = c.rel_bias[T5_BUCKET[g][u] * 12 + gh]; }
        else if (i < 12 * 129 + WB) { const int ch = (int)(i - 12 * 129); sm[SM_LB + ch] = sigmoidf_(c.lb_logits[ch] - c.lb_logits[WB + ch]); }
        else { const int j = (int)(i - 12 * 129 - WB); wsp<unsigned>(c, OFF_CTL)[j] = 0u; } } };

struct G_proj { Ctx c; int half; static constexpr int N = NP, NSEGS = 1, NBP = 1;
    HD int M() const { return TH; } HD int K(int) const { return D; }
    HD const bf16_t* arow(int, int row) const { return wsp<bf16_t>(c, OFF_XB) + ((size_t)half * TH + row) * D; }
    HD const bf16_t* brow(int, int, int col, int) const { return wsp<bf16_t>(c, WT_IN) + (size_t)col * D; }
    HD void between(int, int, int, float&, float&) const {}
    HD void store(int row, int col, float a, float) const { const int pr = col < COLS_A ? perm_row(row, col / 1536) : row; wsp<bf16_t>(c, OFF_P)[(size_t)pr * NP + col] = f2bf(a); } };
struct G_memkv { Ctx c; static constexpr int N = 1024, NSEGS = 1, NBP = 1;
    HD int M() const { return NBATCH * MEM; } HD int K(int) const { return D; }
    HD const bf16_t* arow(int, int row) const { return wsp<bf16_t>(c, OFF_MEMB) + (size_t)row * D; }
    HD const bf16_t* brow(int, int, int col, int) const { return wsp<bf16_t>(c, WT_KV) + (size_t)col * D; }
    HD void between(int, int, int, float&, float&) const {}
    HD void store(int row, int col, float a, float) const { wsp<bf16_t>(c, OFF_MEMKV)[(size_t)row * 1024 + col] = f2bf(a); } };
struct G_gates { Ctx c; static constexpr int N = 3 * D, NSEGS = 1, NBP = 1;
    HD int M() const { return T; } HD int K(int) const { return D; }
    HD const bf16_t* arow(int, int row) const { return wsp<bf16_t>(c, OFF_XB) + (size_t)row * D; }
    HD const bf16_t* brow(int, int, int col, int) const { return wsp<bf16_t>(c, WT_IN) + (size_t)(NP + col) * D; }
    HD void between(int, int, int, float&, float&) const {}
    HD void store(int row, int col, float a, float) const { wsp<bf16_t>(c, OFF_GATES)[((size_t)(col / D) * T + row) * D + col % D] = f2bf(sigmoidf_(a)); } };
struct G_merge { Ctx c; static constexpr int N = D, NSEGS = 3, NBP = 1;
    HD int M() const { return T; } HD int K(int s) const { return s == 1 ? WB : 512; }
    HD const bf16_t* arow(int s, int row) const { return (const bf16_t*)c.out + (size_t)row * OW + (s == 0 ? 0 : (s == 1 ? WA : WA + WB)); }
    HD const bf16_t* brow(int s, int, int col, int) const { return wsp<bf16_t>(c, WT_A) + (size_t)col * OW + (s == 0 ? 0 : (s == 1 ? WA : WA + WB)); }
    HD void between(int s, int row, int col, float& acc, float& carry) const { carry += bf2f(wsp<bf16_t>(c, OFF_GATES)[((size_t)s * T + row) * D + col]) * acc; acc = 0.f; }
    HD void store(int row, int col, float, float carry) const { wsp<bf16_t>(c, OFF_MERGED)[(size_t)row * D + col] = f2bf(carry); } };
struct G_wout { Ctx c; static constexpr int N = D, NSEGS = 1, NBP = 1;
    HD int M() const { return T; } HD int K(int) const { return D; }
    HD const bf16_t* arow(int, int row) const { return wsp<bf16_t>(c, OFF_MERGED) + (size_t)row * D; }
    HD const bf16_t* brow(int, int, int col, int) const { return wsp<bf16_t>(c, WT_OUT) + (size_t)col * D; }
    HD void between(int, int, int, float&, float&) const {}
    HD void store(int row, int col, float a, float) const { wsp<float>(c, OFF_H1)[(size_t)row * D + col] = DN_ALPHA * c.x[(size_t)row * D + col] + a; } };
struct MoeRow { int e, pos, valid, entry; };
HD MoeRow moe_row(const Ctx& c, int row) {
    const int* blk = wsp<int>(c, OFF_SMALL) + SM_BLK; const unsigned* cnt = wsp<unsigned>(c, OFF_CTL) + CW_CNT;
    MoeRow r; const int rb = row >> 8; r.e = blk[64 + rb]; r.pos = ((rb - blk[r.e]) << 8) + (row & 255); r.valid = r.pos < (int)cnt[r.e];
    r.entry = wsp<int>(c, OFF_LIST)[(size_t)r.e * T + (r.valid ? r.pos : 0)]; return r; }
HD int moe_rows_total(const Ctx& c) { return (wsp<int>(c, OFF_SMALL) + SM_BLK)[32] << 8; }
struct G_moe1 { Ctx c; static constexpr int N = DE, NSEGS = 1, NBP = 2;
    HD int M() const { return moe_rows_total(c); } HD int K(int) const { return D; }
    HD const bf16_t* arow(int, int row) const { const MoeRow r = moe_row(c, row); return wsp<bf16_t>(c, OFF_X1B) + (size_t)(r.entry >> 1) * D; }
    HD const bf16_t* brow(int, int row0, int col, int which) const { const int e = (wsp<int>(c, OFF_SMALL) + SM_BLK)[64 + (row0 >> 8)];
        return wsp<bf16_t>(c, OFF_WTGU) + ((size_t)e * 2 * DE + (col / HBK) * 2 * HBK + which * HBK + col % HBK) * D; }
    HD void between(int, int, int, float&, float&) const {}
    HD void store(int row, int col, float g, float u) const { wsp<bf16_t>(c, OFF_HBUF)[(size_t)row * DE + col] = f2bf(siluf_(g) * u); } };
struct G_moe2 { Ctx c; static constexpr int N = D, NSEGS = 1, NBP = 1;
    HD int M() const { return moe_rows_total(c); } HD int K(int) const { return DE; }
    HD const bf16_t* arow(int, int row) const { return wsp<bf16_t>(c, OFF_HBUF) + (size_t)row * DE; }
    HD const bf16_t* brow(int, int row0, int col, int) const { const int e = (wsp<int>(c, OFF_SMALL) + SM_BLK)[64 + (row0 >> 8)]; return wsp<bf16_t>(c, OFF_WTDN) + ((size_t)e * D + col) * DE; }
    HD void between(int, int, int, float&, float&) const {}
    HD void store(int row, int col, float a, float) const { const MoeRow r = moe_row(c, row); if (!r.valid) return;
        wsp<bf16_t>(c, (r.entry & 1) ? OFF_Y1 : OFF_Y0)[(size_t)(r.entry >> 1) * D + col] = f2bf(a); } };

struct u32x4_t { unsigned x, y, z, w; };
HD float bflo(unsigned u) { union { unsigned u; float f; } c; c.u = u << 16; return c.f; }
HD float bfhi(unsigned u) { union { unsigned u; float f; } c; c.u = u & 0xffff0000u; return c.f; }
HD float dot128(const bf16_t* a, const bf16_t* b) { float s = 0.f; const u32x4_t* pa = (const u32x4_t*)a; const u32x4_t* pb = (const u32x4_t*)b;
#ifndef HOST_TEST
#pragma unroll 4
#endif
    for (int d = 0; d < 16; ++d) { const u32x4_t ua = pa[d], ub = pb[d];
        s += bflo(ua.x) * bflo(ub.x) + bfhi(ua.x) * bfhi(ub.x) + bflo(ua.y) * bflo(ub.y) + bfhi(ua.y) * bfhi(ub.y) + bflo(ua.z) * bflo(ub.z) + bfhi(ua.z) * bfhi(ub.z) + bflo(ua.w) * bflo(ub.w) + bfhi(ua.w) * bfhi(ub.w); }
    return s; }
struct E_attnA { Ctx c; int half; static constexpr long n = (long)TH * 3 * 4 * 8;
    HD void operator()(long idx) const {
        const int p = (int)(idx & 7), h = (int)((idx >> 3) & 3); const long rest = idx >> 5; const int g = (int)(rest % 3), tl = (int)(rest / 3);
        const int r = dil_of(g), bl = tl / S, s = tl % S, cc = s % r, nq = s / r, L = S / r, base = bl * S + cc * L;
        const bf16_t* P = wsp<bf16_t>(c, OFF_P); const float* bias = wsp<float>(c, OFF_SMALL) + SM_BIAS + (g * 4 + h) * 129;
        const bf16_t* q = P + (size_t)(base + nq) * NP + g * 1536 + h * 128;
        float m = -INFINITY, l = 0.f, o[16];
#ifndef HOST_TEST
#pragma unroll
#endif
        for (int j = 0; j < 16; ++j) o[j] = 0.f;
        const int umax = nq < 128 ? nq : 128;
        for (int u = 0; u <= umax; ++u) {
            const bf16_t* kr = P + (size_t)(base + nq - u) * NP + g * 1536 + 512 + h * 128; const bf16_t* vr = kr + 512 + p * 16;
            const float sc = dot128(q, kr) * QK_SCALE + bias[u];
            const float mn = fmaxf(m, sc), a = expf(m - mn), pw = expf(sc - mn); l = l * a + pw; m = mn;
#ifndef HOST_TEST
#pragma unroll
#endif
            for (int j = 0; j < 16; ++j) o[j] = o[j] * a + pw * bf2f(vr[j]);
        }
        bf16_t* op = wsp<bf16_t>(c, OFF_PART) + ((size_t)g * TH + tl) * WA + h * 128 + p * 16; const float il = 1.f / l;
#ifndef HOST_TEST
#pragma unroll
#endif
        for (int j = 0; j < 16; ++j) op[j] = f2bf(o[j] * il);
        if (p == 0) wsp<float>(c, OFF_LSE)[((size_t)g * TH + tl) * 4 + h] = m + logf(l);
    } };
struct E_combA { Ctx c; int half; static constexpr long n = (long)TH * WA;
    HD void operator()(long idx) const { const int col = (int)(idx % WA), tl = (int)(idx / WA), h = col >> 7;
        const float* lse = wsp<float>(c, OFF_LSE); const bf16_t* part = wsp<bf16_t>(c, OFF_PART);
        const float l0 = lse[((size_t)0 * TH + tl) * 4 + h], l1 = lse[((size_t)1 * TH + tl) * 4 + h], l2 = lse[((size_t)2 * TH + tl) * 4 + h];
        const float mx = fmaxf(l0, fmaxf(l1, l2)), e0 = expf(l0 - mx), e1 = expf(l1 - mx), e2 = expf(l2 - mx), inv = 1.f / (e0 + e1 + e2);
        const float v = (e0 * bf2f(part[((size_t)0 * TH + tl) * WA + col]) + e1 * bf2f(part[((size_t)1 * TH + tl) * WA + col]) + e2 * bf2f(part[((size_t)2 * TH + tl) * WA + col])) * inv;
        ((bf16_t*)c.out)[((size_t)half * TH + tl) * OW + col] = f2bf(v); } };
struct E_attnC { Ctx c; int half; static constexpr long n = (long)TH * 4 * 8;
    HD void operator()(long idx) const { const int p = (int)(idx & 7), h = (int)((idx >> 3) & 3), tl = (int)(idx >> 5), b = half * BH + tl / S;
        const bf16_t* q = wsp<bf16_t>(c, OFF_P) + (size_t)tl * NP + COLS_A + COLS_B + h * 128; const bf16_t* kv = wsp<bf16_t>(c, OFF_MEMKV) + (size_t)b * MEM * 1024;
        float m = -INFINITY, l = 0.f, o[16];
#ifndef HOST_TEST
#pragma unroll
#endif
        for (int j = 0; j < 16; ++j) o[j] = 0.f;
        for (int k = 0; k < MEM; ++k) { const bf16_t* kr = kv + (size_t)k * 1024 + h * 128; const bf16_t* vr = kr + 512 + p * 16;
            const float sc = dot128(q, kr) * QK_SCALE; const float mn = fmaxf(m, sc), a = expf(m - mn), pw = expf(sc - mn); l = l * a + pw; m = mn;
#ifndef HOST_TEST
#pragma unroll
#endif
            for (int j = 0; j < 16; ++j) o[j] = o[j] * a + pw * bf2f(vr[j]); }
        bf16_t* op = (bf16_t*)c.out + ((size_t)half * TH + tl) * OW + WA + WB + h * 128 + p * 16; const float il = 1.f / l;
#ifndef HOST_TEST
#pragma unroll
#endif
        for (int j = 0; j < 16; ++j) op[j] = f2bf(o[j] * il); } };

HD float hg_f(const Ctx& c, const bf16_t* prow, int ch) { const float lb = wsp<float>(c, OFF_SMALL)[SM_LB + ch]; return lb + (1.f - lb) * sigmoidf_(bf2f(prow[COLS_A + WB + ch])); }
struct E_hg1 { Ctx c; int half; static constexpr long n = (long)BH * HB * NSEG * 128 * 128;
    HD void operator()(long idx) const { const int v = (int)(idx & 127), k = (int)((idx >> 7) & 127); const long r = idx >> 14; const int seg = (int)(r % NSEG), bhl = (int)(r / NSEG), h = bhl % HB, bl = bhl / HB;
        const bf16_t* P = wsp<bf16_t>(c, OFF_P); const int ch = h * 128 + k; float st = 0.f, dsum = 0.f;
        for (int s = 0; s < 256; ++s) { const bf16_t* pr = P + (size_t)(bl * S + seg * 256 + s) * NP; const float f = hg_f(c, pr, ch); st = f * st + (1.f - f) * bf2f(pr[COLS_A + 2 * WB + h * 128 + v]); dsum += logf(f); }
        wsp<float>(c, OFF_HG)[idx] = st; if (v == 0) wsp<float>(c, OFF_DSEG)[((size_t)bhl * NSEG + seg) * 128 + k] = dsum; } };
struct E_hg2 { Ctx c; static constexpr long n = (long)BH * HB * 128 * 128;
    HD void operator()(long idx) const { const int v = (int)(idx & 127), k = (int)((idx >> 7) & 127), bhl = (int)(idx >> 14); float run = 0.f;
        for (int seg = 0; seg < NSEG; ++seg) { float* p = wsp<float>(c, OFF_HG) + (((size_t)bhl * NSEG + seg) * 128 + k) * 128 + v; const float tmp = *p; *p = run;
            run = expf(wsp<float>(c, OFF_DSEG)[((size_t)bhl * NSEG + seg) * 128 + k]) * run + tmp; } } };
struct E_hg3 { Ctx c; int half; static constexpr long n = (long)BH * HB * NSEG * 128;
    HD void operator()(long idx) const { const int v = (int)(idx & 127); const long r = idx >> 7; const int seg = (int)(r % NSEG), bhl = (int)(r / NSEG), h = bhl % HB, bl = bhl / HB;
        const bf16_t* P = wsp<bf16_t>(c, OFF_P); float st[128];
#ifndef HOST_TEST
#pragma unroll
#endif
        for (int k = 0; k < 128; ++k) st[k] = wsp<float>(c, OFF_HG)[(((size_t)bhl * NSEG + seg) * 128 + k) * 128 + v];
        for (int s = 0; s < 256; ++s) { const int tl = bl * S + seg * 256 + s; const bf16_t* pr = P + (size_t)tl * NP; const float iv = bf2f(pr[COLS_A + 2 * WB + h * 128 + v]); float o = 0.f;
#ifndef HOST_TEST
#pragma unroll
#endif
            for (int k = 0; k < 128; ++k) { const float f = hg_f(c, pr, h * 128 + k); st[k] = f * st[k] + (1.f - f) * iv; o += siluf_(bf2f(pr[COLS_A + h * 128 + k])) * st[k]; }
            ((bf16_t*)c.out)[((size_t)half * TH + tl) * OW + WA + h * 128 + v] = f2bf(o); } } };
struct E_hgnorm { Ctx c; int half; static constexpr long n = (long)TH * HB;
    HD void operator()(long idx) const { const int h = (int)(idx % HB), tl = (int)(idx / HB); bf16_t* o = (bf16_t*)c.out + ((size_t)half * TH + tl) * OW + WA + h * 128;
        const bf16_t* pr = wsp<bf16_t>(c, OFF_P) + (size_t)tl * NP + COLS_A + 3 * WB + h * 128; float ss = 0.f;
        for (int v = 0; v < 128; ++v) { const float x = bf2f(o[v]); ss += x * x; }
        const float rs = 1.f / sqrtf(ss * (1.f / 128.f) + RMS_EPS);
        for (int v = 0; v < 128; ++v) o[v] = f2bf(bf2f(o[v]) * rs * c.norm_g[h * 128 + v] * siluf_(bf2f(pr[v]))); } };

struct E_ln1 { Ctx c; static constexpr long n = T;
    HD void operator()(long row) const { float* h1 = wsp<float>(c, OFF_H1) + (size_t)row * D; bf16_t* xb1 = wsp<bf16_t>(c, OFF_X1B) + (size_t)row * D;
        float mu = 0.f; for (int i = 0; i < D; ++i) mu += h1[i]; mu *= (1.f / D);
        float var = 0.f; for (int i = 0; i < D; ++i) { const float d = h1[i] - mu; var += d * d; } var *= (1.f / D); const float rs = 1.f / sqrtf(var + LN_EPS);
        float gl0 = c.b_rg[0], gl1 = c.b_rg[1], gl2 = c.b_rg[2], gl3 = c.b_rg[3];
        for (int i = 0; i < D; ++i) { const float v = (h1[i] - mu) * rs * c.ln1_g[i] + c.ln1_b[i]; h1[i] = v; xb1[i] = f2bf(v);
            gl0 += v * c.w_rg[i * 4 + 0]; gl1 += v * c.w_rg[i * 4 + 1]; gl2 += v * c.w_rg[i * 4 + 2]; gl3 += v * c.w_rg[i * 4 + 3]; }
        int gs = 0; float gm = gl0; if (gl1 > gm) { gm = gl1; gs = 1; } if (gl2 > gm) { gm = gl2; gs = 2; } if (gl3 > gm) { gm = gl3; gs = 3; }
        const float gp = 1.f / (expf(gl0 - gm) + expf(gl1 - gm) + expf(gl2 - gm) + expf(gl3 - gm));
        float v0 = -INFINITY, v1 = -INFINITY; int i0 = 0, i1 = 0;
        for (int j = 0; j < 8; ++j) { float el = c.b_re[gs * 8 + j]; for (int i = 0; i < D; ++i) el += h1[i] * c.w_re[i * 32 + gs * 8 + j];
            if (el > v0) { v1 = v0; i1 = i0; v0 = el; i0 = j; } else if (el > v1) { v1 = el; i1 = j; } }
        const float e1 = expf(v1 - v0), w0 = gp / (1.f + e1), w1 = gp * e1 / (1.f + e1);
        unsigned* cnt = wsp<unsigned>(c, OFF_CTL) + CW_CNT; int* list = wsp<int>(c, OFF_LIST); float* rw = wsp<float>(c, OFF_RW);
        const int ea = gs * 8 + i0, eb = gs * 8 + i1;
        list[(size_t)ea * T + atomic_inc_u32(cnt + ea)] = (int)row * 2 + 0; list[(size_t)eb * T + atomic_inc_u32(cnt + eb)] = (int)row * 2 + 1;
        rw[row * 2 + 0] = w0; rw[row * 2 + 1] = w1; } };
struct E_blk { Ctx c; static constexpr long n = 1;
    HD void operator()(long) const { int* blk = wsp<int>(c, OFF_SMALL) + SM_BLK; const unsigned* cnt = wsp<unsigned>(c, OFF_CTL) + CW_CNT; int acc = 0;
        for (int e = 0; e < NE; ++e) { blk[e] = acc; const int nb = ((int)cnt[e] + 255) >> 8; for (int j = 0; j < nb; ++j) blk[64 + acc + j] = e; acc += nb; } blk[32] = acc; } };
struct E_ln2 { Ctx c; static constexpr long n = T;
    HD void operator()(long row) const { const float* x1 = wsp<float>(c, OFF_H1) + (size_t)row * D; const bf16_t* y0 = wsp<bf16_t>(c, OFF_Y0) + (size_t)row * D; const bf16_t* y1 = wsp<bf16_t>(c, OFF_Y1) + (size_t)row * D;
        const float w0 = wsp<float>(c, OFF_RW)[row * 2], w1 = wsp<float>(c, OFF_RW)[row * 2 + 1]; float* o = c.out + (size_t)row * D;
        float mu = 0.f; for (int i = 0; i < D; ++i) { const float v = DN_ALPHA * x1[i] + w0 * bf2f(y0[i]) + w1 * bf2f(y1[i]); mu += v; } mu *= (1.f / D);
        float var = 0.f; for (int i = 0; i < D; ++i) { const float v = DN_ALPHA * x1[i] + w0 * bf2f(y0[i]) + w1 * bf2f(y1[i]) - mu; var += v * v; } var *= (1.f / D); const float rs = 1.f / sqrtf(var + LN_EPS);
        for (int i = 0; i < D; ++i) { const float v = DN_ALPHA * x1[i] + w0 * bf2f(y0[i]) + w1 * bf2f(y1[i]); o[i] = (v - mu) * rs * c.ln2_g[i] + c.ln2_b[i]; } } };
typedef short bf16x8 __attribute__((ext_vector_type(8)));
typedef float f32x4 __attribute__((ext_vector_type(4)));

template <class F> __global__ void __launch_bounds__(256) k_elems(F f, long n) {
    for (long i = (long)blockIdx.x * 256 + threadIdx.x; i < n; i += (long)gridDim.x * 256) f(i);
}
template <class F> __global__ void __launch_bounds__(64) k_elems64(F f, long n) {
    for (long i = (long)blockIdx.x * 64 + threadIdx.x; i < n; i += (long)gridDim.x * 64) f(i);
}
template <class G> __global__ void __launch_bounds__(256) k_sgemm(G g) {
    const int M = g.M(); const int lane = threadIdx.x & 63, wid = threadIdx.x >> 6; constexpr int ntn = G::N / 64;
    const long ntiles = (long)(M / 64) * ntn;
    for (long tile = blockIdx.x; tile < ntiles; tile += gridDim.x) {
        const int tm = (int)(tile / ntn), tn = (int)(tile % ntn), r0 = tm * 64 + wid * 16, c0 = tn * 64;
        f32x4 acc[G::NBP][4], carry[4];
#pragma unroll
        for (int j = 0; j < 4; ++j) { carry[j] = (f32x4){0.f, 0.f, 0.f, 0.f};
#pragma unroll
            for (int w = 0; w < G::NBP; ++w) acc[w][j] = (f32x4){0.f, 0.f, 0.f, 0.f}; }
#pragma unroll
        for (int seg = 0; seg < G::NSEGS; ++seg) {
            const bf16_t* ar = g.arow(seg, r0 + (lane & 15)) + 8 * (lane >> 4); const bf16_t* br[G::NBP][4];
#pragma unroll
            for (int w = 0; w < G::NBP; ++w)
#pragma unroll
                for (int j = 0; j < 4; ++j) br[w][j] = g.brow(seg, r0, c0 + 16 * j + (lane & 15), w) + 8 * (lane >> 4);
            const int K = g.K(seg);
            for (int k0 = 0; k0 < K; k0 += 32) { const bf16x8 a = *(const bf16x8*)(ar + k0);
#pragma unroll
                for (int w = 0; w < G::NBP; ++w)
#pragma unroll
                    for (int j = 0; j < 4; ++j) { const bf16x8 b = *(const bf16x8*)(br[w][j] + k0); acc[w][j] = __builtin_amdgcn_mfma_f32_16x16x32_bf16(a, b, acc[w][j], 0, 0, 0); } }
#pragma unroll
            for (int j = 0; j < 4; ++j)
#pragma unroll
                for (int i = 0; i < 4; ++i) { float a = acc[0][j][i], cr = carry[j][i]; g.between(seg, r0 + (lane >> 4) * 4 + i, c0 + 16 * j + (lane & 15), a, cr); acc[0][j][i] = a; carry[j][i] = cr; }
        }
#pragma unroll
        for (int j = 0; j < 4; ++j)
#pragma unroll
            for (int i = 0; i < 4; ++i) g.store(r0 + (lane >> 4) * 4 + i, c0 + 16 * j + (lane & 15), acc[0][j][i], G::NBP == 2 ? acc[G::NBP - 1][j][i] : carry[j][i]);
    }
}
template <class F> static void launch_elems(const F& f, long n, hipStream_t st) { long nb = (n + 255) / 256; if (nb > 32768) nb = 32768; if (nb < 1) nb = 1; hipLaunchKernelGGL(k_elems<F>, dim3((unsigned)nb), dim3(256), 0, st, f, n); }
template <class F> static void launch_elems64(const F& f, long n, hipStream_t st) { long nb = (n + 63) / 64; if (nb > 65536) nb = 65536; hipLaunchKernelGGL(k_elems64<F>, dim3((unsigned)nb), dim3(64), 0, st, f, n); }
template <class G> static void launch_sgemm(const G& g, hipStream_t st) { hipLaunchKernelGGL(k_sgemm<G>, dim3(4096), dim3(256), 0, st, g); }

static Ctx make_ctx(void* const* d_in, void* d_out, void* d_ws) {
    Ctx c; memset(&c, 0, sizeof(c)); const float** ip = (const float**)&c; for (int i = 0; i < 22; ++i) ip[i] = (const float*)d_in[i];
    c.out = (float*)d_out; c.ws = (unsigned char*)d_ws; return c;
}
static void v1_stage0(Ctx c, hipStream_t st) {
    launch_elems(S0_xb{c}, S0_xb::n, st); launch_elems(S0_memb{c}, S0_memb::n, st); launch_elems(S0_small{c}, S0_small::n, st);
    launch_elems(S0_tr{c.w_in, wsp<bf16_t>(c, WT_IN), D, N_IN, (long)D * N_IN, D}, (long)D * N_IN, st);
    launch_elems(S0_tr{c.w_kv, wsp<bf16_t>(c, WT_KV), D, 1024, (long)D * 1024, D}, (long)D * 1024, st);
    launch_elems(S0_tr{c.w_a, wsp<bf16_t>(c, WT_A), WA, D, (long)D * WA, OW}, (long)D * WA, st);
    launch_elems(S0_tr{c.w_b, wsp<bf16_t>(c, WT_A) + WA, WB, D, (long)D * WB, OW}, (long)D * WB, st);
    launch_elems(S0_tr{c.w_c, wsp<bf16_t>(c, WT_A) + WA + WB, WC, D, (long)D * WC, OW}, (long)D * WC, st);
    launch_elems(S0_tr{c.w_out, wsp<bf16_t>(c, WT_OUT), D, D, (long)D * D, D}, (long)D * D, st);
}
static void v1_proj(Ctx c, int half, hipStream_t st) { if (half == 0) launch_sgemm(G_memkv{c}, st); launch_sgemm(G_proj{c, half}, st); }
static void v1_mixers(Ctx c, int half, hipStream_t st) {
    launch_elems(E_hg1{c, half}, E_hg1::n, st); launch_elems(E_hg2{c}, E_hg2::n, st);
    launch_elems(E_attnA{c, half}, E_attnA::n, st); launch_elems(E_attnC{c, half}, E_attnC::n, st);
    launch_elems64(E_hg3{c, half}, E_hg3::n, st); launch_elems(E_hgnorm{c, half}, E_hgnorm::n, st); launch_elems(E_combA{c, half}, E_combA::n, st);
}
static void v1_expw(Ctx c, hipStream_t st) { launch_elems(S0_gu{c}, S0_gu::n, st); launch_elems(S0_dn{c}, S0_dn::n, st); }
static void v1_gates(Ctx c, hipStream_t st) { launch_sgemm(G_gates{c}, st); }
static void v1_merge(Ctx c, hipStream_t st) { launch_sgemm(G_merge{c}, st); }
static void v1_wout(Ctx c, hipStream_t st) { launch_sgemm(G_wout{c}, st); }
static void v1_ln1(Ctx c, hipStream_t st) { launch_elems(E_ln1{c}, E_ln1::n, st); launch_elems(E_blk{c}, 1, st); }
static void v1_moe1(Ctx c, hipStream_t st) { launch_sgemm(G_moe1{c}, st); }
static void v1_moe2(Ctx c, hipStream_t st) { launch_sgemm(G_moe2{c}, st); }
static void v1_ln2(Ctx c, hipStream_t st) { launch_elems(E_ln2{c}, E_ln2::n, st); }
namespace pg8 {
#define PG8_LAS __attribute__((address_space(3)))
typedef unsigned u32x4 __attribute__((ext_vector_type(4)));
constexpr int BM = 256, BK = 64, HALF = 128, HTB = HALF * BK * 2, STAGE_BYTES = 8 * HTB, NXCD = 8, WGM = 8;
__host__ __device__ __forceinline__ int lds_byte(int r, int c) { const int st = (r >> 4) * 2 + (c >> 5), rr = r & 15, cc = c & 31, ob = rr * 64 + cc * 2; return st * 1024 + (ob ^ (((ob >> 9) & 1) << 5)); }
__host__ __device__ __forceinline__ void stage_rc(int b, int& R, int& C) { const int st = b / 1024, sb = b % 1024, swz = sb ^ (((sb >> 9) & 1) << 5); R = (st >> 1) * 16 + swz / 64; C = (st & 1) * 32 + (swz % 64) / 2; }
__host__ __device__ __forceinline__ int perm32(int rho) { const int n = rho >> 4, i = rho & 15; return 8 * (i >> 2) + 4 * n + (i & 3); }
__device__ __forceinline__ unsigned cvt_pk_bf16(float lo, float hi) { unsigned r; asm volatile("v_cvt_pk_bf16_f32 %0, %1, %2" : "=v"(r) : "v"(lo), "v"(hi)); return r; }

__device__ __forceinline__ int lane_id_opaque() { int l; asm volatile("v_mbcnt_lo_u32_b32 %0, -1, 0\n\tv_mbcnt_hi_u32_b32 %0, -1, %0" : "=v"(l)); return l; }
struct Unit { const char* A; const char* B; int nt, pm, pn, tag; };
__device__ __forceinline__ void tile_of(int L, int nM, int nN, int& pm, int& pn) {
    const int nwg = nM * nN; int wgid = L; { const int q = nwg / NXCD, r = nwg % NXCD, xcd = wgid % NXCD, off = wgid / NXCD; wgid = (xcd < r ? xcd * (q + 1) : r * (q + 1) + (xcd - r) * q) + off; }
    const int nig = WGM * nN, gid = wgid / nig, fm = gid * WGM, gsz = (nM - fm) < WGM ? (nM - fm) : WGM;
    pm = fm + ((wgid % nig) % gsz); pn = (wgid % nig) / gsz;
}
template <class Epi, class Sched>
__device__ __forceinline__ void gemm_phase(PG8_LAS unsigned char* lds, const Sched& S, const Epi& E, int tid) {
    constexpr bool GA = Sched::GATHER;
    asm volatile("" : "+v"(tid));
    const int wid = __builtin_amdgcn_readfirstlane(tid >> 6), lane = tid & 63, wr = wid >> 2, wc = wid & 3, fr = lane & 15, fq = lane >> 4;
    const unsigned lda = S.lda, ldb = S.ldb;
    int sR[2]; unsigned voffA[2], voffB[2];
#pragma unroll
    for (int i = 0; i < 2; ++i) { int R, C; stage_rc(tid * 16 + i * 8192, R, C); sR[i] = R; const int Rb = Epi::PERM ? ((R & ~31) + perm32(R & 31)) : R;
        voffA[i] = (GA ? 0u : (unsigned)R * lda) + (unsigned)C * 2u; voffB[i] = (unsigned)Rb * ldb + (unsigned)C * 2u; }
    const size_t kstep = (size_t)(BK * 2), hstepA = (size_t)HALF * lda, hstepB = (size_t)HALF * ldb;
    const unsigned ldsw = (unsigned)wid * 1024u;
    const int aoff = lds_byte(wr * 64 + fr, fq * 8), boff = lds_byte(wc * 32 + fr, fq * 8);
#define PG8_SA(b, h) (((b) * 2 + (h)) * HTB)
#define PG8_SB(b, h) ((4 + (b) * 2 + (h)) * HTB)
#define PG8_STAGE(bufoff, gbase, voff) do { const char* gb_ = (const char*)(gbase); asm volatile("" : "+s"(gb_));     \
        _Pragma("unroll") for (int _i = 0; _i < 2; ++_i) \
        __builtin_amdgcn_global_load_lds((const unsigned*)(gb_ + (voff)[_i]), (PG8_LAS unsigned*)(lds + (bufoff) + ldsw + _i * 8192), 16, 0, 0); } while (0)
#define PG8_STAGE_A(bufoff, gbase, h, tk) do { if constexpr (GA) { unsigned _o[2]; _Pragma("unroll") for (int _i = 0; _i < 2; ++_i) _o[_i] = (((tk)[_i] >> (16 * (h))) & 0xffffu) * lda + voffA[_i]; PG8_STAGE(bufoff, gbase, _o); } \
        else { PG8_STAGE(bufoff, (gbase) + (h) * hstepA, voffA); } } while (0)
#define PG8_LDA(dst, b, h) do { _Pragma("unroll") for (int m = 0; m < 4; ++m) _Pragma("unroll") for (int k = 0; k < 2; ++k) dst[m][k] = *(const PG8_LAS bf16x8*)(lds + PG8_SA(b, h) + aoff + m * 2048 + k * 1024); } while (0)
#define PG8_LDB(dst, b, h) do { _Pragma("unroll") for (int n = 0; n < 2; ++n) _Pragma("unroll") for (int k = 0; k < 2; ++k) dst[n][k] = *(const PG8_LAS bf16x8*)(lds + PG8_SB(b, h) + boff + n * 2048 + k * 1024); } while (0)
#define PG8_MMA(ai, bj, At, Bt) do { __builtin_amdgcn_s_setprio(1); _Pragma("unroll") for (int m = 0; m < 4; ++m) _Pragma("unroll") for (int n = 0; n < 2; ++n) _Pragma("unroll") for (int k = 0; k < 2; ++k) \
        acc[ai][bj][m][n] = __builtin_amdgcn_mfma_f32_16x16x32_bf16(Bt[n][k], At[m][k], acc[ai][bj][m][n], 0, 0, 0); __builtin_amdgcn_s_setprio(0); } while (0)
#define PG8_WAIT_V(n) asm volatile("s_waitcnt vmcnt(" #n ")" ::: "memory")
#define PG8_WAIT_L(n) asm volatile("s_waitcnt lgkmcnt(" #n ")" ::: "memory")
#define PG8_BAR __builtin_amdgcn_s_barrier()
#define PG8_SCHED __builtin_amdgcn_sched_barrier(0)
#define PG8_TOKS(u, tk) do { if constexpr (GA) { _Pragma("unroll") for (int _i = 0; _i < 2; ++_i) tk[_i] = S.a_row(u, sR[_i]) | (S.a_row(u, sR[_i] + HALF) << 16); } } while (0)
    Unit cur, nxt; int ui = 0;
    if (!S.next(0, cur)) return;
    f32x4 acc[2][2][4][2];
#pragma unroll
    for (int a = 0; a < 2; ++a)
#pragma unroll
        for (int b = 0; b < 2; ++b)
#pragma unroll
            for (int m = 0; m < 4; ++m)
#pragma unroll
                for (int n = 0; n < 2; ++n) acc[a][b][m][n] = (f32x4){0.f, 0.f, 0.f, 0.f};
    bf16x8 At[4][2], B0[2][2], B1[2][2];
    unsigned ctk[2] = {0u, 0u}, ntk[2] = {0u, 0u};
    PG8_TOKS(cur, ctk);
    const char* cA = cur.A; const char* cB = cur.B;
    PG8_STAGE(PG8_SB(0, 0), cB, voffB); PG8_STAGE(PG8_SB(0, 1), cB + hstepB, voffB); PG8_STAGE_A(PG8_SA(0, 0), cA, 0, ctk); PG8_STAGE_A(PG8_SA(0, 1), cA, 1, ctk);
    if (wr == 1) PG8_BAR;
    PG8_WAIT_V(2); PG8_BAR;
    PG8_STAGE(PG8_SB(1, 0), cB + kstep, voffB); PG8_STAGE_A(PG8_SA(1, 0), cA + kstep, 0, ctk); PG8_STAGE(PG8_SB(1, 1), cB + hstepB + kstep, voffB);
    PG8_WAIT_V(6); PG8_BAR;
    for (;;) {
        const bool has_next = S.next(ui + 1, nxt);
        const char* nA = cA; const char* nB = cB;
        if constexpr (GA) { ntk[0] = ctk[0]; ntk[1] = ctk[1]; }
        if (has_next) { nA = nxt.A; nB = nxt.B; PG8_TOKS(nxt, ntk); }
        const int nt = cur.nt;
#define PG8_TRIP(a1, a2, b2, tk2) do { const char* a3 = (a2) + kstep; const char* b3 = (b2) + kstep; \
            PG8_LDB(B0, 0, 0); PG8_LDB(B1, 0, 1); PG8_SCHED; PG8_LDA(At, 0, 0); PG8_STAGE_A(PG8_SA(1, 1), a1, 1, ctk); \
            PG8_WAIT_V(8); PG8_WAIT_L(0); PG8_BAR; PG8_MMA(0, 0, At, B0); PG8_MMA(0, 1, At, B1); PG8_BAR; PG8_SCHED; \
            PG8_LDA(At, 0, 1); PG8_STAGE(PG8_SB(0, 0), b2, voffB); PG8_STAGE(PG8_SB(0, 1), (b2) + hstepB, voffB); PG8_STAGE_A(PG8_SA(0, 0), a2, 0, tk2); \
            PG8_WAIT_V(8); PG8_WAIT_L(0); PG8_BAR; PG8_MMA(1, 0, At, B0); PG8_MMA(1, 1, At, B1); PG8_BAR; PG8_SCHED; \
            PG8_LDB(B0, 1, 0); PG8_LDB(B1, 1, 1); PG8_SCHED; PG8_LDA(At, 1, 0); PG8_STAGE_A(PG8_SA(0, 1), a2, 1, tk2); \
            PG8_WAIT_V(8); PG8_WAIT_L(0); PG8_BAR; PG8_MMA(0, 0, At, B0); PG8_MMA(0, 1, At, B1); PG8_BAR; PG8_SCHED; \
            PG8_LDA(At, 1, 1); PG8_STAGE(PG8_SB(1, 0), b3, voffB); PG8_STAGE(PG8_SB(1, 1), b3 + hstepB, voffB); PG8_STAGE_A(PG8_SA(1, 0), a3, 0, tk2); \
            PG8_WAIT_V(8); PG8_WAIT_L(0); PG8_BAR; PG8_MMA(1, 0, At, B0); PG8_MMA(1, 1, At, B1); PG8_BAR; PG8_SCHED; } while (0)
        for (int t = 0; t < nt - 2; t += 2) { const char* a1 = cA + (size_t)(t + 1) * kstep; const char* a2 = cA + (size_t)(t + 2) * kstep; const char* b2 = cB + (size_t)(t + 2) * kstep;
            PG8_TRIP(a1, a2, b2, ctk); }
        { const char* a1 = cA + (size_t)(nt - 1) * kstep; PG8_TRIP(a1, nA, nB, ntk); }
#undef PG8_TRIP
        if (wr == 0) PG8_BAR;
        { const int el = lane_id_opaque(); E(acc, cur, wr, wc, el & 15, el >> 4); }
        if (!has_next) break;
        cur = nxt; cA = nA; cB = nB;
        if constexpr (GA) { ctk[0] = ntk[0]; ctk[1] = ntk[1]; }
        ++ui;
        if (wr == 1) PG8_BAR;
    }
    PG8_WAIT_V(0);
    PG8_BAR;
#undef PG8_SA
#undef PG8_SB
#undef PG8_STAGE
#undef PG8_STAGE_A
#undef PG8_LDA
#undef PG8_LDB
#undef PG8_MMA
#undef PG8_WAIT_V
#undef PG8_WAIT_L
#undef PG8_BAR
#undef PG8_SCHED
#undef PG8_TOKS
}
}
namespace pg8 {
#define ZERO_ACC() do { _Pragma("unroll") for (int a_ = 0; a_ < 2; ++a_) _Pragma("unroll") for (int b_ = 0; b_ < 2; ++b_) _Pragma("unroll") for (int m_ = 0; m_ < 4; ++m_) _Pragma("unroll") for (int n_ = 0; n_ < 2; ++n_) acc[a_][b_][m_][n_] = (f32x4){0.f, 0.f, 0.f, 0.f}; } while (0)
typedef f32x4 (&AccRef)[2][2][4][2];
__device__ __forceinline__ u32x4 pack8(f32x4 v0, f32x4 v1) { u32x4 w; w.x = cvt_pk_bf16(v0[0], v0[1]); w.y = cvt_pk_bf16(v0[2], v0[3]); w.z = cvt_pk_bf16(v1[0], v1[1]); w.w = cvt_pk_bf16(v1[2], v1[3]); return w; }
__device__ __forceinline__ void unpack8(u32x4 w, f32x4& v0, f32x4& v1) { v0 = (f32x4){bflo(w.x), bfhi(w.x), bflo(w.y), bfhi(w.y)}; v1 = (f32x4){bflo(w.z), bfhi(w.z), bflo(w.w), bfhi(w.w)}; }
__device__ __forceinline__ float fsigmoid(float x) { return __builtin_amdgcn_rcpf(1.f + __expf(-x)); }

struct SchedGrid {
    static constexpr bool GATHER = false; unsigned lda, ldb;
    int nM, nN, G, c, nt; const char *A0, *B0;
    __device__ __forceinline__ bool next(int i, Unit& u) const { const long L = (long)i * G + c; if (L >= (long)nM * nN) return false;
        int pm, pn; tile_of((int)L, nM, nN, pm, pn); u.pm = pm; u.pn = pn; u.tag = 0; u.nt = nt;
        u.A = A0 + (size_t)pm * BM * lda; u.B = B0 + (size_t)pn * BM * ldb; return true; }
};
struct SchedMerge {
    static constexpr bool GATHER = false; unsigned lda, ldb;
    int nM, nN, G, c; const char *A0, *B0;
    __device__ __forceinline__ bool next(int i, Unit& u) const { const int r = i / 3, s = i - r * 3; const long L = (long)r * G + c; if (L >= (long)nM * nN) return false;
        int pm, pn; tile_of((int)L, nM, nN, pm, pn); u.pm = pm; u.pn = pn; u.tag = s; u.nt = (s == 1 ? WB : WA) / BK;
        const size_t so = (size_t)((s > 0 ? WA : 0) + (s > 1 ? WB : 0)) * 2;
        u.A = A0 + (size_t)pm * BM * lda + so; u.B = B0 + (size_t)pn * BM * ldb + so; return true; }
};
#define ROWS_BEGIN(off0) { unsigned ro_ = (off0); _Pragma("unroll") for (int ai = 0; ai < 2; ++ai) { _Pragma("unroll") for (int m = 0; m < 4; ++m) {
#define ROWS_END(step16) ro_ += (m == 3 ? 5u : 1u) * (step16); asm volatile("" : "+v"(ro_) :: "memory"); } } }
struct EpiProj { static constexpr bool PERM = true; bf16_t* P;
    __device__ __forceinline__ void operator()(AccRef acc, const Unit& u, int wr, int wc, int fr, int fq) const {
        const int g = u.pn < 18 ? u.pn / 6 : -1; const int col0 = u.pn * BM + wc * 32 + 8 * fq; const int r0 = u.pm * BM + wr * 64 + fr;
        const int pr0 = g >= 0 ? perm_row(r0, g) : r0; const unsigned step16 = (unsigned)(16 >> (g <= 0 ? 0 : 2 * g)) * (NP * 2);
        char* base = (char*)P;
        ROWS_BEGIN((unsigned)pr0 * (NP * 2) + (unsigned)col0 * 2)
#pragma unroll
            for (int bj = 0; bj < 2; ++bj) *(u32x4*)(base + ro_ + bj * (HALF * 2)) = pack8(acc[ai][bj][m][0], acc[ai][bj][m][1]);
        ROWS_END(step16)
        ZERO_ACC(); } };
struct EpiGates { static constexpr bool PERM = true; bf16_t* Gt;
    __device__ __forceinline__ void operator()(AccRef acc, const Unit& u, int wr, int wc, int fr, int fq) const {
        const int pl = u.pn / (D / BM), col0 = (u.pn % (D / BM)) * BM + wc * 32 + 8 * fq, r0 = u.pm * BM + wr * 64 + fr; char* base = (char*)Gt + (size_t)pl * T * D * 2;
        ROWS_BEGIN((unsigned)r0 * (D * 2) + (unsigned)col0 * 2)
#pragma unroll
            for (int bj = 0; bj < 2; ++bj) { f32x4 v0 = acc[ai][bj][m][0], v1 = acc[ai][bj][m][1];
#pragma unroll
                for (int e = 0; e < 4; ++e) { v0[e] = fsigmoid(v0[e]); v1[e] = fsigmoid(v1[e]); }
                *(u32x4*)(base + ro_ + bj * (HALF * 2)) = pack8(v0, v1); }
        ROWS_END(16u * D * 2)
        ZERO_ACC(); } };
struct EpiMerge { static constexpr bool PERM = true; const bf16_t* Gt; bf16_t* Mg;
    __device__ __forceinline__ void operator()(AccRef acc, const Unit& u, int wr, int wc, int fr, int fq) const {
        const int s = u.tag; const int col0 = u.pn * BM + wc * 32 + 8 * fq, r0 = u.pm * BM + wr * 64 + fr; const char* gbase = (const char*)Gt + (size_t)s * T * D * 2; char* mbase = (char*)Mg;
        ROWS_BEGIN((unsigned)r0 * (D * 2) + (unsigned)col0 * 2)
#pragma unroll
            for (int bj = 0; bj < 2; ++bj) { f32x4 g0, g1; unpack8(*(const u32x4*)(gbase + ro_ + bj * (HALF * 2)), g0, g1);
                if (s < 2) { f32x4 h0, h1; unpack8(*(const u32x4*)(gbase + (size_t)T * D * 2 + ro_ + bj * (HALF * 2)), h0, h1);
#pragma unroll
                    for (int e = 0; e < 4; ++e) { g0[e] *= __builtin_amdgcn_rcpf(fmaxf(h0[e], 1e-20f)); g1[e] *= __builtin_amdgcn_rcpf(fmaxf(h1[e], 1e-20f)); } }
                acc[ai][bj][m][0] *= g0; acc[ai][bj][m][1] *= g1;
                if (s == 2) *(u32x4*)(mbase + ro_ + bj * (HALF * 2)) = pack8(acc[ai][bj][m][0], acc[ai][bj][m][1]); }
        ROWS_END(16u * D * 2)
        if (s == 2) ZERO_ACC(); } };
struct EpiWout { static constexpr bool PERM = false; const float* X; float* H1;
    __device__ __forceinline__ void operator()(AccRef acc, const Unit& u, int wr, int wc, int fr, int fq) const {
        const int col0 = u.pn * BM + wc * 32 + 4 * fq, r0 = u.pm * BM + wr * 64 + fr; const char* xb_ = (const char*)X; char* hb_ = (char*)H1;
        ROWS_BEGIN((unsigned)r0 * (D * 4) + (unsigned)col0 * 4)
#pragma unroll
            for (int bj = 0; bj < 2; ++bj)
#pragma unroll
                for (int n = 0; n < 2; ++n) { const f32x4 xv = *(const f32x4*)(xb_ + ro_ + (bj * HALF + n * 16) * 4); *(f32x4*)(hb_ + ro_ + (bj * HALF + n * 16) * 4) = xv * DN_ALPHA + acc[ai][bj][m][n]; }
        ROWS_END(16u * D * 4)
        ZERO_ACC(); } };
template <bool GA> struct SchedMoe {
    static constexpr bool GATHER = GA; unsigned lda, ldb;
    int G, c, ncol, nt; const int* blk; const int* list; const unsigned* cnt; const char* A; const char* B; size_t b_estride, b_pnstride;
    __device__ __forceinline__ bool next(int i, Unit& u) const { const long L = (long)i * G + c; const int nblk = __builtin_amdgcn_readfirstlane(blk[32]); if (L >= (long)nblk * ncol) return false;
        const int rb = (int)(L / ncol), pn = (int)(L % ncol), e = __builtin_amdgcn_readfirstlane(blk[64 + rb]); u.pm = rb; u.pn = pn; u.tag = e; u.nt = nt;
        u.A = GA ? A : A + (size_t)rb * BM * lda; u.B = B + (size_t)e * b_estride + (size_t)pn * b_pnstride; return true; }
    __device__ __forceinline__ unsigned a_row(const Unit& u, int row) const {
        const int e = u.tag, pos = ((u.pm - __builtin_amdgcn_readfirstlane(blk[e])) << 8) + row; const int entry = list[(size_t)e * T + (pos < __builtin_amdgcn_readfirstlane((int)cnt[e]) ? pos : 0)]; return (unsigned)(entry >> 1); }
};
struct EpiMoe1 { static constexpr bool PERM = true; bf16_t* Hb;
    __device__ __forceinline__ void operator()(AccRef acc, const Unit& u, int wr, int wc, int fr, int fq) const {
        const int col0 = u.pn * HALF + wc * 32 + 8 * fq, r0 = u.pm * BM + wr * 64 + fr; char* base = (char*)Hb;
        ROWS_BEGIN((unsigned)r0 * (DE * 2) + (unsigned)col0 * 2)
            f32x4 v0 = acc[ai][0][m][0], v1 = acc[ai][0][m][1];
#pragma unroll
            for (int e = 0; e < 4; ++e) { v0[e] = v0[e] * fsigmoid(v0[e]) * acc[ai][1][m][0][e]; v1[e] = v1[e] * fsigmoid(v1[e]) * acc[ai][1][m][1][e]; }
            *(u32x4*)(base + ro_) = pack8(v0, v1);
        ROWS_END(16u * DE * 2)
        ZERO_ACC(); } };
struct EpiMoe2 { static constexpr bool PERM = true; const int* blk; const int* list; const unsigned* cnt; bf16_t* Y0; bf16_t* Y1;
    __device__ __forceinline__ void operator()(AccRef acc, const Unit& u, int wr, int wc, int fr, int fq) const {
        const int e = u.tag, col0 = u.pn * BM + wc * 32 + 8 * fq, pbase = ((u.pm - __builtin_amdgcn_readfirstlane(blk[e])) << 8) + wr * 64 + fr, n_e = __builtin_amdgcn_readfirstlane((int)cnt[e]); const int* le = list + (size_t)e * T;
        ROWS_BEGIN((unsigned)pbase)
            const int pos = (int)ro_;
            if (pos < n_e) { const int entry = le[pos]; bf16_t* rowp = ((entry & 1) ? Y1 : Y0) + (size_t)(entry >> 1) * D + col0;
#pragma unroll
                for (int bj = 0; bj < 2; ++bj) *(u32x4*)(rowp + bj * HALF) = pack8(acc[ai][bj][m][0], acc[ai][bj][m][1]); }
        ROWS_END(16u)
        ZERO_ACC(); } };
#undef ROWS_BEGIN
#undef ROWS_END
#undef ZERO_ACC
}

__device__ __forceinline__ void fast_proj(const Ctx& c, int half, PG8_LAS unsigned char* lds, int tid, int bid, int nblk) {
    pg8::SchedGrid S; S.nM = TH / 256; S.nN = NP / 256; S.G = nblk; S.c = bid; S.nt = D / 64; S.lda = D * 2; S.ldb = D * 2;
    S.A0 = (const char*)(wsp<bf16_t>(c, OFF_XB) + (size_t)half * TH * D); S.B0 = (const char*)wsp<bf16_t>(c, WT_IN);
    pg8::EpiProj E{wsp<bf16_t>(c, OFF_P)}; pg8::gemm_phase(lds, S, E, tid);
}
__device__ __forceinline__ void fast_gates(const Ctx& c, PG8_LAS unsigned char* lds, int tid, int bid, int nblk) {
    pg8::SchedGrid S; S.nM = T / 256; S.nN = 3 * D / 256; S.G = nblk; S.c = bid; S.nt = D / 64; S.lda = D * 2; S.ldb = D * 2;
    S.A0 = (const char*)wsp<bf16_t>(c, OFF_XB); S.B0 = (const char*)(wsp<bf16_t>(c, WT_IN) + (size_t)NP * D);
    pg8::EpiGates E{wsp<bf16_t>(c, OFF_GATES)}; pg8::gemm_phase(lds, S, E, tid);
}
__device__ __forceinline__ void fast_merge(const Ctx& c, PG8_LAS unsigned char* lds, int tid, int bid, int nblk) {
    pg8::SchedMerge S; S.nM = T / 256; S.nN = D / 256; S.G = nblk; S.c = bid; S.lda = OW * 2; S.ldb = OW * 2;
    S.A0 = (const char*)c.out; S.B0 = (const char*)wsp<bf16_t>(c, WT_A);
    pg8::EpiMerge E{wsp<bf16_t>(c, OFF_GATES), wsp<bf16_t>(c, OFF_MERGED)}; pg8::gemm_phase(lds, S, E, tid);
}
__device__ __forceinline__ void fast_wout(const Ctx& c, PG8_LAS unsigned char* lds, int tid, int bid, int nblk) {
    pg8::SchedGrid S; S.nM = T / 256; S.nN = D / 256; S.G = nblk; S.c = bid; S.nt = D / 64; S.lda = D * 2; S.ldb = D * 2;
    S.A0 = (const char*)wsp<bf16_t>(c, OFF_MERGED); S.B0 = (const char*)wsp<bf16_t>(c, WT_OUT);
    pg8::EpiWout E{c.x, wsp<float>(c, OFF_H1)}; pg8::gemm_phase(lds, S, E, tid);
}
__device__ __forceinline__ void fast_moe1(const Ctx& c, PG8_LAS unsigned char* lds, int tid, int bid, int nblk) {
    pg8::SchedMoe<true> S; S.G = nblk; S.c = bid; S.ncol = 2; S.nt = D / 64; S.blk = wsp<int>(c, OFF_SMALL) + SM_BLK; S.list = wsp<int>(c, OFF_LIST); S.cnt = wsp<unsigned>(c, OFF_CTL) + CW_CNT;
    S.A = (const char*)wsp<bf16_t>(c, OFF_X1B); S.B = (const char*)wsp<bf16_t>(c, OFF_WTGU); S.b_estride = (size_t)2 * DE * D * 2; S.b_pnstride = (size_t)256 * D * 2; S.lda = D * 2; S.ldb = D * 2;
    pg8::EpiMoe1 E{wsp<bf16_t>(c, OFF_HBUF)}; pg8::gemm_phase(lds, S, E, tid);
}
__device__ __forceinline__ void fast_moe2(const Ctx& c, PG8_LAS unsigned char* lds, int tid, int bid, int nblk) {
    pg8::SchedMoe<false> S; S.G = nblk; S.c = bid; S.ncol = D / 256; S.nt = DE / 64; S.blk = wsp<int>(c, OFF_SMALL) + SM_BLK; S.list = wsp<int>(c, OFF_LIST); S.cnt = wsp<unsigned>(c, OFF_CTL) + CW_CNT;
    S.A = (const char*)wsp<bf16_t>(c, OFF_HBUF); S.B = (const char*)wsp<bf16_t>(c, OFF_WTDN); S.b_estride = (size_t)D * DE * 2; S.b_pnstride = (size_t)256 * DE * 2; S.lda = DE * 2; S.ldb = DE * 2;
    pg8::EpiMoe2 E{S.blk, S.list, S.cnt, wsp<bf16_t>(c, OFF_Y0), wsp<bf16_t>(c, OFF_Y1)}; pg8::gemm_phase(lds, S, E, tid);
}
namespace attn {
typedef short s16x4 __attribute__((ext_vector_type(4)));
typedef float f32x16 __attribute__((ext_vector_type(16)));
typedef unsigned u32x4 __attribute__((ext_vector_type(4)));
constexpr int KVBLK = 64, DH = 128, SHM_V = KVBLK * DH * 2, SHM_K = KVBLK * DH * 2;
constexpr int LDS_V = 0, LDS_K = 2 * SHM_V, LDS_WS = LDS_K + 2 * SHM_K, LDS_BIAS = LDS_WS + 8 * 64 * 4, BIAS_PAD = 96, BIAS_N = 129 + 2 * BIAS_PAD, LDS_END = LDS_BIAS + ((BIAS_N * 4 + 15) & ~15);
constexpr float LOG2E = 1.4426950408889634f, C2 = LOG2E * QK_SCALE, LN2 = 0.6931471805599453f;
#define KSWZ(row, colB) ((row) * 256 + ((colB) ^ (((row) & 7) << 4)))
#define SBAR() __builtin_amdgcn_sched_barrier(0)
__device__ __forceinline__ int v_st(int k, int c) { const int kk = (k & ~0xC) | ((k & 4) << 1) | ((k & 8) >> 1); return ((kk >> 3) * 4 + (c >> 5)) * 512 + ((kk & 7) * 32 + (c & 31)) * 2; }
__device__ __forceinline__ int v_rd_base(int lane) { return ((lane & 3) << 3) | (((lane >> 2) & 3) << 6) | (((lane >> 4) & 1) << 5) | (((lane >> 5) & 1) << 8); }
constexpr int v_rd_off(int d0, int ks, int half) { return d0 * 512 + ks * 4096 + half * 2048; }
__device__ __forceinline__ int crow(int r, int hi) { return (r & 3) + 8 * (r >> 2) + 4 * hi; }
__device__ __forceinline__ unsigned cvtpk(float lo, float hi) { unsigned r; asm volatile("v_cvt_pk_bf16_f32 %0, %1, %2" : "=v"(r) : "v"(lo), "v"(hi)); return r; }
__device__ __forceinline__ void qkt(f32x16& p0, f32x16& p1, const PG8_LAS char* kbuf, int r32, int hi, const bf16x8* qr) {
    p0 = f32x16{}; p1 = f32x16{};
    const PG8_LAS char* kb[4];
#pragma unroll
    for (int dd = 0; dd < 4; ++dd) kb[dd] = kbuf + KSWZ(r32, (dd * 16 + hi * 8) * 2);
#pragma unroll
    for (int d0 = 0; d0 < 8; ++d0) { const PG8_LAS char* a = kb[d0 & 3] + (d0 >> 2) * 128;
        const bf16x8 b0 = *(const PG8_LAS bf16x8*)(a);
        const bf16x8 b1 = *(const PG8_LAS bf16x8*)(a + 32 * 256);
        p0 = __builtin_amdgcn_mfma_f32_32x32x16_bf16(b0, qr[d0], p0, 0, 0, 0);
        p1 = __builtin_amdgcn_mfma_f32_32x32x16_bf16(b1, qr[d0], p1, 0, 0, 0); }
}
__device__ __forceinline__ void pv_tile(f32x16* o, int vb0, bf16x8 pa0, bf16x8 pa1, bf16x8 pa2, bf16x8 pa3) {
#define TRRD(dst, off) asm volatile("ds_read_b64_tr_b16 %0, %1 offset:%2" : "=&v"(dst) : "v"(vb0), "i"(off) : "memory")
#define PV_D0(d0) do { s16x4 l0, l1, l2, l3, h0, h1, h2, h3; constexpr int b_ = v_rd_off(d0, 0, 0); \
        TRRD(l0, b_); TRRD(h0, b_ + 2048); TRRD(l1, b_ + 4096); TRRD(h1, b_ + 6144); TRRD(l2, b_ + 8192); TRRD(h2, b_ + 10240); TRRD(l3, b_ + 12288); TRRD(h3, b_ + 14336); \
        asm volatile("s_waitcnt lgkmcnt(0)" ::: "memory"); SBAR(); \
        o[d0] = __builtin_amdgcn_mfma_f32_32x32x16_bf16(pa0, (bf16x8){l0[0], l0[1], l0[2], l0[3], h0[0], h0[1], h0[2], h0[3]}, o[d0], 0, 0, 0); \
        o[d0] = __builtin_amdgcn_mfma_f32_32x32x16_bf16(pa1, (bf16x8){l1[0], l1[1], l1[2], l1[3], h1[0], h1[1], h1[2], h1[3]}, o[d0], 0, 0, 0); \
        o[d0] = __builtin_amdgcn_mfma_f32_32x32x16_bf16(pa2, (bf16x8){l2[0], l2[1], l2[2], l2[3], h2[0], h2[1], h2[2], h2[3]}, o[d0], 0, 0, 0); \
        o[d0] = __builtin_amdgcn_mfma_f32_32x32x16_bf16(pa3, (bf16x8){l3[0], l3[1], l3[2], l3[3], h3[0], h3[1], h3[2], h3[3]}, o[d0], 0, 0, 0); } while (0)
    PV_D0(0); PV_D0(1); PV_D0(2); PV_D0(3);
#undef PV_D0
#undef TRRD
}
template <bool BAND>
__device__ __forceinline__ void attn_unit(PG8_LAS char* lds, const bf16_t* Q, size_t qs, const bf16_t* K, const bf16_t* V, size_t ks, int NT, int qpos0, int kpos0,
                                          bf16_t* Ob, size_t ostride, float* lse, int obase, int omul, int tid) {
    const int wid = __builtin_amdgcn_readfirstlane(tid >> 6), lane = tid & 63, r32 = lane & 31, hi = lane >> 5;
    PG8_LAS char* V_lds = lds + LDS_V; PG8_LAS char* K_lds = lds + LDS_K;
    PG8_LAS float* wsf = (PG8_LAS float*)(lds + LDS_WS) + wid * 64; const PG8_LAS float* bias = (const PG8_LAS float*)(lds + LDS_BIAS);
    const int sr = tid >> 4, sc = (tid & 15) * 8, vst0 = v_st(sr, sc), vst1 = v_st(32 + sr, sc), kws = KSWZ(sr, sc * 2);
    const int vbl = (int)(uintptr_t)V_lds + v_rd_base(lane);
    bf16x8 qr[8];
    { const bf16_t* qp = Q + (size_t)(wid * 32 + r32) * qs + hi * 8;
#pragma unroll
      for (int d0 = 0; d0 < 8; ++d0) qr[d0] = *(const bf16x8*)(qp + d0 * 16); }
    bf16x8 st_k0, st_k1, st_v0, st_v1;
#define SLOAD(t) do { const size_t ro_ = (size_t)((t) * KVBLK + sr) * ks + sc; st_k0 = *(const bf16x8*)(K + ro_); st_k1 = *(const bf16x8*)(K + ro_ + 32 * ks); st_v0 = *(const bf16x8*)(V + ro_); st_v1 = *(const bf16x8*)(V + ro_ + 32 * ks); } while (0)
#define SWRITE(bf) do { *(PG8_LAS bf16x8*)(K_lds + (bf) * SHM_K + kws) = st_k0; *(PG8_LAS bf16x8*)(K_lds + (bf) * SHM_K + kws + 32 * 256) = st_k1; \
                        *(PG8_LAS bf16x8*)(V_lds + (bf) * SHM_V + vst0) = st_v0; *(PG8_LAS bf16x8*)(V_lds + (bf) * SHM_V + vst1) = st_v1; } while (0)
    SLOAD(0); SWRITE(0);
    __syncthreads();
    float m_run = -1e30f, l_run = 0.f; f32x16 o[4] = {};
    const int qlo = qpos0 + wid * 32;
    for (int t = 0; t < NT; ++t) {
        const int buf = t & 1;
        if (t + 1 < NT) SLOAD(t + 1);
        const int kb = kpos0 + t * KVBLK;
        const bool act = !BAND || (kb <= qlo + 31 && kb + KVBLK - 1 >= qlo - 128);
        if (act) {
            f32x16 p0, p1;
            qkt(p0, p1, K_lds + buf * SHM_K, r32, hi, qr);
            if (BAND) {
                const int dq = qlo + r32 - kb - 4 * hi;
                const PG8_LAS float* bp = bias + (dq + BIAS_PAD - 59);
#pragma unroll
                for (int r = 0; r < 16; ++r) { const int cr = (r & 3) + 8 * (r >> 2);
                    const float b0 = bp[59 - cr], b1 = bp[59 - cr - 32];
                    p0[r] = ((unsigned)(dq - cr) <= 128u) ? fmaf(p0[r], C2, b0) : -INFINITY;
                    p1[r] = ((unsigned)(dq - cr - 32) <= 128u) ? fmaf(p1[r], C2, b1) : -INFINITY; }
            } else {
#pragma unroll
                for (int r = 0; r < 16; ++r) { p0[r] *= C2; p1[r] *= C2; }
            }
            float pmax = p0[0];
#pragma unroll
            for (int r = 1; r < 16; ++r) pmax = fmaxf(pmax, p0[r]);
#pragma unroll
            for (int r = 0; r < 16; ++r) pmax = fmaxf(pmax, p1[r]);
            { auto rr = __builtin_amdgcn_permlane32_swap(__float_as_uint(pmax), __float_as_uint(pmax), false, false); pmax = fmaxf(__uint_as_float(rr[0]), __uint_as_float(rr[1])); }
            const float mn = fmaxf(m_run, pmax), alpha = __builtin_amdgcn_exp2f(m_run - mn); m_run = mn;
            float ps = 0.f;
#pragma unroll
            for (int r = 0; r < 16; ++r) { p0[r] = __builtin_amdgcn_exp2f(p0[r] - mn); p1[r] = __builtin_amdgcn_exp2f(p1[r] - mn); ps += p0[r] + p1[r]; }
            { auto rr = __builtin_amdgcn_permlane32_swap(__float_as_uint(ps), __float_as_uint(ps), false, false); ps = __uint_as_float(rr[0]) + __uint_as_float(rr[1]); }
            l_run = l_run * alpha + ps;
            if (__any(alpha < 1.f)) { if (hi == 0) wsf[r32] = alpha; asm volatile("s_waitcnt lgkmcnt(0)" ::: "memory");
#pragma unroll
                for (int r = 0; r < 16; ++r) { const float a = wsf[crow(r, hi)];
#pragma unroll
                    for (int d_ = 0; d_ < 4; ++d_) o[d_][r] *= a; }
                asm volatile("s_waitcnt lgkmcnt(0)" ::: "memory"); }
            bf16x8 pa0, pa1, pa2, pa3;
#define PK4(P, B_, OUT) do { unsigned a0 = cvtpk(P[B_ + 0], P[B_ + 1]), a1 = cvtpk(P[B_ + 2], P[B_ + 3]); unsigned b0 = cvtpk(P[B_ + 4], P[B_ + 5]), b1 = cvtpk(P[B_ + 6], P[B_ + 7]); \
        auto r0 = __builtin_amdgcn_permlane32_swap(a0, b0, false, false); auto r1 = __builtin_amdgcn_permlane32_swap(a1, b1, false, false); \
        u32x4 w = {r0[0], r1[0], r0[1], r1[1]}; OUT = *reinterpret_cast<bf16x8*>(&w); } while (0)
            PK4(p0, 0, pa0); PK4(p0, 8, pa1); PK4(p1, 0, pa2); PK4(p1, 8, pa3);
#undef PK4
            SBAR();
            pv_tile(o, vbl + buf * SHM_V, pa0, pa1, pa2, pa3);
        }
        if (t + 1 < NT) SWRITE(buf ^ 1);
        __syncthreads();
    }
#undef SLOAD
#undef SWRITE
    if (hi == 0) wsf[r32] = l_run; asm volatile("s_waitcnt lgkmcnt(0)" ::: "memory");
    float rli[16];
#pragma unroll
    for (int r = 0; r < 16; ++r) rli[r] = __builtin_amdgcn_rcpf(wsf[crow(r, hi)]);
#pragma unroll
    for (int r = 0; r < 16; ++r) { const int row = wid * 32 + crow(r, hi); bf16_t* op = Ob + (size_t)(obase + row * omul) * ostride;
#pragma unroll
        for (int d0 = 0; d0 < 4; ++d0) { const float v = o[d0][r] * rli[r]; const float vn = __shfl_xor(v, 1);
            if ((r32 & 1) == 0) *(unsigned*)(op + d0 * 32 + r32) = cvtpk(v, vn); } }
    if (BAND) { if (hi == 0) lse[(size_t)(obase + (wid * 32 + r32) * omul) * 4] = (m_run + __log2f(l_run)) * LN2; }
    __syncthreads();
}
#undef KSWZ
#undef SBAR

__device__ __forceinline__ void attn_phase(const Ctx& c, int half, PG8_LAS unsigned char* lds_u, int tid, int bid, int nblk) {
    asm volatile("" : "+v"(tid));
    PG8_LAS char* lds = (PG8_LAS char*)lds_u;
    constexpr int QB = S / 256, NUA = BH * 3 * 4 * QB, NUC = BH * 4 * QB, NU = NUA + NUC;
    const bf16_t* P = wsp<bf16_t>(c, OFF_P);
    for (int u = bid; u < NU; u += nblk) {
        if (u < NUA) {
            const int j = u % QB, h = (u / QB) & 3, g = (u / (QB * 4)) % 3, bl = u / (QB * 12);
            const int r = dil_of(g), L = S / r, nqb = L / 256, cc = j / nqb, qb = j % nqb, q0 = qb * 256, base = bl * S + cc * L;
            { PG8_LAS float* bt = (PG8_LAS float*)(lds + LDS_BIAS); const float* bsrc = wsp<float>(c, OFF_SMALL) + SM_BIAS + (g * 4 + h) * 129;
              for (int i = tid; i < BIAS_N; i += 512) { const int uu = i - BIAS_PAD; bt[i] = (uu >= 0 && uu <= 128) ? bsrc[uu] * LOG2E : 0.f; } }
            const int klo = q0 >= 128 ? q0 - 128 : 0, NT = (q0 + 256 - klo) / 64;
            const bf16_t* Qp = P + (size_t)(base + q0) * NP + g * 1536 + h * 128; const bf16_t* Kp = P + (size_t)(base + klo) * NP + g * 1536 + 512 + h * 128;
            attn_unit<true>(lds, Qp, NP, Kp, Kp + 512, NP, NT, q0, klo, wsp<bf16_t>(c, OFF_PART) + (size_t)g * TH * WA + h * 128, WA, wsp<float>(c, OFF_LSE) + (size_t)g * TH * 4 + h,
                            bl * S + q0 * r + cc, r, tid);
        } else {
            const int v = u - NUA, j = v % QB, h = (v / QB) & 3, bl = v / (QB * 4), b = half * BH + bl, tl0 = bl * S + j * 256;
            const bf16_t* Qp = P + (size_t)tl0 * NP + COLS_A + COLS_B + h * 128; const bf16_t* Kp = wsp<bf16_t>(c, OFF_MEMKV) + (size_t)b * MEM * 1024 + h * 128;
            attn_unit<false>(lds, Qp, NP, Kp, Kp + 512, 1024, MEM / 64, 0, 0, (bf16_t*)c.out + (size_t)half * TH * OW + WA + WB + h * 128, OW, nullptr, tl0, 1, tid);
        }
    }
}
}
namespace rowops {
typedef float f32x4 __attribute__((ext_vector_type(4)));
typedef unsigned u32x2 __attribute__((ext_vector_type(2)));
typedef unsigned u32x4 __attribute__((ext_vector_type(4)));
__device__ __forceinline__ float wave_sum(float v) {
#pragma unroll
    for (int o = 1; o < 64; o <<= 1) v += __shfl_xor(v, o);
    return v;
}
__device__ __forceinline__ unsigned pk2(float lo, float hi) { return pg8::cvt_pk_bf16(lo, hi); }

__device__ __forceinline__ void ln1_router_phase(const Ctx& c, int tid, int bid, int nblk) {
    asm volatile("" : "+v"(tid));
    const int lane = tid & 63, wid = tid >> 6, gw = bid * 8 + wid, NGW = nblk * 8;
    float* H1 = wsp<float>(c, OFF_H1); bf16_t* X1B = wsp<bf16_t>(c, OFF_X1B);
    unsigned* cnt = wsp<unsigned>(c, OFF_CTL) + CW_CNT; int* list = wsp<int>(c, OFF_LIST); float* rw = wsp<float>(c, OFF_RW);
    f32x4 gv[4], bv[4];
#pragma unroll
    for (int j = 0; j < 4; ++j) { gv[j] = *(const f32x4*)(c.ln1_g + 4 * lane + 256 * j); bv[j] = *(const f32x4*)(c.ln1_b + 4 * lane + 256 * j); }
    for (int row = gw; row < T; row += NGW) {
        f32x4* hp = (f32x4*)(H1 + (size_t)row * D) + lane; f32x4 v[4]; float s = 0.f;
#pragma unroll
        for (int j = 0; j < 4; ++j) { v[j] = hp[64 * j]; s += (v[j][0] + v[j][1]) + (v[j][2] + v[j][3]); }
        const float mean = wave_sum(s) * (1.f / D); float s2 = 0.f;
#pragma unroll
        for (int j = 0; j < 4; ++j) { v[j] = v[j] - mean; s2 += (v[j][0] * v[j][0] + v[j][1] * v[j][1]) + (v[j][2] * v[j][2] + v[j][3] * v[j][3]); }
        const float rstd = 1.f / sqrtf(wave_sum(s2) * (1.f / D) + LN_EPS);
        float gl[4] = {0.f, 0.f, 0.f, 0.f};
#pragma unroll
        for (int j = 0; j < 4; ++j) { v[j] = v[j] * rstd * gv[j] + bv[j]; hp[64 * j] = v[j];
            u32x2 w; w.x = pk2(v[j][0], v[j][1]); w.y = pk2(v[j][2], v[j][3]); *((u32x2*)(X1B + (size_t)row * D) + lane + 64 * j) = w;
#pragma unroll
            for (int e = 0; e < 4; ++e) { const f32x4 wg = *(const f32x4*)(c.w_rg + (size_t)(4 * lane + 256 * j + e) * 4); gl[0] += v[j][e] * wg[0]; gl[1] += v[j][e] * wg[1]; gl[2] += v[j][e] * wg[2]; gl[3] += v[j][e] * wg[3]; } }
#pragma unroll
        for (int g = 0; g < 4; ++g) gl[g] = wave_sum(gl[g]) + c.b_rg[g];
        int gs = 0; float gm = gl[0];
#pragma unroll
        for (int g = 1; g < 4; ++g) if (gl[g] > gm) { gm = gl[g]; gs = g; }
        const float gp = 1.f / (__expf(gl[0] - gm) + __expf(gl[1] - gm) + __expf(gl[2] - gm) + __expf(gl[3] - gm));
        float el[8] = {0.f, 0.f, 0.f, 0.f, 0.f, 0.f, 0.f, 0.f};
#pragma unroll
        for (int j = 0; j < 4; ++j)
#pragma unroll
            for (int e = 0; e < 4; ++e) { const float* wp = c.w_re + (size_t)(4 * lane + 256 * j + e) * 32 + gs * 8; const f32x4 wa = *(const f32x4*)wp, wb = *(const f32x4*)(wp + 4);
                el[0] += v[j][e] * wa[0]; el[1] += v[j][e] * wa[1]; el[2] += v[j][e] * wa[2]; el[3] += v[j][e] * wa[3]; el[4] += v[j][e] * wb[0]; el[5] += v[j][e] * wb[1]; el[6] += v[j][e] * wb[2]; el[7] += v[j][e] * wb[3]; }
        float v0 = -INFINITY, v1 = -INFINITY; int i0 = 0, i1 = 0;
#pragma unroll
        for (int j = 0; j < 8; ++j) { const float x = wave_sum(el[j]) + c.b_re[gs * 8 + j];
            if (x > v0) { v1 = v0; i1 = i0; v0 = x; i0 = j; } else if (x > v1) { v1 = x; i1 = j; } }
        if (lane == 0) { const float e1 = __expf(v1 - v0), w0 = gp / (1.f + e1), w1 = gp * e1 / (1.f + e1); const int ea = gs * 8 + i0, eb = gs * 8 + i1;
            list[(size_t)ea * T + atomicAdd(cnt + ea, 1u)] = row * 2; list[(size_t)eb * T + atomicAdd(cnt + eb, 1u)] = row * 2 + 1;
            rw[row * 2] = w0; rw[row * 2 + 1] = w1; }
    }
}
__device__ __forceinline__ void ln2_phase(const Ctx& c, int tid, int bid, int nblk) {
    asm volatile("" : "+v"(tid));
    const int lane = tid & 63, wid = tid >> 6, gw = bid * 8 + wid, NGW = nblk * 8;
    const float* X1 = wsp<float>(c, OFF_H1); const bf16_t* Y0 = wsp<bf16_t>(c, OFF_Y0); const bf16_t* Y1 = wsp<bf16_t>(c, OFF_Y1); const float* rw = wsp<float>(c, OFF_RW);
    f32x4 gv[4], bv[4];
#pragma unroll
    for (int j = 0; j < 4; ++j) { gv[j] = *(const f32x4*)(c.ln2_g + 4 * lane + 256 * j); bv[j] = *(const f32x4*)(c.ln2_b + 4 * lane + 256 * j); }
    for (int row = gw; row < T; row += NGW) {
        const f32x4* xp = (const f32x4*)(X1 + (size_t)row * D) + lane; const u32x2* y0p = (const u32x2*)(Y0 + (size_t)row * D) + lane; const u32x2* y1p = (const u32x2*)(Y1 + (size_t)row * D) + lane;
        const float w0 = rw[row * 2], w1 = rw[row * 2 + 1]; f32x4 v[4]; float s = 0.f;
#pragma unroll
        for (int j = 0; j < 4; ++j) { const f32x4 x = xp[64 * j]; const u32x2 a = y0p[64 * j], b = y1p[64 * j];
            v[j][0] = DN_ALPHA * x[0] + w0 * bflo(a.x) + w1 * bflo(b.x); v[j][1] = DN_ALPHA * x[1] + w0 * bfhi(a.x) + w1 * bfhi(b.x);
            v[j][2] = DN_ALPHA * x[2] + w0 * bflo(a.y) + w1 * bflo(b.y); v[j][3] = DN_ALPHA * x[3] + w0 * bfhi(a.y) + w1 * bfhi(b.y);
            s += (v[j][0] + v[j][1]) + (v[j][2] + v[j][3]); }
        const float mean = wave_sum(s) * (1.f / D); float s2 = 0.f;
#pragma unroll
        for (int j = 0; j < 4; ++j) { v[j] = v[j] - mean; s2 += (v[j][0] * v[j][0] + v[j][1] * v[j][1]) + (v[j][2] * v[j][2] + v[j][3] * v[j][3]); }
        const float rstd = 1.f / sqrtf(wave_sum(s2) * (1.f / D) + LN_EPS);
        f32x4* op = (f32x4*)(c.out + (size_t)row * D) + lane;
#pragma unroll
        for (int j = 0; j < 4; ++j) op[64 * j] = v[j] * rstd * gv[j] + bv[j];
    }
}
__device__ __forceinline__ void transpose_item(const float* W, int N, bf16_t* Wt, size_t ldo, PG8_LAS float* scr, int k0, int n0, int lane) {
#pragma unroll 8
    for (int i = 0; i < 32; ++i) { const int kk = 2 * i + (lane >> 5); scr[kk * 33 + (lane & 31)] = W[(size_t)(k0 + kk) * N + n0 + (lane & 31)]; }
    asm volatile("s_waitcnt lgkmcnt(0)" ::: "memory");
    const int ch = lane & 7;
#pragma unroll
    for (int j = 0; j < 4; ++j) { const int n = (lane >> 3) + 8 * j; const PG8_LAS float* s = scr + (8 * ch) * 33 + n;
        u32x4 o; o.x = pk2(s[0 * 33], s[1 * 33]); o.y = pk2(s[2 * 33], s[3 * 33]); o.z = pk2(s[4 * 33], s[5 * 33]); o.w = pk2(s[6 * 33], s[7 * 33]);
        *(u32x4*)(Wt + (size_t)n * ldo + k0 + 8 * ch) = o; }
    asm volatile("s_waitcnt lgkmcnt(0)" ::: "memory");
}
__device__ __forceinline__ void cvt_copy(const float* src, bf16_t* dst, long n, int tid, int bid, int nblk) {
    const long n8 = n / 8;
    for (long i = (long)bid * 512 + tid; i < n8; i += (long)nblk * 512) { const f32x4 a = *(const f32x4*)(src + i * 8), b = *(const f32x4*)(src + i * 8 + 4);
        u32x4 o; o.x = pk2(a[0], a[1]); o.y = pk2(a[2], a[3]); o.z = pk2(b[0], b[1]); o.w = pk2(b[2], b[3]); *(u32x4*)(dst + i * 8) = o; }
}
__device__ __forceinline__ void prologue_phase(const Ctx& c, PG8_LAS unsigned char* lds, int tid, int bid, int nblk) {
    asm volatile("" : "+v"(tid));
    const int lane = tid & 63, wid = tid >> 6, gw = bid * 8 + wid, NGW = nblk * 8;
    PG8_LAS float* scr = (PG8_LAS float*)(lds + wid * 16384);
    constexpr int I_IN = (D / 64) * (N_IN / 32), I_KV = (D / 64) * (1024 / 32), I_A = (WA / 64) * (D / 32), I_B = (WB / 64) * (D / 32), I_C = (WC / 64) * (D / 32), I_O = (D / 64) * (D / 32);
    constexpr int NIT = I_IN + I_KV + I_A + I_B + I_C + I_O;
    for (int it = gw; it < NIT; it += NGW) { int r = it;
        if (r < I_IN) { const int nb = N_IN / 32; transpose_item(c.w_in, N_IN, wsp<bf16_t>(c, WT_IN) + (size_t)(r % nb) * 32 * D, D, scr, (r / nb) * 64, (r % nb) * 32, lane); continue; } r -= I_IN;
        if (r < I_KV) { const int nb = 1024 / 32; transpose_item(c.w_kv, 1024, wsp<bf16_t>(c, WT_KV) + (size_t)(r % nb) * 32 * D, D, scr, (r / nb) * 64, (r % nb) * 32, lane); continue; } r -= I_KV;
        if (r < I_A) { const int nb = D / 32; transpose_item(c.w_a, D, wsp<bf16_t>(c, WT_A) + (size_t)(r % nb) * 32 * OW, OW, scr, (r / nb) * 64, (r % nb) * 32, lane); continue; } r -= I_A;
        if (r < I_B) { const int nb = D / 32; transpose_item(c.w_b, D, wsp<bf16_t>(c, WT_A) + WA + (size_t)(r % nb) * 32 * OW, OW, scr, (r / nb) * 64, (r % nb) * 32, lane); continue; } r -= I_B;
        if (r < I_C) { const int nb = D / 32; transpose_item(c.w_c, D, wsp<bf16_t>(c, WT_A) + WA + WB + (size_t)(r % nb) * 32 * OW, OW, scr, (r / nb) * 64, (r % nb) * 32, lane); continue; } r -= I_C;
        { const int nb = D / 32; transpose_item(c.w_out, D, wsp<bf16_t>(c, WT_OUT) + (size_t)(r % nb) * 32 * D, D, scr, (r / nb) * 64, (r % nb) * 32, lane); }
    }
    cvt_copy(c.x, wsp<bf16_t>(c, OFF_XB), (long)T * D, tid, bid, nblk);
    cvt_copy(c.mem, wsp<bf16_t>(c, OFF_MEMB), (long)NBATCH * MEM * D, tid, bid, nblk);
}
__device__ __forceinline__ void expert_weights_phase(const Ctx& c, PG8_LAS unsigned char* lds, int tid, int bid, int nblk) {
    asm volatile("" : "+v"(tid));
    const int lane = tid & 63, wid = tid >> 6, gw = bid * 8 + wid, NGW = nblk * 8;
    PG8_LAS float* scr = (PG8_LAS float*)(lds + wid * 16384);
    constexpr int I_G = (D / 64) * (DE / 32), I_D = (DE / 64) * (D / 32), PER_E = 2 * I_G + I_D;
    for (int it = gw; it < NE * PER_E; it += NGW) { const int e = it / PER_E; int r = it % PER_E;
        if (r < 2 * I_G) { const int up = r / I_G; r %= I_G; const int nb = DE / 32, n0 = (r % nb) * 32, k0 = (r / nb) * 64; const float* src = (up ? c.w_eu : c.w_eg) + (size_t)e * D * DE;
            transpose_item(src, DE, wsp<bf16_t>(c, OFF_WTGU) + ((size_t)e * 2 * DE + (n0 / 128) * 256 + up * 128 + n0 % 128) * D, D, scr, k0, n0, lane); }
        else { r -= 2 * I_G; const int nb = D / 32, n0 = (r % nb) * 32, k0 = (r / nb) * 64;
            transpose_item(c.w_ed + (size_t)e * DE * D, D, wsp<bf16_t>(c, OFF_WTDN) + ((size_t)e * D + n0) * DE, DE, scr, k0, n0, lane); }
    }
}
}
namespace hgrn {
typedef float f32x4 __attribute__((ext_vector_type(4)));
typedef unsigned u32x2 __attribute__((ext_vector_type(2)));
typedef unsigned u32x4 __attribute__((ext_vector_type(4)));
constexpr int QS = 272, SS = 144;
constexpr int L_QE = 0, L_KE = L_QE + 64 * QS, L_KDT = L_KE + 64 * QS, L_VT = L_KDT + 128 * SS, L_PM = L_VT + 128 * SS, L_ST = L_PM + 64 * SS, L_F32 = L_ST + 128 * QS;
constexpr int F_QTOT = 0, F_DL = 512, F_ER = 640, F_SSQ = 768, L_END = L_F32 + (768 + 512) * 4;
static_assert(L_END <= 131072, "hgrn LDS");
__device__ __forceinline__ float fexp(float x) { return __expf(fminf(fmaxf(x, -80.f), 80.f)); }
__device__ __forceinline__ bf16x8 ldfrag(const PG8_LAS char* mat, int stride, int row, int ks, int lq) { return *(const PG8_LAS bf16x8*)(mat + row * stride + ks * 64 + lq * 16); }

template <bool FULL>
__device__ __forceinline__ void hg_unit(const Ctx& c, int half, int bl, int h, int seg, PG8_LAS char* lds, int tid) {
    const int wid = __builtin_amdgcn_readfirstlane(tid >> 6), lane = tid & 63, l15 = lane & 15, lq = lane >> 4;
    const int ek = tid & 127, etq = tid >> 7;
    const int sr = tid >> 4, sc = (tid & 15) * 8;
    const int bhl = bl * HB + h;
    const bf16_t* P = wsp<bf16_t>(c, OFF_P);
    PG8_LAS float* F = (PG8_LAS float*)(lds + L_F32);
    const float lbk = wsp<float>(c, OFF_SMALL)[SM_LB + h * 128 + ek];
    float* Shat = wsp<float>(c, OFF_HG) + ((size_t)bhl * NSEG + seg) * 128 * 128;
    const int vcol = wid * 16 + l15;
    f32x4 Sacc[8];
#pragma unroll
    for (int kt = 0; kt < 8; ++kt) {
        if (FULL) {
#pragma unroll
            for (int i = 0; i < 4; ++i) Sacc[kt][i] = Shat[(size_t)(kt * 16 + lq * 4 + i) * 128 + vcol];
        } else Sacc[kt] = (f32x4){0.f, 0.f, 0.f, 0.f};
    }
    float dsum = 0.f;
    for (int ch = 0; ch < 4; ++ch) {
        int row0 = bl * S + seg * 256 + ch * 64;
        asm volatile("" : "+s"(row0));
        float lf[16], kf[16];
        { const bf16_t* fp = P + (size_t)(row0 + etq * 16) * NP + COLS_A + WB + h * 128 + ek; float run = 0.f;
#pragma unroll
          for (int j = 0; j < 16; ++j) { const float f = lbk + (1.f - lbk) * pg8::fsigmoid(bf2f(fp[(size_t)j * NP])); run += __logf(f); lf[j] = run; kf[j] = 1.f - f; }
          F[F_QTOT + etq * 128 + ek] = run; }
        { const bf16_t* vp = P + (size_t)(row0 + sr) * NP + COLS_A + 2 * WB + h * 128 + sc; const bf16x8 v0 = *(const bf16x8*)vp, v1 = *(const bf16x8*)(vp + (size_t)32 * NP);
#pragma unroll
          for (int j = 0; j < 8; ++j) { *(PG8_LAS short*)(lds + L_VT + (sc + j) * SS + sr * 2) = v0[j]; *(PG8_LAS short*)(lds + L_VT + (sc + j) * SS + (sr + 32) * 2) = v1[j]; } }
        __syncthreads();
        { const float q0 = F[F_QTOT + ek], q1 = F[F_QTOT + 128 + ek], q2 = F[F_QTOT + 256 + ek], q3 = F[F_QTOT + 384 + ek];
          const float blast = (q0 + q1) + (q2 + q3), off = etq == 0 ? 0.f : (etq == 1 ? q0 : (etq == 2 ? q0 + q1 : (q0 + q1) + q2)), r = 0.5f * blast;
          if (etq == 0) { F[F_DL + ek] = fexp(blast); F[F_ER + ek] = fexp(r); dsum += blast; }
          unsigned kd[8];
          const bf16_t* qp = P + (size_t)(row0 + etq * 16) * NP + COLS_A + h * 128 + ek;
#pragma unroll
          for (int j = 0; j < 16; ++j) { const float b = off + lf[j];
              const float kdv = kf[j] * fexp(blast - b);
              if (j & 1) kd[j >> 1] |= (unsigned)f2bf(kdv) << 16; else kd[j >> 1] = (unsigned)f2bf(kdv);
              if (FULL) { const float qr = bf2f(qp[(size_t)j * NP]); const float qs = qr * pg8::fsigmoid(qr);
                  *(PG8_LAS bf16_t*)(lds + L_QE + (etq * 16 + j) * QS + ek * 2) = f2bf(qs * fexp(b - r));
                  *(PG8_LAS bf16_t*)(lds + L_KE + (etq * 16 + j) * QS + ek * 2) = f2bf(kf[j] * fexp(r - b)); } }
          *(PG8_LAS u32x4*)(lds + L_KDT + ek * SS + etq * 32) = (u32x4){kd[0], kd[1], kd[2], kd[3]};
          *(PG8_LAS u32x4*)(lds + L_KDT + ek * SS + etq * 32 + 16) = (u32x4){kd[4], kd[5], kd[6], kd[7]}; }
        __syncthreads();
        f32x4 oacc[4];
        unsigned short graw[16];
        if (FULL) {
#pragma unroll
            for (int kt = 0; kt < 8; ++kt) { const f32x4 er = *(const PG8_LAS f32x4*)(F + F_ER + kt * 16 + lq * 4);
                u32x2 w; w.x = pg8::cvt_pk_bf16(Sacc[kt][0] * er[0], Sacc[kt][1] * er[1]); w.y = pg8::cvt_pk_bf16(Sacc[kt][2] * er[2], Sacc[kt][3] * er[3]);
                *(PG8_LAS u32x2*)(lds + L_ST + vcol * QS + (kt * 16 + lq * 4) * 2) = w; }
            { const int tt = wid & 3;
#pragma unroll
              for (int sti = 0; sti < 2; ++sti) { const int st = 2 * (wid >> 2) + sti; f32x4 a = (f32x4){0.f, 0.f, 0.f, 0.f};
#pragma unroll
                  for (int ks = 0; ks < 4; ++ks) a = __builtin_amdgcn_mfma_f32_16x16x32_bf16(ldfrag(lds + L_KE, QS, st * 16 + l15, ks, lq), ldfrag(lds + L_QE, QS, tt * 16 + l15, ks, lq), a, 0, 0, 0);
                  const int t = tt * 16 + l15, s0 = st * 16 + lq * 4;
                  u32x2 w; w.x = pg8::cvt_pk_bf16(s0 <= t ? a[0] : 0.f, s0 + 1 <= t ? a[1] : 0.f); w.y = pg8::cvt_pk_bf16(s0 + 2 <= t ? a[2] : 0.f, s0 + 3 <= t ? a[3] : 0.f);
                  *(PG8_LAS u32x2*)(lds + L_PM + t * SS + s0 * 2) = w; } }
            { const bf16_t* gp = P + (size_t)(row0 + lq * 4) * NP + COLS_A + 3 * WB + h * 128 + vcol;
#pragma unroll
              for (int mt = 0; mt < 4; ++mt)
#pragma unroll
                  for (int i = 0; i < 4; ++i) graw[mt * 4 + i] = gp[(size_t)(mt * 16 + i) * NP]; }
            __syncthreads();
        }
        const bf16x8 vb0 = ldfrag(lds + L_VT, SS, vcol, 0, lq), vb1 = ldfrag(lds + L_VT, SS, vcol, 1, lq);
        if (FULL) {
            bf16x8 sb[4];
#pragma unroll
            for (int ks = 0; ks < 4; ++ks) sb[ks] = ldfrag(lds + L_ST, QS, vcol, ks, lq);
#pragma unroll
            for (int mt = 0; mt < 4; ++mt) { f32x4 a = (f32x4){0.f, 0.f, 0.f, 0.f};
#pragma unroll
                for (int ks = 0; ks < 4; ++ks) a = __builtin_amdgcn_mfma_f32_16x16x32_bf16(ldfrag(lds + L_QE, QS, mt * 16 + l15, ks, lq), sb[ks], a, 0, 0, 0);
                a = __builtin_amdgcn_mfma_f32_16x16x32_bf16(ldfrag(lds + L_PM, SS, mt * 16 + l15, 0, lq), vb0, a, 0, 0, 0);
                a = __builtin_amdgcn_mfma_f32_16x16x32_bf16(ldfrag(lds + L_PM, SS, mt * 16 + l15, 1, lq), vb1, a, 0, 0, 0);
                oacc[mt] = a; }
        }
#pragma unroll
        for (int kt = 0; kt < 8; ++kt) { const f32x4 dl = *(const PG8_LAS f32x4*)(F + F_DL + kt * 16 + lq * 4); f32x4 a = Sacc[kt] * dl;
            a = __builtin_amdgcn_mfma_f32_16x16x32_bf16(ldfrag(lds + L_KDT, SS, kt * 16 + l15, 0, lq), vb0, a, 0, 0, 0);
            a = __builtin_amdgcn_mfma_f32_16x16x32_bf16(ldfrag(lds + L_KDT, SS, kt * 16 + l15, 1, lq), vb1, a, 0, 0, 0);
            Sacc[kt] = a; }
        if (FULL) {
#pragma unroll
            for (int mt = 0; mt < 4; ++mt)
#pragma unroll
                for (int i = 0; i < 4; ++i) { float q = oacc[mt][i] * oacc[mt][i]; q += __shfl_xor(q, 1); q += __shfl_xor(q, 2); q += __shfl_xor(q, 4); q += __shfl_xor(q, 8);
                    if (l15 == 0) F[F_SSQ + (mt * 16 + lq * 4 + i) * 8 + wid] = q; }
            __syncthreads();
            const float ng = c.norm_g[h * 128 + vcol];
            bf16_t* op = (bf16_t*)c.out + ((size_t)half * TH + row0 + lq * 4) * OW + WA + h * 128 + vcol;
#pragma unroll
            for (int mt = 0; mt < 4; ++mt)
#pragma unroll
                for (int i = 0; i < 4; ++i) { const PG8_LAS f32x4* sp = (const PG8_LAS f32x4*)(F + F_SSQ + (mt * 16 + lq * 4 + i) * 8); const f32x4 s0 = sp[0], s1 = sp[1];
                    const float ss = ((s0[0] + s0[1]) + (s0[2] + s0[3])) + ((s1[0] + s1[1]) + (s1[2] + s1[3])); const float rs = 1.f / sqrtf(ss * (1.f / 128.f) + RMS_EPS);
                    const float g = bf2f(graw[mt * 4 + i]);
                    op[(size_t)(mt * 16 + i) * OW] = f2bf(oacc[mt][i] * rs * ng * (g * pg8::fsigmoid(g))); }
        }
        __syncthreads();
    }
    if (!FULL) {
#pragma unroll
        for (int kt = 0; kt < 8; ++kt)
#pragma unroll
            for (int i = 0; i < 4; ++i) Shat[(size_t)(kt * 16 + lq * 4 + i) * 128 + vcol] = Sacc[kt][i];
        if (etq == 0) wsp<float>(c, OFF_DSEG)[((size_t)bhl * NSEG + seg) * 128 + ek] = dsum;
    }
}
template <bool FULL>
__device__ __forceinline__ void hg_phase(const Ctx& c, int half, PG8_LAS unsigned char* lds_u, int tid, int bid, int nblk) {
    asm volatile("" : "+v"(tid));
    PG8_LAS char* lds = (PG8_LAS char*)lds_u;
    constexpr int NU = BH * HB * NSEG;
    for (int u = bid; u < NU; u += nblk) { const int seg = u % NSEG, bhl = u / NSEG; hg_unit<FULL>(c, half, bhl / HB, bhl % HB, seg, lds, tid); }
}
}
#include <hip/hip_cooperative_groups.h>
namespace cg = cooperative_groups;
constexpr int NTHR = 512, LDS_BYTES = 147456;

template <class F> __device__ __forceinline__ void dev_elems_(const F& f, long n, int tid, int bid, int nblk) {
    asm volatile("" : "+v"(tid));
    for (long i = (long)bid * NTHR + tid; i < n; i += (long)nblk * NTHR) f(i);
}
template <class G> __device__ __forceinline__ void dev_sgemm_(const G& g, int tid, int bid, int nblk) {
    asm volatile("" : "+v"(tid));
    const int M = g.M(); const int lane = tid & 63, wid = tid >> 6; constexpr int ntn = G::N / 64;
    const long ntiles = (long)(M / 16) * ntn;
    for (long tile = (long)bid * 8 + wid; tile < ntiles; tile += (long)nblk * 8) {
        const int tm = (int)(tile / ntn), tn = (int)(tile % ntn), r0 = tm * 16, c0 = tn * 64;
        f32x4 acc[G::NBP][4], carry[4];
#pragma unroll
        for (int j = 0; j < 4; ++j) { carry[j] = (f32x4){0.f, 0.f, 0.f, 0.f};
#pragma unroll
            for (int w = 0; w < G::NBP; ++w) acc[w][j] = (f32x4){0.f, 0.f, 0.f, 0.f}; }
#pragma unroll
        for (int seg = 0; seg < G::NSEGS; ++seg) {
            const bf16_t* ar = g.arow(seg, r0 + (lane & 15)) + 8 * (lane >> 4); const bf16_t* br[G::NBP][4];
#pragma unroll
            for (int w = 0; w < G::NBP; ++w)
#pragma unroll
                for (int j = 0; j < 4; ++j) br[w][j] = g.brow(seg, r0, c0 + 16 * j + (lane & 15), w) + 8 * (lane >> 4);
            const int K = g.K(seg);
            for (int k0 = 0; k0 < K; k0 += 32) { const bf16x8 a = *(const bf16x8*)(ar + k0);
#pragma unroll
                for (int w = 0; w < G::NBP; ++w)
#pragma unroll
                    for (int j = 0; j < 4; ++j) { const bf16x8 b = *(const bf16x8*)(br[w][j] + k0); acc[w][j] = __builtin_amdgcn_mfma_f32_16x16x32_bf16(a, b, acc[w][j], 0, 0, 0); } }
#pragma unroll
            for (int j = 0; j < 4; ++j)
#pragma unroll
                for (int i = 0; i < 4; ++i) { float a = acc[0][j][i], cr = carry[j][i]; g.between(seg, r0 + (lane >> 4) * 4 + i, c0 + 16 * j + (lane & 15), a, cr); acc[0][j][i] = a; carry[j][i] = cr; }
        }
#pragma unroll
        for (int j = 0; j < 4; ++j)
#pragma unroll
            for (int i = 0; i < 4; ++i) g.store(r0 + (lane >> 4) * 4 + i, c0 + 16 * j + (lane & 15), acc[0][j][i], G::NBP == 2 ? acc[G::NBP - 1][j][i] : carry[j][i]);
    }
}

struct E_hg3q { Ctx c; int half; static constexpr long n = (long)BH * HB * NSEG * 128 * 4;
    __device__ __forceinline__ void operator()(long idx) const { const int kq = (int)(idx & 3), v = (int)((idx >> 2) & 127); const long r = idx >> 9; const int seg = (int)(r % NSEG), bhl = (int)(r / NSEG), h = bhl % HB, bl = bhl / HB;
        const bf16_t* P = wsp<bf16_t>(c, OFF_P); float st[32];
#pragma unroll
        for (int k = 0; k < 32; ++k) st[k] = wsp<float>(c, OFF_HG)[(((size_t)bhl * NSEG + seg) * 128 + kq * 32 + k) * 128 + v];
        for (int s = 0; s < 256; ++s) { const int tl = bl * S + seg * 256 + s; const bf16_t* pr = P + (size_t)tl * NP; const float iv = bf2f(pr[COLS_A + 2 * WB + h * 128 + v]); float o = 0.f;
#pragma unroll
            for (int k = 0; k < 32; ++k) { const int kk = kq * 32 + k; const float f = hg_f(c, pr, h * 128 + kk); st[k] = f * st[k] + (1.f - f) * iv; o += siluf_(bf2f(pr[COLS_A + h * 128 + kk])) * st[k]; }
            o += __shfl_xor(o, 1); o += __shfl_xor(o, 2);
            if (kq == 0) ((bf16_t*)c.out)[((size_t)half * TH + tl) * OW + WA + h * 128 + v] = f2bf(o); } } };

typedef const __attribute__((address_space(4))) Ctx* CtxK;
#if defined(__HIP_DEVICE_COMPILE__)
__device__ __forceinline__ Ctx load_ctx() { CtxK p = (CtxK)__builtin_amdgcn_kernarg_segment_ptr(); asm volatile("" : "+s"(p)); return *p; }
#else
__device__ inline Ctx load_ctx() { return Ctx(); }
#endif
#define PH_BEGIN { const Ctx c = load_ctx(); const int tid = wid_s * 64 + pg8::lane_id_opaque(); int bid = blockIdx.x, nblk = gridDim.x; asm volatile("" : "+s"(bid), "+s"(nblk));
#define dev_elems(...) dev_elems_(__VA_ARGS__, tid, bid, nblk)
#define dev_sgemm(...) dev_sgemm_(__VA_ARGS__, tid, bid, nblk)
#define PH_END }

__global__ void __launch_bounds__(NTHR) mega(Ctx c_arg) {
    extern __shared__ __attribute__((aligned(16))) unsigned char lds_raw[];
    PG8_LAS unsigned char* lds = (PG8_LAS unsigned char*)lds_raw;
    cg::grid_group grid = cg::this_grid();
    const int wid_s = __builtin_amdgcn_readfirstlane((int)threadIdx.x >> 6);
    PH_BEGIN
    dev_elems(S0_small{c}, S0_small::n); rowops::prologue_phase(c, lds, tid, bid, nblk);
    PH_END
    grid.sync();
#pragma unroll
    for (int half = 0; half < NHALF; ++half) {
        PH_BEGIN
        if (half == 0) dev_sgemm(G_memkv{c});
        fast_proj(c, half, lds, tid, bid, nblk);
        PH_END
        grid.sync();
        PH_BEGIN
        hgrn::hg_phase<false>(c, half, lds, tid, bid, nblk);
        PH_END
        grid.sync();
        PH_BEGIN
        dev_elems(E_hg2{c}, E_hg2::n); attn::attn_phase(c, half, lds, tid, bid, nblk);
        PH_END
        grid.sync();
        PH_BEGIN
        hgrn::hg_phase<true>(c, half, lds, tid, bid, nblk); dev_elems(E_combA{c, half}, E_combA::n);
        PH_END
        grid.sync();
    }
    PH_BEGIN
    rowops::expert_weights_phase(c, lds, tid, bid, nblk); __syncthreads(); fast_gates(c, lds, tid, bid, nblk);
    PH_END
    grid.sync();
    PH_BEGIN
    fast_merge(c, lds, tid, bid, nblk);
    PH_END
    grid.sync();
    PH_BEGIN
    fast_wout(c, lds, tid, bid, nblk);
    PH_END
    grid.sync();
    PH_BEGIN
    rowops::ln1_router_phase(c, tid, bid, nblk);
    PH_END
    grid.sync();
    PH_BEGIN
    dev_elems(E_blk{c}, 1);
    PH_END
    grid.sync();
    PH_BEGIN
    fast_moe1(c, lds, tid, bid, nblk);
    PH_END
    grid.sync();
    PH_BEGIN
    fast_moe2(c, lds, tid, bid, nblk);
    PH_END
    grid.sync();
    PH_BEGIN
    rowops::ln2_phase(c, tid, bid, nblk);
    PH_END
}

extern "C" void kernel_launch(void* const* d_in, const int* in_sizes, int n_in, void* d_out, int out_size, void* d_ws, size_t ws_size, hipStream_t stream) {
    if (n_in != 22 || in_sizes[0] != T * D || out_size != T * D || ws_size < WS_END) { fprintf(stderr, "kernel_launch: unexpected shapes / workspace (%zu < %zu)\n", ws_size, (size_t)WS_END); return; }
    static int grid_blocks = 0;
    if (!grid_blocks) {
        int dev = 0, cus = 0, per_cu = 0;
        hipGetDevice(&dev); hipDeviceGetAttribute(&cus, hipDeviceAttributeMultiprocessorCount, dev);
        hipFuncSetAttribute((const void*)mega, hipFuncAttributeMaxDynamicSharedMemorySize, LDS_BYTES);
        hipOccupancyMaxActiveBlocksPerMultiprocessor(&per_cu, (const void*)mega, NTHR, LDS_BYTES);
        if (per_cu < 1) { fprintf(stderr, "kernel_launch: occupancy query says %d blocks/CU\n", per_cu); per_cu = 1; }
        if (per_cu > 1) per_cu = 1;
        grid_blocks = cus * per_cu;
    }
    Ctx c = make_ctx(d_in, d_out, d_ws);
    void* args[] = {&c};
    hipError_t e = hipLaunchCooperativeKernel((const void*)mega, dim3(grid_blocks), dim3(NTHR), args, LDS_BYTES, stream);
    if (e != hipSuccess) fprintf(stderr, "cooperative launch failed: %s (grid %d)\n", hipGetErrorString(e), grid_blocks);
}
```

```cpp
#ifdef HOST_TEST
#include <cmath>
#include <cstdint>
#include <cstdio>
#include <cstring>
#define HD
#define GLOBAL
#else
#include <hip/hip_runtime.h>
#include <cstdint>
#include <cstdio>
#include <cstring>
#include <cmath>
#define HD __host__ __device__ __forceinline__
#endif

#ifndef CFG_D
#define CFG_D 1024
#define CFG_B 4
#define CFG_S 8192
#endif
typedef unsigned short bf16_t;
constexpr int D = CFG_D, NBATCH = CFG_B, S = CFG_S, T = NBATCH * S;
constexpr int NHALF = 2, TH = T / NHALF, BH = NBATCH / NHALF;
constexpr int WA = 512, HB = D / 128, WB = D, WC = 512;
constexpr int COLS_A = 4608, COLS_B = 4 * WB, COLS_C = 512, COLS_G = 3 * D;
constexpr int NP = COLS_A + COLS_B + COLS_C, N_IN = NP + COLS_G;
constexpr int OW = WA + WB + WC;
constexpr int DE = D / 4, NE = 32, HBK = DE < 128 ? DE : 128;
constexpr int MEM = 256, NSEG = S / 256;
constexpr int MAXROWS = 2 * T + NE * 256;
constexpr float DN_ALPHA = 1.189207115002721f;
constexpr float LN_EPS = 1e-5f, RMS_EPS = 1e-6f;
constexpr float QK_SCALE = 0.08838834764831845f;

constexpr size_t MiB = 1u << 20;
constexpr size_t al(size_t x) { return (x + 4095) & ~(size_t)4095; }
constexpr size_t OFF_CTL = 0;
constexpr size_t OFF_SMALL = 1 * MiB;
constexpr size_t OFF_WT = 2 * MiB;
constexpr size_t WT_IN = OFF_WT, WT_KV = WT_IN + al((size_t)N_IN * D * 2), WT_A = WT_KV + al((size_t)1024 * D * 2),
                 WT_B = WT_A + al((size_t)D * WA * 2), WT_C = WT_B + al((size_t)D * WB * 2), WT_OUT = WT_C + al((size_t)D * WC * 2),
                 OFF_MEMB = WT_OUT + al((size_t)D * D * 2), OFF_MEMKV = OFF_MEMB + al((size_t)NBATCH * MEM * D * 2),
                 OFF_LIST = OFF_MEMKV + al((size_t)NBATCH * MEM * 1024 * 2), OFF_RW = OFF_LIST + al((size_t)NE * T * 4),
                 OFF_XB = OFF_RW + al((size_t)T * 2 * 4), OFF_P = OFF_XB + al((size_t)T * D * 2),
                 OFF_PART = OFF_P + al((size_t)TH * NP * 2), OFF_LSE = OFF_PART + al((size_t)3 * TH * WA * 2),
                 OFF_HG = OFF_LSE + al((size_t)3 * TH * 4 * 4), OFF_DSEG = OFF_HG + al((size_t)BH * HB * NSEG * 128 * 128 * 4),
                 WS_END = OFF_DSEG + al((size_t)BH * HB * NSEG * 128 * 4);
constexpr size_t OFF_GATES = OFF_P, OFF_H1 = OFF_P, OFF_X1B = OFF_P + al((size_t)T * D * 4),
                 OFF_WTGU = OFF_P + al((size_t)T * 3 * D * 2), OFF_WTDN = OFF_WTGU + al((size_t)NE * 2 * DE * D * 2),
                 OFF_HBUF = OFF_WTDN + al((size_t)NE * D * DE * 2), OFF_PEND = OFF_HBUF + al((size_t)MAXROWS * DE * 2);
constexpr size_t OFF_MERGED = OFF_XB, OFF_Y0 = OFF_XB, OFF_Y1 = OFF_PART;
static_assert(OFF_X1B + (size_t)T * D * 2 <= OFF_WTGU, "x1b inside dead gates region");
static_assert(OFF_PEND <= OFF_PART, "P-region overlays fit");
static_assert(OFF_Y1 + (size_t)T * D * 2 <= WS_END, "y1 fits in part+hg region");
constexpr int CW_CNT = 0;
constexpr int SM_BIAS = 0, SM_LB = 2048, SM_BLK = 2048 + 4096;

HD float bf2f(bf16_t v) { union { unsigned u; float f; } c; c.u = (unsigned)v << 16; return c.f; }
HD bf16_t f2bf(float f) { union { unsigned u; float f; } c; c.f = f; unsigned u = c.u; return (bf16_t)((u + 0x7fffu + ((u >> 16) & 1u)) >> 16); }
HD float sigmoidf_(float x) { return 1.0f / (1.0f + expf(-x)); }
HD float siluf_(float x) { return x / (1.0f + expf(-x)); }
HD int dil_of(int g) { return g == 0 ? 1 : (g == 1 ? 4 : 16); }
HD int perm_row(int tl, int g) { const int r = dil_of(g), bl = tl / S, s = tl % S; return bl * S + (s % r) * (S / r) + s / r; }

struct Ctx {
    const float *x, *mem, *rel_bias, *lb_logits, *w_in, *w_kv, *norm_g, *w_a, *w_b, *w_c, *w_out, *ln1_g, *ln1_b, *w_rg, *b_rg, *w_re, *b_re, *w_eg, *w_eu, *w_ed, *ln2_g, *ln2_b;
    float* out; unsigned char* ws;
};
#ifdef HOST_TEST
static const unsigned char T5_BUCKET[3][129] = {
#else
__device__ const unsigned char T5_BUCKET[3][129] = {
#endif
{0,1,2,3,4,5,6,7,8,9,10,11,12,13,14,15,16,16,16,16,16,16,17,17,17,17,17,17,17,17,18,18,18,18,18,18,18,18,18,18,19,19,19,19,19,19,19,19,19,19,19,19,19,19,20,20,20,20,20,20,20,20,20,20,20,20,20,20,20,20,20,20,20,21,21,21,21,21,21,21,21,21,21,21,21,21,21,21,21,21,21,21,21,21,21,21,21,21,21,22,22,22,22,22,22,22,22,22,22,22,22,22,22,22,22,22,22,22,22,22,22,22,22,22,22,22,22,22,22},
{0,4,8,12,16,16,17,17,18,18,19,19,19,19,20,20,20,20,20,21,21,21,21,21,21,22,22,22,22,22,22,22,22,22,23,23,23,23,23,23,23,23,23,23,23,23,24,24,24,24,24,24,24,24,24,24,24,24,24,24,24,24,25,25,25,25,25,25,25,25,25,25,25,25,25,25,25,25,25,25,25,25,25,26,26,26,26,26,26,26,26,26,26,26,26,26,26,26,26,26,26,26,26,26,26,26,26,26,26,26,26,26,26,27,27,27,27,27,27,27,27,27,27,27,27,27,27,27,27},
{0,16,18,19,20,21,21,22,22,23,23,23,24,24,24,24,25,25,25,25,25,26,26,26,26,26,26,26,26,27,27,27,27,27,27,27,27,27,27,28,28,28,28,28,28,28,28,28,28,28,28,28,29,29,29,29,29,29,29,29,29,29,29,29,29,29,29,29,29,29,30,30,30,30,30,30,30,30,30,30,30,30,30,30,30,30,30,30,30,30,30,30,30,30,30,31,31,31,31,31,31,31,31,31,31,31,31,31,31,31,31,31,31,31,31,31,31,31,31,31,31,31,31,31,31,31,31,31,31}};
template <class Tp> HD Tp* wsp(const Ctx& c, size_t off) { return (Tp*)(c.ws + off); }

#ifdef HOST_TEST
static inline unsigned atomic_inc_u32(unsigned* p) { unsigned r;
#pragma omp atomic capture
    { r = *p; *p += 1; }
    return r; }
#else
__device__ __forceinline__ unsigned atomic_inc_u32(unsigned* p) { return atomicAdd(p, 1u); }
#endif

struct S0_xb { Ctx c; static constexpr long n = (long)T * D;
    HD void operator()(long i) const { wsp<bf16_t>(c, OFF_XB)[i] = f2bf(c.x[i]); } };
struct S0_memb { Ctx c; static constexpr long n = (long)NBATCH * MEM * D;
    HD void operator()(long i) const { wsp<bf16_t>(c, OFF_MEMB)[i] = f2bf(c.mem[i]); } };
struct S0_tr { const float* W; bf16_t* Wt; int K, N; long n; int ldo;
    HD void operator()(long i) const { const int k = (int)(i % K); const long nn = i / K; Wt[(size_t)nn * ldo + k] = f2bf(W[(size_t)k * N + nn]); } };
struct S0_gu { Ctx c; static constexpr long n = (long)NE * 2 * DE * D;
    HD void operator()(long i) const { const int k = (int)(i % D); const long r = i / D; const int j = (int)(r % (2 * DE)), e = (int)(r / (2 * DE));
        const int u = j / (2 * HBK), w = j % (2 * HBK), hid = u * HBK + w % HBK, up = w / HBK;
        const float* src = up ? c.w_eu : c.w_eg; wsp<bf16_t>(c, OFF_WTGU)[i] = f2bf(src[((size_t)e * D + k) * DE + hid]); } };
struct S0_dn { Ctx c; static constexpr long n = (long)NE * D * DE;
    HD void operator()(long i) const { const int k = (int)(i % DE); const long r = i / DE; const int col = (int)(r % D), e = (int)(r / D);
        wsp<bf16_t>(c, OFF_WTDN)[i] = f2bf(c.w_ed[((size_t)e * DE + k) * D + col]); } };
struct S0_small { Ctx c; static constexpr long n = 12 * 129 + WB + 64;
    HD void operator()(long i) const { float* sm = wsp<float>(c, OFF_SMALL);
        if (i < 12 * 129) { const int gh = (int)(i / 129), u = (int)(i % 129), g = gh / 4; sm[SM_BIAS + i] = c.rel_bias[T5_BUCKET[g][u] * 12 + gh]; }
        else if (i < 12 * 129 + WB) { const int ch = (int)(i - 12 * 129); sm[SM_LB + ch] = sigmoidf_(c.lb_logits[ch] - c.lb_logits[WB + ch]); }
        else { const int j = (int)(i - 12 * 129 - WB); wsp<unsigned>(c, OFF_CTL)[j] = 0u; } } };

struct G_proj { Ctx c; int half; static constexpr int N = NP, NSEGS = 1, NBP = 1;
    HD int M() const { return TH; } HD int K(int) const { return D; }
    HD const bf16_t* arow(int, int row) const { return wsp<bf16_t>(c, OFF_XB) + ((size_t)half * TH + row) * D; }
    HD const bf16_t* brow(int, int, int col, int) const { return wsp<bf16_t>(c, WT_IN) + (size_t)col * D; }
    HD void between(int, int, int, float&, float&) const {}
    HD void store(int row, int col, float a, float) const { const int pr = col < COLS_A ? perm_row(row, col / 1536) : row; wsp<bf16_t>(c, OFF_P)[(size_t)pr * NP + col] = f2bf(a); } };
struct G_memkv { Ctx c; static constexpr int N = 1024, NSEGS = 1, NBP = 1;
    HD int M() const { return NBATCH * MEM; } HD int K(int) const { return D; }
    HD const bf16_t* arow(int, int row) const { return wsp<bf16_t>(c, OFF_MEMB) + (size_t)row * D; }
    HD const bf16_t* brow(int, int, int col, int) const { return wsp<bf16_t>(c, WT_KV) + (size_t)col * D; }
    HD void between(int, int, int, float&, float&) const {}
    HD void store(int row, int col, float a, float) const { wsp<bf16_t>(c, OFF_MEMKV)[(size_t)row * 1024 + col] = f2bf(a); } };
struct G_gates { Ctx c; static constexpr int N = 3 * D, NSEGS = 1, NBP = 1;
    HD int M() const { return T; } HD int K(int) const { return D; }
    HD const bf16_t* arow(int, int row) const { return wsp<bf16_t>(c, OFF_XB) + (size_t)row * D; }
    HD const bf16_t* brow(int, int, int col, int) const { return wsp<bf16_t>(c, WT_IN) + (size_t)(NP + col) * D; }
    HD void between(int, int, int, float&, float&) const {}
    HD void store(int row, int col, float a, float) const { wsp<bf16_t>(c, OFF_GATES)[((size_t)(col / D) * T + row) * D + col % D] = f2bf(sigmoidf_(a)); } };
struct G_merge { Ctx c; static constexpr int N = D, NSEGS = 3, NBP = 1;
    HD int M() const { return T; } HD int K(int s) const { return s == 1 ? WB : 512; }
    HD const bf16_t* arow(int s, int row) const { return (const bf16_t*)c.out + (size_t)row * OW + (s == 0 ? 0 : (s == 1 ? WA : WA + WB)); }
    HD const bf16_t* brow(int s, int, int col, int) const { return wsp<bf16_t>(c, WT_A) + (size_t)col * OW + (s == 0 ? 0 : (s == 1 ? WA : WA + WB)); }
    HD void between(int s, int row, int col, float& acc, float& carry) const { carry += bf2f(wsp<bf16_t>(c, OFF_GATES)[((size_t)s * T + row) * D + col]) * acc; acc = 0.f; }
    HD void store(int row, int col, float, float carry) const { wsp<bf16_t>(c, OFF_MERGED)[(size_t)row * D + col] = f2bf(carry); } };
struct G_wout { Ctx c; static constexpr int N = D, NSEGS = 1, NBP = 1;
    HD int M() const { return T; } HD int K(int) const { return D; }
    HD const bf16_t* arow(int, int row) const { return wsp<bf16_t>(c, OFF_MERGED) + (size_t)row * D; }
    HD const bf16_t* brow(int, int, int col, int) const { return wsp<bf16_t>(c, WT_OUT) + (size_t)col * D; }
    HD void between(int, int, int, float&, float&) const {}
    HD void store(int row, int col, float a, float) const { wsp<float>(c, OFF_H1)[(size_t)row * D + col] = DN_ALPHA * c.x[(size_t)row * D + col] + a; } };
struct MoeRow { int e, pos, valid, entry; };
HD MoeRow moe_row(const Ctx& c, int row) {
    const int* blk = wsp<int>(c, OFF_SMALL) + SM_BLK; const unsigned* cnt = wsp<unsigned>(c, OFF_CTL) + CW_CNT;
    MoeRow r; const int rb = row >> 8; r.e = blk[64 + rb]; r.pos = ((rb - blk[r.e]) << 8) + (row & 255); r.valid = r.pos < (int)cnt[r.e];
    r.entry = wsp<int>(c, OFF_LIST)[(size_t)r.e * T + (r.valid ? r.pos : 0)]; return r; }
HD int moe_rows_total(const Ctx& c) { return (wsp<int>(c, OFF_SMALL) + SM_BLK)[32] << 8; }
struct G_moe1 { Ctx c; static constexpr int N = DE, NSEGS = 1, NBP = 2;
    HD int M() const { return moe_rows_total(c); } HD int K(int) const { return D; }
    HD const bf16_t* arow(int, int row) const { const MoeRow r = moe_row(c, row); return wsp<bf16_t>(c, OFF_X1B) + (size_t)(r.entry >> 1) * D; }
    HD const bf16_t* brow(int, int row0, int col, int which) const { const int e = (wsp<int>(c, OFF_SMALL) + SM_BLK)[64 + (row0 >> 8)];
        return wsp<bf16_t>(c, OFF_WTGU) + ((size_t)e * 2 * DE + (col / HBK) * 2 * HBK + which * HBK + col % HBK) * D; }
    HD void between(int, int, int, float&, float&) const {}
    HD void store(int row, int col, float g, float u) const { wsp<bf16_t>(c, OFF_HBUF)[(size_t)row * DE + col] = f2bf(siluf_(g) * u); } };
struct G_moe2 { Ctx c; static constexpr int N = D, NSEGS = 1, NBP = 1;
    HD int M() const { return moe_rows_total(c); } HD int K(int) const { return DE; }
    HD const bf16_t* arow(int, int row) const { return wsp<bf16_t>(c, OFF_HBUF) + (size_t)row * DE; }
    HD const bf16_t* brow(int, int row0, int col, int) const { const int e = (wsp<int>(c, OFF_SMALL) + SM_BLK)[64 + (row0 >> 8)]; return wsp<bf16_t>(c, OFF_WTDN) + ((size_t)e * D + col) * DE; }
    HD void between(int, int, int, float&, float&) const {}
    HD void store(int row, int col, float a, float) const { const MoeRow r = moe_row(c, row); if (!r.valid) return;
        wsp<bf16_t>(c, (r.entry & 1) ? OFF_Y1 : OFF_Y0)[(size_t)(r.entry >> 1) * D + col] = f2bf(a); } };

struct u32x4_t { unsigned x, y, z, w; };
HD float bflo(unsigned u) { union { unsigned u; float f; } c; c.u = u << 16; return c.f; }
HD float bfhi(unsigned u) { union { unsigned u; float f; } c; c.u = u & 0xffff0000u; return c.f; }
HD float dot128(const bf16_t* a, const bf16_t* b) { float s = 0.f; const u32x4_t* pa = (const u32x4_t*)a; const u32x4_t* pb = (const u32x4_t*)b;
#ifndef HOST_TEST
#pragma unroll 4
#endif
    for (int d = 0; d < 16; ++d) { const u32x4_t ua = pa[d], ub = pb[d];
        s += bflo(ua.x) * bflo(ub.x) + bfhi(ua.x) * bfhi(ub.x) + bflo(ua.y) * bflo(ub.y) + bfhi(ua.y) * bfhi(ub.y) + bflo(ua.z) * bflo(ub.z) + bfhi(ua.z) * bfhi(ub.z) + bflo(ua.w) * bflo(ub.w) + bfhi(ua.w) * bfhi(ub.w); }
    return s; }
struct E_attnA { Ctx c; int half; static constexpr long n = (long)TH * 3 * 4 * 8;
    HD void operator()(long idx) const {
        const int p = (int)(idx & 7), h = (int)((idx >> 3) & 3); const long rest = idx >> 5; const int g = (int)(rest % 3), tl = (int)(rest / 3);
        const int r = dil_of(g), bl = tl / S, s = tl % S, cc = s % r, nq = s / r, L = S / r, base = bl * S + cc * L;
        const bf16_t* P = wsp<bf16_t>(c, OFF_P); const float* bias = wsp<float>(c, OFF_SMALL) + SM_BIAS + (g * 4 + h) * 129;
        const bf16_t* q = P + (size_t)(base + nq) * NP + g * 1536 + h * 128;
        float m = -INFINITY, l = 0.f, o[16];
#ifndef HOST_TEST
#pragma unroll
#endif
        for (int j = 0; j < 16; ++j) o[j] = 0.f;
        const int umax = nq < 128 ? nq : 128;
        for (int u = 0; u <= umax; ++u) {
            const bf16_t* kr = P + (size_t)(base + nq - u) * NP + g * 1536 + 512 + h * 128; const bf16_t* vr = kr + 512 + p * 16;
            const float sc = dot128(q, kr) * QK_SCALE + bias[u];
            const float mn = fmaxf(m, sc), a = expf(m - mn), pw = expf(sc - mn); l = l * a + pw; m = mn;
#ifndef HOST_TEST
#pragma unroll
#endif
            for (int j = 0; j < 16; ++j) o[j] = o[j] * a + pw * bf2f(vr[j]);
        }
        bf16_t* op = wsp<bf16_t>(c, OFF_PART) + ((size_t)g * TH + tl) * WA + h * 128 + p * 16; const float il = 1.f / l;
#ifndef HOST_TEST
#pragma unroll
#endif
        for (int j = 0; j < 16; ++j) op[j] = f2bf(o[j] * il);
        if (p == 0) wsp<float>(c, OFF_LSE)[((size_t)g * TH + tl) * 4 + h] = m + logf(l);
    } };
struct E_combA { Ctx c; int half; static constexpr long n = (long)TH * WA;
    HD void operator()(long idx) const { const int col = (int)(idx % WA), tl = (int)(idx / WA), h = col >> 7;
        const float* lse = wsp<float>(c, OFF_LSE); const bf16_t* part = wsp<bf16_t>(c, OFF_PART);
        const float l0 = lse[((size_t)0 * TH + tl) * 4 + h], l1 = lse[((size_t)1 * TH + tl) * 4 + h], l2 = lse[((size_t)2 * TH + tl) * 4 + h];
        const float mx = fmaxf(l0, fmaxf(l1, l2)), e0 = expf(l0 - mx), e1 = expf(l1 - mx), e2 = expf(l2 - mx), inv = 1.f / (e0 + e1 + e2);
        const float v = (e0 * bf2f(part[((size_t)0 * TH + tl) * WA + col]) + e1 * bf2f(part[((size_t)1 * TH + tl) * WA + col]) + e2 * bf2f(part[((size_t)2 * TH + tl) * WA + col])) * inv;
        ((bf16_t*)c.out)[((size_t)half * TH + tl) * OW + col] = f2bf(v); } };
struct E_attnC { Ctx c; int half; static constexpr long n = (long)TH * 4 * 8;
    HD void operator()(long idx) const { const int p = (int)(idx & 7), h = (int)((idx >> 3) & 3), tl = (int)(idx >> 5), b = half * BH + tl / S;
        const bf16_t* q = wsp<bf16_t>(c, OFF_P) + (size_t)tl * NP + COLS_A + COLS_B + h * 128; const bf16_t* kv = wsp<bf16_t>(c, OFF_MEMKV) + (size_t)b * MEM * 1024;
        float m = -INFINITY, l = 0.f, o[16];
#ifndef HOST_TEST
#pragma unroll
#endif
        for (int j = 0; j < 16; ++j) o[j] = 0.f;
        for (int k = 0; k < MEM; ++k) { const bf16_t* kr = kv + (size_t)k * 1024 + h * 128; const bf16_t* vr = kr + 512 + p * 16;
            const float sc = dot128(q, kr) * QK_SCALE; const float mn = fmaxf(m, sc), a = expf(m - mn), pw = expf(sc - mn); l = l * a + pw; m = mn;
#ifndef HOST_TEST
#pragma unroll
#endif
            for (int j = 0; j < 16; ++j) o[j] = o[j] * a + pw * bf2f(vr[j]); }
        bf16_t* op = (bf16_t*)c.out + ((size_t)half * TH + tl) * OW + WA + WB + h * 128 + p * 16; const float il = 1.f / l;
#ifndef HOST_TEST
#pragma unroll
#endif
        for (int j = 0; j < 16; ++j) op[j] = f2bf(o[j] * il); } };

HD float hg_f(const Ctx& c, const bf16_t* prow, int ch) { const float lb = wsp<float>(c, OFF_SMALL)[SM_LB + ch]; return lb + (1.f - lb) * sigmoidf_(bf2f(prow[COLS_A + WB + ch])); }
struct E_hg1 { Ctx c; int half; static constexpr long n = (long)BH * HB * NSEG * 128 * 128;
    HD void operator()(long idx) const { const int v = (int)(idx & 127), k = (int)((idx >> 7) & 127); const long r = idx >> 14; const int seg = (int)(r % NSEG), bhl = (int)(r / NSEG), h = bhl % HB, bl = bhl / HB;
        const bf16_t* P = wsp<bf16_t>(c, OFF_P); const int ch = h * 128 + k; float st = 0.f, dsum = 0.f;
        for (int s = 0; s < 256; ++s) { const bf16_t* pr = P + (size_t)(bl * S + seg * 256 + s) * NP; const float f = hg_f(c, pr, ch); st = f * st + (1.f - f) * bf2f(pr[COLS_A + 2 * WB + h * 128 + v]); dsum += logf(f); }
        wsp<float>(c, OFF_HG)[idx] = st; if (v == 0) wsp<float>(c, OFF_DSEG)[((size_t)bhl * NSEG + seg) * 128 + k] = dsum; } };
struct E_hg2 { Ctx c; static constexpr long n = (long)BH * HB * 128 * 128;
    HD void operator()(long idx) const { const int v = (int)(idx & 127), k = (int)((idx >> 7) & 127), bhl = (int)(idx >> 14); float run = 0.f;
        for (int seg = 0; seg < NSEG; ++seg) { float* p = wsp<float>(c, OFF_HG) + (((size_t)bhl * NSEG + seg) * 128 + k) * 128 + v; const float tmp = *p; *p = run;
            run = expf(wsp<float>(c, OFF_DSEG)[((size_t)bhl * NSEG + seg) * 128 + k]) * run + tmp; } } };
struct E_hg3 { Ctx c; int half; static constexpr long n = (long)BH * HB * NSEG * 128;
    HD void operator()(long idx) const { const int v = (int)(idx & 127); const long r = idx >> 7; const int seg = (int)(r % NSEG), bhl = (int)(r / NSEG), h = bhl % HB, bl = bhl / HB;
        const bf16_t* P = wsp<bf16_t>(c, OFF_P); float st[128];
#ifndef HOST_TEST
#pragma unroll
#endif
        for (int k = 0; k < 128; ++k) st[k] = wsp<float>(c, OFF_HG)[(((size_t)bhl * NSEG + seg) * 128 + k) * 128 + v];
        for (int s = 0; s < 256; ++s) { const int tl = bl * S + seg * 256 + s; const bf16_t* pr = P + (size_t)tl * NP; const float iv = bf2f(pr[COLS_A + 2 * WB + h * 128 + v]); float o = 0.f;
#ifndef HOST_TEST
#pragma unroll
#endif
            for (int k = 0; k < 128; ++k) { const float f = hg_f(c, pr, h * 128 + k); st[k] = f * st[k] + (1.f - f) * iv; o += siluf_(bf2f(pr[COLS_A + h * 128 + k])) * st[k]; }
            ((bf16_t*)c.out)[((size_t)half * TH + tl) * OW + WA + h * 128 + v] = f2bf(o); } } };
struct E_hgnorm { Ctx c; int half; static constexpr long n = (long)TH * HB;
    HD void operator()(long idx) const { const int h = (int)(idx % HB), tl = (int)(idx / HB); bf16_t* o = (bf16_t*)c.out + ((size_t)half * TH + tl) * OW + WA + h * 128;
        const bf16_t* pr = wsp<bf16_t>(c, OFF_P) + (size_t)tl * NP + COLS_A + 3 * WB + h * 128; float ss = 0.f;
        for (int v = 0; v < 128; ++v) { const float x = bf2f(o[v]); ss += x * x; }
        const float rs = 1.f / sqrtf(ss * (1.f / 128.f) + RMS_EPS);
        for (int v = 0; v < 128; ++v) o[v] = f2bf(bf2f(o[v]) * rs * c.norm_g[h * 128 + v] * siluf_(bf2f(pr[v]))); } };

struct E_ln1 { Ctx c; static constexpr long n = T;
    HD void operator()(long row) const { float* h1 = wsp<float>(c, OFF_H1) + (size_t)row * D; bf16_t* xb1 = wsp<bf16_t>(c, OFF_X1B) + (size_t)row * D;
        float mu = 0.f; for (int i = 0; i < D; ++i) mu += h1[i]; mu *= (1.f / D);
        float var = 0.f; for (int i = 0; i < D; ++i) { const float d = h1[i] - mu; var += d * d; } var *= (1.f / D); const float rs = 1.f / sqrtf(var + LN_EPS);
        float gl0 = c.b_rg[0], gl1 = c.b_rg[1], gl2 = c.b_rg[2], gl3 = c.b_rg[3];
        for (int i = 0; i < D; ++i) { const float v = (h1[i] - mu) * rs * c.ln1_g[i] + c.ln1_b[i]; h1[i] = v; xb1[i] = f2bf(v);
            gl0 += v * c.w_rg[i * 4 + 0]; gl1 += v * c.w_rg[i * 4 + 1]; gl2 += v * c.w_rg[i * 4 + 2]; gl3 += v * c.w_rg[i * 4 + 3]; }
        int gs = 0; float gm = gl0; if (gl1 > gm) { gm = gl1; gs = 1; } if (gl2 > gm) { gm = gl2; gs = 2; } if (gl3 > gm) { gm = gl3; gs = 3; }
        const float gp = 1.f / (expf(gl0 - gm) + expf(gl1 - gm) + expf(gl2 - gm) + expf(gl3 - gm));
        float v0 = -INFINITY, v1 = -INFINITY; int i0 = 0, i1 = 0;
        for (int j = 0; j < 8; ++j) { float el = c.b_re[gs * 8 + j]; for (int i = 0; i < D; ++i) el += h1[i] * c.w_re[i * 32 + gs * 8 + j];
            if (el > v0) { v1 = v0; i1 = i0; v0 = el; i0 = j; } else if (el > v1) { v1 = el; i1 = j; } }
        const float e1 = expf(v1 - v0), w0 = gp / (1.f + e1), w1 = gp * e1 / (1.f + e1);
        unsigned* cnt = wsp<unsigned>(c, OFF_CTL) + CW_CNT; int* list = wsp<int>(c, OFF_LIST); float* rw = wsp<float>(c, OFF_RW);
        const int ea = gs * 8 + i0, eb = gs * 8 + i1;
        list[(size_t)ea * T + atomic_inc_u32(cnt + ea)] = (int)row * 2 + 0; list[(size_t)eb * T + atomic_inc_u32(cnt + eb)] = (int)row * 2 + 1;
        rw[row * 2 + 0] = w0; rw[row * 2 + 1] = w1; } };
struct E_blk { Ctx c; static constexpr long n = 1;
    HD void operator()(long) const { int* blk = wsp<int>(c, OFF_SMALL) + SM_BLK; const unsigned* cnt = wsp<unsigned>(c, OFF_CTL) + CW_CNT; int acc = 0;
        for (int e = 0; e < NE; ++e) { blk[e] = acc; const int nb = ((int)cnt[e] + 255) >> 8; for (int j = 0; j < nb; ++j) blk[64 + acc + j] = e; acc += nb; } blk[32] = acc; } };
struct E_ln2 { Ctx c; static constexpr long n = T;
    HD void operator()(long row) const { const float* x1 = wsp<float>(c, OFF_H1) + (size_t)row * D; const bf16_t* y0 = wsp<bf16_t>(c, OFF_Y0) + (size_t)row * D; const bf16_t* y1 = wsp<bf16_t>(c, OFF_Y1) + (size_t)row * D;
        const float w0 = wsp<float>(c, OFF_RW)[row * 2], w1 = wsp<float>(c, OFF_RW)[row * 2 + 1]; float* o = c.out + (size_t)row * D;
        float mu = 0.f; for (int i = 0; i < D; ++i) { const float v = DN_ALPHA * x1[i] + w0 * bf2f(y0[i]) + w1 * bf2f(y1[i]); mu += v; } mu *= (1.f / D);
        float var = 0.f; for (int i = 0; i < D; ++i) { const float v = DN_ALPHA * x1[i] + w0 * bf2f(y0[i]) + w1 * bf2f(y1[i]) - mu; var += v * v; } var *= (1.f / D); const float rs = 1.f / sqrtf(var + LN_EPS);
        for (int i = 0; i < D; ++i) { const float v = DN_ALPHA * x1[i] + w0 * bf2f(y0[i]) + w1 * bf2f(y1[i]); o[i] = (v - mu) * rs * c.ln2_g[i] + c.ln2_b[i]; } } };
typedef short bf16x8 __attribute__((ext_vector_type(8)));
typedef float f32x4 __attribute__((ext_vector_type(4)));

template <class F> __global__ void __launch_bounds__(256) k_elems(F f, long n) {
    for (long i = (long)blockIdx.x * 256 + threadIdx.x; i < n; i += (long)gridDim.x * 256) f(i);
}
template <class F> __global__ void __launch_bounds__(64) k_elems64(F f, long n) {
    for (long i = (long)blockIdx.x * 64 + threadIdx.x; i < n; i += (long)gridDim.x * 64) f(i);
}
template <class G> __global__ void __launch_bounds__(256) k_sgemm(G g) {
    const int M = g.M(); const int lane = threadIdx.x & 63, wid = threadIdx.x >> 6; constexpr int ntn = G::N / 64;
    const long ntiles = (long)(M / 64) * ntn;
    for (long tile = blockIdx.x; tile < ntiles; tile += gridDim.x) {
        const int tm = (int)(tile / ntn), tn = (int)(tile % ntn), r0 = tm * 64 + wid * 16, c0 = tn * 64;
        f32x4 acc[G::NBP][4], carry[4];
#pragma unroll
        for (int j = 0; j < 4; ++j) { carry[j] = (f32x4){0.f, 0.f, 0.f, 0.f};
#pragma unroll
            for (int w = 0; w < G::NBP; ++w) acc[w][j] = (f32x4){0.f, 0.f, 0.f, 0.f}; }
#pragma unroll
        for (int seg = 0; seg < G::NSEGS; ++seg) {
            const bf16_t* ar = g.arow(seg, r0 + (lane & 15)) + 8 * (lane >> 4); const bf16_t* br[G::NBP][4];
#pragma unroll
            for (int w = 0; w < G::NBP; ++w)
#pragma unroll
                for (int j = 0; j < 4; ++j) br[w][j] = g.brow(seg, r0, c0 + 16 * j + (lane & 15), w) + 8 * (lane >> 4);
            const int K = g.K(seg);
            for (int k0 = 0; k0 < K; k0 += 32) { const bf16x8 a = *(const bf16x8*)(ar + k0);
#pragma unroll
                for (int w = 0; w < G::NBP; ++w)
#pragma unroll
                    for (int j = 0; j < 4; ++j) { const bf16x8 b = *(const bf16x8*)(br[w][j] + k0); acc[w][j] = __builtin_amdgcn_mfma_f32_16x16x32_bf16(a, b, acc[w][j], 0, 0, 0); } }
#pragma unroll
            for (int j = 0; j < 4; ++j)
#pragma unroll
                for (int i = 0; i < 4; ++i) { float a = acc[0][j][i], cr = carry[j][i]; g.between(seg, r0 + (lane >> 4) * 4 + i, c0 + 16 * j + (lane & 15), a, cr); acc[0][j][i] = a; carry[j][i] = cr; }
        }
#pragma unroll
        for (int j = 0; j < 4; ++j)
#pragma unroll
            for (int i = 0; i < 4; ++i) g.store(r0 + (lane >> 4) * 4 + i, c0 + 16 * j + (lane & 15), acc[0][j][i], G::NBP == 2 ? acc[G::NBP - 1][j][i] : carry[j][i]);
    }
}
template <class F> static void launch_elems(const F& f, long n, hipStream_t st) { long nb = (n + 255) / 256; if (nb > 32768) nb = 32768; if (nb < 1) nb = 1; hipLaunchKernelGGL(k_elems<F>, dim3((unsigned)nb), dim3(256), 0, st, f, n); }
template <class F> static void launch_elems64(const F& f, long n, hipStream_t st) { long nb = (n + 63) / 64; if (nb > 65536) nb = 65536; hipLaunchKernelGGL(k_elems64<F>, dim3((unsigned)nb), dim3(64), 0, st, f, n); }
template <class G> static void launch_sgemm(const G& g, hipStream_t st) { hipLaunchKernelGGL(k_sgemm<G>, dim3(4096), dim3(256), 0, st, g); }

static Ctx make_ctx(void* const* d_in, void* d_out, void* d_ws) {
    Ctx c; memset(&c, 0, sizeof(c)); const float** ip = (const float**)&c; for (int i = 0; i < 22; ++i) ip[i] = (const float*)d_in[i];
    c.out = (float*)d_out; c.ws = (unsigned char*)d_ws; return c;
}
static void v1_stage0(Ctx c, hipStream_t st) {
    launch_elems(S0_xb{c}, S0_xb::n, st); launch_elems(S0_memb{c}, S0_memb::n, st); launch_elems(S0_small{c}, S0_small::n, st);
    launch_elems(S0_tr{c.w_in, wsp<bf16_t>(c, WT_IN), D, N_IN, (long)D * N_IN, D}, (long)D * N_IN, st);
    launch_elems(S0_tr{c.w_kv, wsp<bf16_t>(c, WT_KV), D, 1024, (long)D * 1024, D}, (long)D * 1024, st);
    launch_elems(S0_tr{c.w_a, wsp<bf16_t>(c, WT_A), WA, D, (long)D * WA, OW}, (long)D * WA, st);
    launch_elems(S0_tr{c.w_b, wsp<bf16_t>(c, WT_A) + WA, WB, D, (long)D * WB, OW}, (long)D * WB, st);
    launch_elems(S0_tr{c.w_c, wsp<bf16_t>(c, WT_A) + WA + WB, WC, D, (long)D * WC, OW}, (long)D * WC, st);
    launch_elems(S0_tr{c.w_out, wsp<bf16_t>(c, WT_OUT), D, D, (long)D * D, D}, (long)D * D, st);
}
static void v1_proj(Ctx c, int half, hipStream_t st) { if (half == 0) launch_sgemm(G_memkv{c}, st); launch_sgemm(G_proj{c, half}, st); }
static void v1_mixers(Ctx c, int half, hipStream_t st) {
    launch_elems(E_hg1{c, half}, E_hg1::n, st); launch_elems(E_hg2{c}, E_hg2::n, st);
    launch_elems(E_attnA{c, half}, E_attnA::n, st); launch_elems(E_attnC{c, half}, E_attnC::n, st);
    launch_elems64(E_hg3{c, half}, E_hg3::n, st); launch_elems(E_hgnorm{c, half}, E_hgnorm::n, st); launch_elems(E_combA{c, half}, E_combA::n, st);
}
static void v1_expw(Ctx c, hipStream_t st) { launch_elems(S0_gu{c}, S0_gu::n, st); launch_elems(S0_dn{c}, S0_dn::n, st); }
static void v1_gates(Ctx c, hipStream_t st) { launch_sgemm(G_gates{c}, st); }
static void v1_merge(Ctx c, hipStream_t st) { launch_sgemm(G_merge{c}, st); }
static void v1_wout(Ctx c, hipStream_t st) { launch_sgemm(G_wout{c}, st); }
static void v1_ln1(Ctx c, hipStream_t st) { launch_elems(E_ln1{c}, E_ln1::n, st); launch_elems(E_blk{c}, 1, st); }
static void v1_moe1(Ctx c, hipStream_t st) { launch_sgemm(G_moe1{c}, st); }
static void v1_moe2(Ctx c, hipStream_t st) { launch_sgemm(G_moe2{c}, st); }
static void v1_ln2(Ctx c, hipStream_t st) { launch_elems(E_ln2{c}, E_ln2::n, st); }
namespace pg8 {
#define PG8_LAS __attribute__((address_space(3)))
typedef unsigned u32x4 __attribute__((ext_vector_type(4)));
constexpr int BM = 256, BK = 64, HALF = 128, HTB = HALF * BK * 2, STAGE_BYTES = 8 * HTB, NXCD = 8, WGM = 8;
__host__ __device__ __forceinline__ int lds_byte(int r, int c) { const int st = (r >> 4) * 2 + (c >> 5), rr = r & 15, cc = c & 31, ob = rr * 64 + cc * 2; return st * 1024 + (ob ^ (((ob >> 9) & 1) << 5)); }
__host__ __device__ __forceinline__ void stage_rc(int b, int& R, int& C) { const int st = b / 1024, sb = b % 1024, swz = sb ^ (((sb >> 9) & 1) << 5); R = (st >> 1) * 16 + swz / 64; C = (st & 1) * 32 + (swz % 64) / 2; }
__host__ __device__ __forceinline__ int perm32(int rho) { const int n = rho >> 4, i = rho & 15; return 8 * (i >> 2) + 4 * n + (i & 3); }
__device__ __forceinline__ unsigned cvt_pk_bf16(float lo, float hi) { unsigned r; asm volatile("v_cvt_pk_bf16_f32 %0, %1, %2" : "=v"(r) : "v"(lo), "v"(hi)); return r; }

__device__ __forceinline__ int lane_id_opaque() { int l; asm volatile("v_mbcnt_lo_u32_b32 %0, -1, 0\n\tv_mbcnt_hi_u32_b32 %0, -1, %0" : "=v"(l)); return l; }
struct Unit { const char* A; const char* B; int nt, pm, pn, tag; };
__device__ __forceinline__ void tile_of(int L, int nM, int nN, int& pm, int& pn) {
    const int nwg = nM * nN; int wgid = L; { const int q = nwg / NXCD, r = nwg % NXCD, xcd = wgid % NXCD, off = wgid / NXCD; wgid = (xcd < r ? xcd * (q + 1) : r * (q + 1) + (xcd - r) * q) + off; }
    const int nig = WGM * nN, gid = wgid / nig, fm = gid * WGM, gsz = (nM - fm) < WGM ? (nM - fm) : WGM;
    pm = fm + ((wgid % nig) % gsz); pn = (wgid % nig) / gsz;
}
template <class Epi, class Sched>
__device__ __forceinline__ void gemm_phase(PG8_LAS unsigned char* lds, const Sched& S, const Epi& E, int tid) {
    constexpr bool GA = Sched::GATHER;
    asm volatile("" : "+v"(tid));
    const int wid = __builtin_amdgcn_readfirstlane(tid >> 6), lane = tid & 63, wr = wid >> 2, wc = wid & 3, fr = lane & 15, fq = lane >> 4;
    const unsigned lda = S.lda, ldb = S.ldb;
    int sR[2]; unsigned voffA[2], voffB[2];
#pragma unroll
    for (int i = 0; i < 2; ++i) { int R, C; stage_rc(tid * 16 + i * 8192, R, C); sR[i] = R; const int Rb = Epi::PERM ? ((R & ~31) + perm32(R & 31)) : R;
        voffA[i] = (GA ? 0u : (unsigned)R * lda) + (unsigned)C * 2u; voffB[i] = (unsigned)Rb * ldb + (unsigned)C * 2u; }
    const size_t kstep = (size_t)(BK * 2), hstepA = (size_t)HALF * lda, hstepB = (size_t)HALF * ldb;
    const unsigned ldsw = (unsigned)wid * 1024u;
    const int aoff = lds_byte(wr * 64 + fr, fq * 8), boff = lds_byte(wc * 32 + fr, fq * 8);
#define PG8_SA(b, h) (((b) * 2 + (h)) * HTB)
#define PG8_SB(b, h) ((4 + (b) * 2 + (h)) * HTB)
#define PG8_STAGE(bufoff, gbase, voff) do { const char* gb_ = (const char*)(gbase); asm volatile("" : "+s"(gb_));     \
        _Pragma("unroll") for (int _i = 0; _i < 2; ++_i) \
        __builtin_amdgcn_global_load_lds((const unsigned*)(gb_ + (voff)[_i]), (PG8_LAS unsigned*)(lds + (bufoff) + ldsw + _i * 8192), 16, 0, 0); } while (0)
#define PG8_STAGE_A(bufoff, gbase, h, tk) do { if constexpr (GA) { unsigned _o[2]; _Pragma("unroll") for (int _i = 0; _i < 2; ++_i) _o[_i] = (((tk)[_i] >> (16 * (h))) & 0xffffu) * lda + voffA[_i]; PG8_STAGE(bufoff, gbase, _o); } \
        else { PG8_STAGE(bufoff, (gbase) + (h) * hstepA, voffA); } } while (0)
#define PG8_LDA(dst, b, h) do { _Pragma("unroll") for (int m = 0; m < 4; ++m) _Pragma("unroll") for (int k = 0; k < 2; ++k) dst[m][k] = *(const PG8_LAS bf16x8*)(lds + PG8_SA(b, h) + aoff + m * 2048 + k * 1024); } while (0)
#define PG8_LDB(dst, b, h) do { _Pragma("unroll") for (int n = 0; n < 2; ++n) _Pragma("unroll") for (int k = 0; k < 2; ++k) dst[n][k] = *(const PG8_LAS bf16x8*)(lds + PG8_SB(b, h) + boff + n * 2048 + k * 1024); } while (0)
#define PG8_MMA(ai, bj, At, Bt) do { __builtin_amdgcn_s_setprio(1); _Pragma("unroll") for (int m = 0; m < 4; ++m) _Pragma("unroll") for (int n = 0; n < 2; ++n) _Pragma("unroll") for (int k = 0; k < 2; ++k) \
        acc[ai][bj][m][n] = __builtin_amdgcn_mfma_f32_16x16x32_bf16(Bt[n][k], At[m][k], acc[ai][bj][m][n], 0, 0, 0); __builtin_amdgcn_s_setprio(0); } while (0)
#define PG8_WAIT_V(n) asm volatile("s_waitcnt vmcnt(" #n ")" ::: "memory")
#define PG8_WAIT_L(n) asm volatile("s_waitcnt lgkmcnt(" #n ")" ::: "memory")
#define PG8_BAR __builtin_amdgcn_s_barrier()
#define PG8_SCHED __builtin_amdgcn_sched_barrier(0)
#define PG8_TOKS(u, tk) do { if constexpr (GA) { _Pragma("unroll") for (int _i = 0; _i < 2; ++_i) tk[_i] = S.a_row(u, sR[_i]) | (S.a_row(u, sR[_i] + HALF) << 16); } } while (0)
    Unit cur, nxt; int ui = 0;
    if (!S.next(0, cur)) return;
    f32x4 acc[2][2][4][2];
#pragma unroll
    for (int a = 0; a < 2; ++a)
#pragma unroll
        for (int b = 0; b < 2; ++b)
#pragma unroll
            for (int m = 0; m < 4; ++m)
#pragma unroll
                for (int n = 0; n < 2; ++n) acc[a][b][m][n] = (f32x4){0.f, 0.f, 0.f, 0.f};
    bf16x8 At[4][2], B0[2][2], B1[2][2];
    unsigned ctk[2] = {0u, 0u}, ntk[2] = {0u, 0u};
    PG8_TOKS(cur, ctk);
    const char* cA = cur.A; const char* cB = cur.B;
    PG8_STAGE(PG8_SB(0, 0), cB, voffB); PG8_STAGE(PG8_SB(0, 1), cB + hstepB, voffB); PG8_STAGE_A(PG8_SA(0, 0), cA, 0, ctk); PG8_STAGE_A(PG8_SA(0, 1), cA, 1, ctk);
    if (wr == 1) PG8_BAR;
    PG8_WAIT_V(2); PG8_BAR;
    PG8_STAGE(PG8_SB(1, 0), cB + kstep, voffB); PG8_STAGE_A(PG8_SA(1, 0), cA + kstep, 0, ctk); PG8_STAGE(PG8_SB(1, 1), cB + hstepB + kstep, voffB);
    PG8_WAIT_V(6); PG8_BAR;
    for (;;) {
        const bool has_next = S.next(ui + 1, nxt);
        const char* nA = cA; const char* nB = cB;
        if constexpr (GA) { ntk[0] = ctk[0]; ntk[1] = ctk[1]; }
        if (has_next) { nA = nxt.A; nB = nxt.B; PG8_TOKS(nxt, ntk); }
        const int nt = cur.nt;
#define PG8_TRIP(a1, a2, b2, tk2) do { const char* a3 = (a2) + kstep; const char* b3 = (b2) + kstep; \
            PG8_LDB(B0, 0, 0); PG8_LDB(B1, 0, 1); PG8_SCHED; PG8_LDA(At, 0, 0); PG8_STAGE_A(PG8_SA(1, 1), a1, 1, ctk); \
            PG8_WAIT_V(8); PG8_WAIT_L(0); PG8_BAR; PG8_MMA(0, 0, At, B0); PG8_MMA(0, 1, At, B1); PG8_BAR; PG8_SCHED; \
            PG8_LDA(At, 0, 1); PG8_STAGE(PG8_SB(0, 0), b2, voffB); PG8_STAGE(PG8_SB(0, 1), (b2) + hstepB, voffB); PG8_STAGE_A(PG8_SA(0, 0), a2, 0, tk2); \
            PG8_WAIT_V(8); PG8_WAIT_L(0); PG8_BAR; PG8_MMA(1, 0, At, B0); PG8_MMA(1, 1, At, B1); PG8_BAR; PG8_SCHED; \
            PG8_LDB(B0, 1, 0); PG8_LDB(B1, 1, 1); PG8_SCHED; PG8_LDA(At, 1, 0); PG8_STAGE_A(PG8_SA(0, 1), a2, 1, tk2); \
            PG8_WAIT_V(8); PG8_WAIT_L(0); PG8_BAR; PG8_MMA(0, 0, At, B0); PG8_MMA(0, 1, At, B1); PG8_BAR; PG8_SCHED; \
            PG8_LDA(At, 1, 1); PG8_STAGE(PG8_SB(1, 0), b3, voffB); PG8_STAGE(PG8_SB(1, 1), b3 + hstepB, voffB); PG8_STAGE_A(PG8_SA(1, 0), a3, 0, tk2); \
            PG8_WAIT_V(8); PG8_WAIT_L(0); PG8_BAR; PG8_MMA(1, 0, At, B0); PG8_MMA(1, 1, At, B1); PG8_BAR; PG8_SCHED; } while (0)
        for (int t = 0; t < nt - 2; t += 2) { const char* a1 = cA + (size_t)(t + 1) * kstep; const char* a2 = cA + (size_t)(t + 2) * kstep; const char* b2 = cB + (size_t)(t + 2) * kstep;
            PG8_TRIP(a1, a2, b2, ctk); }
        { const char* a1 = cA + (size_t)(nt - 1) * kstep; PG8_TRIP(a1, nA, nB, ntk); }
#undef PG8_TRIP
        if (wr == 0) PG8_BAR;
        { const int el = lane_id_opaque(); E(acc, cur, wr, wc, el & 15, el >> 4); }
        if (!has_next) break;
        cur = nxt; cA = nA; cB = nB;
        if constexpr (GA) { ctk[0] = ntk[0]; ctk[1] = ntk[1]; }
        ++ui;
        if (wr == 1) PG8_BAR;
    }
    PG8_WAIT_V(0);
    PG8_BAR;
#undef PG8_SA
#undef PG8_SB
#undef PG8_STAGE
#undef PG8_STAGE_A
#undef PG8_LDA
#undef PG8_LDB
#undef PG8_MMA
#undef PG8_WAIT_V
#undef PG8_WAIT_L
#undef PG8_BAR
#undef PG8_SCHED
#undef PG8_TOKS
}
}
namespace pg8 {
#define ZERO_ACC() do { _Pragma("unroll") for (int a_ = 0; a_ < 2; ++a_) _Pragma("unroll") for (int b_ = 0; b_ < 2; ++b_) _Pragma("unroll") for (int m_ = 0; m_ < 4; ++m_) _Pragma("unroll") for (int n_ = 0; n_ < 2; ++n_) acc[a_][b_][m_][n_] = (f32x4){0.f, 0.f, 0.f, 0.f}; } while (0)
typedef f32x4 (&AccRef)[2][2][4][2];
__device__ __forceinline__ u32x4 pack8(f32x4 v0, f32x4 v1) { u32x4 w; w.x = cvt_pk_bf16(v0[0], v0[1]); w.y = cvt_pk_bf16(v0[2], v0[3]); w.z = cvt_pk_bf16(v1[0], v1[1]); w.w = cvt_pk_bf16(v1[2], v1[3]); return w; }
__device__ __forceinline__ void unpack8(u32x4 w, f32x4& v0, f32x4& v1) { v0 = (f32x4){bflo(w.x), bfhi(w.x), bflo(w.y), bfhi(w.y)}; v1 = (f32x4){bflo(w.z), bfhi(w.z), bflo(w.w), bfhi(w.w)}; }
__device__ __forceinline__ float fsigmoid(float x) { return __builtin_amdgcn_rcpf(1.f + __expf(-x)); }

struct SchedGrid {
    static constexpr bool GATHER = false; unsigned lda, ldb;
    int nM, nN, G, c, nt; const char *A0, *B0;
    __device__ __forceinline__ bool next(int i, Unit& u) const { const long L = (long)i * G + c; if (L >= (long)nM * nN) return false;
        int pm, pn; tile_of((int)L, nM, nN, pm, pn); u.pm = pm; u.pn = pn; u.tag = 0; u.nt = nt;
        u.A = A0 + (size_t)pm * BM * lda; u.B = B0 + (size_t)pn * BM * ldb; return true; }
};
struct SchedMerge {
    static constexpr bool GATHER = false; unsigned lda, ldb;
    int nM, nN, G, c; const char *A0, *B0;
    __device__ __forceinline__ bool next(int i, Unit& u) const { const int r = i / 3, s = i - r * 3; const long L = (long)r * G + c; if (L >= (long)nM * nN) return false;
        int pm, pn; tile_of((int)L, nM, nN, pm, pn); u.pm = pm; u.pn = pn; u.tag = s; u.nt = (s == 1 ? WB : WA) / BK;
        const size_t so = (size_t)((s > 0 ? WA : 0) + (s > 1 ? WB : 0)) * 2;
        u.A = A0 + (size_t)pm * BM * lda + so; u.B = B0 + (size_t)pn * BM * ldb + so; return true; }
};
#define ROWS_BEGIN(off0) { unsigned ro_ = (off0); _Pragma("unroll") for (int ai = 0; ai < 2; ++ai) { _Pragma("unroll") for (int m = 0; m < 4; ++m) {
#define ROWS_END(step16) ro_ += (m == 3 ? 5u : 1u) * (step16); asm volatile("" : "+v"(ro_) :: "memory"); } } }
struct EpiProj { static constexpr bool PERM = true; bf16_t* P;
    __device__ __forceinline__ void operator()(AccRef acc, const Unit& u, int wr, int wc, int fr, int fq) const {
        const int g = u.pn < 18 ? u.pn / 6 : -1; const int col0 = u.pn * BM + wc * 32 + 8 * fq; const int r0 = u.pm * BM + wr * 64 + fr;
        const int pr0 = g >= 0 ? perm_row(r0, g) : r0; const unsigned step16 = (unsigned)(16 >> (g <= 0 ? 0 : 2 * g)) * (NP * 2);
        char* base = (char*)P;
        ROWS_BEGIN((unsigned)pr0 * (NP * 2) + (unsigned)col0 * 2)
#pragma unroll
            for (int bj = 0; bj < 2; ++bj) *(u32x4*)(base + ro_ + bj * (HALF * 2)) = pack8(acc[ai][bj][m][0], acc[ai][bj][m][1]);
        ROWS_END(step16)
        ZERO_ACC(); } };
struct EpiGates { static constexpr bool PERM = true; bf16_t* Gt;
    __device__ __forceinline__ void operator()(AccRef acc, const Unit& u, int wr, int wc, int fr, int fq) const {
        const int pl = u.pn / (D / BM), col0 = (u.pn % (D / BM)) * BM + wc * 32 + 8 * fq, r0 = u.pm * BM + wr * 64 + fr; char* base = (char*)Gt + (size_t)pl * T * D * 2;
        ROWS_BEGIN((unsigned)r0 * (D * 2) + (unsigned)col0 * 2)
#pragma unroll
            for (int bj = 0; bj < 2; ++bj) { f32x4 v0 = acc[ai][bj][m][0], v1 = acc[ai][bj][m][1];
#pragma unroll
                for (int e = 0; e < 4; ++e) { v0[e] = fsigmoid(v0[e]); v1[e] = fsigmoid(v1[e]); }
                *(u32x4*)(base + ro_ + bj * (HALF * 2)) = pack8(v0, v1); }
        ROWS_END(16u * D * 2)
        ZERO_ACC(); } };
struct EpiMerge { static constexpr bool PERM = true; const bf16_t* Gt; bf16_t* Mg;
    __device__ __forceinline__ void operator()(AccRef acc, const Unit& u, int wr, int wc, int fr, int fq) const {
        const int s = u.tag; const int col0 = u.pn * BM + wc * 32 + 8 * fq, r0 = u.pm * BM + wr * 64 + fr; const char* gbase = (const char*)Gt + (size_t)s * T * D * 2; char* mbase = (char*)Mg;
        ROWS_BEGIN((unsigned)r0 * (D * 2) + (unsigned)col0 * 2)
#pragma unroll
            for (int bj = 0; bj < 2; ++bj) { f32x4 g0, g1; unpack8(*(const u32x4*)(gbase + ro_ + bj * (HALF * 2)), g0, g1);
                if (s < 2) { f32x4 h0, h1; unpack8(*(const u32x4*)(gbase + (size_t)T * D * 2 + ro_ + bj * (HALF * 2)), h0, h1);
#pragma unroll
                    for (int e = 0; e < 4; ++e) { g0[e] *= __builtin_amdgcn_rcpf(fmaxf(h0[e], 1e-20f)); g1[e] *= __builtin_amdgcn_rcpf(fmaxf(h1[e], 1e-20f)); } }
                acc[ai][bj][m][0] *= g0; acc[ai][bj][m][1] *= g1;
                if (s == 2) *(u32x4*)(mbase + ro_ + bj * (HALF * 2)) = pack8(acc[ai][bj][m][0], acc[ai][bj][m][1]); }
        ROWS_END(16u * D * 2)
        if (s == 2) ZERO_ACC(); } };
struct EpiWout { static constexpr bool PERM = false; const float* X; float* H1;
    __device__ __forceinline__ void operator()(AccRef acc, const Unit& u, int wr, int wc, int fr, int fq) const {
        const int col0 = u.pn * BM + wc * 32 + 4 * fq, r0 = u.pm * BM + wr * 64 + fr; const char* xb_ = (const char*)X; char* hb_ = (char*)H1;
        ROWS_BEGIN((unsigned)r0 * (D * 4) + (unsigned)col0 * 4)
#pragma unroll
            for (int bj = 0; bj < 2; ++bj)
#pragma unroll
                for (int n = 0; n < 2; ++n) { const f32x4 xv = *(const f32x4*)(xb_ + ro_ + (bj * HALF + n * 16) * 4); *(f32x4*)(hb_ + ro_ + (bj * HALF + n * 16) * 4) = xv * DN_ALPHA + acc[ai][bj][m][n]; }
        ROWS_END(16u * D * 4)
        ZERO_ACC(); } };
template <bool GA> struct SchedMoe {
    static constexpr bool GATHER = GA; unsigned lda, ldb;
    int G, c, ncol, nt; const PG8_LAS int* blk; const int* list; const unsigned* cnt; const char* A; const char* B; size_t b_estride, b_pnstride;
    __device__ __forceinline__ bool next(int i, Unit& u) const { const long L = (long)i * G + c; const int nblk = __builtin_amdgcn_readfirstlane(blk[32]); if (L >= (long)nblk * ncol) return false;
        const int rb = (int)(L / ncol), pn = (int)(L % ncol), e = __builtin_amdgcn_readfirstlane(blk[64 + rb]); u.pm = rb; u.pn = pn; u.tag = e; u.nt = nt;
        u.A = GA ? A : A + (size_t)rb * BM * lda; u.B = B + (size_t)e * b_estride + (size_t)pn * b_pnstride; return true; }
    __device__ __forceinline__ unsigned a_row(const Unit& u, int row) const {
        const int e = u.tag, pos = ((u.pm - __builtin_amdgcn_readfirstlane(blk[e])) << 8) + row; const int entry = list[(size_t)e * T + (pos < __builtin_amdgcn_readfirstlane((int)cnt[e]) ? pos : 0)]; return (unsigned)(entry >> 1); }
};
struct EpiMoe1 { static constexpr bool PERM = true; bf16_t* Hb;
    __device__ __forceinline__ void operator()(AccRef acc, const Unit& u, int wr, int wc, int fr, int fq) const {
        const int col0 = u.pn * HALF + wc * 32 + 8 * fq, r0 = u.pm * BM + wr * 64 + fr; char* base = (char*)Hb;
        ROWS_BEGIN((unsigned)r0 * (DE * 2) + (unsigned)col0 * 2)
            f32x4 v0 = acc[ai][0][m][0], v1 = acc[ai][0][m][1];
#pragma unroll
            for (int e = 0; e < 4; ++e) { v0[e] = v0[e] * fsigmoid(v0[e]) * acc[ai][1][m][0][e]; v1[e] = v1[e] * fsigmoid(v1[e]) * acc[ai][1][m][1][e]; }
            *(u32x4*)(base + ro_) = pack8(v0, v1);
        ROWS_END(16u * DE * 2)
        ZERO_ACC(); } };
struct EpiMoe2 { static constexpr bool PERM = true; const PG8_LAS int* blk; const int* list; const unsigned* cnt; bf16_t* Y0; bf16_t* Y1;
    __device__ __forceinline__ void operator()(AccRef acc, const Unit& u, int wr, int wc, int fr, int fq) const {
        const int e = u.tag, col0 = u.pn * BM + wc * 32 + 8 * fq, pbase = ((u.pm - __builtin_amdgcn_readfirstlane(blk[e])) << 8) + wr * 64 + fr, n_e = __builtin_amdgcn_readfirstlane((int)cnt[e]); const int* le = list + (size_t)e * T;
        ROWS_BEGIN((unsigned)pbase)
            const int pos = (int)ro_;
            if (pos < n_e) { const int entry = le[pos]; bf16_t* rowp = ((entry & 1) ? Y1 : Y0) + (size_t)(entry >> 1) * D + col0;
#pragma unroll
                for (int bj = 0; bj < 2; ++bj) *(u32x4*)(rowp + bj * HALF) = pack8(acc[ai][bj][m][0], acc[ai][bj][m][1]); }
        ROWS_END(16u)
        ZERO_ACC(); } };
#undef ROWS_BEGIN
#undef ROWS_END
#undef ZERO_ACC
}

__device__ __forceinline__ void fast_proj(const Ctx& c, int half, PG8_LAS unsigned char* lds, int tid, int bid, int nblk) {
    pg8::SchedGrid S; S.nM = TH / 256; S.nN = NP / 256; S.G = nblk; S.c = bid; S.nt = D / 64; S.lda = D * 2; S.ldb = D * 2;
    S.A0 = (const char*)(wsp<bf16_t>(c, OFF_XB) + (size_t)half * TH * D); S.B0 = (const char*)wsp<bf16_t>(c, WT_IN);
    pg8::EpiProj E{wsp<bf16_t>(c, OFF_P)}; pg8::gemm_phase(lds, S, E, tid);
}
struct EpiPlain { static constexpr bool PERM = true; bf16_t* O; int ldc;
    __device__ __forceinline__ void operator()(pg8::AccRef acc, const pg8::Unit& u, int wr, int wc, int fr, int fq) const {
        const int col0 = u.pn * 256 + wc * 32 + 8 * fq, r0 = u.pm * 256 + wr * 64 + fr; char* base = (char*)O; unsigned ro = (unsigned)r0 * (unsigned)(ldc * 2) + (unsigned)col0 * 2;
#pragma unroll
        for (int ai = 0; ai < 2; ++ai)
#pragma unroll
            for (int m = 0; m < 4; ++m) {
#pragma unroll
                for (int bj = 0; bj < 2; ++bj) { *(pg8::u32x4*)(base + ro + bj * 256) = pg8::pack8(acc[ai][bj][m][0], acc[ai][bj][m][1]); acc[ai][bj][m][0] = (f32x4){0.f, 0.f, 0.f, 0.f}; acc[ai][bj][m][1] = (f32x4){0.f, 0.f, 0.f, 0.f}; }
                ro += (m == 3 ? 5u : 1u) * 16u * (unsigned)(ldc * 2); asm volatile("" : "+v"(ro) :: "memory"); } } };
__device__ __forceinline__ void fast_memkv(const Ctx& c, PG8_LAS unsigned char* lds, int tid, int bid, int nblk) {
    pg8::SchedGrid S; S.nM = NBATCH * MEM / 256; S.nN = 1024 / 256; S.G = nblk; S.c = bid; S.nt = D / 64; S.lda = D * 2; S.ldb = D * 2;
    S.A0 = (const char*)wsp<bf16_t>(c, OFF_MEMB); S.B0 = (const char*)wsp<bf16_t>(c, WT_KV);
    EpiPlain E{wsp<bf16_t>(c, OFF_MEMKV), 1024}; pg8::gemm_phase(lds, S, E, tid);
}
__device__ __forceinline__ void fast_gates(const Ctx& c, PG8_LAS unsigned char* lds, int tid, int bid, int nblk) {
    pg8::SchedGrid S; S.nM = T / 256; S.nN = 3 * D / 256; S.G = nblk; S.c = bid; S.nt = D / 64; S.lda = D * 2; S.ldb = D * 2;
    S.A0 = (const char*)wsp<bf16_t>(c, OFF_XB); S.B0 = (const char*)(wsp<bf16_t>(c, WT_IN) + (size_t)NP * D);
    pg8::EpiGates E{wsp<bf16_t>(c, OFF_GATES)}; pg8::gemm_phase(lds, S, E, tid);
}
__device__ __forceinline__ void fast_merge(const Ctx& c, PG8_LAS unsigned char* lds, int tid, int bid, int nblk) {
    pg8::SchedMerge S; S.nM = T / 256; S.nN = D / 256; S.G = nblk; S.c = bid; S.lda = OW * 2; S.ldb = OW * 2;
    S.A0 = (const char*)c.out; S.B0 = (const char*)wsp<bf16_t>(c, WT_A);
    pg8::EpiMerge E{wsp<bf16_t>(c, OFF_GATES), wsp<bf16_t>(c, OFF_MERGED)}; pg8::gemm_phase(lds, S, E, tid);
}
__device__ __forceinline__ void fast_wout(const Ctx& c, PG8_LAS unsigned char* lds, int tid, int bid, int nblk) {
    pg8::SchedGrid S; S.nM = T / 256; S.nN = D / 256; S.G = nblk; S.c = bid; S.nt = D / 64; S.lda = D * 2; S.ldb = D * 2;
    S.A0 = (const char*)wsp<bf16_t>(c, OFF_MERGED); S.B0 = (const char*)wsp<bf16_t>(c, WT_OUT);
    pg8::EpiWout E{c.x, wsp<float>(c, OFF_H1)}; pg8::gemm_phase(lds, S, E, tid);
}
constexpr int LDS_MISC = 131072, LDS_BLK = LDS_MISC + 1024;
__device__ __forceinline__ const PG8_LAS int* build_blk_table(const Ctx& c, PG8_LAS unsigned char* lds, int tid) {
    PG8_LAS int* blk = (PG8_LAS int*)(lds + LDS_BLK); const unsigned* cnt = wsp<unsigned>(c, OFF_CTL) + CW_CNT;
    if (tid < 32) blk[512 + tid] = ((int)cnt[tid] + 255) >> 8;
    __syncthreads();
    if (tid == 0) { int acc = 0; for (int e = 0; e < NE; ++e) { blk[e] = acc; acc += blk[512 + e]; } blk[32] = acc; }
    __syncthreads();
    { const int total = blk[32]; for (int rb = tid; rb < total; rb += 512) { int e = 0;
#pragma unroll 1
        for (int j = 1; j < NE; ++j) if (blk[j] <= rb) e = j;
        blk[64 + rb] = e; } }
    __syncthreads();
    return blk;
}
__device__ __forceinline__ void fast_moe1(const Ctx& c, PG8_LAS unsigned char* lds, int tid, int bid, int nblk) {
    pg8::SchedMoe<true> S; S.G = nblk; S.c = bid; S.ncol = 2; S.nt = D / 64; S.blk = build_blk_table(c, lds, tid); S.list = wsp<int>(c, OFF_LIST); S.cnt = wsp<unsigned>(c, OFF_CTL) + CW_CNT;
    S.A = (const char*)wsp<bf16_t>(c, OFF_X1B); S.B = (const char*)wsp<bf16_t>(c, OFF_WTGU); S.b_estride = (size_t)2 * DE * D * 2; S.b_pnstride = (size_t)256 * D * 2; S.lda = D * 2; S.ldb = D * 2;
    pg8::EpiMoe1 E{wsp<bf16_t>(c, OFF_HBUF)}; pg8::gemm_phase(lds, S, E, tid);
}
__device__ __forceinline__ void fast_moe2(const Ctx& c, PG8_LAS unsigned char* lds, int tid, int bid, int nblk) {
    pg8::SchedMoe<false> S; S.G = nblk; S.c = bid; S.ncol = D / 256; S.nt = DE / 64; S.blk = build_blk_table(c, lds, tid); S.list = wsp<int>(c, OFF_LIST); S.cnt = wsp<unsigned>(c, OFF_CTL) + CW_CNT;
    S.A = (const char*)wsp<bf16_t>(c, OFF_HBUF); S.B = (const char*)wsp<bf16_t>(c, OFF_WTDN); S.b_estride = (size_t)D * DE * 2; S.b_pnstride = (size_t)256 * DE * 2; S.lda = DE * 2; S.ldb = DE * 2;
    pg8::EpiMoe2 E{S.blk, S.list, S.cnt, wsp<bf16_t>(c, OFF_Y0), wsp<bf16_t>(c, OFF_Y1)}; pg8::gemm_phase(lds, S, E, tid);
}
namespace attn {
typedef short s16x4 __attribute__((ext_vector_type(4)));
typedef float f32x16 __attribute__((ext_vector_type(16)));
typedef unsigned u32x4 __attribute__((ext_vector_type(4)));
constexpr int KVBLK = 64, DH = 128, SHM_V = KVBLK * DH * 2, SHM_K = KVBLK * DH * 2;
constexpr int LDS_V = 0, LDS_K = 2 * SHM_V, LDS_WS = LDS_K + 2 * SHM_K, LDS_BIAS = LDS_WS + 8 * 64 * 4, BIAS_PAD = 96, BIAS_N = 129 + 2 * BIAS_PAD, LDS_END = LDS_BIAS + ((BIAS_N * 4 + 15) & ~15);
constexpr float LOG2E = 1.4426950408889634f, C2 = LOG2E * QK_SCALE, LN2 = 0.6931471805599453f;
#define KSWZ(row, colB) ((row) * 256 + ((colB) ^ (((row) & 7) << 4)))
#define SBAR() __builtin_amdgcn_sched_barrier(0)
__device__ __forceinline__ int v_st(int k, int c) { const int kk = (k & ~0xC) | ((k & 4) << 1) | ((k & 8) >> 1); return ((kk >> 3) * 4 + (c >> 5)) * 512 + ((kk & 7) * 32 + (c & 31)) * 2; }
__device__ __forceinline__ int v_rd_base(int lane) { return ((lane & 3) << 3) | (((lane >> 2) & 3) << 6) | (((lane >> 4) & 1) << 5) | (((lane >> 5) & 1) << 8); }
constexpr int v_rd_off(int d0, int ks, int half) { return d0 * 512 + ks * 4096 + half * 2048; }
__device__ __forceinline__ int crow(int r, int hi) { return (r & 3) + 8 * (r >> 2) + 4 * hi; }
__device__ __forceinline__ unsigned cvtpk(float lo, float hi) { unsigned r; asm volatile("v_cvt_pk_bf16_f32 %0, %1, %2" : "=v"(r) : "v"(lo), "v"(hi)); return r; }
__device__ __forceinline__ void qkt(f32x16& p0, f32x16& p1, const PG8_LAS char* kbuf, int r32, int hi, const bf16x8* qr) {
    p0 = f32x16{}; p1 = f32x16{};
    const PG8_LAS char* kb[4];
#pragma unroll
    for (int dd = 0; dd < 4; ++dd) kb[dd] = kbuf + KSWZ(r32, (dd * 16 + hi * 8) * 2);
#pragma unroll
    for (int d0 = 0; d0 < 8; ++d0) { const PG8_LAS char* a = kb[d0 & 3] + (d0 >> 2) * 128;
        const bf16x8 b0 = *(const PG8_LAS bf16x8*)(a);
        const bf16x8 b1 = *(const PG8_LAS bf16x8*)(a + 32 * 256);
        p0 = __builtin_amdgcn_mfma_f32_32x32x16_bf16(b0, qr[d0], p0, 0, 0, 0);
        p1 = __builtin_amdgcn_mfma_f32_32x32x16_bf16(b1, qr[d0], p1, 0, 0, 0); }
}
__device__ __forceinline__ void pv_tile(f32x16* o, int vb0, bf16x8 pa0, bf16x8 pa1, bf16x8 pa2, bf16x8 pa3) {
#define TRRD(dst, off) asm volatile("ds_read_b64_tr_b16 %0, %1 offset:%2" : "=&v"(dst) : "v"(vb0), "i"(off) : "memory")
#define PV_D0(d0) do { s16x4 l0, l1, l2, l3, h0, h1, h2, h3; constexpr int b_ = v_rd_off(d0, 0, 0); \
        TRRD(l0, b_); TRRD(h0, b_ + 2048); TRRD(l1, b_ + 4096); TRRD(h1, b_ + 6144); TRRD(l2, b_ + 8192); TRRD(h2, b_ + 10240); TRRD(l3, b_ + 12288); TRRD(h3, b_ + 14336); \
        asm volatile("s_waitcnt lgkmcnt(0)" ::: "memory"); SBAR(); \
        o[d0] = __builtin_amdgcn_mfma_f32_32x32x16_bf16(pa0, (bf16x8){l0[0], l0[1], l0[2], l0[3], h0[0], h0[1], h0[2], h0[3]}, o[d0], 0, 0, 0); \
        o[d0] = __builtin_amdgcn_mfma_f32_32x32x16_bf16(pa1, (bf16x8){l1[0], l1[1], l1[2], l1[3], h1[0], h1[1], h1[2], h1[3]}, o[d0], 0, 0, 0); \
        o[d0] = __builtin_amdgcn_mfma_f32_32x32x16_bf16(pa2, (bf16x8){l2[0], l2[1], l2[2], l2[3], h2[0], h2[1], h2[2], h2[3]}, o[d0], 0, 0, 0); \
        o[d0] = __builtin_amdgcn_mfma_f32_32x32x16_bf16(pa3, (bf16x8){l3[0], l3[1], l3[2], l3[3], h3[0], h3[1], h3[2], h3[3]}, o[d0], 0, 0, 0); } while (0)
    PV_D0(0); PV_D0(1); PV_D0(2); PV_D0(3);
#undef PV_D0
#undef TRRD
}
template <bool BAND>
__device__ __forceinline__ void attn_unit(PG8_LAS char* lds, const bf16_t* Q, size_t qs, const bf16_t* K, const bf16_t* V, size_t ks, int NT, int qpos0, int kpos0,
                                          bf16_t* Ob, size_t ostride, float* lse, int obase, int omul, int tid) {
    const int wid = __builtin_amdgcn_readfirstlane(tid >> 6), lane = tid & 63, r32 = lane & 31, hi = lane >> 5;
    PG8_LAS char* V_lds = lds + LDS_V; PG8_LAS char* K_lds = lds + LDS_K;
    PG8_LAS float* wsf = (PG8_LAS float*)(lds + LDS_WS) + wid * 64; const PG8_LAS float* bias = (const PG8_LAS float*)(lds + LDS_BIAS);
    const int sr = tid >> 4, sc = (tid & 15) * 8, vst0 = v_st(sr, sc), vst1 = v_st(32 + sr, sc), kws = KSWZ(sr, sc * 2);
    const int vbl = (int)(uintptr_t)V_lds + v_rd_base(lane);
    bf16x8 qr[8];
    { const bf16_t* qp = Q + (size_t)(wid * 32 + r32) * qs + hi * 8;
#pragma unroll
      for (int d0 = 0; d0 < 8; ++d0) qr[d0] = *(const bf16x8*)(qp + d0 * 16); }
    bf16x8 st_k0, st_k1, st_v0, st_v1;
#define SLOAD(t) do { const size_t ro_ = (size_t)((t) * KVBLK + sr) * ks + sc; st_k0 = *(const bf16x8*)(K + ro_); st_k1 = *(const bf16x8*)(K + ro_ + 32 * ks); st_v0 = *(const bf16x8*)(V + ro_); st_v1 = *(const bf16x8*)(V + ro_ + 32 * ks); } while (0)
#define SWRITE(bf) do { *(PG8_LAS bf16x8*)(K_lds + (bf) * SHM_K + kws) = st_k0; *(PG8_LAS bf16x8*)(K_lds + (bf) * SHM_K + kws + 32 * 256) = st_k1; \
                        *(PG8_LAS bf16x8*)(V_lds + (bf) * SHM_V + vst0) = st_v0; *(PG8_LAS bf16x8*)(V_lds + (bf) * SHM_V + vst1) = st_v1; } while (0)
    SLOAD(0); SWRITE(0);
    __syncthreads();
    float m_run = -1e30f, l_run = 0.f; f32x16 o[4] = {};
    const int qlo = qpos0 + wid * 32;
    for (int t = 0; t < NT; ++t) {
        const int buf = t & 1;
        if (t + 1 < NT) SLOAD(t + 1);
        const int kb = kpos0 + t * KVBLK;
        const bool act = !BAND || (kb <= qlo + 31 && kb + KVBLK - 1 >= qlo - 128);
        if (act) {
            f32x16 p0, p1;
            qkt(p0, p1, K_lds + buf * SHM_K, r32, hi, qr);
            if (BAND) {
                const int dq = qlo + r32 - kb - 4 * hi;
                const PG8_LAS float* bp = bias + (dq + BIAS_PAD - 59);
#pragma unroll
                for (int r = 0; r < 16; ++r) { const int cr = (r & 3) + 8 * (r >> 2);
                    const float b0 = bp[59 - cr], b1 = bp[59 - cr - 32];
                    p0[r] = ((unsigned)(dq - cr) <= 128u) ? fmaf(p0[r], C2, b0) : -INFINITY;
                    p1[r] = ((unsigned)(dq - cr - 32) <= 128u) ? fmaf(p1[r], C2, b1) : -INFINITY; }
            } else {
#pragma unroll
                for (int r = 0; r < 16; ++r) { p0[r] *= C2; p1[r] *= C2; }
            }
            float pmax = p0[0];
#pragma unroll
            for (int r = 1; r < 16; ++r) pmax = fmaxf(pmax, p0[r]);
#pragma unroll
            for (int r = 0; r < 16; ++r) pmax = fmaxf(pmax, p1[r]);
            { auto rr = __builtin_amdgcn_permlane32_swap(__float_as_uint(pmax), __float_as_uint(pmax), false, false); pmax = fmaxf(__uint_as_float(rr[0]), __uint_as_float(rr[1])); }
            const float mn = fmaxf(m_run, pmax), alpha = __builtin_amdgcn_exp2f(m_run - mn); m_run = mn;
            float ps = 0.f;
#pragma unroll
            for (int r = 0; r < 16; ++r) { p0[r] = __builtin_amdgcn_exp2f(p0[r] - mn); p1[r] = __builtin_amdgcn_exp2f(p1[r] - mn); ps += p0[r] + p1[r]; }
            { auto rr = __builtin_amdgcn_permlane32_swap(__float_as_uint(ps), __float_as_uint(ps), false, false); ps = __uint_as_float(rr[0]) + __uint_as_float(rr[1]); }
            l_run = l_run * alpha + ps;
            if (__any(alpha < 1.f)) { if (hi == 0) wsf[r32] = alpha; asm volatile("s_waitcnt lgkmcnt(0)" ::: "memory");
#pragma unroll
                for (int r = 0; r < 16; ++r) { const float a = wsf[crow(r, hi)];
#pragma unroll
                    for (int d_ = 0; d_ < 4; ++d_) o[d_][r] *= a; }
                asm volatile("s_waitcnt lgkmcnt(0)" ::: "memory"); }
            bf16x8 pa0, pa1, pa2, pa3;
#define PK4(P, B_, OUT) do { unsigned a0 = cvtpk(P[B_ + 0], P[B_ + 1]), a1 = cvtpk(P[B_ + 2], P[B_ + 3]); unsigned b0 = cvtpk(P[B_ + 4], P[B_ + 5]), b1 = cvtpk(P[B_ + 6], P[B_ + 7]); \
        auto r0 = __builtin_amdgcn_permlane32_swap(a0, b0, false, false); auto r1 = __builtin_amdgcn_permlane32_swap(a1, b1, false, false); \
        u32x4 w = {r0[0], r1[0], r0[1], r1[1]}; OUT = *reinterpret_cast<bf16x8*>(&w); } while (0)
            PK4(p0, 0, pa0); PK4(p0, 8, pa1); PK4(p1, 0, pa2); PK4(p1, 8, pa3);
#undef PK4
            SBAR();
            pv_tile(o, vbl + buf * SHM_V, pa0, pa1, pa2, pa3);
        }
        if (t + 1 < NT) SWRITE(buf ^ 1);
        __syncthreads();
    }
#undef SLOAD
#undef SWRITE
    if (hi == 0) wsf[r32] = l_run; asm volatile("s_waitcnt lgkmcnt(0)" ::: "memory");
    float rli[16];
#pragma unroll
    for (int r = 0; r < 16; ++r) rli[r] = __builtin_amdgcn_rcpf(wsf[crow(r, hi)]);
#pragma unroll
    for (int r = 0; r < 16; ++r) { const int row = wid * 32 + crow(r, hi); bf16_t* op = Ob + (size_t)(obase + row * omul) * ostride;
#pragma unroll
        for (int d0 = 0; d0 < 4; ++d0) { const float v = o[d0][r] * rli[r]; const float vn = __shfl_xor(v, 1);
            if ((r32 & 1) == 0) *(unsigned*)(op + d0 * 32 + r32) = cvtpk(v, vn); } }
    if (BAND) { if (hi == 0) lse[(size_t)(obase + (wid * 32 + r32) * omul) * 4] = (m_run + __log2f(l_run)) * LN2; }
    __syncthreads();
}
#undef KSWZ
#undef SBAR

__device__ __forceinline__ void attn_phase(const Ctx& c, int half, PG8_LAS unsigned char* lds_u, int tid, int bid, int nblk) {
    asm volatile("" : "+v"(tid));
    PG8_LAS char* lds = (PG8_LAS char*)lds_u;
    constexpr int QB = S / 256, NUA = BH * 3 * 4 * QB, NUC = BH * 4 * QB, NU = NUA + NUC;
    const bf16_t* P = wsp<bf16_t>(c, OFF_P);
    for (int u = bid; u < NU; u += nblk) {
        if (u < NUA) {
            const int j = u % QB, h = (u / QB) & 3, g = (u / (QB * 4)) % 3, bl = u / (QB * 12);
            const int r = dil_of(g), L = S / r, nqb = L / 256, cc = j / nqb, qb = j % nqb, q0 = qb * 256, base = bl * S + cc * L;
            { PG8_LAS float* bt = (PG8_LAS float*)(lds + LDS_BIAS); const float* bsrc = wsp<float>(c, OFF_SMALL) + SM_BIAS + (g * 4 + h) * 129;
              for (int i = tid; i < BIAS_N; i += 512) { const int uu = i - BIAS_PAD; bt[i] = (uu >= 0 && uu <= 128) ? bsrc[uu] * LOG2E : 0.f; } }
            const int klo = q0 >= 128 ? q0 - 128 : 0, NT = (q0 + 256 - klo) / 64;
            const bf16_t* Qp = P + (size_t)(base + q0) * NP + g * 1536 + h * 128; const bf16_t* Kp = P + (size_t)(base + klo) * NP + g * 1536 + 512 + h * 128;
            attn_unit<true>(lds, Qp, NP, Kp, Kp + 512, NP, NT, q0, klo, wsp<bf16_t>(c, OFF_PART) + (size_t)g * TH * WA + h * 128, WA, wsp<float>(c, OFF_LSE) + (size_t)g * TH * 4 + h,
                            bl * S + q0 * r + cc, r, tid);
        } else {
            const int v = u - NUA, j = v % QB, h = (v / QB) & 3, bl = v / (QB * 4), b = half * BH + bl, tl0 = bl * S + j * 256;
            const bf16_t* Qp = P + (size_t)tl0 * NP + COLS_A + COLS_B + h * 128; const bf16_t* Kp = wsp<bf16_t>(c, OFF_MEMKV) + (size_t)b * MEM * 1024 + h * 128;
            attn_unit<false>(lds, Qp, NP, Kp, Kp + 512, 1024, MEM / 64, 0, 0, (bf16_t*)c.out + (size_t)half * TH * OW + WA + WB + h * 128, OW, nullptr, tl0, 1, tid);
        }
    }
}
}
namespace rowops {
typedef float f32x4 __attribute__((ext_vector_type(4)));
typedef unsigned u32x2 __attribute__((ext_vector_type(2)));
typedef unsigned u32x4 __attribute__((ext_vector_type(4)));
__device__ __forceinline__ float wave_sum(float v) {
#pragma unroll
    for (int o = 1; o < 64; o <<= 1) v += __shfl_xor(v, o);
    return v;
}
__device__ __forceinline__ unsigned pk2(float lo, float hi) { return pg8::cvt_pk_bf16(lo, hi); }

__device__ __forceinline__ void ln1_router_phase(const Ctx& c, PG8_LAS unsigned char* lds, int tid, int bid, int nblk) {
    asm volatile("" : "+v"(tid));
    PG8_LAS int* lh = (PG8_LAS int*)lds; PG8_LAS int* asg = lh + 64;
    if (tid < 64) lh[tid] = 0;
    __syncthreads();
    int nrow = 0;
    const int lane = tid & 63, wid = tid >> 6, gw = bid * 8 + wid, NGW = nblk * 8;
    float* H1 = wsp<float>(c, OFF_H1); bf16_t* X1B = wsp<bf16_t>(c, OFF_X1B);
    unsigned* cnt = wsp<unsigned>(c, OFF_CTL) + CW_CNT; int* list = wsp<int>(c, OFF_LIST); float* rw = wsp<float>(c, OFF_RW);
    static_assert(T / (256 * 8) <= 16, "rows per wave");
    f32x4 gv[4], bv[4];
#pragma unroll
    for (int j = 0; j < 4; ++j) { gv[j] = *(const f32x4*)(c.ln1_g + 4 * lane + 256 * j); bv[j] = *(const f32x4*)(c.ln1_b + 4 * lane + 256 * j); }
    for (int row = gw; row < T; row += NGW) {
        f32x4* hp = (f32x4*)(H1 + (size_t)row * D) + lane; f32x4 v[4]; float s = 0.f;
#pragma unroll
        for (int j = 0; j < 4; ++j) { v[j] = hp[64 * j]; s += (v[j][0] + v[j][1]) + (v[j][2] + v[j][3]); }
        const float mean = wave_sum(s) * (1.f / D); float s2 = 0.f;
#pragma unroll
        for (int j = 0; j < 4; ++j) { v[j] = v[j] - mean; s2 += (v[j][0] * v[j][0] + v[j][1] * v[j][1]) + (v[j][2] * v[j][2] + v[j][3] * v[j][3]); }
        const float rstd = 1.f / sqrtf(wave_sum(s2) * (1.f / D) + LN_EPS);
        float gl[4] = {0.f, 0.f, 0.f, 0.f};
#pragma unroll
        for (int j = 0; j < 4; ++j) { v[j] = v[j] * rstd * gv[j] + bv[j]; hp[64 * j] = v[j];
            u32x2 w; w.x = pk2(v[j][0], v[j][1]); w.y = pk2(v[j][2], v[j][3]); *((u32x2*)(X1B + (size_t)row * D) + lane + 64 * j) = w;
#pragma unroll
            for (int e = 0; e < 4; ++e) { const f32x4 wg = *(const f32x4*)(c.w_rg + (size_t)(4 * lane + 256 * j + e) * 4); gl[0] += v[j][e] * wg[0]; gl[1] += v[j][e] * wg[1]; gl[2] += v[j][e] * wg[2]; gl[3] += v[j][e] * wg[3]; } }
#pragma unroll
        for (int g = 0; g < 4; ++g) gl[g] = wave_sum(gl[g]) + c.b_rg[g];
        int gs = 0; float gm = gl[0];
#pragma unroll
        for (int g = 1; g < 4; ++g) if (gl[g] > gm) { gm = gl[g]; gs = g; }
        const float gp = 1.f / (__expf(gl[0] - gm) + __expf(gl[1] - gm) + __expf(gl[2] - gm) + __expf(gl[3] - gm));
        float el[8] = {0.f, 0.f, 0.f, 0.f, 0.f, 0.f, 0.f, 0.f};
#pragma unroll
        for (int j = 0; j < 4; ++j)
#pragma unroll
            for (int e = 0; e < 4; ++e) { const float* wp = c.w_re + (size_t)(4 * lane + 256 * j + e) * 32 + gs * 8; const f32x4 wa = *(const f32x4*)wp, wb = *(const f32x4*)(wp + 4);
                el[0] += v[j][e] * wa[0]; el[1] += v[j][e] * wa[1]; el[2] += v[j][e] * wa[2]; el[3] += v[j][e] * wa[3]; el[4] += v[j][e] * wb[0]; el[5] += v[j][e] * wb[1]; el[6] += v[j][e] * wb[2]; el[7] += v[j][e] * wb[3]; }
        float v0 = -INFINITY, v1 = -INFINITY; int i0 = 0, i1 = 0;
#pragma unroll
        for (int j = 0; j < 8; ++j) { const float x = wave_sum(el[j]) + c.b_re[gs * 8 + j];
            if (x > v0) { v1 = v0; i1 = i0; v0 = x; i0 = j; } else if (x > v1) { v1 = x; i1 = j; } }
        if (lane == 0) { const float e1 = __expf(v1 - v0), w0 = gp / (1.f + e1), w1 = gp * e1 / (1.f + e1); const int ea = gs * 8 + i0, eb = gs * 8 + i1;
            const int ra = __hip_atomic_fetch_add(lh + ea, 1, __ATOMIC_RELAXED, __HIP_MEMORY_SCOPE_WORKGROUP), rb = __hip_atomic_fetch_add(lh + eb, 1, __ATOMIC_RELAXED, __HIP_MEMORY_SCOPE_WORKGROUP);
            PG8_LAS int* a = asg + (wid * 16 + nrow) * 4; a[0] = row; a[1] = ea | (ra << 8); a[2] = eb | (rb << 8);
            rw[row * 2] = w0; rw[row * 2 + 1] = w1; }
        ++nrow;
    }
    __syncthreads();
    if (tid < 32) lh[32 + tid] = (int)atomicAdd(cnt + tid, (unsigned)lh[tid]);
    __syncthreads();
    if (lane < nrow) { const PG8_LAS int* a = asg + (wid * 16 + lane) * 4; const int row = a[0], xa = a[1], xb = a[2];
        list[(size_t)(xa & 255) * T + lh[32 + (xa & 255)] + (xa >> 8)] = row * 2; list[(size_t)(xb & 255) * T + lh[32 + (xb & 255)] + (xb >> 8)] = row * 2 + 1; }
    __syncthreads();
}
__device__ __forceinline__ void ln2_phase(const Ctx& c, int tid, int bid, int nblk) {
    asm volatile("" : "+v"(tid));
    const int lane = tid & 63, wid = tid >> 6, gw = bid * 8 + wid, NGW = nblk * 8;
    const float* X1 = wsp<float>(c, OFF_H1); const bf16_t* Y0 = wsp<bf16_t>(c, OFF_Y0); const bf16_t* Y1 = wsp<bf16_t>(c, OFF_Y1); const float* rw = wsp<float>(c, OFF_RW);
    f32x4 gv[4], bv[4];
#pragma unroll
    for (int j = 0; j < 4; ++j) { gv[j] = *(const f32x4*)(c.ln2_g + 4 * lane + 256 * j); bv[j] = *(const f32x4*)(c.ln2_b + 4 * lane + 256 * j); }
    for (int row = gw; row < T; row += NGW) {
        const f32x4* xp = (const f32x4*)(X1 + (size_t)row * D) + lane; const u32x2* y0p = (const u32x2*)(Y0 + (size_t)row * D) + lane; const u32x2* y1p = (const u32x2*)(Y1 + (size_t)row * D) + lane;
        const float w0 = rw[row * 2], w1 = rw[row * 2 + 1]; f32x4 v[4]; float s = 0.f;
#pragma unroll
        for (int j = 0; j < 4; ++j) { const f32x4 x = xp[64 * j]; const u32x2 a = y0p[64 * j], b = y1p[64 * j];
            v[j][0] = DN_ALPHA * x[0] + w0 * bflo(a.x) + w1 * bflo(b.x); v[j][1] = DN_ALPHA * x[1] + w0 * bfhi(a.x) + w1 * bfhi(b.x);
            v[j][2] = DN_ALPHA * x[2] + w0 * bflo(a.y) + w1 * bflo(b.y); v[j][3] = DN_ALPHA * x[3] + w0 * bfhi(a.y) + w1 * bfhi(b.y);
            s += (v[j][0] + v[j][1]) + (v[j][2] + v[j][3]); }
        const float mean = wave_sum(s) * (1.f / D); float s2 = 0.f;
#pragma unroll
        for (int j = 0; j < 4; ++j) { v[j] = v[j] - mean; s2 += (v[j][0] * v[j][0] + v[j][1] * v[j][1]) + (v[j][2] * v[j][2] + v[j][3] * v[j][3]); }
        const float rstd = 1.f / sqrtf(wave_sum(s2) * (1.f / D) + LN_EPS);
        f32x4* op = (f32x4*)(c.out + (size_t)row * D) + lane;
#pragma unroll
        for (int j = 0; j < 4; ++j) op[64 * j] = v[j] * rstd * gv[j] + bv[j];
    }
}
__device__ __forceinline__ void transpose_item(const float* W, int N, bf16_t* Wt, size_t ldo, PG8_LAS float* scr, int k0, int n0, int lane) {
#pragma unroll 8
    for (int i = 0; i < 32; ++i) { const int kk = 2 * i + (lane >> 5); scr[kk * 33 + (lane & 31)] = W[(size_t)(k0 + kk) * N + n0 + (lane & 31)]; }
    asm volatile("s_waitcnt lgkmcnt(0)" ::: "memory");
    const int ch = lane & 7;
#pragma unroll
    for (int j = 0; j < 4; ++j) { const int n = (lane >> 3) + 8 * j; const PG8_LAS float* s = scr + (8 * ch) * 33 + n;
        u32x4 o; o.x = pk2(s[0 * 33], s[1 * 33]); o.y = pk2(s[2 * 33], s[3 * 33]); o.z = pk2(s[4 * 33], s[5 * 33]); o.w = pk2(s[6 * 33], s[7 * 33]);
        *(u32x4*)(Wt + (size_t)n * ldo + k0 + 8 * ch) = o; }
    asm volatile("s_waitcnt lgkmcnt(0)" ::: "memory");
}
__device__ __forceinline__ void cvt_copy(const float* src, bf16_t* dst, long n, int tid, int bid, int nblk) {
    const long n8 = n / 8;
    for (long i = (long)bid * 512 + tid; i < n8; i += (long)nblk * 512) { const f32x4 a = *(const f32x4*)(src + i * 8), b = *(const f32x4*)(src + i * 8 + 4);
        u32x4 o; o.x = pk2(a[0], a[1]); o.y = pk2(a[2], a[3]); o.z = pk2(b[0], b[1]); o.w = pk2(b[2], b[3]); *(u32x4*)(dst + i * 8) = o; }
}
__device__ __forceinline__ void prologue_phase(const Ctx& c, PG8_LAS unsigned char* lds, int tid, int bid, int nblk) {
    asm volatile("" : "+v"(tid));
    const int lane = tid & 63, wid = tid >> 6, gw = bid * 8 + wid, NGW = nblk * 8;
    PG8_LAS float* scr = (PG8_LAS float*)(lds + wid * 16384);
    constexpr int I_IN = (D / 64) * (N_IN / 32), I_KV = (D / 64) * (1024 / 32), I_A = (WA / 64) * (D / 32), I_B = (WB / 64) * (D / 32), I_C = (WC / 64) * (D / 32), I_O = (D / 64) * (D / 32);
    constexpr int NIT = I_IN + I_KV + I_A + I_B + I_C + I_O;
    for (int it = gw; it < NIT; it += NGW) { int r = it;
        if (r < I_IN) { const int nb = N_IN / 32; transpose_item(c.w_in, N_IN, wsp<bf16_t>(c, WT_IN) + (size_t)(r % nb) * 32 * D, D, scr, (r / nb) * 64, (r % nb) * 32, lane); continue; } r -= I_IN;
        if (r < I_KV) { const int nb = 1024 / 32; transpose_item(c.w_kv, 1024, wsp<bf16_t>(c, WT_KV) + (size_t)(r % nb) * 32 * D, D, scr, (r / nb) * 64, (r % nb) * 32, lane); continue; } r -= I_KV;
        if (r < I_A) { const int nb = D / 32; transpose_item(c.w_a, D, wsp<bf16_t>(c, WT_A) + (size_t)(r % nb) * 32 * OW, OW, scr, (r / nb) * 64, (r % nb) * 32, lane); continue; } r -= I_A;
        if (r < I_B) { const int nb = D / 32; transpose_item(c.w_b, D, wsp<bf16_t>(c, WT_A) + WA + (size_t)(r % nb) * 32 * OW, OW, scr, (r / nb) * 64, (r % nb) * 32, lane); continue; } r -= I_B;
        if (r < I_C) { const int nb = D / 32; transpose_item(c.w_c, D, wsp<bf16_t>(c, WT_A) + WA + WB + (size_t)(r % nb) * 32 * OW, OW, scr, (r / nb) * 64, (r % nb) * 32, lane); continue; } r -= I_C;
        { const int nb = D / 32; transpose_item(c.w_out, D, wsp<bf16_t>(c, WT_OUT) + (size_t)(r % nb) * 32 * D, D, scr, (r / nb) * 64, (r % nb) * 32, lane); }
    }
    cvt_copy(c.x, wsp<bf16_t>(c, OFF_XB), (long)T * D, tid, bid, nblk);
    cvt_copy(c.mem, wsp<bf16_t>(c, OFF_MEMB), (long)NBATCH * MEM * D, tid, bid, nblk);
}
__device__ __forceinline__ void expert_weights_phase(const Ctx& c, PG8_LAS unsigned char* lds, int tid, int bid, int nblk) {
    asm volatile("" : "+v"(tid));
    const int lane = tid & 63, wid = tid >> 6, gw = bid * 8 + wid, NGW = nblk * 8;
    PG8_LAS float* scr = (PG8_LAS float*)(lds + wid * 16384);
    constexpr int I_G = (D / 64) * (DE / 32), I_D = (DE / 64) * (D / 32), PER_E = 2 * I_G + I_D;
    for (int it = gw; it < NE * PER_E; it += NGW) { const int e = it / PER_E; int r = it % PER_E;
        if (r < 2 * I_G) { const int up = r / I_G; r %= I_G; const int nb = DE / 32, n0 = (r % nb) * 32, k0 = (r / nb) * 64; const float* src = (up ? c.w_eu : c.w_eg) + (size_t)e * D * DE;
            transpose_item(src, DE, wsp<bf16_t>(c, OFF_WTGU) + ((size_t)e * 2 * DE + (n0 / 128) * 256 + up * 128 + n0 % 128) * D, D, scr, k0, n0, lane); }
        else { r -= 2 * I_G; const int nb = D / 32, n0 = (r % nb) * 32, k0 = (r / nb) * 64;
            transpose_item(c.w_ed + (size_t)e * DE * D, D, wsp<bf16_t>(c, OFF_WTDN) + ((size_t)e * D + n0) * DE, DE, scr, k0, n0, lane); }
    }
}
}
namespace hgrn {
typedef float f32x4 __attribute__((ext_vector_type(4)));
typedef unsigned u32x2 __attribute__((ext_vector_type(2)));
typedef unsigned u32x4 __attribute__((ext_vector_type(4)));
constexpr int QS = 272, SS = 144;
constexpr int L_QE = 0, L_KE = L_QE + 64 * QS, L_KDT = L_KE + 64 * QS, L_VT = L_KDT + 128 * SS, L_PM = L_VT + 128 * SS, L_ST = L_PM + 64 * SS, L_F32 = L_ST + 128 * QS;
constexpr int F_QTOT = 0, F_DL = 512, F_ER = 640, F_SSQ = 768, L_END = L_F32 + (768 + 512) * 4;
static_assert(L_END <= 131072, "hgrn LDS");
__device__ __forceinline__ float fexp(float x) { return __expf(fminf(fmaxf(x, -80.f), 80.f)); }
__device__ __forceinline__ bf16x8 ldfrag(const PG8_LAS char* mat, int stride, int row, int ks, int lq) { return *(const PG8_LAS bf16x8*)(mat + row * stride + ks * 64 + lq * 16); }

template <bool FULL>
__device__ __forceinline__ void hg_unit(const Ctx& c, int half, int bl, int h, int seg, PG8_LAS char* lds, int tid) {
    const int wid = __builtin_amdgcn_readfirstlane(tid >> 6), lane = tid & 63, l15 = lane & 15, lq = lane >> 4;
    const int ek = tid & 127, etq = tid >> 7;
    const int sr = tid >> 4, sc = (tid & 15) * 8;
    const int bhl = bl * HB + h;
    const bf16_t* P = wsp<bf16_t>(c, OFF_P);
    PG8_LAS float* F = (PG8_LAS float*)(lds + L_F32);
    const float lbk = wsp<float>(c, OFF_SMALL)[SM_LB + h * 128 + ek];
    float* Shat = wsp<float>(c, OFF_HG) + ((size_t)bhl * NSEG + seg) * 128 * 128;
    const int vcol = wid * 16 + l15;
    f32x4 Sacc[8];
#pragma unroll
    for (int kt = 0; kt < 8; ++kt) {
        if (FULL) {
#pragma unroll
            for (int i = 0; i < 4; ++i) Sacc[kt][i] = Shat[(size_t)(kt * 16 + lq * 4 + i) * 128 + vcol];
        } else Sacc[kt] = (f32x4){0.f, 0.f, 0.f, 0.f};
    }
    float dsum = 0.f;
    for (int ch = 0; ch < 4; ++ch) {
        int row0 = bl * S + seg * 256 + ch * 64;
        asm volatile("" : "+s"(row0));
        float lf[16], kf[16];
        { const bf16_t* fp = P + (size_t)(row0 + etq * 16) * NP + COLS_A + WB + h * 128 + ek; float run = 0.f;
#pragma unroll
          for (int j = 0; j < 16; ++j) { const float f = lbk + (1.f - lbk) * pg8::fsigmoid(bf2f(fp[(size_t)j * NP])); run += __logf(f); lf[j] = run; kf[j] = 1.f - f; }
          F[F_QTOT + etq * 128 + ek] = run; }
        { const bf16_t* vp = P + (size_t)(row0 + sr) * NP + COLS_A + 2 * WB + h * 128 + sc; const bf16x8 v0 = *(const bf16x8*)vp, v1 = *(const bf16x8*)(vp + (size_t)32 * NP);
#pragma unroll
          for (int j = 0; j < 8; ++j) { *(PG8_LAS short*)(lds + L_VT + (sc + j) * SS + sr * 2) = v0[j]; *(PG8_LAS short*)(lds + L_VT + (sc + j) * SS + (sr + 32) * 2) = v1[j]; } }
        __syncthreads();
        { const float q0 = F[F_QTOT + ek], q1 = F[F_QTOT + 128 + ek], q2 = F[F_QTOT + 256 + ek], q3 = F[F_QTOT + 384 + ek];
          const float blast = (q0 + q1) + (q2 + q3), off = etq == 0 ? 0.f : (etq == 1 ? q0 : (etq == 2 ? q0 + q1 : (q0 + q1) + q2)), r = 0.5f * blast;
          if (etq == 0) { F[F_DL + ek] = fexp(blast); F[F_ER + ek] = fexp(r); dsum += blast; }
          unsigned kd[8];
          const bf16_t* qp = P + (size_t)(row0 + etq * 16) * NP + COLS_A + h * 128 + ek;
#pragma unroll
          for (int j = 0; j < 16; ++j) { const float b = off + lf[j];
              const float kdv = kf[j] * fexp(blast - b);
              if (j & 1) kd[j >> 1] |= (unsigned)f2bf(kdv) << 16; else kd[j >> 1] = (unsigned)f2bf(kdv);
              if (FULL) { const float qr = bf2f(qp[(size_t)j * NP]); const float qs = qr * pg8::fsigmoid(qr);
                  *(PG8_LAS bf16_t*)(lds + L_QE + (etq * 16 + j) * QS + ek * 2) = f2bf(qs * fexp(b - r));
                  *(PG8_LAS bf16_t*)(lds + L_KE + (etq * 16 + j) * QS + ek * 2) = f2bf(kf[j] * fexp(r - b)); } }
          *(PG8_LAS u32x4*)(lds + L_KDT + ek * SS + etq * 32) = (u32x4){kd[0], kd[1], kd[2], kd[3]};
          *(PG8_LAS u32x4*)(lds + L_KDT + ek * SS + etq * 32 + 16) = (u32x4){kd[4], kd[5], kd[6], kd[7]}; }
        __syncthreads();
        f32x4 oacc[4];
        unsigned short graw[16];
        if (FULL) {
#pragma unroll
            for (int kt = 0; kt < 8; ++kt) { const f32x4 er = *(const PG8_LAS f32x4*)(F + F_ER + kt * 16 + lq * 4);
                u32x2 w; w.x = pg8::cvt_pk_bf16(Sacc[kt][0] * er[0], Sacc[kt][1] * er[1]); w.y = pg8::cvt_pk_bf16(Sacc[kt][2] * er[2], Sacc[kt][3] * er[3]);
                *(PG8_LAS u32x2*)(lds + L_ST + vcol * QS + (kt * 16 + lq * 4) * 2) = w; }
            { const int tt = wid & 3;
#pragma unroll
              for (int sti = 0; sti < 2; ++sti) { const int st = 2 * (wid >> 2) + sti; f32x4 a = (f32x4){0.f, 0.f, 0.f, 0.f};
#pragma unroll
                  for (int ks = 0; ks < 4; ++ks) a = __builtin_amdgcn_mfma_f32_16x16x32_bf16(ldfrag(lds + L_KE, QS, st * 16 + l15, ks, lq), ldfrag(lds + L_QE, QS, tt * 16 + l15, ks, lq), a, 0, 0, 0);
                  const int t = tt * 16 + l15, s0 = st * 16 + lq * 4;
                  u32x2 w; w.x = pg8::cvt_pk_bf16(s0 <= t ? a[0] : 0.f, s0 + 1 <= t ? a[1] : 0.f); w.y = pg8::cvt_pk_bf16(s0 + 2 <= t ? a[2] : 0.f, s0 + 3 <= t ? a[3] : 0.f);
                  *(PG8_LAS u32x2*)(lds + L_PM + t * SS + s0 * 2) = w; } }
            { const bf16_t* gp = P + (size_t)(row0 + lq * 4) * NP + COLS_A + 3 * WB + h * 128 + vcol;
#pragma unroll
              for (int mt = 0; mt < 4; ++mt)
#pragma unroll
                  for (int i = 0; i < 4; ++i) graw[mt * 4 + i] = gp[(size_t)(mt * 16 + i) * NP]; }
            __syncthreads();
        }
        const bf16x8 vb0 = ldfrag(lds + L_VT, SS, vcol, 0, lq), vb1 = ldfrag(lds + L_VT, SS, vcol, 1, lq);
        if (FULL) {
            bf16x8 sb[4];
#pragma unroll
            for (int ks = 0; ks < 4; ++ks) sb[ks] = ldfrag(lds + L_ST, QS, vcol, ks, lq);
#pragma unroll
            for (int mt = 0; mt < 4; ++mt) { f32x4 a = (f32x4){0.f, 0.f, 0.f, 0.f};
#pragma unroll
                for (int ks = 0; ks < 4; ++ks) a = __builtin_amdgcn_mfma_f32_16x16x32_bf16(ldfrag(lds + L_QE, QS, mt * 16 + l15, ks, lq), sb[ks], a, 0, 0, 0);
                a = __builtin_amdgcn_mfma_f32_16x16x32_bf16(ldfrag(lds + L_PM, SS, mt * 16 + l15, 0, lq), vb0, a, 0, 0, 0);
                a = __builtin_amdgcn_mfma_f32_16x16x32_bf16(ldfrag(lds + L_PM, SS, mt * 16 + l15, 1, lq), vb1, a, 0, 0, 0);
                oacc[mt] = a; }
        }
#pragma unroll
        for (int kt = 0; kt < 8; ++kt) { const f32x4 dl = *(const PG8_LAS f32x4*)(F + F_DL + kt * 16 + lq * 4); f32x4 a = Sacc[kt] * dl;
            a = __builtin_amdgcn_mfma_f32_16x16x32_bf16(ldfrag(lds + L_KDT, SS, kt * 16 + l15, 0, lq), vb0, a, 0, 0, 0);
            a = __builtin_amdgcn_mfma_f32_16x16x32_bf16(ldfrag(lds + L_KDT, SS, kt * 16 + l15, 1, lq), vb1, a, 0, 0, 0);
            Sacc[kt] = a; }
        if (FULL) {
#pragma unroll
            for (int mt = 0; mt < 4; ++mt)
#pragma unroll
                for (int i = 0; i < 4; ++i) { float q = oacc[mt][i] * oacc[mt][i]; q += __shfl_xor(q, 1); q += __shfl_xor(q, 2); q += __shfl_xor(q, 4); q += __shfl_xor(q, 8);
                    if (l15 == 0) F[F_SSQ + (mt * 16 + lq * 4 + i) * 8 + wid] = q; }
            __syncthreads();
            const float ng = c.norm_g[h * 128 + vcol];
            bf16_t* op = (bf16_t*)c.out + ((size_t)half * TH + row0 + lq * 4) * OW + WA + h * 128 + vcol;
#pragma unroll
            for (int mt = 0; mt < 4; ++mt)
#pragma unroll
                for (int i = 0; i < 4; ++i) { const PG8_LAS f32x4* sp = (const PG8_LAS f32x4*)(F + F_SSQ + (mt * 16 + lq * 4 + i) * 8); const f32x4 s0 = sp[0], s1 = sp[1];
                    const float ss = ((s0[0] + s0[1]) + (s0[2] + s0[3])) + ((s1[0] + s1[1]) + (s1[2] + s1[3])); const float rs = 1.f / sqrtf(ss * (1.f / 128.f) + RMS_EPS);
                    const float g = bf2f(graw[mt * 4 + i]);
                    op[(size_t)(mt * 16 + i) * OW] = f2bf(oacc[mt][i] * rs * ng * (g * pg8::fsigmoid(g))); }
        }
        __syncthreads();
    }
    if (!FULL) {
#pragma unroll
        for (int kt = 0; kt < 8; ++kt)
#pragma unroll
            for (int i = 0; i < 4; ++i) Shat[(size_t)(kt * 16 + lq * 4 + i) * 128 + vcol] = Sacc[kt][i];
        if (etq == 0) wsp<float>(c, OFF_DSEG)[((size_t)bhl * NSEG + seg) * 128 + ek] = dsum;
    }
}
template <bool FULL>
__device__ __forceinline__ void hg_phase(const Ctx& c, int half, PG8_LAS unsigned char* lds_u, int tid, int bid, int nblk) {
    asm volatile("" : "+v"(tid));
    PG8_LAS char* lds = (PG8_LAS char*)lds_u;
    constexpr int NU = BH * HB * NSEG;
    for (int u = bid; u < NU; u += nblk) { const int seg = u % NSEG, bhl = u / NSEG; hg_unit<FULL>(c, half, bhl / HB, bhl % HB, seg, lds, tid); }
}
__device__ __forceinline__ void hg_scan_phase(const Ctx& c, int tid, int bid, int nblk) {
    asm volatile("" : "+v"(tid));
    constexpr long N = (long)BH * HB * 128 * 128;
    for (long idx = (long)bid * 512 + tid; idx < N; idx += (long)nblk * 512) { const int v = (int)(idx & 127), k = (int)((idx >> 7) & 127), bhl = (int)(idx >> 14);
        float* sp = wsp<float>(c, OFF_HG) + ((size_t)bhl * NSEG * 128 + k) * 128 + v; const float* dp = wsp<float>(c, OFF_DSEG) + (size_t)bhl * NSEG * 128 + k;
        float tmp[NSEG], dd[NSEG];
#pragma unroll
        for (int sg = 0; sg < NSEG; ++sg) { tmp[sg] = sp[(size_t)sg * 128 * 128]; dd[sg] = dp[sg * 128]; }
        float run = 0.f;
#pragma unroll
        for (int sg = 0; sg < NSEG; ++sg) { const float t = tmp[sg]; tmp[sg] = run; run = __expf(dd[sg]) * run + t; }
#pragma unroll
        for (int sg = 0; sg < NSEG; ++sg) sp[(size_t)sg * 128 * 128] = tmp[sg];
    }
}
__device__ __forceinline__ void comb_phase(const Ctx& c, int half, int tid, int bid, int nblk) {
    asm volatile("" : "+v"(tid));
    constexpr long N = (long)TH * WA / 8; const float* lse = wsp<float>(c, OFF_LSE); const bf16_t* part = wsp<bf16_t>(c, OFF_PART);
    for (long idx = (long)bid * 512 + tid; idx < N; idx += (long)nblk * 512) { const int c8 = (int)(idx % (WA / 8)), tl = (int)(idx / (WA / 8)), col = c8 * 8, h = col >> 7;
        const float l0 = lse[((size_t)0 * TH + tl) * 4 + h], l1 = lse[((size_t)1 * TH + tl) * 4 + h], l2 = lse[((size_t)2 * TH + tl) * 4 + h];
        const float mx = fmaxf(l0, fmaxf(l1, l2)), e0 = __expf(l0 - mx), e1 = __expf(l1 - mx), e2 = __expf(l2 - mx), inv = 1.f / (e0 + e1 + e2), w0 = e0 * inv, w1 = e1 * inv, w2 = e2 * inv;
        f32x4 a0, a1, b0, b1, c0, c1;
        pg8::unpack8(*(const u32x4*)(part + ((size_t)0 * TH + tl) * WA + col), a0, a1); pg8::unpack8(*(const u32x4*)(part + ((size_t)1 * TH + tl) * WA + col), b0, b1); pg8::unpack8(*(const u32x4*)(part + ((size_t)2 * TH + tl) * WA + col), c0, c1);
        *(u32x4*)((bf16_t*)c.out + ((size_t)half * TH + tl) * OW + col) = pg8::pack8(a0 * w0 + b0 * w1 + c0 * w2, a1 * w0 + b1 * w1 + c1 * w2); }
}
}
#define XB_TMO      128
#define XB_XCNT(j)  (256  + 64 * (j))
#define XB_XSUB(j)  (1280 + 64 * (j))
#define XB_XGEN(j)  (2304 + 64 * (j))
#define XB_TOP      3328
#define XB_TOPGEN   3392
#define XCD_BAR_WORDS 3456
#define XB_SPIN_CAP (1u << 18)
__device__ __forceinline__ unsigned xb_ld(unsigned* p)              { return __hip_atomic_load(p, __ATOMIC_RELAXED, __HIP_MEMORY_SCOPE_AGENT); }
__device__ __forceinline__ unsigned xb_add(unsigned* p, unsigned v) { return __hip_atomic_fetch_add(p, v, __ATOMIC_RELAXED, __HIP_MEMORY_SCOPE_AGENT); }
__device__ __forceinline__ unsigned xb_xcc_id() { return (unsigned)__builtin_amdgcn_s_getreg((3 << 11) | 20) & 0xFu; }
#define XB_SPIN(cond, bar) do { unsigned _sp = 0; while (cond) { __builtin_amdgcn_s_sleep(1); \
    if ((++_sp & 255u) == 0u) { if (xb_ld(&(bar)[XB_TMO])) break; if (_sp > XB_SPIN_CAP) { atomicAdd(&(bar)[XB_TMO], 1u); break; } } } } while (0)
struct XcdBarrier { unsigned* bar; unsigned x; volatile PG8_LAS unsigned* st; };
__device__ __forceinline__ XcdBarrier xcd_barrier_post(unsigned* bar, volatile PG8_LAS unsigned* st, int tid) {
    XcdBarrier b; b.bar = bar; b.x = xb_xcc_id(); b.st = st;
    if (tid == 0) (void)xb_add(&bar[XB_XCNT(b.x)], 1u);
    return b;
}
__device__ __forceinline__ void xcd_barrier_complete(unsigned* bar, unsigned x, unsigned& nloc, unsigned& nx) {
    const unsigned G = gridDim.x * gridDim.y * gridDim.z;
    unsigned sum, cnt, mine, sp = 0u;
    for (;;) {
        sum = 0u; cnt = 0u; mine = 0u;
#pragma unroll
        for (unsigned j = 0; j < 16; ++j) { const unsigned c = xb_ld(&bar[XB_XCNT(j)]); sum += c; cnt += (c > 0u) ? 1u : 0u; mine = (j == x) ? c : mine; }
        if (sum == G) break;
        __builtin_amdgcn_s_sleep(1);
        if ((++sp & 255u) == 0u) { if (xb_ld(&bar[XB_TMO])) break; if (sp > XB_SPIN_CAP) { atomicAdd(&bar[XB_TMO], 1u); break; } }
    }
    nloc = mine > 0u ? mine : 1u; nx = cnt > 0u ? cnt : 1u;
}
__device__ __forceinline__ void xcd_barrier(const XcdBarrier& b, int tid) {
    asm volatile("s_waitcnt vmcnt(0)" ::: "memory");
    __syncthreads();
    if (tid == 0) {
        unsigned* bar = b.bar;
        __builtin_amdgcn_s_waitcnt(0);
        unsigned nloc = b.st[0], nx = b.st[1];
        if (nloc == 0u) { xcd_barrier_complete(bar, b.x, nloc, nx); b.st[0] = nloc; b.st[1] = nx; }
        const unsigned old = xb_add(&bar[XB_XSUB(b.x)], 1u);
        const unsigned gen = old / nloc;
        if (old + 1u == (gen + 1u) * nloc) {
            __builtin_amdgcn_fence(__ATOMIC_RELEASE, "agent");
            asm volatile("s_waitcnt vmcnt(0)" ::: "memory");
            const unsigned og = xb_add(&bar[XB_TOP], 1u);
            const unsigned tg = og / nx;
            if (og + 1u == (tg + 1u) * nx) xb_add(&bar[XB_TOPGEN], 1u);
            else XB_SPIN(xb_ld(&bar[XB_TOPGEN]) == tg, bar);
            __builtin_amdgcn_fence(__ATOMIC_ACQUIRE, "agent");
            xb_add(&bar[XB_XGEN(b.x)], 1u);
            asm volatile("s_waitcnt vmcnt(0)" ::: "memory");
        } else {
            XB_SPIN(xb_ld(&bar[XB_XGEN(b.x)]) == gen, bar);
            __builtin_amdgcn_fence(__ATOMIC_ACQUIRE, "agent");
            asm volatile("s_waitcnt vmcnt(0)" ::: "memory");
        }
    }
    __syncthreads();
}
#include <hip/hip_cooperative_groups.h>
namespace cg = cooperative_groups;
constexpr int NTHR = 512, LDS_BYTES = 147456;

template <class F> __device__ __forceinline__ void dev_elems_(const F& f, long n, int tid, int bid, int nblk) {
    asm volatile("" : "+v"(tid));
    for (long i = (long)bid * NTHR + tid; i < n; i += (long)nblk * NTHR) f(i);
}
template <class G> __device__ __forceinline__ void dev_sgemm_(const G& g, int tid, int bid, int nblk) {
    asm volatile("" : "+v"(tid));
    const int M = g.M(); const int lane = tid & 63, wid = tid >> 6; constexpr int ntn = G::N / 64;
    const long ntiles = (long)(M / 16) * ntn;
    for (long tile = (long)bid * 8 + wid; tile < ntiles; tile += (long)nblk * 8) {
        const int tm = (int)(tile / ntn), tn = (int)(tile % ntn), r0 = tm * 16, c0 = tn * 64;
        f32x4 acc[G::NBP][4], carry[4];
#pragma unroll
        for (int j = 0; j < 4; ++j) { carry[j] = (f32x4){0.f, 0.f, 0.f, 0.f};
#pragma unroll
            for (int w = 0; w < G::NBP; ++w) acc[w][j] = (f32x4){0.f, 0.f, 0.f, 0.f}; }
#pragma unroll
        for (int seg = 0; seg < G::NSEGS; ++seg) {
            const bf16_t* ar = g.arow(seg, r0 + (lane & 15)) + 8 * (lane >> 4); const bf16_t* br[G::NBP][4];
#pragma unroll
            for (int w = 0; w < G::NBP; ++w)
#pragma unroll
                for (int j = 0; j < 4; ++j) br[w][j] = g.brow(seg, r0, c0 + 16 * j + (lane & 15), w) + 8 * (lane >> 4);
            const int K = g.K(seg);
            for (int k0 = 0; k0 < K; k0 += 32) { const bf16x8 a = *(const bf16x8*)(ar + k0);
#pragma unroll
                for (int w = 0; w < G::NBP; ++w)
#pragma unroll
                    for (int j = 0; j < 4; ++j) { const bf16x8 b = *(const bf16x8*)(br[w][j] + k0); acc[w][j] = __builtin_amdgcn_mfma_f32_16x16x32_bf16(a, b, acc[w][j], 0, 0, 0); } }
#pragma unroll
            for (int j = 0; j < 4; ++j)
#pragma unroll
                for (int i = 0; i < 4; ++i) { float a = acc[0][j][i], cr = carry[j][i]; g.between(seg, r0 + (lane >> 4) * 4 + i, c0 + 16 * j + (lane & 15), a, cr); acc[0][j][i] = a; carry[j][i] = cr; }
        }
#pragma unroll
        for (int j = 0; j < 4; ++j)
#pragma unroll
            for (int i = 0; i < 4; ++i) g.store(r0 + (lane >> 4) * 4 + i, c0 + 16 * j + (lane & 15), acc[0][j][i], G::NBP == 2 ? acc[G::NBP - 1][j][i] : carry[j][i]);
    }
}

struct E_hg3q { Ctx c; int half; static constexpr long n = (long)BH * HB * NSEG * 128 * 4;
    __device__ __forceinline__ void operator()(long idx) const { const int kq = (int)(idx & 3), v = (int)((idx >> 2) & 127); const long r = idx >> 9; const int seg = (int)(r % NSEG), bhl = (int)(r / NSEG), h = bhl % HB, bl = bhl / HB;
        const bf16_t* P = wsp<bf16_t>(c, OFF_P); float st[32];
#pragma unroll
        for (int k = 0; k < 32; ++k) st[k] = wsp<float>(c, OFF_HG)[(((size_t)bhl * NSEG + seg) * 128 + kq * 32 + k) * 128 + v];
        for (int s = 0; s < 256; ++s) { const int tl = bl * S + seg * 256 + s; const bf16_t* pr = P + (size_t)tl * NP; const float iv = bf2f(pr[COLS_A + 2 * WB + h * 128 + v]); float o = 0.f;
#pragma unroll
            for (int k = 0; k < 32; ++k) { const int kk = kq * 32 + k; const float f = hg_f(c, pr, h * 128 + kk); st[k] = f * st[k] + (1.f - f) * iv; o += siluf_(bf2f(pr[COLS_A + h * 128 + kk])) * st[k]; }
            o += __shfl_xor(o, 1); o += __shfl_xor(o, 2);
            if (kq == 0) ((bf16_t*)c.out)[((size_t)half * TH + tl) * OW + WA + h * 128 + v] = f2bf(o); } } };

typedef const __attribute__((address_space(4))) Ctx* CtxK;
#if defined(__HIP_DEVICE_COMPILE__)
__device__ __forceinline__ Ctx load_ctx() { CtxK p = (CtxK)__builtin_amdgcn_kernarg_segment_ptr(); asm volatile("" : "+s"(p)); return *p; }
#else
__device__ inline Ctx load_ctx() { return Ctx(); }
#endif
#define PH_BEGIN { const Ctx c = load_ctx(); const int tid = wid_s * 64 + pg8::lane_id_opaque(); int bid = blockIdx.x, nblk = gridDim.x; asm volatile("" : "+s"(bid), "+s"(nblk));
#define dev_elems(...) dev_elems_(__VA_ARGS__, tid, bid, nblk)
#define dev_sgemm(...) dev_sgemm_(__VA_ARGS__, tid, bid, nblk)
#define PH_END }
#ifndef DUP
#define DUP -1
#endif
#define GSYNC() do { xcd_barrier(xbar, tid_k); if (DUP == 20) xcd_barrier(xbar, tid_k); } while (0)
#define REP(k) for (int rep_ = 0; rep_ < ((DUP == (k)) ? 2 : 1); ++rep_)

__global__ void __launch_bounds__(NTHR) mega(Ctx c_arg) {
    extern __shared__ __attribute__((aligned(16))) unsigned char lds_raw[];
    PG8_LAS unsigned char* lds = (PG8_LAS unsigned char*)lds_raw;
    cg::grid_group grid = cg::this_grid();
    const int wid_s = __builtin_amdgcn_readfirstlane((int)threadIdx.x >> 6);
    volatile PG8_LAS unsigned* bst = (volatile PG8_LAS unsigned*)(lds + LDS_MISC);
    if (threadIdx.x == 0) { bst[0] = 0u; bst[1] = 0u; }
    __syncthreads();
    const XcdBarrier xbar = xcd_barrier_post(wsp<unsigned>(c_arg, OFF_CTL) + 4096, bst, (int)threadIdx.x);
#define tid_k (wid_s * 64 + pg8::lane_id_opaque())
    PH_BEGIN
    dev_elems(S0_small{c}, S0_small::n); REP(0) rowops::prologue_phase(c, lds, tid, bid, nblk);
    PH_END
    grid.sync();
#pragma unroll
    for (int half = 0; half < NHALF; ++half) {
        PH_BEGIN
        REP(1) fast_proj(c, half, lds, tid, bid, nblk);
        PH_END
        GSYNC();
        PH_BEGIN
        if (half == 0) fast_memkv(c, lds, tid, bid, nblk);
        REP(2) hgrn::hg_phase<false>(c, half, lds, tid, bid, nblk);
        PH_END
        GSYNC();
        PH_BEGIN
        hgrn::hg_scan_phase(c, tid, bid, nblk); REP(3) attn::attn_phase(c, half, lds, tid, bid, nblk);
        PH_END
        GSYNC();
        PH_BEGIN
        REP(4) hgrn::hg_phase<true>(c, half, lds, tid, bid, nblk); REP(12) hgrn::comb_phase(c, half, tid, bid, nblk);
        PH_END
        GSYNC();
    }
    PH_BEGIN
    REP(13) { rowops::expert_weights_phase(c, lds, tid, bid, nblk); __syncthreads(); } REP(5) fast_gates(c, lds, tid, bid, nblk);
    PH_END
    GSYNC();
    PH_BEGIN
    REP(6) fast_merge(c, lds, tid, bid, nblk);
    PH_END
    GSYNC();
    PH_BEGIN
    REP(7) fast_wout(c, lds, tid, bid, nblk);
    PH_END
    GSYNC();
    PH_BEGIN
    rowops::ln1_router_phase(c, lds, tid, bid, nblk);
    PH_END
    GSYNC();
    PH_BEGIN
    REP(9) fast_moe1(c, lds, tid, bid, nblk);
    PH_END
    GSYNC();
    PH_BEGIN
    REP(10) fast_moe2(c, lds, tid, bid, nblk);
    PH_END
    GSYNC();
    PH_BEGIN
    REP(11) rowops::ln2_phase(c, tid, bid, nblk);
    PH_END
}

extern "C" void kernel_launch(void* const* d_in, const int* in_sizes, int n_in, void* d_out, int out_size, void* d_ws, size_t ws_size, hipStream_t stream) {
    if (n_in != 22 || in_sizes[0] != T * D || out_size != T * D || ws_size < WS_END) { fprintf(stderr, "kernel_launch: unexpected shapes / workspace (%zu < %zu)\n", ws_size, (size_t)WS_END); return; }
    static int grid_blocks = 0;
    if (!grid_blocks) {
        int dev = 0, cus = 0, per_cu = 0;
        hipGetDevice(&dev); hipDeviceGetAttribute(&cus, hipDeviceAttributeMultiprocessorCount, dev);
        hipFuncSetAttribute((const void*)mega, hipFuncAttributeMaxDynamicSharedMemorySize, LDS_BYTES);
        hipOccupancyMaxActiveBlocksPerMultiprocessor(&per_cu, (const void*)mega, NTHR, LDS_BYTES);
        if (per_cu < 1) { fprintf(stderr, "kernel_launch: occupancy query says %d blocks/CU\n", per_cu); per_cu = 1; }
        if (per_cu > 1) per_cu = 1;
        grid_blocks = cus * per_cu;
    }
    Ctx c = make_ctx(d_in, d_out, d_ws);
    hipMemsetAsync((char*)d_ws + OFF_CTL, 0, 65536, stream);
    void* args[] = {&c};
    hipError_t e = hipLaunchCooperativeKernel((const void*)mega, dim3(grid_blocks), dim3(NTHR), args, LDS_BYTES, stream);
    if (e != hipSuccess) fprintf(stderr, "cooperative launch failed: %s (grid %d)\n", hipGetErrorString(e), grid_blocks);
}
```

```cpp
#ifdef HOST_TEST
#include <cmath>
#include <cstdint>
#include <cstdio>
#include <cstring>
#define HD
#define GLOBAL
#else
#include <hip/hip_runtime.h>
#include <cstdint>
#include <cstdio>
#include <cstring>
#include <cmath>
#define HD __host__ __device__ __forceinline__
#endif

#ifndef CFG_D
#define CFG_D 1024
#define CFG_B 4
#define CFG_S 8192
#endif
typedef unsigned short bf16_t;
constexpr int D = CFG_D, NBATCH = CFG_B, S = CFG_S, T = NBATCH * S;
constexpr int NHALF = 2, TH = T / NHALF, BH = NBATCH / NHALF;
constexpr int WA = 512, HB = D / 128, WB = D, WC = 512;
constexpr int COLS_A = 4608, COLS_B = 4 * WB, COLS_C = 512, COLS_G = 3 * D;
constexpr int NP = COLS_A + COLS_B + COLS_C, N_IN = NP + COLS_G;
constexpr int OW = WA + WB + WC;
constexpr int DE = D / 4, NE = 32, HBK = DE < 128 ? DE : 128;
constexpr int MEM = 256, NSEG = S / 256;
constexpr int MAXROWS = 2 * T + NE * 256;
constexpr float DN_ALPHA = 1.189207115002721f;
constexpr float LN_EPS = 1e-5f, RMS_EPS = 1e-6f;
constexpr float QK_SCALE = 0.08838834764831845f;

constexpr size_t MiB = 1u << 20;
constexpr size_t al(size_t x) { return (x + 4095) & ~(size_t)4095; }
constexpr size_t OFF_CTL = 0;
constexpr size_t OFF_SMALL = 1 * MiB;
constexpr size_t OFF_WT = 2 * MiB;
constexpr size_t WT_IN = OFF_WT, WT_KV = WT_IN + al((size_t)N_IN * D * 2), WT_A = WT_KV + al((size_t)1024 * D * 2),
                 WT_B = WT_A + al((size_t)D * WA * 2), WT_C = WT_B + al((size_t)D * WB * 2), WT_OUT = WT_C + al((size_t)D * WC * 2),
                 OFF_MEMB = WT_OUT + al((size_t)D * D * 2), OFF_MEMKV = OFF_MEMB + al((size_t)NBATCH * MEM * D * 2),
                 OFF_LIST = OFF_MEMKV + al((size_t)NBATCH * MEM * 1024 * 2), OFF_RW = OFF_LIST + al((size_t)NE * T * 4),
                 OFF_XB = OFF_RW + al((size_t)T * 2 * 4), OFF_P = OFF_XB + al((size_t)T * D * 2),
                 OFF_PART = OFF_P + al((size_t)TH * NP * 2), OFF_LSE = OFF_PART + al((size_t)3 * TH * WA * 2),
                 OFF_HG = OFF_LSE + al((size_t)3 * TH * 4 * 4), OFF_DSEG = OFF_HG + al((size_t)BH * HB * NSEG * 128 * 128 * 4),
                 WS_END = OFF_DSEG + al((size_t)BH * HB * NSEG * 128 * 4);
constexpr size_t OFF_GATES = OFF_P, OFF_H1 = OFF_P, OFF_X1B = OFF_P + al((size_t)T * D * 4),
                 OFF_WTGU = OFF_P + al((size_t)T * 3 * D * 2), OFF_WTDN = OFF_WTGU + al((size_t)NE * 2 * DE * D * 2),
                 OFF_HBUF = OFF_WTDN + al((size_t)NE * D * DE * 2), OFF_PEND = OFF_HBUF + al((size_t)MAXROWS * DE * 2);
constexpr size_t OFF_MERGED = OFF_XB, OFF_Y0 = OFF_XB, OFF_Y1 = OFF_PART;
static_assert(OFF_X1B + (size_t)T * D * 2 <= OFF_WTGU, "x1b inside dead gates region");
static_assert(OFF_PEND <= OFF_PART, "P-region overlays fit");
static_assert(OFF_Y1 + (size_t)T * D * 2 <= WS_END, "y1 fits in part+hg region");
constexpr int CW_CNT = 0;
constexpr int SM_BIAS = 0, SM_LB = 2048, SM_BLK = 2048 + 4096;

HD float bf2f(bf16_t v) { union { unsigned u; float f; } c; c.u = (unsigned)v << 16; return c.f; }
HD bf16_t f2bf(float f) { union { unsigned u; float f; } c; c.f = f; unsigned u = c.u; return (bf16_t)((u + 0x7fffu + ((u >> 16) & 1u)) >> 16); }
HD float sigmoidf_(float x) { return 1.0f / (1.0f + expf(-x)); }
HD float siluf_(float x) { return x / (1.0f + expf(-x)); }
HD int dil_of(int g) { return g == 0 ? 1 : (g == 1 ? 4 : 16); }
HD int perm_row(int tl, int g) { const int r = dil_of(g), bl = tl / S, s = tl % S; return bl * S + (s % r) * (S / r) + s / r; }

struct Ctx {
    const float *x, *mem, *rel_bias, *lb_logits, *w_in, *w_kv, *norm_g, *w_a, *w_b, *w_c, *w_out, *ln1_g, *ln1_b, *w_rg, *b_rg, *w_re, *b_re, *w_eg, *w_eu, *w_ed, *ln2_g, *ln2_b;
    float* out; unsigned char* ws;
};
#ifdef HOST_TEST
static const unsigned char T5_BUCKET[3][129] = {
#else
__device__ const unsigned char T5_BUCKET[3][129] = {
#endif
{0,1,2,3,4,5,6,7,8,9,10,11,12,13,14,15,16,16,16,16,16,16,17,17,17,17,17,17,17,17,18,18,18,18,18,18,18,18,18,18,19,19,19,19,19,19,19,19,19,19,19,19,19,19,20,20,20,20,20,20,20,20,20,20,20,20,20,20,20,20,20,20,20,21,21,21,21,21,21,21,21,21,21,21,21,21,21,21,21,21,21,21,21,21,21,21,21,21,21,22,22,22,22,22,22,22,22,22,22,22,22,22,22,22,22,22,22,22,22,22,22,22,22,22,22,22,22,22,22},
{0,4,8,12,16,16,17,17,18,18,19,19,19,19,20,20,20,20,20,21,21,21,21,21,21,22,22,22,22,22,22,22,22,22,23,23,23,23,23,23,23,23,23,23,23,23,24,24,24,24,24,24,24,24,24,24,24,24,24,24,24,24,25,25,25,25,25,25,25,25,25,25,25,25,25,25,25,25,25,25,25,25,25,26,26,26,26,26,26,26,26,26,26,26,26,26,26,26,26,26,26,26,26,26,26,26,26,26,26,26,26,26,26,27,27,27,27,27,27,27,27,27,27,27,27,27,27,27,27},
{0,16,18,19,20,21,21,22,22,23,23,23,24,24,24,24,25,25,25,25,25,26,26,26,26,26,26,26,26,27,27,27,27,27,27,27,27,27,27,28,28,28,28,28,28,28,28,28,28,28,28,28,29,29,29,29,29,29,29,29,29,29,29,29,29,29,29,29,29,29,30,30,30,30,30,30,30,30,30,30,30,30,30,30,30,30,30,30,30,30,30,30,30,30,30,31,31,31,31,31,31,31,31,31,31,31,31,31,31,31,31,31,31,31,31,31,31,31,31,31,31,31,31,31,31,31,31,31,31}};
template <class Tp> HD Tp* wsp(const Ctx& c, size_t off) { return (Tp*)(c.ws + off); }

#ifdef HOST_TEST
static inline unsigned atomic_inc_u32(unsigned* p) { unsigned r;
#pragma omp atomic capture
    { r = *p; *p += 1; }
    return r; }
#else
__device__ __forceinline__ unsigned atomic_inc_u32(unsigned* p) { return atomicAdd(p, 1u); }
#endif

struct S0_xb { Ctx c; static constexpr long n = (long)T * D;
    HD void operator()(long i) const { wsp<bf16_t>(c, OFF_XB)[i] = f2bf(c.x[i]); } };
struct S0_memb { Ctx c; static constexpr long n = (long)NBATCH * MEM * D;
    HD void operator()(long i) const { wsp<bf16_t>(c, OFF_MEMB)[i] = f2bf(c.mem[i]); } };
struct S0_tr { const float* W; bf16_t* Wt; int K, N; long n; int ldo;
    HD void operator()(long i) const { const int k = (int)(i % K); const long nn = i / K; Wt[(size_t)nn * ldo + k] = f2bf(W[(size_t)k * N + nn]); } };
struct S0_gu { Ctx c; static constexpr long n = (long)NE * 2 * DE * D;
    HD void operator()(long i) const { const int k = (int)(i % D); const long r = i / D; const int j = (int)(r % (2 * DE)), e = (int)(r / (2 * DE));
        const int u = j / (2 * HBK), w = j % (2 * HBK), hid = u * HBK + w % HBK, up = w / HBK;
        const float* src = up ? c.w_eu : c.w_eg; wsp<bf16_t>(c, OFF_WTGU)[i] = f2bf(src[((size_t)e * D + k) * DE + hid]); } };
struct S0_dn { Ctx c; static constexpr long n = (long)NE * D * DE;
    HD void operator()(long i) const { const int k = (int)(i % DE); const long r = i / DE; const int col = (int)(r % D), e = (int)(r / D);
        wsp<bf16_t>(c, OFF_WTDN)[i] = f2bf(c.w_ed[((size_t)e * DE + k) * D + col]); } };
struct S0_small { Ctx c; static constexpr long n = 12 * 129 + WB + 64;
    HD void operator()(long i) const { float* sm = wsp<float>(c, OFF_SMALL);
        if (i < 12 * 129) { const int gh = (int)(i / 129), u = (int)(i % 129), g = gh / 4; sm[SM_BIAS + i] = c.rel_bias[T5_BUCKET[g][u] * 12 + gh]; }
        else if (i < 12 * 129 + WB) { const int ch = (int)(i - 12 * 129); sm[SM_LB + ch] = sigmoidf_(c.lb_logits[ch] - c.lb_logits[WB + ch]); }
        else { const int j = (int)(i - 12 * 129 - WB); wsp<unsigned>(c, OFF_CTL)[j] = 0u; } } };

struct G_proj { Ctx c; int half; static constexpr int N = NP, NSEGS = 1, NBP = 1;
    HD int M() const { return TH; } HD int K(int) const { return D; }
    HD const bf16_t* arow(int, int row) const { return wsp<bf16_t>(c, OFF_XB) + ((size_t)half * TH + row) * D; }
    HD const bf16_t* brow(int, int, int col, int) const { return wsp<bf16_t>(c, WT_IN) + (size_t)col * D; }
    HD void between(int, int, int, float&, float&) const {}
    HD void store(int row, int col, float a, float) const { const int pr = col < COLS_A ? perm_row(row, col / 1536) : row; wsp<bf16_t>(c, OFF_P)[(size_t)pr * NP + col] = f2bf(a); } };
struct G_memkv { Ctx c; static constexpr int N = 1024, NSEGS = 1, NBP = 1;
    HD int M() const { return NBATCH * MEM; } HD int K(int) const { return D; }
    HD const bf16_t* arow(int, int row) const { return wsp<bf16_t>(c, OFF_MEMB) + (size_t)row * D; }
    HD const bf16_t* brow(int, int, int col, int) const { return wsp<bf16_t>(c, WT_KV) + (size_t)col * D; }
    HD void between(int, int, int, float&, float&) const {}
    HD void store(int row, int col, float a, float) const { wsp<bf16_t>(c, OFF_MEMKV)[(size_t)row * 1024 + col] = f2bf(a); } };
struct G_gates { Ctx c; static constexpr int N = 3 * D, NSEGS = 1, NBP = 1;
    HD int M() const { return T; } HD int K(int) const { return D; }
    HD const bf16_t* arow(int, int row) const { return wsp<bf16_t>(c, OFF_XB) + (size_t)row * D; }
    HD const bf16_t* brow(int, int, int col, int) const { return wsp<bf16_t>(c, WT_IN) + (size_t)(NP + col) * D; }
    HD void between(int, int, int, float&, float&) const {}
    HD void store(int row, int col, float a, float) const { wsp<bf16_t>(c, OFF_GATES)[((size_t)(col / D) * T + row) * D + col % D] = f2bf(sigmoidf_(a)); } };
struct G_merge { Ctx c; static constexpr int N = D, NSEGS = 3, NBP = 1;
    HD int M() const { return T; } HD int K(int s) const { return s == 1 ? WB : 512; }
    HD const bf16_t* arow(int s, int row) const { return (const bf16_t*)c.out + (size_t)row * OW + (s == 0 ? 0 : (s == 1 ? WA : WA + WB)); }
    HD const bf16_t* brow(int s, int, int col, int) const { return wsp<bf16_t>(c, WT_A) + (size_t)col * OW + (s == 0 ? 0 : (s == 1 ? WA : WA + WB)); }
    HD void between(int s, int row, int col, float& acc, float& carry) const { carry += bf2f(wsp<bf16_t>(c, OFF_GATES)[((size_t)s * T + row) * D + col]) * acc; acc = 0.f; }
    HD void store(int row, int col, float, float carry) const { wsp<bf16_t>(c, OFF_MERGED)[(size_t)row * D + col] = f2bf(carry); } };
struct G_wout { Ctx c; static constexpr int N = D, NSEGS = 1, NBP = 1;
    HD int M() const { return T; } HD int K(int) const { return D; }
    HD const bf16_t* arow(int, int row) const { return wsp<bf16_t>(c, OFF_MERGED) + (size_t)row * D; }
    HD const bf16_t* brow(int, int, int col, int) const { return wsp<bf16_t>(c, WT_OUT) + (size_t)col * D; }
    HD void between(int, int, int, float&, float&) const {}
    HD void store(int row, int col, float a, float) const { wsp<float>(c, OFF_H1)[(size_t)row * D + col] = DN_ALPHA * c.x[(size_t)row * D + col] + a; } };
struct MoeRow { int e, pos, valid, entry; };
HD MoeRow moe_row(const Ctx& c, int row) {
    const int* blk = wsp<int>(c, OFF_SMALL) + SM_BLK; const unsigned* cnt = wsp<unsigned>(c, OFF_CTL) + CW_CNT;
    MoeRow r; const int rb = row >> 8; r.e = blk[64 + rb]; r.pos = ((rb - blk[r.e]) << 8) + (row & 255); r.valid = r.pos < (int)cnt[r.e];
    r.entry = wsp<int>(c, OFF_LIST)[(size_t)r.e * T + (r.valid ? r.pos : 0)]; return r; }
HD int moe_rows_total(const Ctx& c) { return (wsp<int>(c, OFF_SMALL) + SM_BLK)[32] << 8; }
struct G_moe1 { Ctx c; static constexpr int N = DE, NSEGS = 1, NBP = 2;
    HD int M() const { return moe_rows_total(c); } HD int K(int) const { return D; }
    HD const bf16_t* arow(int, int row) const { const MoeRow r = moe_row(c, row); return wsp<bf16_t>(c, OFF_X1B) + (size_t)(r.entry >> 1) * D; }
    HD const bf16_t* brow(int, int row0, int col, int which) const { const int e = (wsp<int>(c, OFF_SMALL) + SM_BLK)[64 + (row0 >> 8)];
        return wsp<bf16_t>(c, OFF_WTGU) + ((size_t)e * 2 * DE + (col / HBK) * 2 * HBK + which * HBK + col % HBK) * D; }
    HD void between(int, int, int, float&, float&) const {}
    HD void store(int row, int col, float g, float u) const { wsp<bf16_t>(c, OFF_HBUF)[(size_t)row * DE + col] = f2bf(siluf_(g) * u); } };
struct G_moe2 { Ctx c; static constexpr int N = D, NSEGS = 1, NBP = 1;
    HD int M() const { return moe_rows_total(c); } HD int K(int) const { return DE; }
    HD const bf16_t* arow(int, int row) const { return wsp<bf16_t>(c, OFF_HBUF) + (size_t)row * DE; }
    HD const bf16_t* brow(int, int row0, int col, int) const { const int e = (wsp<int>(c, OFF_SMALL) + SM_BLK)[64 + (row0 >> 8)]; return wsp<bf16_t>(c, OFF_WTDN) + ((size_t)e * D + col) * DE; }
    HD void between(int, int, int, float&, float&) const {}
    HD void store(int row, int col, float a, float) const { const MoeRow r = moe_row(c, row); if (!r.valid) return;
        wsp<bf16_t>(c, (r.entry & 1) ? OFF_Y1 : OFF_Y0)[(size_t)(r.entry >> 1) * D + col] = f2bf(a); } };

struct u32x4_t { unsigned x, y, z, w; };
HD float bflo(unsigned u) { union { unsigned u; float f; } c; c.u = u << 16; return c.f; }
HD float bfhi(unsigned u) { union { unsigned u; float f; } c; c.u = u & 0xffff0000u; return c.f; }
HD float dot128(const bf16_t* a, const bf16_t* b) { float s = 0.f; const u32x4_t* pa = (const u32x4_t*)a; const u32x4_t* pb = (const u32x4_t*)b;
#ifndef HOST_TEST
#pragma unroll 4
#endif
    for (int d = 0; d < 16; ++d) { const u32x4_t ua = pa[d], ub = pb[d];
        s += bflo(ua.x) * bflo(ub.x) + bfhi(ua.x) * bfhi(ub.x) + bflo(ua.y) * bflo(ub.y) + bfhi(ua.y) * bfhi(ub.y) + bflo(ua.z) * bflo(ub.z) + bfhi(ua.z) * bfhi(ub.z) + bflo(ua.w) * bflo(ub.w) + bfhi(ua.w) * bfhi(ub.w); }
    return s; }
struct E_attnA { Ctx c; int half; static constexpr long n = (long)TH * 3 * 4 * 8;
    HD void operator()(long idx) const {
        const int p = (int)(idx & 7), h = (int)((idx >> 3) & 3); const long rest = idx >> 5; const int g = (int)(rest % 3), tl = (int)(rest / 3);
        const int r = dil_of(g), bl = tl / S, s = tl % S, cc = s % r, nq = s / r, L = S / r, base = bl * S + cc * L;
        const bf16_t* P = wsp<bf16_t>(c, OFF_P); const float* bias = wsp<float>(c, OFF_SMALL) + SM_BIAS + (g * 4 + h) * 129;
        const bf16_t* q = P + (size_t)(base + nq) * NP + g * 1536 + h * 128;
        float m = -INFINITY, l = 0.f, o[16];
#ifndef HOST_TEST
#pragma unroll
#endif
        for (int j = 0; j < 16; ++j) o[j] = 0.f;
        const int umax = nq < 128 ? nq : 128;
        for (int u = 0; u <= umax; ++u) {
            const bf16_t* kr = P + (size_t)(base + nq - u) * NP + g * 1536 + 512 + h * 128; const bf16_t* vr = kr + 512 + p * 16;
            const float sc = dot128(q, kr) * QK_SCALE + bias[u];
            const float mn = fmaxf(m, sc), a = expf(m - mn), pw = expf(sc - mn); l = l * a + pw; m = mn;
#ifndef HOST_TEST
#pragma unroll
#endif
            for (int j = 0; j < 16; ++j) o[j] = o[j] * a + pw * bf2f(vr[j]);
        }
        bf16_t* op = wsp<bf16_t>(c, OFF_PART) + ((size_t)g * TH + tl) * WA + h * 128 + p * 16; const float il = 1.f / l;
#ifndef HOST_TEST
#pragma unroll
#endif
        for (int j = 0; j < 16; ++j) op[j] = f2bf(o[j] * il);
        if (p == 0) wsp<float>(c, OFF_LSE)[((size_t)g * TH + tl) * 4 + h] = m + logf(l);
    } };
struct E_combA { Ctx c; int half; static constexpr long n = (long)TH * WA;
    HD void operator()(long idx) const { const int col = (int)(idx % WA), tl = (int)(idx / WA), h = col >> 7;
        const float* lse = wsp<float>(c, OFF_LSE); const bf16_t* part = wsp<bf16_t>(c, OFF_PART);
        const float l0 = lse[((size_t)0 * TH + tl) * 4 + h], l1 = lse[((size_t)1 * TH + tl) * 4 + h], l2 = lse[((size_t)2 * TH + tl) * 4 + h];
        const float mx = fmaxf(l0, fmaxf(l1, l2)), e0 = expf(l0 - mx), e1 = expf(l1 - mx), e2 = expf(l2 - mx), inv = 1.f / (e0 + e1 + e2);
        const float v = (e0 * bf2f(part[((size_t)0 * TH + tl) * WA + col]) + e1 * bf2f(part[((size_t)1 * TH + tl) * WA + col]) + e2 * bf2f(part[((size_t)2 * TH + tl) * WA + col])) * inv;
        ((bf16_t*)c.out)[((size_t)half * TH + tl) * OW + col] = f2bf(v); } };
struct E_attnC { Ctx c; int half; static constexpr long n = (long)TH * 4 * 8;
    HD void operator()(long idx) const { const int p = (int)(idx & 7), h = (int)((idx >> 3) & 3), tl = (int)(idx >> 5), b = half * BH + tl / S;
        const bf16_t* q = wsp<bf16_t>(c, OFF_P) + (size_t)tl * NP + COLS_A + COLS_B + h * 128; const bf16_t* kv = wsp<bf16_t>(c, OFF_MEMKV) + (size_t)b * MEM * 1024;
        float m = -INFINITY, l = 0.f, o[16];
#ifndef HOST_TEST
#pragma unroll
#endif
        for (int j = 0; j < 16; ++j) o[j] = 0.f;
        for (int k = 0; k < MEM; ++k) { const bf16_t* kr = kv + (size_t)k * 1024 + h * 128; const bf16_t* vr = kr + 512 + p * 16;
            const float sc = dot128(q, kr) * QK_SCALE; const float mn = fmaxf(m, sc), a = expf(m - mn), pw = expf(sc - mn); l = l * a + pw; m = mn;
#ifndef HOST_TEST
#pragma unroll
#endif
            for (int j = 0; j < 16; ++j) o[j] = o[j] * a + pw * bf2f(vr[j]); }
        bf16_t* op = (bf16_t*)c.out + ((size_t)half * TH + tl) * OW + WA + WB + h * 128 + p * 16; const float il = 1.f / l;
#ifndef HOST_TEST
#pragma unroll
#endif
        for (int j = 0; j < 16; ++j) op[j] = f2bf(o[j] * il); } };

HD float hg_f(const Ctx& c, const bf16_t* prow, int ch) { const float lb = wsp<float>(c, OFF_SMALL)[SM_LB + ch]; return lb + (1.f - lb) * sigmoidf_(bf2f(prow[COLS_A + WB + ch])); }
struct E_hg1 { Ctx c; int half; static constexpr long n = (long)BH * HB * NSEG * 128 * 128;
    HD void operator()(long idx) const { const int v = (int)(idx & 127), k = (int)((idx >> 7) & 127); const long r = idx >> 14; const int seg = (int)(r % NSEG), bhl = (int)(r / NSEG), h = bhl % HB, bl = bhl / HB;
        const bf16_t* P = wsp<bf16_t>(c, OFF_P); const int ch = h * 128 + k; float st = 0.f, dsum = 0.f;
        for (int s = 0; s < 256; ++s) { const bf16_t* pr = P + (size_t)(bl * S + seg * 256 + s) * NP; const float f = hg_f(c, pr, ch); st = f * st + (1.f - f) * bf2f(pr[COLS_A + 2 * WB + h * 128 + v]); dsum += logf(f); }
        wsp<float>(c, OFF_HG)[idx] = st; if (v == 0) wsp<float>(c, OFF_DSEG)[((size_t)bhl * NSEG + seg) * 128 + k] = dsum; } };
struct E_hg2 { Ctx c; static constexpr long n = (long)BH * HB * 128 * 128;
    HD void operator()(long idx) const { const int v = (int)(idx & 127), k = (int)((idx >> 7) & 127), bhl = (int)(idx >> 14); float run = 0.f;
        for (int seg = 0; seg < NSEG; ++seg) { float* p = wsp<float>(c, OFF_HG) + (((size_t)bhl * NSEG + seg) * 128 + k) * 128 + v; const float tmp = *p; *p = run;
            run = expf(wsp<float>(c, OFF_DSEG)[((size_t)bhl * NSEG + seg) * 128 + k]) * run + tmp; } } };
struct E_hg3 { Ctx c; int half; static constexpr long n = (long)BH * HB * NSEG * 128;
    HD void operator()(long idx) const { const int v = (int)(idx & 127); const long r = idx >> 7; const int seg = (int)(r % NSEG), bhl = (int)(r / NSEG), h = bhl % HB, bl = bhl / HB;
        const bf16_t* P = wsp<bf16_t>(c, OFF_P); float st[128];
#ifndef HOST_TEST
#pragma unroll
#endif
        for (int k = 0; k < 128; ++k) st[k] = wsp<float>(c, OFF_HG)[(((size_t)bhl * NSEG + seg) * 128 + k) * 128 + v];
        for (int s = 0; s < 256; ++s) { const int tl = bl * S + seg * 256 + s; const bf16_t* pr = P + (size_t)tl * NP; const float iv = bf2f(pr[COLS_A + 2 * WB + h * 128 + v]); float o = 0.f;
#ifndef HOST_TEST
#pragma unroll
#endif
            for (int k = 0; k < 128; ++k) { const float f = hg_f(c, pr, h * 128 + k); st[k] = f * st[k] + (1.f - f) * iv; o += siluf_(bf2f(pr[COLS_A + h * 128 + k])) * st[k]; }
            ((bf16_t*)c.out)[((size_t)half * TH + tl) * OW + WA + h * 128 + v] = f2bf(o); } } };
struct E_hgnorm { Ctx c; int half; static constexpr long n = (long)TH * HB;
    HD void operator()(long idx) const { const int h = (int)(idx % HB), tl = (int)(idx / HB); bf16_t* o = (bf16_t*)c.out + ((size_t)half * TH + tl) * OW + WA + h * 128;
        const bf16_t* pr = wsp<bf16_t>(c, OFF_P) + (size_t)tl * NP + COLS_A + 3 * WB + h * 128; float ss = 0.f;
        for (int v = 0; v < 128; ++v) { const float x = bf2f(o[v]); ss += x * x; }
        const float rs = 1.f / sqrtf(ss * (1.f / 128.f) + RMS_EPS);
        for (int v = 0; v < 128; ++v) o[v] = f2bf(bf2f(o[v]) * rs * c.norm_g[h * 128 + v] * siluf_(bf2f(pr[v]))); } };

struct E_ln1 { Ctx c; static constexpr long n = T;
    HD void operator()(long row) const { float* h1 = wsp<float>(c, OFF_H1) + (size_t)row * D; bf16_t* xb1 = wsp<bf16_t>(c, OFF_X1B) + (size_t)row * D;
        float mu = 0.f; for (int i = 0; i < D; ++i) mu += h1[i]; mu *= (1.f / D);
        float var = 0.f; for (int i = 0; i < D; ++i) { const float d = h1[i] - mu; var += d * d; } var *= (1.f / D); const float rs = 1.f / sqrtf(var + LN_EPS);
        float gl0 = c.b_rg[0], gl1 = c.b_rg[1], gl2 = c.b_rg[2], gl3 = c.b_rg[3];
        for (int i = 0; i < D; ++i) { const float v = (h1[i] - mu) * rs * c.ln1_g[i] + c.ln1_b[i]; h1[i] = v; xb1[i] = f2bf(v);
            gl0 += v * c.w_rg[i * 4 + 0]; gl1 += v * c.w_rg[i * 4 + 1]; gl2 += v * c.w_rg[i * 4 + 2]; gl3 += v * c.w_rg[i * 4 + 3]; }
        int gs = 0; float gm = gl0; if (gl1 > gm) { gm = gl1; gs = 1; } if (gl2 > gm) { gm = gl2; gs = 2; } if (gl3 > gm) { gm = gl3; gs = 3; }
        const float gp = 1.f / (expf(gl0 - gm) + expf(gl1 - gm) + expf(gl2 - gm) + expf(gl3 - gm));
        float v0 = -INFINITY, v1 = -INFINITY; int i0 = 0, i1 = 0;
        for (int j = 0; j < 8; ++j) { float el = c.b_re[gs * 8 + j]; for (int i = 0; i < D; ++i) el += h1[i] * c.w_re[i * 32 + gs * 8 + j];
            if (el > v0) { v1 = v0; i1 = i0; v0 = el; i0 = j; } else if (el > v1) { v1 = el; i1 = j; } }
        const float e1 = expf(v1 - v0), w0 = gp / (1.f + e1), w1 = gp * e1 / (1.f + e1);
        unsigned* cnt = wsp<unsigned>(c, OFF_CTL) + CW_CNT; int* list = wsp<int>(c, OFF_LIST); float* rw = wsp<float>(c, OFF_RW);
        const int ea = gs * 8 + i0, eb = gs * 8 + i1;
        list[(size_t)ea * T + atomic_inc_u32(cnt + ea)] = (int)row * 2 + 0; list[(size_t)eb * T + atomic_inc_u32(cnt + eb)] = (int)row * 2 + 1;
        rw[row * 2 + 0] = w0; rw[row * 2 + 1] = w1; } };
struct E_blk { Ctx c; static constexpr long n = 1;
    HD void operator()(long) const { int* blk = wsp<int>(c, OFF_SMALL) + SM_BLK; const unsigned* cnt = wsp<unsigned>(c, OFF_CTL) + CW_CNT; int acc = 0;
        for (int e = 0; e < NE; ++e) { blk[e] = acc; const int nb = ((int)cnt[e] + 255) >> 8; for (int j = 0; j < nb; ++j) blk[64 + acc + j] = e; acc += nb; } blk[32] = acc; } };
struct E_ln2 { Ctx c; static constexpr long n = T;
    HD void operator()(long row) const { const float* x1 = wsp<float>(c, OFF_H1) + (size_t)row * D; const bf16_t* y0 = wsp<bf16_t>(c, OFF_Y0) + (size_t)row * D; const bf16_t* y1 = wsp<bf16_t>(c, OFF_Y1) + (size_t)row * D;
        const float w0 = wsp<float>(c, OFF_RW)[row * 2], w1 = wsp<float>(c, OFF_RW)[row * 2 + 1]; float* o = c.out + (size_t)row * D;
        float mu = 0.f; for (int i = 0; i < D; ++i) { const float v = DN_ALPHA * x1[i] + w0 * bf2f(y0[i]) + w1 * bf2f(y1[i]); mu += v; } mu *= (1.f / D);
        float var = 0.f; for (int i = 0; i < D; ++i) { const float v = DN_ALPHA * x1[i] + w0 * bf2f(y0[i]) + w1 * bf2f(y1[i]) - mu; var += v * v; } var *= (1.f / D); const float rs = 1.f / sqrtf(var + LN_EPS);
        for (int i = 0; i < D; ++i) { const float v = DN_ALPHA * x1[i] + w0 * bf2f(y0[i]) + w1 * bf2f(y1[i]); o[i] = (v - mu) * rs * c.ln2_g[i] + c.ln2_b[i]; } } };
typedef short bf16x8 __attribute__((ext_vector_type(8)));
typedef float f32x4 __attribute__((ext_vector_type(4)));

template <class F> __global__ void __launch_bounds__(256) k_elems(F f, long n) {
    for (long i = (long)blockIdx.x * 256 + threadIdx.x; i < n; i += (long)gridDim.x * 256) f(i);
}
template <class F> __global__ void __launch_bounds__(64) k_elems64(F f, long n) {
    for (long i = (long)blockIdx.x * 64 + threadIdx.x; i < n; i += (long)gridDim.x * 64) f(i);
}
template <class G> __global__ void __launch_bounds__(256) k_sgemm(G g) {
    const int M = g.M(); const int lane = threadIdx.x & 63, wid = threadIdx.x >> 6; constexpr int ntn = G::N / 64;
    const long ntiles = (long)(M / 64) * ntn;
    for (long tile = blockIdx.x; tile < ntiles; tile += gridDim.x) {
        const int tm = (int)(tile / ntn), tn = (int)(tile % ntn), r0 = tm * 64 + wid * 16, c0 = tn * 64;
        f32x4 acc[G::NBP][4], carry[4];
#pragma unroll
        for (int j = 0; j < 4; ++j) { carry[j] = (f32x4){0.f, 0.f, 0.f, 0.f};
#pragma unroll
            for (int w = 0; w < G::NBP; ++w) acc[w][j] = (f32x4){0.f, 0.f, 0.f, 0.f}; }
#pragma unroll
        for (int seg = 0; seg < G::NSEGS; ++seg) {
            const bf16_t* ar = g.arow(seg, r0 + (lane & 15)) + 8 * (lane >> 4); const bf16_t* br[G::NBP][4];
#pragma unroll
            for (int w = 0; w < G::NBP; ++w)
#pragma unroll
                for (int j = 0; j < 4; ++j) br[w][j] = g.brow(seg, r0, c0 + 16 * j + (lane & 15), w) + 8 * (lane >> 4);
            const int K = g.K(seg);
            for (int k0 = 0; k0 < K; k0 += 32) { const bf16x8 a = *(const bf16x8*)(ar + k0);
#pragma unroll
                for (int w = 0; w < G::NBP; ++w)
#pragma unroll
                    for (int j = 0; j < 4; ++j) { const bf16x8 b = *(const bf16x8*)(br[w][j] + k0); acc[w][j] = __builtin_amdgcn_mfma_f32_16x16x32_bf16(a, b, acc[w][j], 0, 0, 0); } }
#pragma unroll
            for (int j = 0; j < 4; ++j)
#pragma unroll
                for (int i = 0; i < 4; ++i) { float a = acc[0][j][i], cr = carry[j][i]; g.between(seg, r0 + (lane >> 4) * 4 + i, c0 + 16 * j + (lane & 15), a, cr); acc[0][j][i] = a; carry[j][i] = cr; }
        }
#pragma unroll
        for (int j = 0; j < 4; ++j)
#pragma unroll
            for (int i = 0; i < 4; ++i) g.store(r0 + (lane >> 4) * 4 + i, c0 + 16 * j + (lane & 15), acc[0][j][i], G::NBP == 2 ? acc[G::NBP - 1][j][i] : carry[j][i]);
    }
}
template <class F> static void launch_elems(const F& f, long n, hipStream_t st) { long nb = (n + 255) / 256; if (nb > 32768) nb = 32768; if (nb < 1) nb = 1; hipLaunchKernelGGL(k_elems<F>, dim3((unsigned)nb), dim3(256), 0, st, f, n); }
template <class F> static void launch_elems64(const F& f, long n, hipStream_t st) { long nb = (n + 63) / 64; if (nb > 65536) nb = 65536; hipLaunchKernelGGL(k_elems64<F>, dim3((unsigned)nb), dim3(64), 0, st, f, n); }
template <class G> static void launch_sgemm(const G& g, hipStream_t st) { hipLaunchKernelGGL(k_sgemm<G>, dim3(4096), dim3(256), 0, st, g); }

static Ctx make_ctx(void* const* d_in, void* d_out, void* d_ws) {
    Ctx c; memset(&c, 0, sizeof(c)); const float** ip = (const float**)&c; for (int i = 0; i < 22; ++i) ip[i] = (const float*)d_in[i];
    c.out = (float*)d_out; c.ws = (unsigned char*)d_ws; return c;
}
static void v1_stage0(Ctx c, hipStream_t st) {
    launch_elems(S0_xb{c}, S0_xb::n, st); launch_elems(S0_memb{c}, S0_memb::n, st); launch_elems(S0_small{c}, S0_small::n, st);
    launch_elems(S0_tr{c.w_in, wsp<bf16_t>(c, WT_IN), D, N_IN, (long)D * N_IN, D}, (long)D * N_IN, st);
    launch_elems(S0_tr{c.w_kv, wsp<bf16_t>(c, WT_KV), D, 1024, (long)D * 1024, D}, (long)D * 1024, st);
    launch_elems(S0_tr{c.w_a, wsp<bf16_t>(c, WT_A), WA, D, (long)D * WA, OW}, (long)D * WA, st);
    launch_elems(S0_tr{c.w_b, wsp<bf16_t>(c, WT_A) + WA, WB, D, (long)D * WB, OW}, (long)D * WB, st);
    launch_elems(S0_tr{c.w_c, wsp<bf16_t>(c, WT_A) + WA + WB, WC, D, (long)D * WC, OW}, (long)D * WC, st);
    launch_elems(S0_tr{c.w_out, wsp<bf16_t>(c, WT_OUT), D, D, (long)D * D, D}, (long)D * D, st);
}
static void v1_proj(Ctx c, int half, hipStream_t st) { if (half == 0) launch_sgemm(G_memkv{c}, st); launch_sgemm(G_proj{c, half}, st); }
static void v1_mixers(Ctx c, int half, hipStream_t st) {
    launch_elems(E_hg1{c, half}, E_hg1::n, st); launch_elems(E_hg2{c}, E_hg2::n, st);
    launch_elems(E_attnA{c, half}, E_attnA::n, st); launch_elems(E_attnC{c, half}, E_attnC::n, st);
    launch_elems64(E_hg3{c, half}, E_hg3::n, st); launch_elems(E_hgnorm{c, half}, E_hgnorm::n, st); launch_elems(E_combA{c, half}, E_combA::n, st);
}
static void v1_expw(Ctx c, hipStream_t st) { launch_elems(S0_gu{c}, S0_gu::n, st); launch_elems(S0_dn{c}, S0_dn::n, st); }
static void v1_gates(Ctx c, hipStream_t st) { launch_sgemm(G_gates{c}, st); }
static void v1_merge(Ctx c, hipStream_t st) { launch_sgemm(G_merge{c}, st); }
static void v1_wout(Ctx c, hipStream_t st) { launch_sgemm(G_wout{c}, st); }
static void v1_ln1(Ctx c, hipStream_t st) { launch_elems(E_ln1{c}, E_ln1::n, st); launch_elems(E_blk{c}, 1, st); }
static void v1_moe1(Ctx c, hipStream_t st) { launch_sgemm(G_moe1{c}, st); }
static void v1_moe2(Ctx c, hipStream_t st) { launch_sgemm(G_moe2{c}, st); }
static void v1_ln2(Ctx c, hipStream_t st) { launch_elems(E_ln2{c}, E_ln2::n, st); }
namespace pg8 {
#define PG8_LAS __attribute__((address_space(3)))
typedef unsigned u32x4 __attribute__((ext_vector_type(4)));
constexpr int BM = 256, BK = 64, HALF = 128, HTB = HALF * BK * 2, STAGE_BYTES = 8 * HTB, NXCD = 8, WGM = 8;
__host__ __device__ __forceinline__ int lds_byte(int r, int c) { const int st = (r >> 4) * 2 + (c >> 5), rr = r & 15, cc = c & 31, ob = rr * 64 + cc * 2; return st * 1024 + (ob ^ (((ob >> 9) & 1) << 5)); }
__host__ __device__ __forceinline__ void stage_rc(int b, int& R, int& C) { const int st = b / 1024, sb = b % 1024, swz = sb ^ (((sb >> 9) & 1) << 5); R = (st >> 1) * 16 + swz / 64; C = (st & 1) * 32 + (swz % 64) / 2; }
__host__ __device__ __forceinline__ int perm32(int rho) { const int n = rho >> 4, i = rho & 15; return 8 * (i >> 2) + 4 * n + (i & 3); }
__device__ __forceinline__ unsigned cvt_pk_bf16(float lo, float hi) { unsigned r; asm volatile("v_cvt_pk_bf16_f32 %0, %1, %2" : "=v"(r) : "v"(lo), "v"(hi)); return r; }

__device__ __forceinline__ int lane_id_opaque() { int l; asm volatile("v_mbcnt_lo_u32_b32 %0, -1, 0\n\tv_mbcnt_hi_u32_b32 %0, -1, %0" : "=v"(l)); return l; }
struct Unit { const char* A; const char* B; int nt, pm, pn, tag; };
__device__ __forceinline__ void tile_of(int L, int nM, int nN, int& pm, int& pn) {
    const int nwg = nM * nN; int wgid = L; { const int q = nwg / NXCD, r = nwg % NXCD, xcd = wgid % NXCD, off = wgid / NXCD; wgid = (xcd < r ? xcd * (q + 1) : r * (q + 1) + (xcd - r) * q) + off; }
    const int nig = WGM * nN, gid = wgid / nig, fm = gid * WGM, gsz = (nM - fm) < WGM ? (nM - fm) : WGM;
    pm = fm + ((wgid % nig) % gsz); pn = (wgid % nig) / gsz;
}
template <class Epi, class Sched>
__device__ __forceinline__ void gemm_phase(PG8_LAS unsigned char* lds, const Sched& S, const Epi& E, int tid) {
    constexpr bool GA = Sched::GATHER;
    asm volatile("" : "+v"(tid));
    const int wid = __builtin_amdgcn_readfirstlane(tid >> 6), lane = tid & 63, wr = wid >> 2, wc = wid & 3, fr = lane & 15, fq = lane >> 4;
    const unsigned lda = S.lda, ldb = S.ldb;
    int sR[2]; unsigned voffA[2], voffB[2];
#pragma unroll
    for (int i = 0; i < 2; ++i) { int R, C; stage_rc(tid * 16 + i * 8192, R, C); sR[i] = R; const int Rb = Epi::PERM ? ((R & ~31) + perm32(R & 31)) : R;
        voffA[i] = (GA ? 0u : (unsigned)R * lda) + (unsigned)C * 2u; voffB[i] = (unsigned)Rb * ldb + (unsigned)C * 2u; }
    const size_t kstep = (size_t)(BK * 2), hstepA = (size_t)HALF * lda, hstepB = (size_t)HALF * ldb;
    const unsigned ldsw = (unsigned)wid * 1024u;
    const int aoff = lds_byte(wr * 64 + fr, fq * 8), boff = lds_byte(wc * 32 + fr, fq * 8);
#define PG8_SA(b, h) (((b) * 2 + (h)) * HTB)
#define PG8_SB(b, h) ((4 + (b) * 2 + (h)) * HTB)
#define PG8_STAGE(bufoff, gbase, voff) do { const char* gb_ = (const char*)(gbase); asm volatile("" : "+s"(gb_));     \
        _Pragma("unroll") for (int _i = 0; _i < 2; ++_i) \
        __builtin_amdgcn_global_load_lds((const unsigned*)(gb_ + (voff)[_i]), (PG8_LAS unsigned*)(lds + (bufoff) + ldsw + _i * 8192), 16, 0, 0); } while (0)
#define PG8_STAGE_A(bufoff, gbase, h, tk) do { if constexpr (GA) { unsigned _o[2]; _Pragma("unroll") for (int _i = 0; _i < 2; ++_i) _o[_i] = (((tk)[_i] >> (16 * (h))) & 0xffffu) * lda + voffA[_i]; PG8_STAGE(bufoff, gbase, _o); } \
        else { PG8_STAGE(bufoff, (gbase) + (h) * hstepA, voffA); } } while (0)
#define PG8_LDA(dst, b, h) do { _Pragma("unroll") for (int m = 0; m < 4; ++m) _Pragma("unroll") for (int k = 0; k < 2; ++k) dst[m][k] = *(const PG8_LAS bf16x8*)(lds + PG8_SA(b, h) + aoff + m * 2048 + k * 1024); } while (0)
#define PG8_LDB(dst, b, h) do { _Pragma("unroll") for (int n = 0; n < 2; ++n) _Pragma("unroll") for (int k = 0; k < 2; ++k) dst[n][k] = *(const PG8_LAS bf16x8*)(lds + PG8_SB(b, h) + boff + n * 2048 + k * 1024); } while (0)
#define PG8_MMA(ai, bj, At, Bt) do { __builtin_amdgcn_s_setprio(1); _Pragma("unroll") for (int m = 0; m < 4; ++m) _Pragma("unroll") for (int n = 0; n < 2; ++n) _Pragma("unroll") for (int k = 0; k < 2; ++k) \
        acc[ai][bj][m][n] = __builtin_amdgcn_mfma_f32_16x16x32_bf16(Bt[n][k], At[m][k], acc[ai][bj][m][n], 0, 0, 0); __builtin_amdgcn_s_setprio(0); } while (0)
#define PG8_WAIT_V(n) asm volatile("s_waitcnt vmcnt(" #n ")" ::: "memory")
#define PG8_WAIT_L(n) asm volatile("s_waitcnt lgkmcnt(" #n ")" ::: "memory")
#define PG8_BAR __builtin_amdgcn_s_barrier()
#define PG8_SCHED __builtin_amdgcn_sched_barrier(0)
#define PG8_TOKS(u, tk) do { if constexpr (GA) { _Pragma("unroll") for (int _i = 0; _i < 2; ++_i) tk[_i] = S.a_row(u, sR[_i]) | (S.a_row(u, sR[_i] + HALF) << 16); } } while (0)
    Unit cur, nxt; int ui = 0;
    if (!S.next(0, cur)) return;
    f32x4 acc[2][2][4][2];
#pragma unroll
    for (int a = 0; a < 2; ++a)
#pragma unroll
        for (int b = 0; b < 2; ++b)
#pragma unroll
            for (int m = 0; m < 4; ++m)
#pragma unroll
                for (int n = 0; n < 2; ++n) acc[a][b][m][n] = (f32x4){0.f, 0.f, 0.f, 0.f};
    bf16x8 At[4][2], B0[2][2], B1[2][2];
    unsigned ctk[2] = {0u, 0u}, ntk[2] = {0u, 0u};
    PG8_TOKS(cur, ctk);
    const char* cA = cur.A; const char* cB = cur.B;
    PG8_STAGE(PG8_SB(0, 0), cB, voffB); PG8_STAGE(PG8_SB(0, 1), cB + hstepB, voffB); PG8_STAGE_A(PG8_SA(0, 0), cA, 0, ctk); PG8_STAGE_A(PG8_SA(0, 1), cA, 1, ctk);
    if (wr == 1) PG8_BAR;
    PG8_WAIT_V(2); PG8_BAR;
    PG8_STAGE(PG8_SB(1, 0), cB + kstep, voffB); PG8_STAGE_A(PG8_SA(1, 0), cA + kstep, 0, ctk); PG8_STAGE(PG8_SB(1, 1), cB + hstepB + kstep, voffB);
    PG8_WAIT_V(6); PG8_BAR;
    for (;;) {
        const bool has_next = S.next(ui + 1, nxt);
        const char* nA = cA; const char* nB = cB;
        if constexpr (GA) { ntk[0] = ctk[0]; ntk[1] = ctk[1]; }
        if (has_next) { nA = nxt.A; nB = nxt.B; PG8_TOKS(nxt, ntk); }
        const int nt = cur.nt;
#define PG8_TRIP(a1, a2, b2, tk2) do { const char* a3 = (a2) + kstep; const char* b3 = (b2) + kstep; \
            PG8_LDB(B0, 0, 0); PG8_LDB(B1, 0, 1); PG8_SCHED; PG8_LDA(At, 0, 0); PG8_STAGE_A(PG8_SA(1, 1), a1, 1, ctk); \
            PG8_WAIT_V(8); PG8_WAIT_L(0); PG8_BAR; PG8_MMA(0, 0, At, B0); PG8_MMA(0, 1, At, B1); PG8_BAR; PG8_SCHED; \
            PG8_LDA(At, 0, 1); PG8_STAGE(PG8_SB(0, 0), b2, voffB); PG8_STAGE(PG8_SB(0, 1), (b2) + hstepB, voffB); PG8_STAGE_A(PG8_SA(0, 0), a2, 0, tk2); \
            PG8_WAIT_V(8); PG8_WAIT_L(0); PG8_BAR; PG8_MMA(1, 0, At, B0); PG8_MMA(1, 1, At, B1); PG8_BAR; PG8_SCHED; \
            PG8_LDB(B0, 1, 0); PG8_LDB(B1, 1, 1); PG8_SCHED; PG8_LDA(At, 1, 0); PG8_STAGE_A(PG8_SA(0, 1), a2, 1, tk2); \
            PG8_WAIT_V(8); PG8_WAIT_L(0); PG8_BAR; PG8_MMA(0, 0, At, B0); PG8_MMA(0, 1, At, B1); PG8_BAR; PG8_SCHED; \
            PG8_LDA(At, 1, 1); PG8_STAGE(PG8_SB(1, 0), b3, voffB); PG8_STAGE(PG8_SB(1, 1), b3 + hstepB, voffB); PG8_STAGE_A(PG8_SA(1, 0), a3, 0, tk2); \
            PG8_WAIT_V(8); PG8_WAIT_L(0); PG8_BAR; PG8_MMA(1, 0, At, B0); PG8_MMA(1, 1, At, B1); PG8_BAR; PG8_SCHED; } while (0)
        for (int t = 0; t < nt - 2; t += 2) { const char* a1 = cA + (size_t)(t + 1) * kstep; const char* a2 = cA + (size_t)(t + 2) * kstep; const char* b2 = cB + (size_t)(t + 2) * kstep;
            PG8_TRIP(a1, a2, b2, ctk); }
        { const char* a1 = cA + (size_t)(nt - 1) * kstep; PG8_TRIP(a1, nA, nB, ntk); }
#undef PG8_TRIP
        if (wr == 0) PG8_BAR;
        { const int el = lane_id_opaque(); E(acc, cur, wr, wc, el & 15, el >> 4); }
        if (!has_next) break;
        cur = nxt; cA = nA; cB = nB;
        if constexpr (GA) { ctk[0] = ntk[0]; ctk[1] = ntk[1]; }
        ++ui;
        if (wr == 1) PG8_BAR;
    }
    PG8_WAIT_V(0);
    PG8_BAR;
#undef PG8_SA
#undef PG8_SB
#undef PG8_STAGE
#undef PG8_STAGE_A
#undef PG8_LDA
#undef PG8_LDB
#undef PG8_MMA
#undef PG8_WAIT_V
#undef PG8_WAIT_L
#undef PG8_BAR
#undef PG8_SCHED
#undef PG8_TOKS
}
}
namespace pg8 {
#define ZERO_ACC() do { _Pragma("unroll") for (int a_ = 0; a_ < 2; ++a_) _Pragma("unroll") for (int b_ = 0; b_ < 2; ++b_) _Pragma("unroll") for (int m_ = 0; m_ < 4; ++m_) _Pragma("unroll") for (int n_ = 0; n_ < 2; ++n_) acc[a_][b_][m_][n_] = (f32x4){0.f, 0.f, 0.f, 0.f}; } while (0)
typedef f32x4 (&AccRef)[2][2][4][2];
__device__ __forceinline__ u32x4 pack8(f32x4 v0, f32x4 v1) { u32x4 w; w.x = cvt_pk_bf16(v0[0], v0[1]); w.y = cvt_pk_bf16(v0[2], v0[3]); w.z = cvt_pk_bf16(v1[0], v1[1]); w.w = cvt_pk_bf16(v1[2], v1[3]); return w; }
__device__ __forceinline__ void unpack8(u32x4 w, f32x4& v0, f32x4& v1) { v0 = (f32x4){bflo(w.x), bfhi(w.x), bflo(w.y), bfhi(w.y)}; v1 = (f32x4){bflo(w.z), bfhi(w.z), bflo(w.w), bfhi(w.w)}; }
__device__ __forceinline__ float fsigmoid(float x) { return __builtin_amdgcn_rcpf(1.f + __expf(-x)); }

struct SchedGrid {
    static constexpr bool GATHER = false; unsigned lda, ldb;
    int nM, nN, G, c, nt; const char *A0, *B0;
    __device__ __forceinline__ bool next(int i, Unit& u) const { const long L = (long)i * G + c; if (L >= (long)nM * nN) return false;
        int pm, pn; tile_of((int)L, nM, nN, pm, pn); u.pm = pm; u.pn = pn; u.tag = 0; u.nt = nt;
        u.A = A0 + (size_t)pm * BM * lda; u.B = B0 + (size_t)pn * BM * ldb; return true; }
};
struct SchedMerge {
    static constexpr bool GATHER = false; unsigned lda, ldb;
    int nM, nN, G, c; const char *A0, *B0;
    __device__ __forceinline__ bool next(int i, Unit& u) const { const int r = i / 3, s = i - r * 3; const long L = (long)r * G + c; if (L >= (long)nM * nN) return false;
        int pm, pn; tile_of((int)L, nM, nN, pm, pn); u.pm = pm; u.pn = pn; u.tag = s; u.nt = (s == 1 ? WB : WA) / BK;
        const size_t so = (size_t)((s > 0 ? WA : 0) + (s > 1 ? WB : 0)) * 2;
        u.A = A0 + (size_t)pm * BM * lda + so; u.B = B0 + (size_t)pn * BM * ldb + so; return true; }
};
#define ROWS_BEGIN(off0) { unsigned ro_ = (off0); _Pragma("unroll") for (int ai = 0; ai < 2; ++ai) { _Pragma("unroll") for (int m = 0; m < 4; ++m) {
#define ROWS_END(step16) ro_ += (m == 3 ? 5u : 1u) * (step16); asm volatile("" : "+v"(ro_) :: "memory"); } } }
struct EpiProj { static constexpr bool PERM = true; bf16_t* P;
    __device__ __forceinline__ void operator()(AccRef acc, const Unit& u, int wr, int wc, int fr, int fq) const {
        const int g = u.pn < 18 ? u.pn / 6 : -1; const int col0 = u.pn * BM + wc * 32 + 8 * fq; const int r0 = u.pm * BM + wr * 64 + fr;
        const int pr0 = g >= 0 ? perm_row(r0, g) : r0; const unsigned step16 = (unsigned)(16 >> (g <= 0 ? 0 : 2 * g)) * (NP * 2);
        char* base = (char*)P;
        ROWS_BEGIN((unsigned)pr0 * (NP * 2) + (unsigned)col0 * 2)
#pragma unroll
            for (int bj = 0; bj < 2; ++bj) *(u32x4*)(base + ro_ + bj * (HALF * 2)) = pack8(acc[ai][bj][m][0], acc[ai][bj][m][1]);
        ROWS_END(step16)
        ZERO_ACC(); } };
struct EpiGates { static constexpr bool PERM = true; bf16_t* Gt;
    __device__ __forceinline__ void operator()(AccRef acc, const Unit& u, int wr, int wc, int fr, int fq) const {
        const int pl = u.pn / (D / BM), col0 = (u.pn % (D / BM)) * BM + wc * 32 + 8 * fq, r0 = u.pm * BM + wr * 64 + fr; char* base = (char*)Gt + (size_t)pl * T * D * 2;
        ROWS_BEGIN((unsigned)r0 * (D * 2) + (unsigned)col0 * 2)
#pragma unroll
            for (int bj = 0; bj < 2; ++bj) { f32x4 v0 = acc[ai][bj][m][0], v1 = acc[ai][bj][m][1];
#pragma unroll
                for (int e = 0; e < 4; ++e) { v0[e] = fsigmoid(v0[e]); v1[e] = fsigmoid(v1[e]); }
                *(u32x4*)(base + ro_ + bj * (HALF * 2)) = pack8(v0, v1); }
        ROWS_END(16u * D * 2)
        ZERO_ACC(); } };
struct EpiMerge { static constexpr bool PERM = true; const bf16_t* Gt; bf16_t* Mg;
    __device__ __forceinline__ void operator()(AccRef acc, const Unit& u, int wr, int wc, int fr, int fq) const {
        const int s = u.tag; const int col0 = u.pn * BM + wc * 32 + 8 * fq, r0 = u.pm * BM + wr * 64 + fr; const char* gbase = (const char*)Gt + (size_t)s * T * D * 2; char* mbase = (char*)Mg;
        ROWS_BEGIN((unsigned)r0 * (D * 2) + (unsigned)col0 * 2)
#pragma unroll
            for (int bj = 0; bj < 2; ++bj) { f32x4 g0, g1; unpack8(*(const u32x4*)(gbase + ro_ + bj * (HALF * 2)), g0, g1);
                if (s < 2) { f32x4 h0, h1; unpack8(*(const u32x4*)(gbase + (size_t)T * D * 2 + ro_ + bj * (HALF * 2)), h0, h1);
#pragma unroll
                    for (int e = 0; e < 4; ++e) { g0[e] *= __builtin_amdgcn_rcpf(fmaxf(h0[e], 1e-20f)); g1[e] *= __builtin_amdgcn_rcpf(fmaxf(h1[e], 1e-20f)); } }
                acc[ai][bj][m][0] *= g0; acc[ai][bj][m][1] *= g1;
                if (s == 2) *(u32x4*)(mbase + ro_ + bj * (HALF * 2)) = pack8(acc[ai][bj][m][0], acc[ai][bj][m][1]); }
        ROWS_END(16u * D * 2)
        if (s == 2) ZERO_ACC(); } };
struct EpiWout { static constexpr bool PERM = false; const float* X; float* H1;
    __device__ __forceinline__ void operator()(AccRef acc, const Unit& u, int wr, int wc, int fr, int fq) const {
        const int col0 = u.pn * BM + wc * 32 + 4 * fq, r0 = u.pm * BM + wr * 64 + fr; const char* xb_ = (const char*)X; char* hb_ = (char*)H1;
        ROWS_BEGIN((unsigned)r0 * (D * 4) + (unsigned)col0 * 4)
#pragma unroll
            for (int bj = 0; bj < 2; ++bj)
#pragma unroll
                for (int n = 0; n < 2; ++n) { const f32x4 xv = *(const f32x4*)(xb_ + ro_ + (bj * HALF + n * 16) * 4); *(f32x4*)(hb_ + ro_ + (bj * HALF + n * 16) * 4) = xv * DN_ALPHA + acc[ai][bj][m][n]; }
        ROWS_END(16u * D * 4)
        ZERO_ACC(); } };
template <bool GA> struct SchedMoe {
    static constexpr bool GATHER = GA; unsigned lda, ldb;
    int G, c, ncol, nt; const PG8_LAS int* blk; const int* list; const unsigned* cnt; const char* A; const char* B; size_t b_estride, b_pnstride;
    __device__ __forceinline__ bool next(int i, Unit& u) const { const long L = (long)i * G + c; const int nblk = __builtin_amdgcn_readfirstlane(blk[32]); if (L >= (long)nblk * ncol) return false;
        const int rb = (int)(L / ncol), pn = (int)(L % ncol), e = __builtin_amdgcn_readfirstlane(blk[64 + rb]); u.pm = rb; u.pn = pn; u.tag = e; u.nt = nt;
        u.A = GA ? A : A + (size_t)rb * BM * lda; u.B = B + (size_t)e * b_estride + (size_t)pn * b_pnstride; return true; }
    __device__ __forceinline__ unsigned a_row(const Unit& u, int row) const {
        const int e = u.tag, pos = ((u.pm - __builtin_amdgcn_readfirstlane(blk[e])) << 8) + row; const int entry = list[(size_t)e * T + (pos < __builtin_amdgcn_readfirstlane((int)cnt[e]) ? pos : 0)]; return (unsigned)(entry >> 1); }
};
struct EpiMoe1 { static constexpr bool PERM = true; bf16_t* Hb;
    __device__ __forceinline__ void operator()(AccRef acc, const Unit& u, int wr, int wc, int fr, int fq) const {
        const int col0 = u.pn * HALF + wc * 32 + 8 * fq, r0 = u.pm * BM + wr * 64 + fr; char* base = (char*)Hb;
        ROWS_BEGIN((unsigned)r0 * (DE * 2) + (unsigned)col0 * 2)
            f32x4 v0 = acc[ai][0][m][0], v1 = acc[ai][0][m][1];
#pragma unroll
            for (int e = 0; e < 4; ++e) { v0[e] = v0[e] * fsigmoid(v0[e]) * acc[ai][1][m][0][e]; v1[e] = v1[e] * fsigmoid(v1[e]) * acc[ai][1][m][1][e]; }
            *(u32x4*)(base + ro_) = pack8(v0, v1);
        ROWS_END(16u * DE * 2)
        ZERO_ACC(); } };
struct EpiMoe2 { static constexpr bool PERM = true; const PG8_LAS int* blk; const int* list; const unsigned* cnt; bf16_t* Y0; bf16_t* Y1;
    __device__ __forceinline__ void operator()(AccRef acc, const Unit& u, int wr, int wc, int fr, int fq) const {
        const int e = u.tag, col0 = u.pn * BM + wc * 32 + 8 * fq, pbase = ((u.pm - __builtin_amdgcn_readfirstlane(blk[e])) << 8) + wr * 64 + fr, n_e = __builtin_amdgcn_readfirstlane((int)cnt[e]); const int* le = list + (size_t)e * T;
        ROWS_BEGIN((unsigned)pbase)
            const int pos = (int)ro_;
            if (pos < n_e) { const int entry = le[pos]; bf16_t* rowp = ((entry & 1) ? Y1 : Y0) + (size_t)(entry >> 1) * D + col0;
#pragma unroll
                for (int bj = 0; bj < 2; ++bj) *(u32x4*)(rowp + bj * HALF) = pack8(acc[ai][bj][m][0], acc[ai][bj][m][1]); }
        ROWS_END(16u)
        ZERO_ACC(); } };
#undef ROWS_BEGIN
#undef ROWS_END
#undef ZERO_ACC
}

__device__ __forceinline__ void fast_proj(const Ctx& c, int half, PG8_LAS unsigned char* lds, int tid, int bid, int nblk) {
    pg8::SchedGrid S; S.nM = TH / 256; S.nN = NP / 256; S.G = nblk; S.c = bid; S.nt = D / 64; S.lda = D * 2; S.ldb = D * 2;
    S.A0 = (const char*)(wsp<bf16_t>(c, OFF_XB) + (size_t)half * TH * D); S.B0 = (const char*)wsp<bf16_t>(c, WT_IN);
    pg8::EpiProj E{wsp<bf16_t>(c, OFF_P)}; pg8::gemm_phase(lds, S, E, tid);
}
struct EpiPlain { static constexpr bool PERM = true; bf16_t* O; int ldc;
    __device__ __forceinline__ void operator()(pg8::AccRef acc, const pg8::Unit& u, int wr, int wc, int fr, int fq) const {
        const int col0 = u.pn * 256 + wc * 32 + 8 * fq, r0 = u.pm * 256 + wr * 64 + fr; char* base = (char*)O; unsigned ro = (unsigned)r0 * (unsigned)(ldc * 2) + (unsigned)col0 * 2;
#pragma unroll
        for (int ai = 0; ai < 2; ++ai)
#pragma unroll
            for (int m = 0; m < 4; ++m) {
#pragma unroll
                for (int bj = 0; bj < 2; ++bj) { *(pg8::u32x4*)(base + ro + bj * 256) = pg8::pack8(acc[ai][bj][m][0], acc[ai][bj][m][1]); acc[ai][bj][m][0] = (f32x4){0.f, 0.f, 0.f, 0.f}; acc[ai][bj][m][1] = (f32x4){0.f, 0.f, 0.f, 0.f}; }
                ro += (m == 3 ? 5u : 1u) * 16u * (unsigned)(ldc * 2); asm volatile("" : "+v"(ro) :: "memory"); } } };
__device__ __forceinline__ void fast_memkv(const Ctx& c, PG8_LAS unsigned char* lds, int tid, int bid, int nblk) {
    pg8::SchedGrid S; S.nM = NBATCH * MEM / 256; S.nN = 1024 / 256; S.G = nblk; S.c = bid; S.nt = D / 64; S.lda = D * 2; S.ldb = D * 2;
    S.A0 = (const char*)wsp<bf16_t>(c, OFF_MEMB); S.B0 = (const char*)wsp<bf16_t>(c, WT_KV);
    EpiPlain E{wsp<bf16_t>(c, OFF_MEMKV), 1024}; pg8::gemm_phase(lds, S, E, tid);
}
__device__ __forceinline__ void fast_gates(const Ctx& c, PG8_LAS unsigned char* lds, int tid, int bid, int nblk) {
    pg8::SchedGrid S; S.nM = T / 256; S.nN = 3 * D / 256; S.G = nblk; S.c = bid; S.nt = D / 64; S.lda = D * 2; S.ldb = D * 2;
    S.A0 = (const char*)wsp<bf16_t>(c, OFF_XB); S.B0 = (const char*)(wsp<bf16_t>(c, WT_IN) + (size_t)NP * D);
    pg8::EpiGates E{wsp<bf16_t>(c, OFF_GATES)}; pg8::gemm_phase(lds, S, E, tid);
}
__device__ __forceinline__ void fast_merge(const Ctx& c, PG8_LAS unsigned char* lds, int tid, int bid, int nblk) {
    pg8::SchedMerge S; S.nM = T / 256; S.nN = D / 256; S.G = nblk; S.c = bid; S.lda = OW * 2; S.ldb = OW * 2;
    S.A0 = (const char*)c.out; S.B0 = (const char*)wsp<bf16_t>(c, WT_A);
    pg8::EpiMerge E{wsp<bf16_t>(c, OFF_GATES), wsp<bf16_t>(c, OFF_MERGED)}; pg8::gemm_phase(lds, S, E, tid);
}
__device__ __forceinline__ void fast_wout(const Ctx& c, PG8_LAS unsigned char* lds, int tid, int bid, int nblk) {
    pg8::SchedGrid S; S.nM = T / 256; S.nN = D / 256; S.G = nblk; S.c = bid; S.nt = D / 64; S.lda = D * 2; S.ldb = D * 2;
    S.A0 = (const char*)wsp<bf16_t>(c, OFF_MERGED); S.B0 = (const char*)wsp<bf16_t>(c, WT_OUT);
    pg8::EpiWout E{c.x, wsp<float>(c, OFF_H1)}; pg8::gemm_phase(lds, S, E, tid);
}
constexpr int LDS_MISC = 131072, LDS_BLK = LDS_MISC + 1024;
__device__ __forceinline__ const PG8_LAS int* build_blk_table(const Ctx& c, PG8_LAS unsigned char* lds, int tid) {
    PG8_LAS int* blk = (PG8_LAS int*)(lds + LDS_BLK); const unsigned* cnt = wsp<unsigned>(c, OFF_CTL) + CW_CNT;
    if (tid < 32) blk[512 + tid] = ((int)cnt[tid] + 255) >> 8;
    __syncthreads();
    if (tid == 0) { int acc = 0; for (int e = 0; e < NE; ++e) { blk[e] = acc; acc += blk[512 + e]; } blk[32] = acc; }
    __syncthreads();
    { const int total = blk[32]; for (int rb = tid; rb < total; rb += 512) { int e = 0;
#pragma unroll 1
        for (int j = 1; j < NE; ++j) if (blk[j] <= rb) e = j;
        blk[64 + rb] = e; } }
    __syncthreads();
    return blk;
}
__device__ __forceinline__ void fast_moe1(const Ctx& c, PG8_LAS unsigned char* lds, int tid, int bid, int nblk) {
    pg8::SchedMoe<true> S; S.G = nblk; S.c = bid; S.ncol = 2; S.nt = D / 64; S.blk = build_blk_table(c, lds, tid); S.list = wsp<int>(c, OFF_LIST); S.cnt = wsp<unsigned>(c, OFF_CTL) + CW_CNT;
    S.A = (const char*)wsp<bf16_t>(c, OFF_X1B); S.B = (const char*)wsp<bf16_t>(c, OFF_WTGU); S.b_estride = (size_t)2 * DE * D * 2; S.b_pnstride = (size_t)256 * D * 2; S.lda = D * 2; S.ldb = D * 2;
    pg8::EpiMoe1 E{wsp<bf16_t>(c, OFF_HBUF)}; pg8::gemm_phase(lds, S, E, tid);
}
__device__ __forceinline__ void fast_moe2(const Ctx& c, PG8_LAS unsigned char* lds, int tid, int bid, int nblk) {
    pg8::SchedMoe<false> S; S.G = nblk; S.c = bid; S.ncol = D / 256; S.nt = DE / 64; S.blk = build_blk_table(c, lds, tid); S.list = wsp<int>(c, OFF_LIST); S.cnt = wsp<unsigned>(c, OFF_CTL) + CW_CNT;
    S.A = (const char*)wsp<bf16_t>(c, OFF_HBUF); S.B = (const char*)wsp<bf16_t>(c, OFF_WTDN); S.b_estride = (size_t)D * DE * 2; S.b_pnstride = (size_t)256 * DE * 2; S.lda = DE * 2; S.ldb = DE * 2;
    pg8::EpiMoe2 E{S.blk, S.list, S.cnt, wsp<bf16_t>(c, OFF_Y0), wsp<bf16_t>(c, OFF_Y1)}; pg8::gemm_phase(lds, S, E, tid);
}
namespace attn {
typedef short s16x4 __attribute__((ext_vector_type(4)));
typedef float f32x16 __attribute__((ext_vector_type(16)));
typedef unsigned u32x4 __attribute__((ext_vector_type(4)));
constexpr int KVBLK = 64, DH = 128, SHM_V = KVBLK * DH * 2, SHM_K = KVBLK * DH * 2;
constexpr int LDS_V = 0, LDS_K = 2 * SHM_V, LDS_WS = LDS_K + 2 * SHM_K, LDS_BIAS = LDS_WS + 8 * 64 * 4, BIAS_PAD = 96, BIAS_N = 129 + 2 * BIAS_PAD, LDS_END = LDS_BIAS + ((BIAS_N * 4 + 15) & ~15);
constexpr float LOG2E = 1.4426950408889634f, C2 = LOG2E * QK_SCALE, LN2 = 0.6931471805599453f;
#define KSWZ(row, colB) ((row) * 256 + ((colB) ^ (((row) & 7) << 4)))
#define SBAR() __builtin_amdgcn_sched_barrier(0)
__device__ __forceinline__ int v_st(int k, int c) { const int kk = (k & ~0xC) | ((k & 4) << 1) | ((k & 8) >> 1); return ((kk >> 3) * 4 + (c >> 5)) * 512 + ((kk & 7) * 32 + (c & 31)) * 2; }
__device__ __forceinline__ int v_rd_base(int lane) { return ((lane & 3) << 3) | (((lane >> 2) & 3) << 6) | (((lane >> 4) & 1) << 5) | (((lane >> 5) & 1) << 8); }
constexpr int v_rd_off(int d0, int ks, int half) { return d0 * 512 + ks * 4096 + half * 2048; }
__device__ __forceinline__ int crow(int r, int hi) { return (r & 3) + 8 * (r >> 2) + 4 * hi; }
__device__ __forceinline__ unsigned cvtpk(float lo, float hi) { unsigned r; asm volatile("v_cvt_pk_bf16_f32 %0, %1, %2" : "=v"(r) : "v"(lo), "v"(hi)); return r; }
__device__ __forceinline__ void qkt(f32x16& p0, f32x16& p1, const PG8_LAS char* kbuf, int r32, int hi, const bf16x8* qr) {
    p0 = f32x16{}; p1 = f32x16{};
    const PG8_LAS char* kb[4];
#pragma unroll
    for (int dd = 0; dd < 4; ++dd) kb[dd] = kbuf + KSWZ(r32, (dd * 16 + hi * 8) * 2);
#pragma unroll
    for (int d0 = 0; d0 < 8; ++d0) { const PG8_LAS char* a = kb[d0 & 3] + (d0 >> 2) * 128;
        const bf16x8 b0 = *(const PG8_LAS bf16x8*)(a);
        const bf16x8 b1 = *(const PG8_LAS bf16x8*)(a + 32 * 256);
        p0 = __builtin_amdgcn_mfma_f32_32x32x16_bf16(b0, qr[d0], p0, 0, 0, 0);
        p1 = __builtin_amdgcn_mfma_f32_32x32x16_bf16(b1, qr[d0], p1, 0, 0, 0); }
}
__device__ __forceinline__ void pv_tile(f32x16* o, int vb0, bf16x8 pa0, bf16x8 pa1, bf16x8 pa2, bf16x8 pa3) {
#define TRRD(dst, off) asm volatile("ds_read_b64_tr_b16 %0, %1 offset:%2" : "=&v"(dst) : "v"(vb0), "i"(off) : "memory")
#define PV_D0(d0) do { s16x4 l0, l1, l2, l3, h0, h1, h2, h3; constexpr int b_ = v_rd_off(d0, 0, 0); \
        TRRD(l0, b_); TRRD(h0, b_ + 2048); TRRD(l1, b_ + 4096); TRRD(h1, b_ + 6144); TRRD(l2, b_ + 8192); TRRD(h2, b_ + 10240); TRRD(l3, b_ + 12288); TRRD(h3, b_ + 14336); \
        asm volatile("s_waitcnt lgkmcnt(0)" ::: "memory"); SBAR(); \
        o[d0] = __builtin_amdgcn_mfma_f32_32x32x16_bf16(pa0, (bf16x8){l0[0], l0[1], l0[2], l0[3], h0[0], h0[1], h0[2], h0[3]}, o[d0], 0, 0, 0); \
        o[d0] = __builtin_amdgcn_mfma_f32_32x32x16_bf16(pa1, (bf16x8){l1[0], l1[1], l1[2], l1[3], h1[0], h1[1], h1[2], h1[3]}, o[d0], 0, 0, 0); \
        o[d0] = __builtin_amdgcn_mfma_f32_32x32x16_bf16(pa2, (bf16x8){l2[0], l2[1], l2[2], l2[3], h2[0], h2[1], h2[2], h2[3]}, o[d0], 0, 0, 0); \
        o[d0] = __builtin_amdgcn_mfma_f32_32x32x16_bf16(pa3, (bf16x8){l3[0], l3[1], l3[2], l3[3], h3[0], h3[1], h3[2], h3[3]}, o[d0], 0, 0, 0); } while (0)
    PV_D0(0); PV_D0(1); PV_D0(2); PV_D0(3);
#undef PV_D0
#undef TRRD
}
template <bool BAND>
__device__ __forceinline__ void attn_unit(PG8_LAS char* lds, const bf16_t* Q, size_t qs, const bf16_t* K, const bf16_t* V, size_t ks, int NT, int qpos0, int kpos0,
                                          bf16_t* Ob, size_t ostride, float* lse, int obase, int omul, int tid) {
    const int wid = __builtin_amdgcn_readfirstlane(tid >> 6), lane = tid & 63, r32 = lane & 31, hi = lane >> 5;
    PG8_LAS char* V_lds = lds + LDS_V; PG8_LAS char* K_lds = lds + LDS_K;
    PG8_LAS float* wsf = (PG8_LAS float*)(lds + LDS_WS) + wid * 64; const PG8_LAS float* bias = (const PG8_LAS float*)(lds + LDS_BIAS);
    const int sr = tid >> 4, sc = (tid & 15) * 8, vst0 = v_st(sr, sc), vst1 = v_st(32 + sr, sc), kws = KSWZ(sr, sc * 2);
    const int vbl = (int)(uintptr_t)V_lds + v_rd_base(lane);
    bf16x8 qr[8];
    { const bf16_t* qp = Q + (size_t)(wid * 32 + r32) * qs + hi * 8;
#pragma unroll
      for (int d0 = 0; d0 < 8; ++d0) qr[d0] = *(const bf16x8*)(qp + d0 * 16); }
    bf16x8 st_k0, st_k1, st_v0, st_v1;
#define SLOAD(t) do { const size_t ro_ = (size_t)((t) * KVBLK + sr) * ks + sc; st_k0 = *(const bf16x8*)(K + ro_); st_k1 = *(const bf16x8*)(K + ro_ + 32 * ks); st_v0 = *(const bf16x8*)(V + ro_); st_v1 = *(const bf16x8*)(V + ro_ + 32 * ks); } while (0)
#define SWRITE(bf) do { *(PG8_LAS bf16x8*)(K_lds + (bf) * SHM_K + kws) = st_k0; *(PG8_LAS bf16x8*)(K_lds + (bf) * SHM_K + kws + 32 * 256) = st_k1; \
                        *(PG8_LAS bf16x8*)(V_lds + (bf) * SHM_V + vst0) = st_v0; *(PG8_LAS bf16x8*)(V_lds + (bf) * SHM_V + vst1) = st_v1; } while (0)
    SLOAD(0); SWRITE(0);
    __syncthreads();
    float m_run = -1e30f, l_run = 0.f; f32x16 o[4] = {};
    const int qlo = qpos0 + wid * 32;
    for (int t = 0; t < NT; ++t) {
        const int buf = t & 1;
        if (t + 1 < NT) SLOAD(t + 1);
        const int kb = kpos0 + t * KVBLK;
        const bool act = !BAND || (kb <= qlo + 31 && kb + KVBLK - 1 >= qlo - 128);
        if (act) {
            f32x16 p0, p1;
            qkt(p0, p1, K_lds + buf * SHM_K, r32, hi, qr);
            if (BAND) {
                const int dq = qlo + r32 - kb - 4 * hi;
                const PG8_LAS float* bp = bias + (dq + BIAS_PAD - 59);
#pragma unroll
                for (int r = 0; r < 16; ++r) { const int cr = (r & 3) + 8 * (r >> 2);
                    const float b0 = bp[59 - cr], b1 = bp[59 - cr - 32];
                    p0[r] = ((unsigned)(dq - cr) <= 128u) ? fmaf(p0[r], C2, b0) : -INFINITY;
                    p1[r] = ((unsigned)(dq - cr - 32) <= 128u) ? fmaf(p1[r], C2, b1) : -INFINITY; }
            } else {
#pragma unroll
                for (int r = 0; r < 16; ++r) { p0[r] *= C2; p1[r] *= C2; }
            }
            float pmax = p0[0];
#pragma unroll
            for (int r = 1; r < 16; ++r) pmax = fmaxf(pmax, p0[r]);
#pragma unroll
            for (int r = 0; r < 16; ++r) pmax = fmaxf(pmax, p1[r]);
            { auto rr = __builtin_amdgcn_permlane32_swap(__float_as_uint(pmax), __float_as_uint(pmax), false, false); pmax = fmaxf(__uint_as_float(rr[0]), __uint_as_float(rr[1])); }
            const float mn = fmaxf(m_run, pmax), alpha = __builtin_amdgcn_exp2f(m_run - mn); m_run = mn;
            float ps = 0.f;
#pragma unroll
            for (int r = 0; r < 16; ++r) { p0[r] = __builtin_amdgcn_exp2f(p0[r] - mn); p1[r] = __builtin_amdgcn_exp2f(p1[r] - mn); ps += p0[r] + p1[r]; }
            { auto rr = __builtin_amdgcn_permlane32_swap(__float_as_uint(ps), __float_as_uint(ps), false, false); ps = __uint_as_float(rr[0]) + __uint_as_float(rr[1]); }
            l_run = l_run * alpha + ps;
            if (__any(alpha < 1.f)) { if (hi == 0) wsf[r32] = alpha; asm volatile("s_waitcnt lgkmcnt(0)" ::: "memory");
#pragma unroll
                for (int r = 0; r < 16; ++r) { const float a = wsf[crow(r, hi)];
#pragma unroll
                    for (int d_ = 0; d_ < 4; ++d_) o[d_][r] *= a; }
                asm volatile("s_waitcnt lgkmcnt(0)" ::: "memory"); }
            bf16x8 pa0, pa1, pa2, pa3;
#define PK4(P, B_, OUT) do { unsigned a0 = cvtpk(P[B_ + 0], P[B_ + 1]), a1 = cvtpk(P[B_ + 2], P[B_ + 3]); unsigned b0 = cvtpk(P[B_ + 4], P[B_ + 5]), b1 = cvtpk(P[B_ + 6], P[B_ + 7]); \
        auto r0 = __builtin_amdgcn_permlane32_swap(a0, b0, false, false); auto r1 = __builtin_amdgcn_permlane32_swap(a1, b1, false, false); \
        u32x4 w = {r0[0], r1[0], r0[1], r1[1]}; OUT = *reinterpret_cast<bf16x8*>(&w); } while (0)
            PK4(p0, 0, pa0); PK4(p0, 8, pa1); PK4(p1, 0, pa2); PK4(p1, 8, pa3);
#undef PK4
            SBAR();
            pv_tile(o, vbl + buf * SHM_V, pa0, pa1, pa2, pa3);
        }
        if (t + 1 < NT) SWRITE(buf ^ 1);
        __syncthreads();
    }
#undef SLOAD
#undef SWRITE
    if (hi == 0) wsf[r32] = l_run; asm volatile("s_waitcnt lgkmcnt(0)" ::: "memory");
    float rli[16];
#pragma unroll
    for (int r = 0; r < 16; ++r) rli[r] = __builtin_amdgcn_rcpf(wsf[crow(r, hi)]);
#pragma unroll
    for (int r = 0; r < 16; ++r) { const int row = wid * 32 + crow(r, hi); bf16_t* op = Ob + (size_t)(obase + row * omul) * ostride;
#pragma unroll
        for (int d0 = 0; d0 < 4; ++d0) { const float v = o[d0][r] * rli[r]; const float vn = __shfl_xor(v, 1);
            if ((r32 & 1) == 0) *(unsigned*)(op + d0 * 32 + r32) = cvtpk(v, vn); } }
    if (BAND) { if (hi == 0) lse[(size_t)(obase + (wid * 32 + r32) * omul) * 4] = (m_run + __log2f(l_run)) * LN2; }
    __syncthreads();
}
#undef KSWZ
#undef SBAR

__device__ __forceinline__ void attn_phase(const Ctx& c, int half, PG8_LAS unsigned char* lds_u, int tid, int bid, int nblk) {
    asm volatile("" : "+v"(tid));
    PG8_LAS char* lds = (PG8_LAS char*)lds_u;
    constexpr int QB = S / 256, NUA = BH * 3 * 4 * QB, NUC = BH * 4 * QB, NU = NUA + NUC;
    const bf16_t* P = wsp<bf16_t>(c, OFF_P);
    for (int u = bid; u < NU; u += nblk) {
        if (u < NUA) {
            const int j = u % QB, h = (u / QB) & 3, g = (u / (QB * 4)) % 3, bl = u / (QB * 12);
            const int r = dil_of(g), L = S / r, nqb = L / 256, cc = j / nqb, qb = j % nqb, q0 = qb * 256, base = bl * S + cc * L;
            { PG8_LAS float* bt = (PG8_LAS float*)(lds + LDS_BIAS); const float* bsrc = wsp<float>(c, OFF_SMALL) + SM_BIAS + (g * 4 + h) * 129;
              for (int i = tid; i < BIAS_N; i += 512) { const int uu = i - BIAS_PAD; bt[i] = (uu >= 0 && uu <= 128) ? bsrc[uu] * LOG2E : 0.f; } }
            const int klo = q0 >= 128 ? q0 - 128 : 0, NT = (q0 + 256 - klo) / 64;
            const bf16_t* Qp = P + (size_t)(base + q0) * NP + g * 1536 + h * 128; const bf16_t* Kp = P + (size_t)(base + klo) * NP + g * 1536 + 512 + h * 128;
            attn_unit<true>(lds, Qp, NP, Kp, Kp + 512, NP, NT, q0, klo, wsp<bf16_t>(c, OFF_PART) + (size_t)g * TH * WA + h * 128, WA, wsp<float>(c, OFF_LSE) + (size_t)g * TH * 4 + h,
                            bl * S + q0 * r + cc, r, tid);
        } else {
            const int v = u - NUA, j = v % QB, h = (v / QB) & 3, bl = v / (QB * 4), b = half * BH + bl, tl0 = bl * S + j * 256;
            const bf16_t* Qp = P + (size_t)tl0 * NP + COLS_A + COLS_B + h * 128; const bf16_t* Kp = wsp<bf16_t>(c, OFF_MEMKV) + (size_t)b * MEM * 1024 + h * 128;
            attn_unit<false>(lds, Qp, NP, Kp, Kp + 512, 1024, MEM / 64, 0, 0, (bf16_t*)c.out + (size_t)half * TH * OW + WA + WB + h * 128, OW, nullptr, tl0, 1, tid);
        }
    }
}
}
namespace rowops {
typedef float f32x4 __attribute__((ext_vector_type(4)));
typedef unsigned u32x2 __attribute__((ext_vector_type(2)));
typedef unsigned u32x4 __attribute__((ext_vector_type(4)));
__device__ __forceinline__ float wave_sum(float v) {
#pragma unroll
    for (int o = 1; o < 64; o <<= 1) v += __shfl_xor(v, o);
    return v;
}
__device__ __forceinline__ unsigned pk2(float lo, float hi) { return pg8::cvt_pk_bf16(lo, hi); }

constexpr int SM_WGT = 16384, SM_CS = SM_WGT + 48 * D, SM_BW = SM_CS + 64;
static_assert((SM_BW + 64) * 4 <= (int)MiB, "small region");
__device__ __forceinline__ void router_weights_prep(const Ctx& c, int tid, int bid, int nblk) {
    const int lane = tid & 63, gw = bid * 8 + (tid >> 6), NGW = nblk * 8; float* sm = wsp<float>(c, OFF_SMALL);
    for (int col = gw; col < 48; col += NGW) { float cs = 0.f, bw = 0.f;
        for (int i = lane; i < D; i += 64) { const float w = col < 4 ? c.w_rg[i * 4 + col] : (col < 36 ? c.w_re[i * 32 + col - 4] : 0.f); const float gwv = c.ln1_g[i] * w; sm[SM_WGT + col * D + i] = gwv; cs += gwv; bw += c.ln1_b[i] * w; }
        cs = wave_sum(cs); bw = wave_sum(bw);
        if (lane == 0) { sm[SM_CS + col] = cs; sm[SM_BW + col] = bw + (col < 4 ? c.b_rg[col] : (col < 36 ? c.b_re[col - 4] : 0.f)); } }
}
template <bool DRY> __device__ __forceinline__ void ln1_router_phase(const Ctx& c, PG8_LAS unsigned char* lds, int tid, int bid, int nblk) {
    asm volatile("" : "+v"(tid));
    const int lane = tid & 63, wid = tid >> 6, l15 = lane & 15, lq = lane >> 4, gw = bid * 8 + wid, NGW = nblk * 8;
    PG8_LAS int* lh = (PG8_LAS int*)lds; PG8_LAS int* asg = lh + 64; PG8_LAS float* lg = (PG8_LAS float*)(lds + 4096) + wid * (16 * 48);
    if (tid < 64) lh[tid] = 0;
    __syncthreads();
    float* H1 = wsp<float>(c, OFF_H1); bf16_t* X1B = wsp<bf16_t>(c, OFF_X1B); const float* sm = wsp<float>(c, OFF_SMALL);
    unsigned* cnt = wsp<unsigned>(c, OFF_CTL) + CW_CNT; int* list = wsp<int>(c, OFF_LIST); float* rw = wsp<float>(c, OFF_RW);
    int ngrp = 0;
    for (int g0 = gw * 16; g0 < T; g0 += NGW * 16, ++ngrp) {
        float my_mean = 0.f, my_rstd = 0.f;
#pragma unroll 4
        for (int r = 0; r < 16; ++r) { const f32x4* hp = (const f32x4*)(H1 + (size_t)(g0 + r) * D) + lane; f32x4 v[4]; float s = 0.f;
#pragma unroll
            for (int j = 0; j < 4; ++j) { v[j] = hp[64 * j]; s += (v[j][0] + v[j][1]) + (v[j][2] + v[j][3]); }
            const float mean = wave_sum(s) * (1.f / D); float s2 = 0.f;
#pragma unroll
            for (int j = 0; j < 4; ++j) { v[j] = v[j] - mean; s2 += (v[j][0] * v[j][0] + v[j][1] * v[j][1]) + (v[j][2] * v[j][2] + v[j][3] * v[j][3]); }
            const float rstd = 1.f / sqrtf(wave_sum(s2) * (1.f / D) + LN_EPS);
            if (lane == r) { my_mean = mean; my_rstd = rstd; } }
        f32x4 acc0 = {0.f, 0.f, 0.f, 0.f}, acc1 = acc0, acc2 = acc0;
        { const float* ap = H1 + (size_t)(g0 + l15) * D + 4 * lq; const float* bp = sm + SM_WGT + (size_t)l15 * D + 4 * lq;
#pragma unroll 4
          for (int st = 0; st < D / 16; ++st) { const f32x4 a = *(const f32x4*)(ap + 16 * st), b0 = *(const f32x4*)(bp + 16 * st), b1 = *(const f32x4*)(bp + 16 * D + 16 * st), b2 = *(const f32x4*)(bp + 32 * D + 16 * st);
#pragma unroll
              for (int j = 0; j < 4; ++j) { acc0 = __builtin_amdgcn_mfma_f32_16x16x4f32(a[j], b0[j], acc0, 0, 0, 0); acc1 = __builtin_amdgcn_mfma_f32_16x16x4f32(a[j], b1[j], acc1, 0, 0, 0); acc2 = __builtin_amdgcn_mfma_f32_16x16x4f32(a[j], b2[j], acc2, 0, 0, 0); } } }
#pragma unroll
        for (int i = 0; i < 4; ++i) { lg[(lq * 4 + i) * 48 + l15] = acc0[i]; lg[(lq * 4 + i) * 48 + 16 + l15] = acc1[i]; lg[(lq * 4 + i) * 48 + 32 + l15] = acc2[i]; }
        asm volatile("s_waitcnt lgkmcnt(0)" ::: "memory");
        if (lane < 16) { const PG8_LAS float* lr = lg + lane * 48; float gl[4], gm; int gs = 0;
#pragma unroll
            for (int g = 0; g < 4; ++g) gl[g] = my_rstd * (lr[g] - my_mean * sm[SM_CS + g]) + sm[SM_BW + g];
            gm = gl[0];
#pragma unroll
            for (int g = 1; g < 4; ++g) if (gl[g] > gm) { gm = gl[g]; gs = g; }
            const float gp = 1.f / (__expf(gl[0] - gm) + __expf(gl[1] - gm) + __expf(gl[2] - gm) + __expf(gl[3] - gm));
            float v0 = -INFINITY, v1 = -INFINITY; int i0 = 0, i1 = 0;
            for (int j = 0; j < 8; ++j) { const int col = 4 + gs * 8 + j; const float x = my_rstd * (lr[col] - my_mean * sm[SM_CS + col]) + sm[SM_BW + col];
                if (x > v0) { v1 = v0; i1 = i0; v0 = x; i0 = j; } else if (x > v1) { v1 = x; i1 = j; } }
            const float e1 = __expf(v1 - v0), w0 = gp / (1.f + e1), w1 = gp * e1 / (1.f + e1); const int ea = gs * 8 + i0, eb = gs * 8 + i1, row = g0 + lane;
            const int ra = __hip_atomic_fetch_add(lh + ea, 1, __ATOMIC_RELAXED, __HIP_MEMORY_SCOPE_WORKGROUP), rb = __hip_atomic_fetch_add(lh + eb, 1, __ATOMIC_RELAXED, __HIP_MEMORY_SCOPE_WORKGROUP);
            PG8_LAS int* a = asg + (wid * 16 + lane) * 4; a[0] = row; a[1] = ea | (ra << 8); a[2] = eb | (rb << 8);
            if (!DRY) { rw[row * 2] = w0; rw[row * 2 + 1] = w1; } }
        f32x4 gv[4], bv[4];
#pragma unroll
        for (int j = 0; j < 4; ++j) { gv[j] = *(const f32x4*)(c.ln1_g + 4 * lane + 256 * j); bv[j] = *(const f32x4*)(c.ln1_b + 4 * lane + 256 * j); }
#pragma unroll 4
        for (int r = 0; r < 16; ++r) { const float mean = __shfl(my_mean, r), rstd = __shfl(my_rstd, r); f32x4* hp = (f32x4*)(H1 + (size_t)(g0 + r) * D) + lane;
#pragma unroll
            for (int j = 0; j < 4; ++j) { const f32x4 v = (hp[64 * j] - mean) * rstd * gv[j] + bv[j]; if (!DRY) hp[64 * j] = v;
                u32x2 w; w.x = pk2(v[0], v[1]); w.y = pk2(v[2], v[3]); if (!DRY) *((u32x2*)(X1B + (size_t)(g0 + r) * D) + lane + 64 * j) = w; } }
    }
    __syncthreads();
    if (DRY) return;
    if (tid < 32) lh[32 + tid] = (int)atomicAdd(cnt + tid, (unsigned)lh[tid]);
    __syncthreads();
    if (lane < 16 && ngrp > 0) { const PG8_LAS int* a = asg + (wid * 16 + lane) * 4; const int row = a[0], xa = a[1], xb = a[2];
        list[(size_t)(xa & 255) * T + lh[32 + (xa & 255)] + (xa >> 8)] = row * 2; list[(size_t)(xb & 255) * T + lh[32 + (xb & 255)] + (xb >> 8)] = row * 2 + 1; }
    __syncthreads();
}
__device__ __forceinline__ void ln2_phase(const Ctx& c, int tid, int bid, int nblk) {
    asm volatile("" : "+v"(tid));
    const int lane = tid & 63, wid = tid >> 6, gw = bid * 8 + wid, NGW = nblk * 8;
    const float* X1 = wsp<float>(c, OFF_H1); const bf16_t* Y0 = wsp<bf16_t>(c, OFF_Y0); const bf16_t* Y1 = wsp<bf16_t>(c, OFF_Y1); const float* rw = wsp<float>(c, OFF_RW);
    f32x4 gv[4], bv[4];
#pragma unroll
    for (int j = 0; j < 4; ++j) { gv[j] = *(const f32x4*)(c.ln2_g + 4 * lane + 256 * j); bv[j] = *(const f32x4*)(c.ln2_b + 4 * lane + 256 * j); }
    for (int row = gw; row < T; row += NGW) {
        const f32x4* xp = (const f32x4*)(X1 + (size_t)row * D) + lane; const u32x2* y0p = (const u32x2*)(Y0 + (size_t)row * D) + lane; const u32x2* y1p = (const u32x2*)(Y1 + (size_t)row * D) + lane;
        const float w0 = rw[row * 2], w1 = rw[row * 2 + 1]; f32x4 v[4]; float s = 0.f;
#pragma unroll
        for (int j = 0; j < 4; ++j) { const f32x4 x = xp[64 * j]; const u32x2 a = y0p[64 * j], b = y1p[64 * j];
            v[j][0] = DN_ALPHA * x[0] + w0 * bflo(a.x) + w1 * bflo(b.x); v[j][1] = DN_ALPHA * x[1] + w0 * bfhi(a.x) + w1 * bfhi(b.x);
            v[j][2] = DN_ALPHA * x[2] + w0 * bflo(a.y) + w1 * bflo(b.y); v[j][3] = DN_ALPHA * x[3] + w0 * bfhi(a.y) + w1 * bfhi(b.y);
            s += (v[j][0] + v[j][1]) + (v[j][2] + v[j][3]); }
        const float mean = wave_sum(s) * (1.f / D); float s2 = 0.f;
#pragma unroll
        for (int j = 0; j < 4; ++j) { v[j] = v[j] - mean; s2 += (v[j][0] * v[j][0] + v[j][1] * v[j][1]) + (v[j][2] * v[j][2] + v[j][3] * v[j][3]); }
        const float rstd = 1.f / sqrtf(wave_sum(s2) * (1.f / D) + LN_EPS);
        f32x4* op = (f32x4*)(c.out + (size_t)row * D) + lane;
#pragma unroll
        for (int j = 0; j < 4; ++j) op[64 * j] = v[j] * rstd * gv[j] + bv[j];
    }
}
__device__ __forceinline__ void transpose_item(const float* W, int N, bf16_t* Wt, size_t ldo, PG8_LAS float* scr, int k0, int n0, int lane) {
#pragma unroll 8
    for (int i = 0; i < 32; ++i) { const int kk = 2 * i + (lane >> 5); scr[kk * 33 + (lane & 31)] = W[(size_t)(k0 + kk) * N + n0 + (lane & 31)]; }
    asm volatile("s_waitcnt lgkmcnt(0)" ::: "memory");
    const int ch = lane & 7;
#pragma unroll
    for (int j = 0; j < 4; ++j) { const int n = (lane >> 3) + 8 * j; const PG8_LAS float* s = scr + (8 * ch) * 33 + n;
        u32x4 o; o.x = pk2(s[0 * 33], s[1 * 33]); o.y = pk2(s[2 * 33], s[3 * 33]); o.z = pk2(s[4 * 33], s[5 * 33]); o.w = pk2(s[6 * 33], s[7 * 33]);
        *(u32x4*)(Wt + (size_t)n * ldo + k0 + 8 * ch) = o; }
    asm volatile("s_waitcnt lgkmcnt(0)" ::: "memory");
}
__device__ __forceinline__ void cvt_copy(const float* src, bf16_t* dst, long n, int tid, int bid, int nblk) {
    const long n8 = n / 8;
    for (long i = (long)bid * 512 + tid; i < n8; i += (long)nblk * 512) { const f32x4 a = *(const f32x4*)(src + i * 8), b = *(const f32x4*)(src + i * 8 + 4);
        u32x4 o; o.x = pk2(a[0], a[1]); o.y = pk2(a[2], a[3]); o.z = pk2(b[0], b[1]); o.w = pk2(b[2], b[3]); *(u32x4*)(dst + i * 8) = o; }
}
__device__ __forceinline__ void prologue_phase(const Ctx& c, PG8_LAS unsigned char* lds, int tid, int bid, int nblk) {
    asm volatile("" : "+v"(tid));
    const int lane = tid & 63, wid = tid >> 6, gw = bid * 8 + wid, NGW = nblk * 8;
    PG8_LAS float* scr = (PG8_LAS float*)(lds + wid * 16384);
    constexpr int I_IN = (D / 64) * (N_IN / 32), I_KV = (D / 64) * (1024 / 32), I_A = (WA / 64) * (D / 32), I_B = (WB / 64) * (D / 32), I_C = (WC / 64) * (D / 32), I_O = (D / 64) * (D / 32);
    constexpr int NIT = I_IN + I_KV + I_A + I_B + I_C + I_O;
    for (int it = gw; it < NIT; it += NGW) { int r = it;
        if (r < I_IN) { const int nb = N_IN / 32; transpose_item(c.w_in, N_IN, wsp<bf16_t>(c, WT_IN) + (size_t)(r % nb) * 32 * D, D, scr, (r / nb) * 64, (r % nb) * 32, lane); continue; } r -= I_IN;
        if (r < I_KV) { const int nb = 1024 / 32; transpose_item(c.w_kv, 1024, wsp<bf16_t>(c, WT_KV) + (size_t)(r % nb) * 32 * D, D, scr, (r / nb) * 64, (r % nb) * 32, lane); continue; } r -= I_KV;
        if (r < I_A) { const int nb = D / 32; transpose_item(c.w_a, D, wsp<bf16_t>(c, WT_A) + (size_t)(r % nb) * 32 * OW, OW, scr, (r / nb) * 64, (r % nb) * 32, lane); continue; } r -= I_A;
        if (r < I_B) { const int nb = D / 32; transpose_item(c.w_b, D, wsp<bf16_t>(c, WT_A) + WA + (size_t)(r % nb) * 32 * OW, OW, scr, (r / nb) * 64, (r % nb) * 32, lane); continue; } r -= I_B;
        if (r < I_C) { const int nb = D / 32; transpose_item(c.w_c, D, wsp<bf16_t>(c, WT_A) + WA + WB + (size_t)(r % nb) * 32 * OW, OW, scr, (r / nb) * 64, (r % nb) * 32, lane); continue; } r -= I_C;
        { const int nb = D / 32; transpose_item(c.w_out, D, wsp<bf16_t>(c, WT_OUT) + (size_t)(r % nb) * 32 * D, D, scr, (r / nb) * 64, (r % nb) * 32, lane); }
    }
    router_weights_prep(c, tid, bid, nblk);
    cvt_copy(c.x, wsp<bf16_t>(c, OFF_XB), (long)T * D, tid, bid, nblk);
    cvt_copy(c.mem, wsp<bf16_t>(c, OFF_MEMB), (long)NBATCH * MEM * D, tid, bid, nblk);
}
__device__ __forceinline__ void expert_weights_phase(const Ctx& c, PG8_LAS unsigned char* lds, int tid, int bid, int nblk) {
    asm volatile("" : "+v"(tid));
    const int lane = tid & 63, wid = tid >> 6, gw = bid * 8 + wid, NGW = nblk * 8;
    PG8_LAS float* scr = (PG8_LAS float*)(lds + wid * 16384);
    constexpr int I_G = (D / 64) * (DE / 32), I_D = (DE / 64) * (D / 32), PER_E = 2 * I_G + I_D;
    for (int it = gw; it < NE * PER_E; it += NGW) { const int e = it / PER_E; int r = it % PER_E;
        if (r < 2 * I_G) { const int up = r / I_G; r %= I_G; const int nb = DE / 32, n0 = (r % nb) * 32, k0 = (r / nb) * 64; const float* src = (up ? c.w_eu : c.w_eg) + (size_t)e * D * DE;
            transpose_item(src, DE, wsp<bf16_t>(c, OFF_WTGU) + ((size_t)e * 2 * DE + (n0 / 128) * 256 + up * 128 + n0 % 128) * D, D, scr, k0, n0, lane); }
        else { r -= 2 * I_G; const int nb = D / 32, n0 = (r % nb) * 32, k0 = (r / nb) * 64;
            transpose_item(c.w_ed + (size_t)e * DE * D, D, wsp<bf16_t>(c, OFF_WTDN) + ((size_t)e * D + n0) * DE, DE, scr, k0, n0, lane); }
    }
}
}
namespace hgrn {
typedef float f32x4 __attribute__((ext_vector_type(4)));
typedef unsigned u32x2 __attribute__((ext_vector_type(2)));
typedef unsigned u32x4 __attribute__((ext_vector_type(4)));
constexpr int QS = 272, SS = 144;
constexpr int L_QE = 0, L_KE = L_QE + 64 * QS, L_KDT = L_KE + 64 * QS, L_VT = L_KDT + 128 * SS, L_PM = L_VT + 128 * SS, L_ST = L_PM + 64 * SS, L_F32 = L_ST + 128 * QS;
constexpr int F_QTOT = 0, F_DL = 512, F_ER = 640, F_SSQ = 768, L_END = L_F32 + (768 + 512) * 4;
static_assert(L_END <= 131072, "hgrn LDS");
__device__ __forceinline__ float fexp(float x) { return __expf(fminf(fmaxf(x, -80.f), 80.f)); }
__device__ __forceinline__ bf16x8 ldfrag(const PG8_LAS char* mat, int stride, int row, int ks, int lq) { return *(const PG8_LAS bf16x8*)(mat + row * stride + ks * 64 + lq * 16); }

template <bool FULL>
__device__ __forceinline__ void hg_unit(const Ctx& c, int half, int bl, int h, int seg, PG8_LAS char* lds, int tid) {
    const int wid = __builtin_amdgcn_readfirstlane(tid >> 6), lane = tid & 63, l15 = lane & 15, lq = lane >> 4;
    const int ek = tid & 127, etq = tid >> 7;
    const int sr = tid >> 4, sc = (tid & 15) * 8;
    const int bhl = bl * HB + h;
    const bf16_t* P = wsp<bf16_t>(c, OFF_P);
    PG8_LAS float* F = (PG8_LAS float*)(lds + L_F32);
    const float lbk = wsp<float>(c, OFF_SMALL)[SM_LB + h * 128 + ek];
    float* Shat = wsp<float>(c, OFF_HG) + ((size_t)bhl * NSEG + seg) * 128 * 128;
    const int vcol = wid * 16 + l15;
    f32x4 Sacc[8];
#pragma unroll
    for (int kt = 0; kt < 8; ++kt) {
        if (FULL) {
#pragma unroll
            for (int i = 0; i < 4; ++i) Sacc[kt][i] = Shat[(size_t)(kt * 16 + lq * 4 + i) * 128 + vcol];
        } else Sacc[kt] = (f32x4){0.f, 0.f, 0.f, 0.f};
    }
    float dsum = 0.f;
    for (int ch = 0; ch < 4; ++ch) {
        int row0 = bl * S + seg * 256 + ch * 64;
        asm volatile("" : "+s"(row0));
        float lf[16], kf[16];
        { const bf16_t* fp = P + (size_t)(row0 + etq * 16) * NP + COLS_A + WB + h * 128 + ek; float run = 0.f;
#pragma unroll
          for (int j = 0; j < 16; ++j) { const float f = lbk + (1.f - lbk) * pg8::fsigmoid(bf2f(fp[(size_t)j * NP])); run += __logf(f); lf[j] = run; kf[j] = 1.f - f; }
          F[F_QTOT + etq * 128 + ek] = run; }
        { const bf16_t* vp = P + (size_t)(row0 + sr) * NP + COLS_A + 2 * WB + h * 128 + sc; const bf16x8 v0 = *(const bf16x8*)vp, v1 = *(const bf16x8*)(vp + (size_t)32 * NP);
#pragma unroll
          for (int j = 0; j < 8; ++j) { *(PG8_LAS short*)(lds + L_VT + (sc + j) * SS + sr * 2) = v0[j]; *(PG8_LAS short*)(lds + L_VT + (sc + j) * SS + (sr + 32) * 2) = v1[j]; } }
        __syncthreads();
        { const float q0 = F[F_QTOT + ek], q1 = F[F_QTOT + 128 + ek], q2 = F[F_QTOT + 256 + ek], q3 = F[F_QTOT + 384 + ek];
          const float blast = (q0 + q1) + (q2 + q3), off = etq == 0 ? 0.f : (etq == 1 ? q0 : (etq == 2 ? q0 + q1 : (q0 + q1) + q2)), r = 0.5f * blast;
          if (etq == 0) { F[F_DL + ek] = fexp(blast); F[F_ER + ek] = fexp(r); dsum += blast; }
          unsigned kd[8];
          const bf16_t* qp = P + (size_t)(row0 + etq * 16) * NP + COLS_A + h * 128 + ek;
#pragma unroll
          for (int j = 0; j < 16; ++j) { const float b = off + lf[j];
              const float kdv = kf[j] * fexp(blast - b);
              if (j & 1) kd[j >> 1] |= (unsigned)f2bf(kdv) << 16; else kd[j >> 1] = (unsigned)f2bf(kdv);
              if (FULL) { const float qr = bf2f(qp[(size_t)j * NP]); const float qs = qr * pg8::fsigmoid(qr);
                  *(PG8_LAS bf16_t*)(lds + L_QE + (etq * 16 + j) * QS + ek * 2) = f2bf(qs * fexp(b - r));
                  *(PG8_LAS bf16_t*)(lds + L_KE + (etq * 16 + j) * QS + ek * 2) = f2bf(kf[j] * fexp(r - b)); } }
          *(PG8_LAS u32x4*)(lds + L_KDT + ek * SS + etq * 32) = (u32x4){kd[0], kd[1], kd[2], kd[3]};
          *(PG8_LAS u32x4*)(lds + L_KDT + ek * SS + etq * 32 + 16) = (u32x4){kd[4], kd[5], kd[6], kd[7]}; }
        __syncthreads();
        f32x4 oacc[4];
        unsigned short graw[16];
        if (FULL) {
#pragma unroll
            for (int kt = 0; kt < 8; ++kt) { const f32x4 er = *(const PG8_LAS f32x4*)(F + F_ER + kt * 16 + lq * 4);
                u32x2 w; w.x = pg8::cvt_pk_bf16(Sacc[kt][0] * er[0], Sacc[kt][1] * er[1]); w.y = pg8::cvt_pk_bf16(Sacc[kt][2] * er[2], Sacc[kt][3] * er[3]);
                *(PG8_LAS u32x2*)(lds + L_ST + vcol * QS + (kt * 16 + lq * 4) * 2) = w; }
            { const int tt = wid & 3;
#pragma unroll
              for (int sti = 0; sti < 2; ++sti) { const int st = 2 * (wid >> 2) + sti; f32x4 a = (f32x4){0.f, 0.f, 0.f, 0.f};
#pragma unroll
                  for (int ks = 0; ks < 4; ++ks) a = __builtin_amdgcn_mfma_f32_16x16x32_bf16(ldfrag(lds + L_KE, QS, st * 16 + l15, ks, lq), ldfrag(lds + L_QE, QS, tt * 16 + l15, ks, lq), a, 0, 0, 0);
                  const int t = tt * 16 + l15, s0 = st * 16 + lq * 4;
                  u32x2 w; w.x = pg8::cvt_pk_bf16(s0 <= t ? a[0] : 0.f, s0 + 1 <= t ? a[1] : 0.f); w.y = pg8::cvt_pk_bf16(s0 + 2 <= t ? a[2] : 0.f, s0 + 3 <= t ? a[3] : 0.f);
                  *(PG8_LAS u32x2*)(lds + L_PM + t * SS + s0 * 2) = w; } }
            { const bf16_t* gp = P + (size_t)(row0 + lq * 4) * NP + COLS_A + 3 * WB + h * 128 + vcol;
#pragma unroll
              for (int mt = 0; mt < 4; ++mt)
#pragma unroll
                  for (int i = 0; i < 4; ++i) graw[mt * 4 + i] = gp[(size_t)(mt * 16 + i) * NP]; }
            __syncthreads();
        }
        const bf16x8 vb0 = ldfrag(lds + L_VT, SS, vcol, 0, lq), vb1 = ldfrag(lds + L_VT, SS, vcol, 1, lq);
        if (FULL) {
            bf16x8 sb[4];
#pragma unroll
            for (int ks = 0; ks < 4; ++ks) sb[ks] = ldfrag(lds + L_ST, QS, vcol, ks, lq);
#pragma unroll
            for (int mt = 0; mt < 4; ++mt) { f32x4 a = (f32x4){0.f, 0.f, 0.f, 0.f};
#pragma unroll
                for (int ks = 0; ks < 4; ++ks) a = __builtin_amdgcn_mfma_f32_16x16x32_bf16(ldfrag(lds + L_QE, QS, mt * 16 + l15, ks, lq), sb[ks], a, 0, 0, 0);
                a = __builtin_amdgcn_mfma_f32_16x16x32_bf16(ldfrag(lds + L_PM, SS, mt * 16 + l15, 0, lq), vb0, a, 0, 0, 0);
                a = __builtin_amdgcn_mfma_f32_16x16x32_bf16(ldfrag(lds + L_PM, SS, mt * 16 + l15, 1, lq), vb1, a, 0, 0, 0);
                oacc[mt] = a; }
        }
#pragma unroll
        for (int kt = 0; kt < 8; ++kt) { const f32x4 dl = *(const PG8_LAS f32x4*)(F + F_DL + kt * 16 + lq * 4); f32x4 a = Sacc[kt] * dl;
            a = __builtin_amdgcn_mfma_f32_16x16x32_bf16(ldfrag(lds + L_KDT, SS, kt * 16 + l15, 0, lq), vb0, a, 0, 0, 0);
            a = __builtin_amdgcn_mfma_f32_16x16x32_bf16(ldfrag(lds + L_KDT, SS, kt * 16 + l15, 1, lq), vb1, a, 0, 0, 0);
            Sacc[kt] = a; }
        if (FULL) {
#pragma unroll
            for (int mt = 0; mt < 4; ++mt)
#pragma unroll
                for (int i = 0; i < 4; ++i) { float q = oacc[mt][i] * oacc[mt][i]; q += __shfl_xor(q, 1); q += __shfl_xor(q, 2); q += __shfl_xor(q, 4); q += __shfl_xor(q, 8);
                    if (l15 == 0) F[F_SSQ + (mt * 16 + lq * 4 + i) * 8 + wid] = q; }
            __syncthreads();
            const float ng = c.norm_g[h * 128 + vcol];
            bf16_t* op = (bf16_t*)c.out + ((size_t)half * TH + row0 + lq * 4) * OW + WA + h * 128 + vcol;
#pragma unroll
            for (int mt = 0; mt < 4; ++mt)
#pragma unroll
                for (int i = 0; i < 4; ++i) { const PG8_LAS f32x4* sp = (const PG8_LAS f32x4*)(F + F_SSQ + (mt * 16 + lq * 4 + i) * 8); const f32x4 s0 = sp[0], s1 = sp[1];
                    const float ss = ((s0[0] + s0[1]) + (s0[2] + s0[3])) + ((s1[0] + s1[1]) + (s1[2] + s1[3])); const float rs = 1.f / sqrtf(ss * (1.f / 128.f) + RMS_EPS);
                    const float g = bf2f(graw[mt * 4 + i]);
                    op[(size_t)(mt * 16 + i) * OW] = f2bf(oacc[mt][i] * rs * ng * (g * pg8::fsigmoid(g))); }
        }
        __syncthreads();
    }
    if (!FULL) {
#pragma unroll
        for (int kt = 0; kt < 8; ++kt)
#pragma unroll
            for (int i = 0; i < 4; ++i) Shat[(size_t)(kt * 16 + lq * 4 + i) * 128 + vcol] = Sacc[kt][i];
        if (etq == 0) wsp<float>(c, OFF_DSEG)[((size_t)bhl * NSEG + seg) * 128 + ek] = dsum;
    }
}
template <bool FULL>
__device__ __forceinline__ void hg_phase(const Ctx& c, int half, PG8_LAS unsigned char* lds_u, int tid, int bid, int nblk) {
    asm volatile("" : "+v"(tid));
    PG8_LAS char* lds = (PG8_LAS char*)lds_u;
    constexpr int NU = BH * HB * NSEG;
    for (int u = bid; u < NU; u += nblk) { const int seg = u % NSEG, bhl = u / NSEG; hg_unit<FULL>(c, half, bhl / HB, bhl % HB, seg, lds, tid); }
}
__device__ __forceinline__ void hg_scan_phase(const Ctx& c, int tid, int bid, int nblk) {
    asm volatile("" : "+v"(tid));
    constexpr long N = (long)BH * HB * 128 * 128;
    for (long idx = (long)bid * 512 + tid; idx < N; idx += (long)nblk * 512) { const int v = (int)(idx & 127), k = (int)((idx >> 7) & 127), bhl = (int)(idx >> 14);
        float* sp = wsp<float>(c, OFF_HG) + ((size_t)bhl * NSEG * 128 + k) * 128 + v; const float* dp = wsp<float>(c, OFF_DSEG) + (size_t)bhl * NSEG * 128 + k;
        float tmp[NSEG], dd[NSEG];
#pragma unroll
        for (int sg = 0; sg < NSEG; ++sg) { tmp[sg] = sp[(size_t)sg * 128 * 128]; dd[sg] = dp[sg * 128]; }
        float run = 0.f;
#pragma unroll
        for (int sg = 0; sg < NSEG; ++sg) { const float t = tmp[sg]; tmp[sg] = run; run = __expf(dd[sg]) * run + t; }
#pragma unroll
        for (int sg = 0; sg < NSEG; ++sg) sp[(size_t)sg * 128 * 128] = tmp[sg];
    }
}
__device__ __forceinline__ void comb_phase(const Ctx& c, int half, int tid, int bid, int nblk) {
    asm volatile("" : "+v"(tid));
    constexpr long N = (long)TH * WA / 8; const float* lse = wsp<float>(c, OFF_LSE); const bf16_t* part = wsp<bf16_t>(c, OFF_PART);
    for (long idx = (long)bid * 512 + tid; idx < N; idx += (long)nblk * 512) { const int c8 = (int)(idx % (WA / 8)), tl = (int)(idx / (WA / 8)), col = c8 * 8, h = col >> 7;
        const float l0 = lse[((size_t)0 * TH + tl) * 4 + h], l1 = lse[((size_t)1 * TH + tl) * 4 + h], l2 = lse[((size_t)2 * TH + tl) * 4 + h];
        const float mx = fmaxf(l0, fmaxf(l1, l2)), e0 = __expf(l0 - mx), e1 = __expf(l1 - mx), e2 = __expf(l2 - mx), inv = 1.f / (e0 + e1 + e2), w0 = e0 * inv, w1 = e1 * inv, w2 = e2 * inv;
        f32x4 a0, a1, b0, b1, c0, c1;
        pg8::unpack8(*(const u32x4*)(part + ((size_t)0 * TH + tl) * WA + col), a0, a1); pg8::unpack8(*(const u32x4*)(part + ((size_t)1 * TH + tl) * WA + col), b0, b1); pg8::unpack8(*(const u32x4*)(part + ((size_t)2 * TH + tl) * WA + col), c0, c1);
        *(u32x4*)((bf16_t*)c.out + ((size_t)half * TH + tl) * OW + col) = pg8::pack8(a0 * w0 + b0 * w1 + c0 * w2, a1 * w0 + b1 * w1 + c1 * w2); }
}
}
#define XB_TMO      128
#define XB_XCNT(j)  (256  + 64 * (j))
#define XB_XSUB(j)  (1280 + 64 * (j))
#define XB_XGEN(j)  (2304 + 64 * (j))
#define XB_TOP      3328
#define XB_TOPGEN   3392
#define XCD_BAR_WORDS 3456
#define XB_SPIN_CAP (1u << 18)
__device__ __forceinline__ unsigned xb_ld(unsigned* p)              { return __hip_atomic_load(p, __ATOMIC_RELAXED, __HIP_MEMORY_SCOPE_AGENT); }
__device__ __forceinline__ unsigned xb_add(unsigned* p, unsigned v) { return __hip_atomic_fetch_add(p, v, __ATOMIC_RELAXED, __HIP_MEMORY_SCOPE_AGENT); }
__device__ __forceinline__ unsigned xb_xcc_id() { return (unsigned)__builtin_amdgcn_s_getreg((3 << 11) | 20) & 0xFu; }
#define XB_SPIN(cond, bar) do { unsigned _sp = 0; while (cond) { __builtin_amdgcn_s_sleep(1); \
    if ((++_sp & 255u) == 0u) { if (xb_ld(&(bar)[XB_TMO])) break; if (_sp > XB_SPIN_CAP) { atomicAdd(&(bar)[XB_TMO], 1u); break; } } } } while (0)
struct XcdBarrier { unsigned* bar; unsigned x; volatile PG8_LAS unsigned* st; };
__device__ __forceinline__ XcdBarrier xcd_barrier_post(unsigned* bar, volatile PG8_LAS unsigned* st, int tid) {
    XcdBarrier b; b.bar = bar; b.x = xb_xcc_id(); b.st = st;
    if (tid == 0) (void)xb_add(&bar[XB_XCNT(b.x)], 1u);
    return b;
}
__device__ __forceinline__ void xcd_barrier_complete(unsigned* bar, unsigned x, unsigned& nloc, unsigned& nx) {
    const unsigned G = gridDim.x * gridDim.y * gridDim.z;
    unsigned sum, cnt, mine, sp = 0u;
    for (;;) {
        sum = 0u; cnt = 0u; mine = 0u;
#pragma unroll
        for (unsigned j = 0; j < 16; ++j) { const unsigned c = xb_ld(&bar[XB_XCNT(j)]); sum += c; cnt += (c > 0u) ? 1u : 0u; mine = (j == x) ? c : mine; }
        if (sum == G) break;
        __builtin_amdgcn_s_sleep(1);
        if ((++sp & 255u) == 0u) { if (xb_ld(&bar[XB_TMO])) break; if (sp > XB_SPIN_CAP) { atomicAdd(&bar[XB_TMO], 1u); break; } }
    }
    nloc = mine > 0u ? mine : 1u; nx = cnt > 0u ? cnt : 1u;
}
__device__ __forceinline__ void xcd_barrier(const XcdBarrier& b, int tid) {
    asm volatile("s_waitcnt vmcnt(0)" ::: "memory");
    __syncthreads();
    if (tid == 0) {
        unsigned* bar = b.bar;
        __builtin_amdgcn_s_waitcnt(0);
        unsigned nloc = b.st[0], nx = b.st[1];
        if (nloc == 0u) { xcd_barrier_complete(bar, b.x, nloc, nx); b.st[0] = nloc; b.st[1] = nx; }
        const unsigned old = xb_add(&bar[XB_XSUB(b.x)], 1u);
        const unsigned gen = old / nloc;
        if (old + 1u == (gen + 1u) * nloc) {
            __builtin_amdgcn_fence(__ATOMIC_RELEASE, "agent");
            asm volatile("s_waitcnt vmcnt(0)" ::: "memory");
            const unsigned og = xb_add(&bar[XB_TOP], 1u);
            const unsigned tg = og / nx;
            if (og + 1u == (tg + 1u) * nx) xb_add(&bar[XB_TOPGEN], 1u);
            else XB_SPIN(xb_ld(&bar[XB_TOPGEN]) == tg, bar);
            __builtin_amdgcn_fence(__ATOMIC_ACQUIRE, "agent");
            xb_add(&bar[XB_XGEN(b.x)], 1u);
            asm volatile("s_waitcnt vmcnt(0)" ::: "memory");
        } else {
            XB_SPIN(xb_ld(&bar[XB_XGEN(b.x)]) == gen, bar);
            __builtin_amdgcn_fence(__ATOMIC_ACQUIRE, "agent");
            asm volatile("s_waitcnt vmcnt(0)" ::: "memory");
        }
    }
    __syncthreads();
}
#include <hip/hip_cooperative_groups.h>
namespace cg = cooperative_groups;
constexpr int NTHR = 512, LDS_BYTES = 147456;

template <class F> __device__ __forceinline__ void dev_elems_(const F& f, long n, int tid, int bid, int nblk) {
    asm volatile("" : "+v"(tid));
    for (long i = (long)bid * NTHR + tid; i < n; i += (long)nblk * NTHR) f(i);
}
template <class G> __device__ __forceinline__ void dev_sgemm_(const G& g, int tid, int bid, int nblk) {
    asm volatile("" : "+v"(tid));
    const int M = g.M(); const int lane = tid & 63, wid = tid >> 6; constexpr int ntn = G::N / 64;
    const long ntiles = (long)(M / 16) * ntn;
    for (long tile = (long)bid * 8 + wid; tile < ntiles; tile += (long)nblk * 8) {
        const int tm = (int)(tile / ntn), tn = (int)(tile % ntn), r0 = tm * 16, c0 = tn * 64;
        f32x4 acc[G::NBP][4], carry[4];
#pragma unroll
        for (int j = 0; j < 4; ++j) { carry[j] = (f32x4){0.f, 0.f, 0.f, 0.f};
#pragma unroll
            for (int w = 0; w < G::NBP; ++w) acc[w][j] = (f32x4){0.f, 0.f, 0.f, 0.f}; }
#pragma unroll
        for (int seg = 0; seg < G::NSEGS; ++seg) {
            const bf16_t* ar = g.arow(seg, r0 + (lane & 15)) + 8 * (lane >> 4); const bf16_t* br[G::NBP][4];
#pragma unroll
            for (int w = 0; w < G::NBP; ++w)
#pragma unroll
                for (int j = 0; j < 4; ++j) br[w][j] = g.brow(seg, r0, c0 + 16 * j + (lane & 15), w) + 8 * (lane >> 4);
            const int K = g.K(seg);
            for (int k0 = 0; k0 < K; k0 += 32) { const bf16x8 a = *(const bf16x8*)(ar + k0);
#pragma unroll
                for (int w = 0; w < G::NBP; ++w)
#pragma unroll
                    for (int j = 0; j < 4; ++j) { const bf16x8 b = *(const bf16x8*)(br[w][j] + k0); acc[w][j] = __builtin_amdgcn_mfma_f32_16x16x32_bf16(a, b, acc[w][j], 0, 0, 0); } }
#pragma unroll
            for (int j = 0; j < 4; ++j)
#pragma unroll
                for (int i = 0; i < 4; ++i) { float a = acc[0][j][i], cr = carry[j][i]; g.between(seg, r0 + (lane >> 4) * 4 + i, c0 + 16 * j + (lane & 15), a, cr); acc[0][j][i] = a; carry[j][i] = cr; }
        }
#pragma unroll
        for (int j = 0; j < 4; ++j)
#pragma unroll
            for (int i = 0; i < 4; ++i) g.store(r0 + (lane >> 4) * 4 + i, c0 + 16 * j + (lane & 15), acc[0][j][i], G::NBP == 2 ? acc[G::NBP - 1][j][i] : carry[j][i]);
    }
}

struct E_hg3q { Ctx c; int half; static constexpr long n = (long)BH * HB * NSEG * 128 * 4;
    __device__ __forceinline__ void operator()(long idx) const { const int kq = (int)(idx & 3), v = (int)((idx >> 2) & 127); const long r = idx >> 9; const int seg = (int)(r % NSEG), bhl = (int)(r / NSEG), h = bhl % HB, bl = bhl / HB;
        const bf16_t* P = wsp<bf16_t>(c, OFF_P); float st[32];
#pragma unroll
        for (int k = 0; k < 32; ++k) st[k] = wsp<float>(c, OFF_HG)[(((size_t)bhl * NSEG + seg) * 128 + kq * 32 + k) * 128 + v];
        for (int s = 0; s < 256; ++s) { const int tl = bl * S + seg * 256 + s; const bf16_t* pr = P + (size_t)tl * NP; const float iv = bf2f(pr[COLS_A + 2 * WB + h * 128 + v]); float o = 0.f;
#pragma unroll
            for (int k = 0; k < 32; ++k) { const int kk = kq * 32 + k; const float f = hg_f(c, pr, h * 128 + kk); st[k] = f * st[k] + (1.f - f) * iv; o += siluf_(bf2f(pr[COLS_A + h * 128 + kk])) * st[k]; }
            o += __shfl_xor(o, 1); o += __shfl_xor(o, 2);
            if (kq == 0) ((bf16_t*)c.out)[((size_t)half * TH + tl) * OW + WA + h * 128 + v] = f2bf(o); } } };

typedef const __attribute__((address_space(4))) Ctx* CtxK;
#if defined(__HIP_DEVICE_COMPILE__)
__device__ __forceinline__ Ctx load_ctx() { CtxK p = (CtxK)__builtin_amdgcn_kernarg_segment_ptr(); asm volatile("" : "+s"(p)); return *p; }
#else
__device__ inline Ctx load_ctx() { return Ctx(); }
#endif
#define PH_BEGIN { const Ctx c = load_ctx(); const int tid = wid_s * 64 + pg8::lane_id_opaque(); int bid = blockIdx.x, nblk = gridDim.x; asm volatile("" : "+s"(bid), "+s"(nblk));
#define dev_elems(...) dev_elems_(__VA_ARGS__, tid, bid, nblk)
#define dev_sgemm(...) dev_sgemm_(__VA_ARGS__, tid, bid, nblk)
#define PH_END }
#ifndef DUP
#define DUP -1
#endif
#define GSYNC() do { xcd_barrier(xbar, tid_k); if (DUP == 20) xcd_barrier(xbar, tid_k); } while (0)
#define REP(k) for (int rep_ = 0; rep_ < ((DUP == (k)) ? 2 : 1); ++rep_)

__global__ void __launch_bounds__(NTHR) mega(Ctx c_arg) {
    extern __shared__ __attribute__((aligned(16))) unsigned char lds_raw[];
    PG8_LAS unsigned char* lds = (PG8_LAS unsigned char*)lds_raw;
    cg::grid_group grid = cg::this_grid();
    const int wid_s = __builtin_amdgcn_readfirstlane((int)threadIdx.x >> 6);
    volatile PG8_LAS unsigned* bst = (volatile PG8_LAS unsigned*)(lds + LDS_MISC);
    if (threadIdx.x == 0) { bst[0] = 0u; bst[1] = 0u; }
    __syncthreads();
    const XcdBarrier xbar = xcd_barrier_post(wsp<unsigned>(c_arg, OFF_CTL) + 4096, bst, (int)threadIdx.x);
#define tid_k (wid_s * 64 + pg8::lane_id_opaque())
    PH_BEGIN
    dev_elems(S0_small{c}, S0_small::n); REP(0) rowops::prologue_phase(c, lds, tid, bid, nblk);
    PH_END
    grid.sync();
#pragma unroll
    for (int half = 0; half < NHALF; ++half) {
        PH_BEGIN
        REP(1) fast_proj(c, half, lds, tid, bid, nblk);
        PH_END
        GSYNC();
        PH_BEGIN
        if (half == 0) fast_memkv(c, lds, tid, bid, nblk);
        REP(2) hgrn::hg_phase<false>(c, half, lds, tid, bid, nblk);
        PH_END
        GSYNC();
        PH_BEGIN
        hgrn::hg_scan_phase(c, tid, bid, nblk); REP(3) attn::attn_phase(c, half, lds, tid, bid, nblk);
        PH_END
        GSYNC();
        PH_BEGIN
        REP(4) hgrn::hg_phase<true>(c, half, lds, tid, bid, nblk); REP(12) hgrn::comb_phase(c, half, tid, bid, nblk);
        PH_END
        GSYNC();
    }
    PH_BEGIN
    REP(13) { rowops::expert_weights_phase(c, lds, tid, bid, nblk); __syncthreads(); } REP(5) fast_gates(c, lds, tid, bid, nblk);
    PH_END
    GSYNC();
    PH_BEGIN
    REP(6) fast_merge(c, lds, tid, bid, nblk);
    PH_END
    GSYNC();
    PH_BEGIN
    REP(7) fast_wout(c, lds, tid, bid, nblk);
    PH_END
    GSYNC();
    PH_BEGIN
    rowops::ln1_router_phase<false>(c, lds, tid, bid, nblk); if (DUP == 8) { __syncthreads(); rowops::ln1_router_phase<true>(c, lds, tid, bid, nblk); }
    PH_END
    GSYNC();
    PH_BEGIN
    REP(9) fast_moe1(c, lds, tid, bid, nblk);
    PH_END
    GSYNC();
    PH_BEGIN
    REP(10) fast_moe2(c, lds, tid, bid, nblk);
    PH_END
    GSYNC();
    PH_BEGIN
    REP(11) rowops::ln2_phase(c, tid, bid, nblk);
    PH_END
}

extern "C" void kernel_launch(void* const* d_in, const int* in_sizes, int n_in, void* d_out, int out_size, void* d_ws, size_t ws_size, hipStream_t stream) {
    if (n_in != 22 || in_sizes[0] != T * D || out_size != T * D || ws_size < WS_END) { fprintf(stderr, "kernel_launch: unexpected shapes / workspace (%zu < %zu)\n", ws_size, (size_t)WS_END); return; }
    static int grid_blocks = 0;
    if (!grid_blocks) {
        int dev = 0, cus = 0, per_cu = 0;
        hipGetDevice(&dev); hipDeviceGetAttribute(&cus, hipDeviceAttributeMultiprocessorCount, dev);
        hipFuncSetAttribute((const void*)mega, hipFuncAttributeMaxDynamicSharedMemorySize, LDS_BYTES);
        hipOccupancyMaxActiveBlocksPerMultiprocessor(&per_cu, (const void*)mega, NTHR, LDS_BYTES);
        if (per_cu < 1) { fprintf(stderr, "kernel_launch: occupancy query says %d blocks/CU\n", per_cu); per_cu = 1; }
        if (per_cu > 1) per_cu = 1;
        grid_blocks = cus * per_cu;
    }
    Ctx c = make_ctx(d_in, d_out, d_ws);
    hipMemsetAsync((char*)d_ws + OFF_CTL, 0, 65536, stream);
    void* args[] = {&c};
    hipError_t e = hipLaunchCooperativeKernel((const void*)mega, dim3(grid_blocks), dim3(NTHR), args, LDS_BYTES, stream);
    if (e != hipSuccess) fprintf(stderr, "cooperative launch failed: %s (grid %d)\n", hipGetErrorString(e), grid_blocks);
}
```

```cpp
#ifdef HOST_TEST
#include <cmath>
#include <cstdint>
#include <cstdio>
#include <cstring>
#define HD
#define GLOBAL
#else
#include <hip/hip_runtime.h>
#include <cstdint>
#include <cstdio>
#include <cstring>
#include <cmath>
#define HD __host__ __device__ __forceinline__
#endif

#ifndef CFG_D
#define CFG_D 1024
#define CFG_B 4
#define CFG_S 8192
#endif
typedef unsigned short bf16_t;
constexpr int D = CFG_D, NBATCH = CFG_B, S = CFG_S, T = NBATCH * S;
constexpr int NHALF = 2, TH = T / NHALF, BH = NBATCH / NHALF;
constexpr int WA = 512, HB = D / 128, WB = D, WC = 512;
constexpr int COLS_A = 4608, COLS_B = 4 * WB, COLS_C = 512, COLS_G = 3 * D;
constexpr int NP = COLS_A + COLS_B + COLS_C, N_IN = NP + COLS_G;
constexpr int OW = WA + WB + WC;
constexpr int DE = D / 4, NE = 32, HBK = DE < 128 ? DE : 128;
constexpr int MEM = 256, NSEG = S / 256;
constexpr int MAXROWS = 2 * T + NE * 256;
constexpr float DN_ALPHA = 1.189207115002721f;
constexpr float LN_EPS = 1e-5f, RMS_EPS = 1e-6f;
constexpr float QK_SCALE = 0.08838834764831845f;

constexpr size_t MiB = 1u << 20;
constexpr size_t al(size_t x) { return (x + 4095) & ~(size_t)4095; }
constexpr size_t OFF_CTL = 0;
constexpr size_t OFF_SMALL = 1 * MiB;
constexpr size_t OFF_WT = 2 * MiB;
constexpr size_t WT_IN = OFF_WT, WT_KV = WT_IN + al((size_t)N_IN * D * 2), WT_A = WT_KV + al((size_t)1024 * D * 2),
                 WT_B = WT_A + al((size_t)D * WA * 2), WT_C = WT_B + al((size_t)D * WB * 2), WT_OUT = WT_C + al((size_t)D * WC * 2),
                 OFF_MEMB = WT_OUT + al((size_t)D * D * 2), OFF_MEMKV = OFF_MEMB + al((size_t)NBATCH * MEM * D * 2),
                 OFF_LIST = OFF_MEMKV + al((size_t)NBATCH * MEM * 1024 * 2), OFF_RW = OFF_LIST + al((size_t)NE * T * 4),
                 OFF_XB = OFF_RW + al((size_t)T * 2 * 4), OFF_P = OFF_XB + al((size_t)T * D * 2),
                 OFF_PART = OFF_P + al((size_t)TH * NP * 2), OFF_LSE = OFF_PART + al((size_t)3 * TH * WA * 2),
                 OFF_HG = OFF_LSE + al((size_t)3 * TH * 4 * 4), OFF_DSEG = OFF_HG + al((size_t)BH * HB * NSEG * 128 * 128 * 4),
                 WS_END = OFF_DSEG + al((size_t)BH * HB * NSEG * 128 * 4);
constexpr size_t OFF_GATES = OFF_P, OFF_H1 = OFF_P, OFF_X1B = OFF_P + al((size_t)T * D * 4),
                 OFF_WTGU = OFF_P + al((size_t)T * 3 * D * 2), OFF_WTDN = OFF_WTGU + al((size_t)NE * 2 * DE * D * 2),
                 OFF_HBUF = OFF_WTDN + al((size_t)NE * D * DE * 2), OFF_PEND = OFF_HBUF + al((size_t)MAXROWS * DE * 2);
constexpr size_t OFF_MERGED = OFF_XB, OFF_Y0 = OFF_XB, OFF_Y1 = OFF_PART;
static_assert(OFF_X1B + (size_t)T * D * 2 <= OFF_WTGU, "x1b inside dead gates region");
static_assert(OFF_PEND <= OFF_PART, "P-region overlays fit");
static_assert(OFF_Y1 + (size_t)T * D * 2 <= WS_END, "y1 fits in part+hg region");
constexpr int CW_CNT = 0;
constexpr int SM_BIAS = 0, SM_LB = 2048, SM_BLK = 2048 + 4096;

HD float bf2f(bf16_t v) { union { unsigned u; float f; } c; c.u = (unsigned)v << 16; return c.f; }
HD bf16_t f2bf(float f) { union { unsigned u; float f; } c; c.f = f; unsigned u = c.u; return (bf16_t)((u + 0x7fffu + ((u >> 16) & 1u)) >> 16); }
HD float sigmoidf_(float x) { return 1.0f / (1.0f + expf(-x)); }
HD float siluf_(float x) { return x / (1.0f + expf(-x)); }
HD int dil_of(int g) { return g == 0 ? 1 : (g == 1 ? 4 : 16); }
HD int perm_row(int tl, int g) { const int r = dil_of(g), bl = tl / S, s = tl % S; return bl * S + (s % r) * (S / r) + s / r; }

struct Ctx {
    const float *x, *mem, *rel_bias, *lb_logits, *w_in, *w_kv, *norm_g, *w_a, *w_b, *w_c, *w_out, *ln1_g, *ln1_b, *w_rg, *b_rg, *w_re, *b_re, *w_eg, *w_eu, *w_ed, *ln2_g, *ln2_b;
    float* out; unsigned char* ws;
};
#ifdef HOST_TEST
static const unsigned char T5_BUCKET[3][129] = {
#else
__device__ const unsigned char T5_BUCKET[3][129] = {
#endif
{0,1,2,3,4,5,6,7,8,9,10,11,12,13,14,15,16,16,16,16,16,16,17,17,17,17,17,17,17,17,18,18,18,18,18,18,18,18,18,18,19,19,19,19,19,19,19,19,19,19,19,19,19,19,20,20,20,20,20,20,20,20,20,20,20,20,20,20,20,20,20,20,20,21,21,21,21,21,21,21,21,21,21,21,21,21,21,21,21,21,21,21,21,21,21,21,21,21,21,22,22,22,22,22,22,22,22,22,22,22,22,22,22,22,22,22,22,22,22,22,22,22,22,22,22,22,22,22,22},
{0,4,8,12,16,16,17,17,18,18,19,19,19,19,20,20,20,20,20,21,21,21,21,21,21,22,22,22,22,22,22,22,22,22,23,23,23,23,23,23,23,23,23,23,23,23,24,24,24,24,24,24,24,24,24,24,24,24,24,24,24,24,25,25,25,25,25,25,25,25,25,25,25,25,25,25,25,25,25,25,25,25,25,26,26,26,26,26,26,26,26,26,26,26,26,26,26,26,26,26,26,26,26,26,26,26,26,26,26,26,26,26,26,27,27,27,27,27,27,27,27,27,27,27,27,27,27,27,27},
{0,16,18,19,20,21,21,22,22,23,23,23,24,24,24,24,25,25,25,25,25,26,26,26,26,26,26,26,26,27,27,27,27,27,27,27,27,27,27,28,28,28,28,28,28,28,28,28,28,28,28,28,29,29,29,29,29,29,29,29,29,29,29,29,29,29,29,29,29,29,30,30,30,30,30,30,30,30,30,30,30,30,30,30,30,30,30,30,30,30,30,30,30,30,30,31,31,31,31,31,31,31,31,31,31,31,31,31,31,31,31,31,31,31,31,31,31,31,31,31,31,31,31,31,31,31,31,31,31}};
template <class Tp> HD Tp* wsp(const Ctx& c, size_t off) { return (Tp*)(c.ws + off); }

#ifdef HOST_TEST
static inline unsigned atomic_inc_u32(unsigned* p) { unsigned r;
#pragma omp atomic capture
    { r = *p; *p += 1; }
    return r; }
#else
__device__ __forceinline__ unsigned atomic_inc_u32(unsigned* p) { return atomicAdd(p, 1u); }
#endif

struct S0_xb { Ctx c; static constexpr long n = (long)T * D;
    HD void operator()(long i) const { wsp<bf16_t>(c, OFF_XB)[i] = f2bf(c.x[i]); } };
struct S0_memb { Ctx c; static constexpr long n = (long)NBATCH * MEM * D;
    HD void operator()(long i) const { wsp<bf16_t>(c, OFF_MEMB)[i] = f2bf(c.mem[i]); } };
struct S0_tr { const float* W; bf16_t* Wt; int K, N; long n; int ldo;
    HD void operator()(long i) const { const int k = (int)(i % K); const long nn = i / K; Wt[(size_t)nn * ldo + k] = f2bf(W[(size_t)k * N + nn]); } };
struct S0_gu { Ctx c; static constexpr long n = (long)NE * 2 * DE * D;
    HD void operator()(long i) const { const int k = (int)(i % D); const long r = i / D; const int j = (int)(r % (2 * DE)), e = (int)(r / (2 * DE));
        const int u = j / (2 * HBK), w = j % (2 * HBK), hid = u * HBK + w % HBK, up = w / HBK;
        const float* src = up ? c.w_eu : c.w_eg; wsp<bf16_t>(c, OFF_WTGU)[i] = f2bf(src[((size_t)e * D + k) * DE + hid]); } };
struct S0_dn { Ctx c; static constexpr long n = (long)NE * D * DE;
    HD void operator()(long i) const { const int k = (int)(i % DE); const long r = i / DE; const int col = (int)(r % D), e = (int)(r / D);
        wsp<bf16_t>(c, OFF_WTDN)[i] = f2bf(c.w_ed[((size_t)e * DE + k) * D + col]); } };
struct S0_small { Ctx c; static constexpr long n = 12 * 129 + WB + 64;
    HD void operator()(long i) const { float* sm = wsp<float>(c, OFF_SMALL);
        if (i < 12 * 129) { const int gh = (int)(i / 129), u = (int)(i % 129), g = gh / 4; sm[SM_BIAS + i] = c.rel_bias[T5_BUCKET[g][u] * 12 + gh]; }
        else if (i < 12 * 129 + WB) { const int ch = (int)(i - 12 * 129); sm[SM_LB + ch] = sigmoidf_(c.lb_logits[ch] - c.lb_logits[WB + ch]); }
        else { const int j = (int)(i - 12 * 129 - WB); wsp<unsigned>(c, OFF_CTL)[j] = 0u; } } };

struct G_proj { Ctx c; int half; static constexpr int N = NP, NSEGS = 1, NBP = 1;
    HD int M() const { return TH; } HD int K(int) const { return D; }
    HD const bf16_t* arow(int, int row) const { return wsp<bf16_t>(c, OFF_XB) + ((size_t)half * TH + row) * D; }
    HD const bf16_t* brow(int, int, int col, int) const { return wsp<bf16_t>(c, WT_IN) + (size_t)col * D; }
    HD void between(int, int, int, float&, float&) const {}
    HD void store(int row, int col, float a, float) const { const int pr = col < COLS_A ? perm_row(row, col / 1536) : row; wsp<bf16_t>(c, OFF_P)[(size_t)pr * NP + col] = f2bf(a); } };
struct G_memkv { Ctx c; static constexpr int N = 1024, NSEGS = 1, NBP = 1;
    HD int M() const { return NBATCH * MEM; } HD int K(int) const { return D; }
    HD const bf16_t* arow(int, int row) const { return wsp<bf16_t>(c, OFF_MEMB) + (size_t)row * D; }
    HD const bf16_t* brow(int, int, int col, int) const { return wsp<bf16_t>(c, WT_KV) + (size_t)col * D; }
    HD void between(int, int, int, float&, float&) const {}
    HD void store(int row, int col, float a, float) const { wsp<bf16_t>(c, OFF_MEMKV)[(size_t)row * 1024 + col] = f2bf(a); } };
struct G_gates { Ctx c; static constexpr int N = 3 * D, NSEGS = 1, NBP = 1;
    HD int M() const { return T; } HD int K(int) const { return D; }
    HD const bf16_t* arow(int, int row) const { return wsp<bf16_t>(c, OFF_XB) + (size_t)row * D; }
    HD const bf16_t* brow(int, int, int col, int) const { return wsp<bf16_t>(c, WT_IN) + (size_t)(NP + col) * D; }
    HD void between(int, int, int, float&, float&) const {}
    HD void store(int row, int col, float a, float) const { wsp<bf16_t>(c, OFF_GATES)[((size_t)(col / D) * T + row) * D + col % D] = f2bf(sigmoidf_(a)); } };
struct G_merge { Ctx c; static constexpr int N = D, NSEGS = 3, NBP = 1;
    HD int M() const { return T; } HD int K(int s) const { return s == 1 ? WB : 512; }
    HD const bf16_t* arow(int s, int row) const { return (const bf16_t*)c.out + (size_t)row * OW + (s == 0 ? 0 : (s == 1 ? WA : WA + WB)); }
    HD const bf16_t* brow(int s, int, int col, int) const { return wsp<bf16_t>(c, WT_A) + (size_t)col * OW + (s == 0 ? 0 : (s == 1 ? WA : WA + WB)); }
    HD void between(int s, int row, int col, float& acc, float& carry) const { carry += bf2f(wsp<bf16_t>(c, OFF_GATES)[((size_t)s * T + row) * D + col]) * acc; acc = 0.f; }
    HD void store(int row, int col, float, float carry) const { wsp<bf16_t>(c, OFF_MERGED)[(size_t)row * D + col] = f2bf(carry); } };
struct G_wout { Ctx c; static constexpr int N = D, NSEGS = 1, NBP = 1;
    HD int M() const { return T; } HD int K(int) const { return D; }
    HD const bf16_t* arow(int, int row) const { return wsp<bf16_t>(c, OFF_MERGED) + (size_t)row * D; }
    HD const bf16_t* brow(int, int, int col, int) const { return wsp<bf16_t>(c, WT_OUT) + (size_t)col * D; }
    HD void between(int, int, int, float&, float&) const {}
    HD void store(int row, int col, float a, float) const { wsp<float>(c, OFF_H1)[(size_t)row * D + col] = DN_ALPHA * c.x[(size_t)row * D + col] + a; } };
struct MoeRow { int e, pos, valid, entry; };
HD MoeRow moe_row(const Ctx& c, int row) {
    const int* blk = wsp<int>(c, OFF_SMALL) + SM_BLK; const unsigned* cnt = wsp<unsigned>(c, OFF_CTL) + CW_CNT;
    MoeRow r; const int rb = row >> 8; r.e = blk[64 + rb]; r.pos = ((rb - blk[r.e]) << 8) + (row & 255); r.valid = r.pos < (int)cnt[r.e];
    r.entry = wsp<int>(c, OFF_LIST)[(size_t)r.e * T + (r.valid ? r.pos : 0)]; return r; }
HD int moe_rows_total(const Ctx& c) { return (wsp<int>(c, OFF_SMALL) + SM_BLK)[32] << 8; }
struct G_moe1 { Ctx c; static constexpr int N = DE, NSEGS = 1, NBP = 2;
    HD int M() const { return moe_rows_total(c); } HD int K(int) const { return D; }
    HD const bf16_t* arow(int, int row) const { const MoeRow r = moe_row(c, row); return wsp<bf16_t>(c, OFF_X1B) + (size_t)(r.entry >> 1) * D; }
    HD const bf16_t* brow(int, int row0, int col, int which) const { const int e = (wsp<int>(c, OFF_SMALL) + SM_BLK)[64 + (row0 >> 8)];
        return wsp<bf16_t>(c, OFF_WTGU) + ((size_t)e * 2 * DE + (col / HBK) * 2 * HBK + which * HBK + col % HBK) * D; }
    HD void between(int, int, int, float&, float&) const {}
    HD void store(int row, int col, float g, float u) const { wsp<bf16_t>(c, OFF_HBUF)[(size_t)row * DE + col] = f2bf(siluf_(g) * u); } };
struct G_moe2 { Ctx c; static constexpr int N = D, NSEGS = 1, NBP = 1;
    HD int M() const { return moe_rows_total(c); } HD int K(int) const { return DE; }
    HD const bf16_t* arow(int, int row) const { return wsp<bf16_t>(c, OFF_HBUF) + (size_t)row * DE; }
    HD const bf16_t* brow(int, int row0, int col, int) const { const int e = (wsp<int>(c, OFF_SMALL) + SM_BLK)[64 + (row0 >> 8)]; return wsp<bf16_t>(c, OFF_WTDN) + ((size_t)e * D + col) * DE; }
    HD void between(int, int, int, float&, float&) const {}
    HD void store(int row, int col, float a, float) const { const MoeRow r = moe_row(c, row); if (!r.valid) return;
        wsp<bf16_t>(c, (r.entry & 1) ? OFF_Y1 : OFF_Y0)[(size_t)(r.entry >> 1) * D + col] = f2bf(a); } };

struct u32x4_t { unsigned x, y, z, w; };
HD float bflo(unsigned u) { union { unsigned u; float f; } c; c.u = u << 16; return c.f; }
HD float bfhi(unsigned u) { union { unsigned u; float f; } c; c.u = u & 0xffff0000u; return c.f; }
HD float dot128(const bf16_t* a, const bf16_t* b) { float s = 0.f; const u32x4_t* pa = (const u32x4_t*)a; const u32x4_t* pb = (const u32x4_t*)b;
#ifndef HOST_TEST
#pragma unroll 4
#endif
    for (int d = 0; d < 16; ++d) { const u32x4_t ua = pa[d], ub = pb[d];
        s += bflo(ua.x) * bflo(ub.x) + bfhi(ua.x) * bfhi(ub.x) + bflo(ua.y) * bflo(ub.y) + bfhi(ua.y) * bfhi(ub.y) + bflo(ua.z) * bflo(ub.z) + bfhi(ua.z) * bfhi(ub.z) + bflo(ua.w) * bflo(ub.w) + bfhi(ua.w) * bfhi(ub.w); }
    return s; }
struct E_attnA { Ctx c; int half; static constexpr long n = (long)TH * 3 * 4 * 8;
    HD void operator()(long idx) const {
        const int p = (int)(idx & 7), h = (int)((idx >> 3) & 3); const long rest = idx >> 5; const int g = (int)(rest % 3), tl = (int)(rest / 3);
        const int r = dil_of(g), bl = tl / S, s = tl % S, cc = s % r, nq = s / r, L = S / r, base = bl * S + cc * L;
        const bf16_t* P = wsp<bf16_t>(c, OFF_P); const float* bias = wsp<float>(c, OFF_SMALL) + SM_BIAS + (g * 4 + h) * 129;
        const bf16_t* q = P + (size_t)(base + nq) * NP + g * 1536 + h * 128;
        float m = -INFINITY, l = 0.f, o[16];
#ifndef HOST_TEST
#pragma unroll
#endif
        for (int j = 0; j < 16; ++j) o[j] = 0.f;
        const int umax = nq < 128 ? nq : 128;
        for (int u = 0; u <= umax; ++u) {
            const bf16_t* kr = P + (size_t)(base + nq - u) * NP + g * 1536 + 512 + h * 128; const bf16_t* vr = kr + 512 + p * 16;
            const float sc = dot128(q, kr) * QK_SCALE + bias[u];
            const float mn = fmaxf(m, sc), a = expf(m - mn), pw = expf(sc - mn); l = l * a + pw; m = mn;
#ifndef HOST_TEST
#pragma unroll
#endif
            for (int j = 0; j < 16; ++j) o[j] = o[j] * a + pw * bf2f(vr[j]);
        }
        bf16_t* op = wsp<bf16_t>(c, OFF_PART) + ((size_t)g * TH + tl) * WA + h * 128 + p * 16; const float il = 1.f / l;
#ifndef HOST_TEST
#pragma unroll
#endif
        for (int j = 0; j < 16; ++j) op[j] = f2bf(o[j] * il);
        if (p == 0) wsp<float>(c, OFF_LSE)[((size_t)g * TH + tl) * 4 + h] = m + logf(l);
    } };
struct E_combA { Ctx c; int half; static constexpr long n = (long)TH * WA;
    HD void operator()(long idx) const { const int col = (int)(idx % WA), tl = (int)(idx / WA), h = col >> 7;
        const float* lse = wsp<float>(c, OFF_LSE); const bf16_t* part = wsp<bf16_t>(c, OFF_PART);
        const float l0 = lse[((size_t)0 * TH + tl) * 4 + h], l1 = lse[((size_t)1 * TH + tl) * 4 + h], l2 = lse[((size_t)2 * TH + tl) * 4 + h];
        const float mx = fmaxf(l0, fmaxf(l1, l2)), e0 = expf(l0 - mx), e1 = expf(l1 - mx), e2 = expf(l2 - mx), inv = 1.f / (e0 + e1 + e2);
        const float v = (e0 * bf2f(part[((size_t)0 * TH + tl) * WA + col]) + e1 * bf2f(part[((size_t)1 * TH + tl) * WA + col]) + e2 * bf2f(part[((size_t)2 * TH + tl) * WA + col])) * inv;
        ((bf16_t*)c.out)[((size_t)half * TH + tl) * OW + col] = f2bf(v); } };
struct E_attnC { Ctx c; int half; static constexpr long n = (long)TH * 4 * 8;
    HD void operator()(long idx) const { const int p = (int)(idx & 7), h = (int)((idx >> 3) & 3), tl = (int)(idx >> 5), b = half * BH + tl / S;
        const bf16_t* q = wsp<bf16_t>(c, OFF_P) + (size_t)tl * NP + COLS_A + COLS_B + h * 128; const bf16_t* kv = wsp<bf16_t>(c, OFF_MEMKV) + (size_t)b * MEM * 1024;
        float m = -INFINITY, l = 0.f, o[16];
#ifndef HOST_TEST
#pragma unroll
#endif
        for (int j = 0; j < 16; ++j) o[j] = 0.f;
        for (int k = 0; k < MEM; ++k) { const bf16_t* kr = kv + (size_t)k * 1024 + h * 128; const bf16_t* vr = kr + 512 + p * 16;
            const float sc = dot128(q, kr) * QK_SCALE; const float mn = fmaxf(m, sc), a = expf(m - mn), pw = expf(sc - mn); l = l * a + pw; m = mn;
#ifndef HOST_TEST
#pragma unroll
#endif
            for (int j = 0; j < 16; ++j) o[j] = o[j] * a + pw * bf2f(vr[j]); }
        bf16_t* op = (bf16_t*)c.out + ((size_t)half * TH + tl) * OW + WA + WB + h * 128 + p * 16; const float il = 1.f / l;
#ifndef HOST_TEST
#pragma unroll
#endif
        for (int j = 0; j < 16; ++j) op[j] = f2bf(o[j] * il); } };

HD float hg_f(const Ctx& c, const bf16_t* prow, int ch) { const float lb = wsp<float>(c, OFF_SMALL)[SM_LB + ch]; return lb + (1.f - lb) * sigmoidf_(bf2f(prow[COLS_A + WB + ch])); }
struct E_hg1 { Ctx c; int half; static constexpr long n = (long)BH * HB * NSEG * 128 * 128;
    HD void operator()(long idx) const { const int v = (int)(idx & 127), k = (int)((idx >> 7) & 127); const long r = idx >> 14; const int seg = (int)(r % NSEG), bhl = (int)(r / NSEG), h = bhl % HB, bl = bhl / HB;
        const bf16_t* P = wsp<bf16_t>(c, OFF_P); const int ch = h * 128 + k; float st = 0.f, dsum = 0.f;
        for (int s = 0; s < 256; ++s) { const bf16_t* pr = P + (size_t)(bl * S + seg * 256 + s) * NP; const float f = hg_f(c, pr, ch); st = f * st + (1.f - f) * bf2f(pr[COLS_A + 2 * WB + h * 128 + v]); dsum += logf(f); }
        wsp<float>(c, OFF_HG)[idx] = st; if (v == 0) wsp<float>(c, OFF_DSEG)[((size_t)bhl * NSEG + seg) * 128 + k] = dsum; } };
struct E_hg2 { Ctx c; static constexpr long n = (long)BH * HB * 128 * 128;
    HD void operator()(long idx) const { const int v = (int)(idx & 127), k = (int)((idx >> 7) & 127), bhl = (int)(idx >> 14); float run = 0.f;
        for (int seg = 0; seg < NSEG; ++seg) { float* p = wsp<float>(c, OFF_HG) + (((size_t)bhl * NSEG + seg) * 128 + k) * 128 + v; const float tmp = *p; *p = run;
            run = expf(wsp<float>(c, OFF_DSEG)[((size_t)bhl * NSEG + seg) * 128 + k]) * run + tmp; } } };
struct E_hg3 { Ctx c; int half; static constexpr long n = (long)BH * HB * NSEG * 128;
    HD void operator()(long idx) const { const int v = (int)(idx & 127); const long r = idx >> 7; const int seg = (int)(r % NSEG), bhl = (int)(r / NSEG), h = bhl % HB, bl = bhl / HB;
        const bf16_t* P = wsp<bf16_t>(c, OFF_P); float st[128];
#ifndef HOST_TEST
#pragma unroll
#endif
        for (int k = 0; k < 128; ++k) st[k] = wsp<float>(c, OFF_HG)[(((size_t)bhl * NSEG + seg) * 128 + k) * 128 + v];
        for (int s = 0; s < 256; ++s) { const int tl = bl * S + seg * 256 + s; const bf16_t* pr = P + (size_t)tl * NP; const float iv = bf2f(pr[COLS_A + 2 * WB + h * 128 + v]); float o = 0.f;
#ifndef HOST_TEST
#pragma unroll
#endif
            for (int k = 0; k < 128; ++k) { const float f = hg_f(c, pr, h * 128 + k); st[k] = f * st[k] + (1.f - f) * iv; o += siluf_(bf2f(pr[COLS_A + h * 128 + k])) * st[k]; }
            ((bf16_t*)c.out)[((size_t)half * TH + tl) * OW + WA + h * 128 + v] = f2bf(o); } } };
struct E_hgnorm { Ctx c; int half; static constexpr long n = (long)TH * HB;
    HD void operator()(long idx) const { const int h = (int)(idx % HB), tl = (int)(idx / HB); bf16_t* o = (bf16_t*)c.out + ((size_t)half * TH + tl) * OW + WA + h * 128;
        const bf16_t* pr = wsp<bf16_t>(c, OFF_P) + (size_t)tl * NP + COLS_A + 3 * WB + h * 128; float ss = 0.f;
        for (int v = 0; v < 128; ++v) { const float x = bf2f(o[v]); ss += x * x; }
        const float rs = 1.f / sqrtf(ss * (1.f / 128.f) + RMS_EPS);
        for (int v = 0; v < 128; ++v) o[v] = f2bf(bf2f(o[v]) * rs * c.norm_g[h * 128 + v] * siluf_(bf2f(pr[v]))); } };

struct E_ln1 { Ctx c; static constexpr long n = T;
    HD void operator()(long row) const { float* h1 = wsp<float>(c, OFF_H1) + (size_t)row * D; bf16_t* xb1 = wsp<bf16_t>(c, OFF_X1B) + (size_t)row * D;
        float mu = 0.f; for (int i = 0; i < D; ++i) mu += h1[i]; mu *= (1.f / D);
        float var = 0.f; for (int i = 0; i < D; ++i) { const float d = h1[i] - mu; var += d * d; } var *= (1.f / D); const float rs = 1.f / sqrtf(var + LN_EPS);
        float gl0 = c.b_rg[0], gl1 = c.b_rg[1], gl2 = c.b_rg[2], gl3 = c.b_rg[3];
        for (int i = 0; i < D; ++i) { const float v = (h1[i] - mu) * rs * c.ln1_g[i] + c.ln1_b[i]; h1[i] = v; xb1[i] = f2bf(v);
            gl0 += v * c.w_rg[i * 4 + 0]; gl1 += v * c.w_rg[i * 4 + 1]; gl2 += v * c.w_rg[i * 4 + 2]; gl3 += v * c.w_rg[i * 4 + 3]; }
        int gs = 0; float gm = gl0; if (gl1 > gm) { gm = gl1; gs = 1; } if (gl2 > gm) { gm = gl2; gs = 2; } if (gl3 > gm) { gm = gl3; gs = 3; }
        const float gp = 1.f / (expf(gl0 - gm) + expf(gl1 - gm) + expf(gl2 - gm) + expf(gl3 - gm));
        float v0 = -INFINITY, v1 = -INFINITY; int i0 = 0, i1 = 0;
        for (int j = 0; j < 8; ++j) { float el = c.b_re[gs * 8 + j]; for (int i = 0; i < D; ++i) el += h1[i] * c.w_re[i * 32 + gs * 8 + j];
            if (el > v0) { v1 = v0; i1 = i0; v0 = el; i0 = j; } else if (el > v1) { v1 = el; i1 = j; } }
        const float e1 = expf(v1 - v0), w0 = gp / (1.f + e1), w1 = gp * e1 / (1.f + e1);
        unsigned* cnt = wsp<unsigned>(c, OFF_CTL) + CW_CNT; int* list = wsp<int>(c, OFF_LIST); float* rw = wsp<float>(c, OFF_RW);
        const int ea = gs * 8 + i0, eb = gs * 8 + i1;
        list[(size_t)ea * T + atomic_inc_u32(cnt + ea)] = (int)row * 2 + 0; list[(size_t)eb * T + atomic_inc_u32(cnt + eb)] = (int)row * 2 + 1;
        rw[row * 2 + 0] = w0; rw[row * 2 + 1] = w1; } };
struct E_blk { Ctx c; static constexpr long n = 1;
    HD void operator()(long) const { int* blk = wsp<int>(c, OFF_SMALL) + SM_BLK; const unsigned* cnt = wsp<unsigned>(c, OFF_CTL) + CW_CNT; int acc = 0;
        for (int e = 0; e < NE; ++e) { blk[e] = acc; const int nb = ((int)cnt[e] + 255) >> 8; for (int j = 0; j < nb; ++j) blk[64 + acc + j] = e; acc += nb; } blk[32] = acc; } };
struct E_ln2 { Ctx c; static constexpr long n = T;
    HD void operator()(long row) const { const float* x1 = wsp<float>(c, OFF_H1) + (size_t)row * D; const bf16_t* y0 = wsp<bf16_t>(c, OFF_Y0) + (size_t)row * D; const bf16_t* y1 = wsp<bf16_t>(c, OFF_Y1) + (size_t)row * D;
        const float w0 = wsp<float>(c, OFF_RW)[row * 2], w1 = wsp<float>(c, OFF_RW)[row * 2 + 1]; float* o = c.out + (size_t)row * D;
        float mu = 0.f; for (int i = 0; i < D; ++i) { const float v = DN_ALPHA * x1[i] + w0 * bf2f(y0[i]) + w1 * bf2f(y1[i]); mu += v; } mu *= (1.f / D);
        float var = 0.f; for (int i = 0; i < D; ++i) { const float v = DN_ALPHA * x1[i] + w0 * bf2f(y0[i]) + w1 * bf2f(y1[i]) - mu; var += v * v; } var *= (1.f / D); const float rs = 1.f / sqrtf(var + LN_EPS);
        for (int i = 0; i < D; ++i) { const float v = DN_ALPHA * x1[i] + w0 * bf2f(y0[i]) + w1 * bf2f(y1[i]); o[i] = (v - mu) * rs * c.ln2_g[i] + c.ln2_b[i]; } } };
typedef short bf16x8 __attribute__((ext_vector_type(8)));
typedef float f32x4 __attribute__((ext_vector_type(4)));

template <class F> __global__ void __launch_bounds__(256) k_elems(F f, long n) {
    for (long i = (long)blockIdx.x * 256 + threadIdx.x; i < n; i += (long)gridDim.x * 256) f(i);
}
template <class F> __global__ void __launch_bounds__(64) k_elems64(F f, long n) {
    for (long i = (long)blockIdx.x * 64 + threadIdx.x; i < n; i += (long)gridDim.x * 64) f(i);
}
template <class G> __global__ void __launch_bounds__(256) k_sgemm(G g) {
    const int M = g.M(); const int lane = threadIdx.x & 63, wid = threadIdx.x >> 6; constexpr int ntn = G::N / 64;
    const long ntiles = (long)(M / 64) * ntn;
    for (long tile = blockIdx.x; tile < ntiles; tile += gridDim.x) {
        const int tm = (int)(tile / ntn), tn = (int)(tile % ntn), r0 = tm * 64 + wid * 16, c0 = tn * 64;
        f32x4 acc[G::NBP][4], carry[4];
#pragma unroll
        for (int j = 0; j < 4; ++j) { carry[j] = (f32x4){0.f, 0.f, 0.f, 0.f};
#pragma unroll
            for (int w = 0; w < G::NBP; ++w) acc[w][j] = (f32x4){0.f, 0.f, 0.f, 0.f}; }
#pragma unroll
        for (int seg = 0; seg < G::NSEGS; ++seg) {
            const bf16_t* ar = g.arow(seg, r0 + (lane & 15)) + 8 * (lane >> 4); const bf16_t* br[G::NBP][4];
#pragma unroll
            for (int w = 0; w < G::NBP; ++w)
#pragma unroll
                for (int j = 0; j < 4; ++j) br[w][j] = g.brow(seg, r0, c0 + 16 * j + (lane & 15), w) + 8 * (lane >> 4);
            const int K = g.K(seg);
            for (int k0 = 0; k0 < K; k0 += 32) { const bf16x8 a = *(const bf16x8*)(ar + k0);
#pragma unroll
                for (int w = 0; w < G::NBP; ++w)
#pragma unroll
                    for (int j = 0; j < 4; ++j) { const bf16x8 b = *(const bf16x8*)(br[w][j] + k0); acc[w][j] = __builtin_amdgcn_mfma_f32_16x16x32_bf16(a, b, acc[w][j], 0, 0, 0); } }
#pragma unroll
            for (int j = 0; j < 4; ++j)
#pragma unroll
                for (int i = 0; i < 4; ++i) { float a = acc[0][j][i], cr = carry[j][i]; g.between(seg, r0 + (lane >> 4) * 4 + i, c0 + 16 * j + (lane & 15), a, cr); acc[0][j][i] = a; carry[j][i] = cr; }
        }
#pragma unroll
        for (int j = 0; j < 4; ++j)
#pragma unroll
            for (int i = 0; i < 4; ++i) g.store(r0 + (lane >> 4) * 4 + i, c0 + 16 * j + (lane & 15), acc[0][j][i], G::NBP == 2 ? acc[G::NBP - 1][j][i] : carry[j][i]);
    }
}
template <class F> static void launch_elems(const F& f, long n, hipStream_t st) { long nb = (n + 255) / 256; if (nb > 32768) nb = 32768; if (nb < 1) nb = 1; hipLaunchKernelGGL(k_elems<F>, dim3((unsigned)nb), dim3(256), 0, st, f, n); }
template <class F> static void launch_elems64(const F& f, long n, hipStream_t st) { long nb = (n + 63) / 64; if (nb > 65536) nb = 65536; hipLaunchKernelGGL(k_elems64<F>, dim3((unsigned)nb), dim3(64), 0, st, f, n); }
template <class G> static void launch_sgemm(const G& g, hipStream_t st) { hipLaunchKernelGGL(k_sgemm<G>, dim3(4096), dim3(256), 0, st, g); }

static Ctx make_ctx(void* const* d_in, void* d_out, void* d_ws) {
    Ctx c; memset(&c, 0, sizeof(c)); const float** ip = (const float**)&c; for (int i = 0; i < 22; ++i) ip[i] = (const float*)d_in[i];
    c.out = (float*)d_out; c.ws = (unsigned char*)d_ws; return c;
}
static void v1_stage0(Ctx c, hipStream_t st) {
    launch_elems(S0_xb{c}, S0_xb::n, st); launch_elems(S0_memb{c}, S0_memb::n, st); launch_elems(S0_small{c}, S0_small::n, st);
    launch_elems(S0_tr{c.w_in, wsp<bf16_t>(c, WT_IN), D, N_IN, (long)D * N_IN, D}, (long)D * N_IN, st);
    launch_elems(S0_tr{c.w_kv, wsp<bf16_t>(c, WT_KV), D, 1024, (long)D * 1024, D}, (long)D * 1024, st);
    launch_elems(S0_tr{c.w_a, wsp<bf16_t>(c, WT_A), WA, D, (long)D * WA, OW}, (long)D * WA, st);
    launch_elems(S0_tr{c.w_b, wsp<bf16_t>(c, WT_A) + WA, WB, D, (long)D * WB, OW}, (long)D * WB, st);
    launch_elems(S0_tr{c.w_c, wsp<bf16_t>(c, WT_A) + WA + WB, WC, D, (long)D * WC, OW}, (long)D * WC, st);
    launch_elems(S0_tr{c.w_out, wsp<bf16_t>(c, WT_OUT), D, D, (long)D * D, D}, (long)D * D, st);
}
static void v1_proj(Ctx c, int half, hipStream_t st) { if (half == 0) launch_sgemm(G_memkv{c}, st); launch_sgemm(G_proj{c, half}, st); }
static void v1_mixers(Ctx c, int half, hipStream_t st) {
    launch_elems(E_hg1{c, half}, E_hg1::n, st); launch_elems(E_hg2{c}, E_hg2::n, st);
    launch_elems(E_attnA{c, half}, E_attnA::n, st); launch_elems(E_attnC{c, half}, E_attnC::n, st);
    launch_elems64(E_hg3{c, half}, E_hg3::n, st); launch_elems(E_hgnorm{c, half}, E_hgnorm::n, st); launch_elems(E_combA{c, half}, E_combA::n, st);
}
static void v1_expw(Ctx c, hipStream_t st) { launch_elems(S0_gu{c}, S0_gu::n, st); launch_elems(S0_dn{c}, S0_dn::n, st); }
static void v1_gates(Ctx c, hipStream_t st) { launch_sgemm(G_gates{c}, st); }
static void v1_merge(Ctx c, hipStream_t st) { launch_sgemm(G_merge{c}, st); }
static void v1_wout(Ctx c, hipStream_t st) { launch_sgemm(G_wout{c}, st); }
static void v1_ln1(Ctx c, hipStream_t st) { launch_elems(E_ln1{c}, E_ln1::n, st); launch_elems(E_blk{c}, 1, st); }
static void v1_moe1(Ctx c, hipStream_t st) { launch_sgemm(G_moe1{c}, st); }
static void v1_moe2(Ctx c, hipStream_t st) { launch_sgemm(G_moe2{c}, st); }
static void v1_ln2(Ctx c, hipStream_t st) { launch_elems(E_ln2{c}, E_ln2::n, st); }
namespace pg8 {
#define PG8_LAS __attribute__((address_space(3)))
typedef unsigned u32x4 __attribute__((ext_vector_type(4)));
constexpr int BM = 256, BK = 64, HALF = 128, HTB = HALF * BK * 2, STAGE_BYTES = 8 * HTB, NXCD = 8, WGM = 8;
__host__ __device__ __forceinline__ int lds_byte(int r, int c) { const int st = (r >> 4) * 2 + (c >> 5), rr = r & 15, cc = c & 31, ob = rr * 64 + cc * 2; return st * 1024 + (ob ^ (((ob >> 9) & 1) << 5)); }
__host__ __device__ __forceinline__ void stage_rc(int b, int& R, int& C) { const int st = b / 1024, sb = b % 1024, swz = sb ^ (((sb >> 9) & 1) << 5); R = (st >> 1) * 16 + swz / 64; C = (st & 1) * 32 + (swz % 64) / 2; }
__host__ __device__ __forceinline__ int perm32(int rho) { const int n = rho >> 4, i = rho & 15; return 8 * (i >> 2) + 4 * n + (i & 3); }
__device__ __forceinline__ unsigned cvt_pk_bf16(float lo, float hi) { unsigned r; asm volatile("v_cvt_pk_bf16_f32 %0, %1, %2" : "=v"(r) : "v"(lo), "v"(hi)); return r; }

__device__ __forceinline__ int lane_id_opaque() { int l; asm volatile("v_mbcnt_lo_u32_b32 %0, -1, 0\n\tv_mbcnt_hi_u32_b32 %0, -1, %0" : "=v"(l)); return l; }
struct Unit { const char* A; const char* B; int nt, pm, pn, tag; };
__device__ __forceinline__ void tile_of(int L, int nM, int nN, int& pm, int& pn) {
    const int nwg = nM * nN; int wgid = L; { const int q = nwg / NXCD, r = nwg % NXCD, xcd = wgid % NXCD, off = wgid / NXCD; wgid = (xcd < r ? xcd * (q + 1) : r * (q + 1) + (xcd - r) * q) + off; }
    const int nig = WGM * nN, gid = wgid / nig, fm = gid * WGM, gsz = (nM - fm) < WGM ? (nM - fm) : WGM;
    pm = fm + ((wgid % nig) % gsz); pn = (wgid % nig) / gsz;
}
template <class Epi, class Sched>
__device__ __forceinline__ void gemm_phase(PG8_LAS unsigned char* lds, const Sched& S, const Epi& E, int tid) {
    constexpr bool GA = Sched::GATHER;
    asm volatile("" : "+v"(tid));
    const int wid = __builtin_amdgcn_readfirstlane(tid >> 6), lane = tid & 63, wr = wid >> 2, wc = wid & 3, fr = lane & 15, fq = lane >> 4;
    const unsigned lda = S.lda, ldb = S.ldb;
    int sR[2]; unsigned voffA[2], voffB[2];
#pragma unroll
    for (int i = 0; i < 2; ++i) { int R, C; stage_rc(tid * 16 + i * 8192, R, C); sR[i] = R; const int Rb = Epi::PERM ? ((R & ~31) + perm32(R & 31)) : R;
        voffA[i] = (GA ? 0u : (unsigned)R * lda) + (unsigned)C * 2u; voffB[i] = (unsigned)Rb * ldb + (unsigned)C * 2u; }
    const size_t kstep = (size_t)(BK * 2), hstepA = (size_t)HALF * lda, hstepB = (size_t)HALF * ldb;
    const unsigned ldsw = (unsigned)wid * 1024u;
    const int aoff = lds_byte(wr * 64 + fr, fq * 8), boff = lds_byte(wc * 32 + fr, fq * 8);
#define PG8_SA(b, h) (((b) * 2 + (h)) * HTB)
#define PG8_SB(b, h) ((4 + (b) * 2 + (h)) * HTB)
#define PG8_STAGE(bufoff, gbase, voff) do { const char* gb_ = (const char*)(gbase); asm volatile("" : "+s"(gb_));     \
        _Pragma("unroll") for (int _i = 0; _i < 2; ++_i) \
        __builtin_amdgcn_global_load_lds((const unsigned*)(gb_ + (voff)[_i]), (PG8_LAS unsigned*)(lds + (bufoff) + ldsw + _i * 8192), 16, 0, 0); } while (0)
#define PG8_STAGE_A(bufoff, gbase, h, tk) do { if constexpr (GA) { unsigned _o[2]; _Pragma("unroll") for (int _i = 0; _i < 2; ++_i) _o[_i] = (((tk)[_i] >> (16 * (h))) & 0xffffu) * lda + voffA[_i]; PG8_STAGE(bufoff, gbase, _o); } \
        else { PG8_STAGE(bufoff, (gbase) + (h) * hstepA, voffA); } } while (0)
#define PG8_LDA(dst, b, h) do { _Pragma("unroll") for (int m = 0; m < 4; ++m) _Pragma("unroll") for (int k = 0; k < 2; ++k) dst[m][k] = *(const PG8_LAS bf16x8*)(lds + PG8_SA(b, h) + aoff + m * 2048 + k * 1024); } while (0)
#define PG8_LDB(dst, b, h) do { _Pragma("unroll") for (int n = 0; n < 2; ++n) _Pragma("unroll") for (int k = 0; k < 2; ++k) dst[n][k] = *(const PG8_LAS bf16x8*)(lds + PG8_SB(b, h) + boff + n * 2048 + k * 1024); } while (0)
#define PG8_MMA(ai, bj, At, Bt) do { __builtin_amdgcn_s_setprio(1); _Pragma("unroll") for (int m = 0; m < 4; ++m) _Pragma("unroll") for (int n = 0; n < 2; ++n) _Pragma("unroll") for (int k = 0; k < 2; ++k) \
        acc[ai][bj][m][n] = __builtin_amdgcn_mfma_f32_16x16x32_bf16(Bt[n][k], At[m][k], acc[ai][bj][m][n], 0, 0, 0); __builtin_amdgcn_s_setprio(0); } while (0)
#define PG8_WAIT_V(n) asm volatile("s_waitcnt vmcnt(" #n ")" ::: "memory")
#define PG8_WAIT_L(n) asm volatile("s_waitcnt lgkmcnt(" #n ")" ::: "memory")
#define PG8_BAR __builtin_amdgcn_s_barrier()
#define PG8_SCHED __builtin_amdgcn_sched_barrier(0)
#define PG8_TOKS(u, tk) do { if constexpr (GA) { _Pragma("unroll") for (int _i = 0; _i < 2; ++_i) tk[_i] = S.a_row(u, sR[_i]) | (S.a_row(u, sR[_i] + HALF) << 16); } } while (0)
    Unit cur, nxt; int ui = 0;
    if (!S.next(0, cur)) return;
    f32x4 acc[2][2][4][2];
#pragma unroll
    for (int a = 0; a < 2; ++a)
#pragma unroll
        for (int b = 0; b < 2; ++b)
#pragma unroll
            for (int m = 0; m < 4; ++m)
#pragma unroll
                for (int n = 0; n < 2; ++n) acc[a][b][m][n] = (f32x4){0.f, 0.f, 0.f, 0.f};
    bf16x8 At[4][2], B0[2][2], B1[2][2];
    unsigned ctk[2] = {0u, 0u}, ntk[2] = {0u, 0u};
    PG8_TOKS(cur, ctk);
    const char* cA = cur.A; const char* cB = cur.B;
    PG8_STAGE(PG8_SB(0, 0), cB, voffB); PG8_STAGE(PG8_SB(0, 1), cB + hstepB, voffB); PG8_STAGE_A(PG8_SA(0, 0), cA, 0, ctk); PG8_STAGE_A(PG8_SA(0, 1), cA, 1, ctk);
    if (wr == 1) PG8_BAR;
    PG8_WAIT_V(2); PG8_BAR;
    PG8_STAGE(PG8_SB(1, 0), cB + kstep, voffB); PG8_STAGE_A(PG8_SA(1, 0), cA + kstep, 0, ctk); PG8_STAGE(PG8_SB(1, 1), cB + hstepB + kstep, voffB);
    PG8_WAIT_V(6); PG8_BAR;
    for (;;) {
        const bool has_next = S.next(ui + 1, nxt);
        const char* nA = cA; const char* nB = cB;
        if constexpr (GA) { ntk[0] = ctk[0]; ntk[1] = ctk[1]; }
        if (has_next) { nA = nxt.A; nB = nxt.B; PG8_TOKS(nxt, ntk); }
        const int nt = cur.nt;
#define PG8_TRIP(a1, a2, b2, tk2) do { const char* a3 = (a2) + kstep; const char* b3 = (b2) + kstep; \
            PG8_LDB(B0, 0, 0); PG8_LDB(B1, 0, 1); PG8_SCHED; PG8_LDA(At, 0, 0); PG8_STAGE_A(PG8_SA(1, 1), a1, 1, ctk); \
            PG8_WAIT_V(8); PG8_WAIT_L(0); PG8_BAR; PG8_MMA(0, 0, At, B0); PG8_MMA(0, 1, At, B1); PG8_BAR; PG8_SCHED; \
            PG8_LDA(At, 0, 1); PG8_STAGE(PG8_SB(0, 0), b2, voffB); PG8_STAGE(PG8_SB(0, 1), (b2) + hstepB, voffB); PG8_STAGE_A(PG8_SA(0, 0), a2, 0, tk2); \
            PG8_WAIT_V(8); PG8_WAIT_L(0); PG8_BAR; PG8_MMA(1, 0, At, B0); PG8_MMA(1, 1, At, B1); PG8_BAR; PG8_SCHED; \
            PG8_LDB(B0, 1, 0); PG8_LDB(B1, 1, 1); PG8_SCHED; PG8_LDA(At, 1, 0); PG8_STAGE_A(PG8_SA(0, 1), a2, 1, tk2); \
            PG8_WAIT_V(8); PG8_WAIT_L(0); PG8_BAR; PG8_MMA(0, 0, At, B0); PG8_MMA(0, 1, At, B1); PG8_BAR; PG8_SCHED; \
            PG8_LDA(At, 1, 1); PG8_STAGE(PG8_SB(1, 0), b3, voffB); PG8_STAGE(PG8_SB(1, 1), b3 + hstepB, voffB); PG8_STAGE_A(PG8_SA(1, 0), a3, 0, tk2); \
            PG8_WAIT_V(8); PG8_WAIT_L(0); PG8_BAR; PG8_MMA(1, 0, At, B0); PG8_MMA(1, 1, At, B1); PG8_BAR; PG8_SCHED; } while (0)
        for (int t = 0; t < nt - 2; t += 2) { const char* a1 = cA + (size_t)(t + 1) * kstep; const char* a2 = cA + (size_t)(t + 2) * kstep; const char* b2 = cB + (size_t)(t + 2) * kstep;
            PG8_TRIP(a1, a2, b2, ctk); }
        { const char* a1 = cA + (size_t)(nt - 1) * kstep; PG8_TRIP(a1, nA, nB, ntk); }
#undef PG8_TRIP
        if (wr == 0) PG8_BAR;
        { const int el = lane_id_opaque(); E(acc, cur, wr, wc, el & 15, el >> 4); }
        if (!has_next) break;
        cur = nxt; cA = nA; cB = nB;
        if constexpr (GA) { ctk[0] = ntk[0]; ctk[1] = ntk[1]; }
        ++ui;
        if (wr == 1) PG8_BAR;
    }
    PG8_WAIT_V(0);
    PG8_BAR;
#undef PG8_SA
#undef PG8_SB
#undef PG8_STAGE
#undef PG8_STAGE_A
#undef PG8_LDA
#undef PG8_LDB
#undef PG8_MMA
#undef PG8_WAIT_V
#undef PG8_WAIT_L
#undef PG8_BAR
#undef PG8_SCHED
#undef PG8_TOKS
}
}
namespace pg8 {
#define ZERO_ACC() do { _Pragma("unroll") for (int a_ = 0; a_ < 2; ++a_) _Pragma("unroll") for (int b_ = 0; b_ < 2; ++b_) _Pragma("unroll") for (int m_ = 0; m_ < 4; ++m_) _Pragma("unroll") for (int n_ = 0; n_ < 2; ++n_) acc[a_][b_][m_][n_] = (f32x4){0.f, 0.f, 0.f, 0.f}; } while (0)
typedef f32x4 (&AccRef)[2][2][4][2];
__device__ __forceinline__ u32x4 pack8(f32x4 v0, f32x4 v1) { u32x4 w; w.x = cvt_pk_bf16(v0[0], v0[1]); w.y = cvt_pk_bf16(v0[2], v0[3]); w.z = cvt_pk_bf16(v1[0], v1[1]); w.w = cvt_pk_bf16(v1[2], v1[3]); return w; }
__device__ __forceinline__ void unpack8(u32x4 w, f32x4& v0, f32x4& v1) { v0 = (f32x4){bflo(w.x), bfhi(w.x), bflo(w.y), bfhi(w.y)}; v1 = (f32x4){bflo(w.z), bfhi(w.z), bflo(w.w), bfhi(w.w)}; }
__device__ __forceinline__ float fsigmoid(float x) { return __builtin_amdgcn_rcpf(1.f + __expf(-x)); }

struct SchedGrid {
    static constexpr bool GATHER = false; unsigned lda, ldb;
    int nM, nN, G, c, nt; const char *A0, *B0;
    __device__ __forceinline__ bool next(int i, Unit& u) const { const long L = (long)i * G + c; if (L >= (long)nM * nN) return false;
        int pm, pn; tile_of((int)L, nM, nN, pm, pn); u.pm = pm; u.pn = pn; u.tag = 0; u.nt = nt;
        u.A = A0 + (size_t)pm * BM * lda; u.B = B0 + (size_t)pn * BM * ldb; return true; }
};
struct SchedMerge {
    static constexpr bool GATHER = false; unsigned lda, ldb;
    int nM, nN, G, c; const char *A0, *B0;
    __device__ __forceinline__ bool next(int i, Unit& u) const { const int r = i / 3, s = i - r * 3; const long L = (long)r * G + c; if (L >= (long)nM * nN) return false;
        int pm, pn; tile_of((int)L, nM, nN, pm, pn); u.pm = pm; u.pn = pn; u.tag = s; u.nt = (s == 1 ? WB : WA) / BK;
        const size_t so = (size_t)((s > 0 ? WA : 0) + (s > 1 ? WB : 0)) * 2;
        u.A = A0 + (size_t)pm * BM * lda + so; u.B = B0 + (size_t)pn * BM * ldb + so; return true; }
};
#define ROWS_BEGIN(off0) { unsigned ro_ = (off0); _Pragma("unroll") for (int ai = 0; ai < 2; ++ai) { _Pragma("unroll") for (int m = 0; m < 4; ++m) {
#define ROWS_END(step16) ro_ += (m == 3 ? 5u : 1u) * (step16); asm volatile("" : "+v"(ro_) :: "memory"); } } }
struct EpiProj { static constexpr bool PERM = true; bf16_t* P;
    __device__ __forceinline__ void operator()(AccRef acc, const Unit& u, int wr, int wc, int fr, int fq) const {
        const int g = u.pn < 18 ? u.pn / 6 : -1; const int col0 = u.pn * BM + wc * 32 + 8 * fq; const int r0 = u.pm * BM + wr * 64 + fr;
        const int pr0 = g >= 0 ? perm_row(r0, g) : r0; const unsigned step16 = (unsigned)(16 >> (g <= 0 ? 0 : 2 * g)) * (NP * 2);
        char* base = (char*)P;
        ROWS_BEGIN((unsigned)pr0 * (NP * 2) + (unsigned)col0 * 2)
#pragma unroll
            for (int bj = 0; bj < 2; ++bj) *(u32x4*)(base + ro_ + bj * (HALF * 2)) = pack8(acc[ai][bj][m][0], acc[ai][bj][m][1]);
        ROWS_END(step16)
        ZERO_ACC(); } };
struct EpiGates { static constexpr bool PERM = true; bf16_t* Gt;
    __device__ __forceinline__ void operator()(AccRef acc, const Unit& u, int wr, int wc, int fr, int fq) const {
        const int pl = u.pn / (D / BM), col0 = (u.pn % (D / BM)) * BM + wc * 32 + 8 * fq, r0 = u.pm * BM + wr * 64 + fr; char* base = (char*)Gt + (size_t)pl * T * D * 2;
        ROWS_BEGIN((unsigned)r0 * (D * 2) + (unsigned)col0 * 2)
#pragma unroll
            for (int bj = 0; bj < 2; ++bj) { f32x4 v0 = acc[ai][bj][m][0], v1 = acc[ai][bj][m][1];
#pragma unroll
                for (int e = 0; e < 4; ++e) { v0[e] = fsigmoid(v0[e]); v1[e] = fsigmoid(v1[e]); }
                *(u32x4*)(base + ro_ + bj * (HALF * 2)) = pack8(v0, v1); }
        ROWS_END(16u * D * 2)
        ZERO_ACC(); } };
struct EpiMerge { static constexpr bool PERM = true; const bf16_t* Gt; bf16_t* Mg;
    __device__ __forceinline__ void operator()(AccRef acc, const Unit& u, int wr, int wc, int fr, int fq) const {
        const int s = u.tag; const int col0 = u.pn * BM + wc * 32 + 8 * fq, r0 = u.pm * BM + wr * 64 + fr; const char* gbase = (const char*)Gt + (size_t)s * T * D * 2; char* mbase = (char*)Mg;
        ROWS_BEGIN((unsigned)r0 * (D * 2) + (unsigned)col0 * 2)
#pragma unroll
            for (int bj = 0; bj < 2; ++bj) { f32x4 g0, g1; unpack8(*(const u32x4*)(gbase + ro_ + bj * (HALF * 2)), g0, g1);
                if (s < 2) { f32x4 h0, h1; unpack8(*(const u32x4*)(gbase + (size_t)T * D * 2 + ro_ + bj * (HALF * 2)), h0, h1);
#pragma unroll
                    for (int e = 0; e < 4; ++e) { g0[e] *= __builtin_amdgcn_rcpf(fmaxf(h0[e], 1e-20f)); g1[e] *= __builtin_amdgcn_rcpf(fmaxf(h1[e], 1e-20f)); } }
                acc[ai][bj][m][0] *= g0; acc[ai][bj][m][1] *= g1;
                if (s == 2) *(u32x4*)(mbase + ro_ + bj * (HALF * 2)) = pack8(acc[ai][bj][m][0], acc[ai][bj][m][1]); }
        ROWS_END(16u * D * 2)
        if (s == 2) ZERO_ACC(); } };
struct EpiWout { static constexpr bool PERM = false; const float* X; float* H1;
    __device__ __forceinline__ void operator()(AccRef acc, const Unit& u, int wr, int wc, int fr, int fq) const {
        const int col0 = u.pn * BM + wc * 32 + 4 * fq, r0 = u.pm * BM + wr * 64 + fr; const char* xb_ = (const char*)X; char* hb_ = (char*)H1;
        ROWS_BEGIN((unsigned)r0 * (D * 4) + (unsigned)col0 * 4)
#pragma unroll
            for (int bj = 0; bj < 2; ++bj)
#pragma unroll
                for (int n = 0; n < 2; ++n) { const f32x4 xv = *(const f32x4*)(xb_ + ro_ + (bj * HALF + n * 16) * 4); *(f32x4*)(hb_ + ro_ + (bj * HALF + n * 16) * 4) = xv * DN_ALPHA + acc[ai][bj][m][n]; }
        ROWS_END(16u * D * 4)
        ZERO_ACC(); } };
template <bool GA> struct SchedMoe {
    static constexpr bool GATHER = GA; unsigned lda, ldb;
    int G, c, ncol, nt; const PG8_LAS int* blk; const int* list; const unsigned* cnt; const char* A; const char* B; size_t b_estride, b_pnstride;
    __device__ __forceinline__ bool next(int i, Unit& u) const { const long L = (long)i * G + c; const int nblk = __builtin_amdgcn_readfirstlane(blk[32]); if (L >= (long)nblk * ncol) return false;
        const int rb = (int)(L / ncol), pn = (int)(L % ncol), e = __builtin_amdgcn_readfirstlane(blk[64 + rb]); u.pm = rb; u.pn = pn; u.tag = e; u.nt = nt;
        u.A = GA ? A : A + (size_t)rb * BM * lda; u.B = B + (size_t)e * b_estride + (size_t)pn * b_pnstride; return true; }
    __device__ __forceinline__ unsigned a_row(const Unit& u, int row) const {
        const int e = u.tag, pos = ((u.pm - __builtin_amdgcn_readfirstlane(blk[e])) << 8) + row; const int entry = list[(size_t)e * T + (pos < __builtin_amdgcn_readfirstlane((int)cnt[e]) ? pos : 0)]; return (unsigned)(entry >> 1); }
};
struct EpiMoe1 { static constexpr bool PERM = true; bf16_t* Hb;
    __device__ __forceinline__ void operator()(AccRef acc, const Unit& u, int wr, int wc, int fr, int fq) const {
        const int col0 = u.pn * HALF + wc * 32 + 8 * fq, r0 = u.pm * BM + wr * 64 + fr; char* base = (char*)Hb;
        ROWS_BEGIN((unsigned)r0 * (DE * 2) + (unsigned)col0 * 2)
            f32x4 v0 = acc[ai][0][m][0], v1 = acc[ai][0][m][1];
#pragma unroll
            for (int e = 0; e < 4; ++e) { v0[e] = v0[e] * fsigmoid(v0[e]) * acc[ai][1][m][0][e]; v1[e] = v1[e] * fsigmoid(v1[e]) * acc[ai][1][m][1][e]; }
            *(u32x4*)(base + ro_) = pack8(v0, v1);
        ROWS_END(16u * DE * 2)
        ZERO_ACC(); } };
struct EpiMoe2 { static constexpr bool PERM = true; const PG8_LAS int* blk; const int* list; const unsigned* cnt; bf16_t* Y0; bf16_t* Y1;
    __device__ __forceinline__ void operator()(AccRef acc, const Unit& u, int wr, int wc, int fr, int fq) const {
        const int e = u.tag, col0 = u.pn * BM + wc * 32 + 8 * fq, pbase = ((u.pm - __builtin_amdgcn_readfirstlane(blk[e])) << 8) + wr * 64 + fr, n_e = __builtin_amdgcn_readfirstlane((int)cnt[e]); const int* le = list + (size_t)e * T;
        ROWS_BEGIN((unsigned)pbase)
            const int pos = (int)ro_;
            if (pos < n_e) { const int entry = le[pos]; bf16_t* rowp = ((entry & 1) ? Y1 : Y0) + (size_t)(entry >> 1) * D + col0;
#pragma unroll
                for (int bj = 0; bj < 2; ++bj) *(u32x4*)(rowp + bj * HALF) = pack8(acc[ai][bj][m][0], acc[ai][bj][m][1]); }
        ROWS_END(16u)
        ZERO_ACC(); } };
#undef ROWS_BEGIN
#undef ROWS_END
#undef ZERO_ACC
}

__device__ __forceinline__ void fast_proj(const Ctx& c, int half, PG8_LAS unsigned char* lds, int tid, int bid, int nblk) {
    pg8::SchedGrid S; S.nM = TH / 256; S.nN = NP / 256; S.G = nblk; S.c = bid; S.nt = D / 64; S.lda = D * 2; S.ldb = D * 2;
    S.A0 = (const char*)(wsp<bf16_t>(c, OFF_XB) + (size_t)half * TH * D); S.B0 = (const char*)wsp<bf16_t>(c, WT_IN);
    pg8::EpiProj E{wsp<bf16_t>(c, OFF_P)}; pg8::gemm_phase(lds, S, E, tid);
}
struct EpiPlain { static constexpr bool PERM = true; bf16_t* O; int ldc;
    __device__ __forceinline__ void operator()(pg8::AccRef acc, const pg8::Unit& u, int wr, int wc, int fr, int fq) const {
        const int col0 = u.pn * 256 + wc * 32 + 8 * fq, r0 = u.pm * 256 + wr * 64 + fr; char* base = (char*)O; unsigned ro = (unsigned)r0 * (unsigned)(ldc * 2) + (unsigned)col0 * 2;
#pragma unroll
        for (int ai = 0; ai < 2; ++ai)
#pragma unroll
            for (int m = 0; m < 4; ++m) {
#pragma unroll
                for (int bj = 0; bj < 2; ++bj) { *(pg8::u32x4*)(base + ro + bj * 256) = pg8::pack8(acc[ai][bj][m][0], acc[ai][bj][m][1]); acc[ai][bj][m][0] = (f32x4){0.f, 0.f, 0.f, 0.f}; acc[ai][bj][m][1] = (f32x4){0.f, 0.f, 0.f, 0.f}; }
                ro += (m == 3 ? 5u : 1u) * 16u * (unsigned)(ldc * 2); asm volatile("" : "+v"(ro) :: "memory"); } } };
__device__ __forceinline__ void fast_memkv(const Ctx& c, PG8_LAS unsigned char* lds, int tid, int bid, int nblk) {
    pg8::SchedGrid S; S.nM = NBATCH * MEM / 256; S.nN = 1024 / 256; S.G = nblk; S.c = bid; S.nt = D / 64; S.lda = D * 2; S.ldb = D * 2;
    S.A0 = (const char*)wsp<bf16_t>(c, OFF_MEMB); S.B0 = (const char*)wsp<bf16_t>(c, WT_KV);
    EpiPlain E{wsp<bf16_t>(c, OFF_MEMKV), 1024}; pg8::gemm_phase(lds, S, E, tid);
}
__device__ __forceinline__ void fast_gates(const Ctx& c, PG8_LAS unsigned char* lds, int tid, int bid, int nblk) {
    pg8::SchedGrid S; S.nM = T / 256; S.nN = 3 * D / 256; S.G = nblk; S.c = bid; S.nt = D / 64; S.lda = D * 2; S.ldb = D * 2;
    S.A0 = (const char*)wsp<bf16_t>(c, OFF_XB); S.B0 = (const char*)(wsp<bf16_t>(c, WT_IN) + (size_t)NP * D);
    pg8::EpiGates E{wsp<bf16_t>(c, OFF_GATES)}; pg8::gemm_phase(lds, S, E, tid);
}
__device__ __forceinline__ void fast_merge(const Ctx& c, PG8_LAS unsigned char* lds, int tid, int bid, int nblk) {
    pg8::SchedMerge S; S.nM = T / 256; S.nN = D / 256; S.G = nblk; S.c = bid; S.lda = OW * 2; S.ldb = OW * 2;
    S.A0 = (const char*)c.out; S.B0 = (const char*)wsp<bf16_t>(c, WT_A);
    pg8::EpiMerge E{wsp<bf16_t>(c, OFF_GATES), wsp<bf16_t>(c, OFF_MERGED)}; pg8::gemm_phase(lds, S, E, tid);
}
__device__ __forceinline__ void fast_wout(const Ctx& c, PG8_LAS unsigned char* lds, int tid, int bid, int nblk) {
    pg8::SchedGrid S; S.nM = T / 256; S.nN = D / 256; S.G = nblk; S.c = bid; S.nt = D / 64; S.lda = D * 2; S.ldb = D * 2;
    S.A0 = (const char*)wsp<bf16_t>(c, OFF_MERGED); S.B0 = (const char*)wsp<bf16_t>(c, WT_OUT);
    pg8::EpiWout E{c.x, wsp<float>(c, OFF_H1)}; pg8::gemm_phase(lds, S, E, tid);
}
constexpr int LDS_MISC = 131072, LDS_BLK = LDS_MISC + 1024;
__device__ __forceinline__ const PG8_LAS int* build_blk_table(const Ctx& c, PG8_LAS unsigned char* lds, int tid) {
    PG8_LAS int* blk = (PG8_LAS int*)(lds + LDS_BLK); const unsigned* cnt = wsp<unsigned>(c, OFF_CTL) + CW_CNT;
    if (tid < 32) blk[512 + tid] = ((int)cnt[tid] + 255) >> 8;
    __syncthreads();
    if (tid == 0) { int acc = 0; for (int e = 0; e < NE; ++e) { blk[e] = acc; acc += blk[512 + e]; } blk[32] = acc; }
    __syncthreads();
    { const int total = blk[32]; for (int rb = tid; rb < total; rb += 512) { int e = 0;
#pragma unroll 1
        for (int j = 1; j < NE; ++j) if (blk[j] <= rb) e = j;
        blk[64 + rb] = e; } }
    __syncthreads();
    return blk;
}
__device__ __forceinline__ void fast_moe1(const Ctx& c, PG8_LAS unsigned char* lds, int tid, int bid, int nblk) {
    pg8::SchedMoe<true> S; S.G = nblk; S.c = bid; S.ncol = 2; S.nt = D / 64; S.blk = build_blk_table(c, lds, tid); S.list = wsp<int>(c, OFF_LIST); S.cnt = wsp<unsigned>(c, OFF_CTL) + CW_CNT;
    S.A = (const char*)wsp<bf16_t>(c, OFF_X1B); S.B = (const char*)wsp<bf16_t>(c, OFF_WTGU); S.b_estride = (size_t)2 * DE * D * 2; S.b_pnstride = (size_t)256 * D * 2; S.lda = D * 2; S.ldb = D * 2;
    pg8::EpiMoe1 E{wsp<bf16_t>(c, OFF_HBUF)}; pg8::gemm_phase(lds, S, E, tid);
}
__device__ __forceinline__ void fast_moe2(const Ctx& c, PG8_LAS unsigned char* lds, int tid, int bid, int nblk) {
    pg8::SchedMoe<false> S; S.G = nblk; S.c = bid; S.ncol = D / 256; S.nt = DE / 64; S.blk = build_blk_table(c, lds, tid); S.list = wsp<int>(c, OFF_LIST); S.cnt = wsp<unsigned>(c, OFF_CTL) + CW_CNT;
    S.A = (const char*)wsp<bf16_t>(c, OFF_HBUF); S.B = (const char*)wsp<bf16_t>(c, OFF_WTDN); S.b_estride = (size_t)D * DE * 2; S.b_pnstride = (size_t)256 * DE * 2; S.lda = DE * 2; S.ldb = DE * 2;
    pg8::EpiMoe2 E{S.blk, S.list, S.cnt, wsp<bf16_t>(c, OFF_Y0), wsp<bf16_t>(c, OFF_Y1)}; pg8::gemm_phase(lds, S, E, tid);
}
namespace attn {
typedef short s16x4 __attribute__((ext_vector_type(4)));
typedef float f32x16 __attribute__((ext_vector_type(16)));
typedef unsigned u32x4 __attribute__((ext_vector_type(4)));
constexpr int KVBLK = 64, DH = 128, SHM_V = KVBLK * DH * 2, SHM_K = KVBLK * DH * 2;
constexpr int LDS_V = 0, LDS_K = 2 * SHM_V, LDS_WS = LDS_K + 2 * SHM_K, LDS_BIAS = LDS_WS + 8 * 64 * 4, BIAS_PAD = 96, BIAS_N = 129 + 2 * BIAS_PAD, LDS_END = LDS_BIAS + ((BIAS_N * 4 + 15) & ~15);
constexpr float LOG2E = 1.4426950408889634f, C2 = LOG2E * QK_SCALE, LN2 = 0.6931471805599453f;
#define KSWZ(row, colB) ((row) * 256 + ((colB) ^ (((row) & 7) << 4)))
#define SBAR() __builtin_amdgcn_sched_barrier(0)
__device__ __forceinline__ int v_st(int k, int c) { const int kk = (k & ~0xC) | ((k & 4) << 1) | ((k & 8) >> 1); return ((kk >> 3) * 4 + (c >> 5)) * 512 + ((kk & 7) * 32 + (c & 31)) * 2; }
__device__ __forceinline__ int v_rd_base(int lane) { return ((lane & 3) << 3) | (((lane >> 2) & 3) << 6) | (((lane >> 4) & 1) << 5) | (((lane >> 5) & 1) << 8); }
constexpr int v_rd_off(int d0, int ks, int half) { return d0 * 512 + ks * 4096 + half * 2048; }
__device__ __forceinline__ int crow(int r, int hi) { return (r & 3) + 8 * (r >> 2) + 4 * hi; }
__device__ __forceinline__ unsigned cvtpk(float lo, float hi) { unsigned r; asm volatile("v_cvt_pk_bf16_f32 %0, %1, %2" : "=v"(r) : "v"(lo), "v"(hi)); return r; }
__device__ __forceinline__ void qkt(f32x16& p0, f32x16& p1, const PG8_LAS char* kbuf, int r32, int hi, const bf16x8* qr) {
    p0 = f32x16{}; p1 = f32x16{};
    const PG8_LAS char* kb[4];
#pragma unroll
    for (int dd = 0; dd < 4; ++dd) kb[dd] = kbuf + KSWZ(r32, (dd * 16 + hi * 8) * 2);
#pragma unroll
    for (int d0 = 0; d0 < 8; ++d0) { const PG8_LAS char* a = kb[d0 & 3] + (d0 >> 2) * 128;
        const bf16x8 b0 = *(const PG8_LAS bf16x8*)(a);
        const bf16x8 b1 = *(const PG8_LAS bf16x8*)(a + 32 * 256);
        p0 = __builtin_amdgcn_mfma_f32_32x32x16_bf16(b0, qr[d0], p0, 0, 0, 0);
        p1 = __builtin_amdgcn_mfma_f32_32x32x16_bf16(b1, qr[d0], p1, 0, 0, 0); }
}
__device__ __forceinline__ void pv_tile(f32x16* o, int vb0, bf16x8 pa0, bf16x8 pa1, bf16x8 pa2, bf16x8 pa3) {
#define TRRD(dst, off) asm volatile("ds_read_b64_tr_b16 %0, %1 offset:%2" : "=&v"(dst) : "v"(vb0), "i"(off) : "memory")
#define PV_D0(d0) do { s16x4 l0, l1, l2, l3, h0, h1, h2, h3; constexpr int b_ = v_rd_off(d0, 0, 0); \
        TRRD(l0, b_); TRRD(h0, b_ + 2048); TRRD(l1, b_ + 4096); TRRD(h1, b_ + 6144); TRRD(l2, b_ + 8192); TRRD(h2, b_ + 10240); TRRD(l3, b_ + 12288); TRRD(h3, b_ + 14336); \
        asm volatile("s_waitcnt lgkmcnt(0)" ::: "memory"); SBAR(); \
        o[d0] = __builtin_amdgcn_mfma_f32_32x32x16_bf16(pa0, (bf16x8){l0[0], l0[1], l0[2], l0[3], h0[0], h0[1], h0[2], h0[3]}, o[d0], 0, 0, 0); \
        o[d0] = __builtin_amdgcn_mfma_f32_32x32x16_bf16(pa1, (bf16x8){l1[0], l1[1], l1[2], l1[3], h1[0], h1[1], h1[2], h1[3]}, o[d0], 0, 0, 0); \
        o[d0] = __builtin_amdgcn_mfma_f32_32x32x16_bf16(pa2, (bf16x8){l2[0], l2[1], l2[2], l2[3], h2[0], h2[1], h2[2], h2[3]}, o[d0], 0, 0, 0); \
        o[d0] = __builtin_amdgcn_mfma_f32_32x32x16_bf16(pa3, (bf16x8){l3[0], l3[1], l3[2], l3[3], h3[0], h3[1], h3[2], h3[3]}, o[d0], 0, 0, 0); } while (0)
    PV_D0(0); PV_D0(1); PV_D0(2); PV_D0(3);
#undef PV_D0
#undef TRRD
}
template <bool BAND>
__device__ __forceinline__ void attn_unit(PG8_LAS char* lds, const bf16_t* Q, size_t qs, const bf16_t* K, const bf16_t* V, size_t ks, int NT, int qpos0, int kpos0,
                                          bf16_t* Ob, size_t ostride, float* lse, int obase, int omul, int tid) {
    const int wid = __builtin_amdgcn_readfirstlane(tid >> 6), lane = tid & 63, r32 = lane & 31, hi = lane >> 5;
    PG8_LAS char* V_lds = lds + LDS_V; PG8_LAS char* K_lds = lds + LDS_K;
    PG8_LAS float* wsf = (PG8_LAS float*)(lds + LDS_WS) + wid * 64; const PG8_LAS float* bias = (const PG8_LAS float*)(lds + LDS_BIAS);
    const int sr = tid >> 4, sc = (tid & 15) * 8, vst0 = v_st(sr, sc), vst1 = v_st(32 + sr, sc), kws = KSWZ(sr, sc * 2);
    const int vbl = (int)(uintptr_t)V_lds + v_rd_base(lane);
    bf16x8 qr[8];
    { const bf16_t* qp = Q + (size_t)(wid * 32 + r32) * qs + hi * 8;
#pragma unroll
      for (int d0 = 0; d0 < 8; ++d0) qr[d0] = *(const bf16x8*)(qp + d0 * 16); }
    bf16x8 st_k0, st_k1, st_v0, st_v1;
#define SLOAD(t) do { const size_t ro_ = (size_t)((t) * KVBLK + sr) * ks + sc; st_k0 = *(const bf16x8*)(K + ro_); st_k1 = *(const bf16x8*)(K + ro_ + 32 * ks); st_v0 = *(const bf16x8*)(V + ro_); st_v1 = *(const bf16x8*)(V + ro_ + 32 * ks); } while (0)
#define SWRITE(bf) do { *(PG8_LAS bf16x8*)(K_lds + (bf) * SHM_K + kws) = st_k0; *(PG8_LAS bf16x8*)(K_lds + (bf) * SHM_K + kws + 32 * 256) = st_k1; \
                        *(PG8_LAS bf16x8*)(V_lds + (bf) * SHM_V + vst0) = st_v0; *(PG8_LAS bf16x8*)(V_lds + (bf) * SHM_V + vst1) = st_v1; } while (0)
    SLOAD(0); SWRITE(0);
    __syncthreads();
    float m_run = -1e30f, l_run = 0.f; f32x16 o[4] = {};
    const int qlo = qpos0 + wid * 32;
    for (int t = 0; t < NT; ++t) {
        const int buf = t & 1;
        if (t + 1 < NT) SLOAD(t + 1);
        const int kb = kpos0 + t * KVBLK;
        const bool act = !BAND || (kb <= qlo + 31 && kb + KVBLK - 1 >= qlo - 128);
        if (act) {
            f32x16 p0, p1;
            qkt(p0, p1, K_lds + buf * SHM_K, r32, hi, qr);
            if (BAND) {
                const int dq = qlo + r32 - kb - 4 * hi;
                const PG8_LAS float* bp = bias + (dq + BIAS_PAD - 59);
#pragma unroll
                for (int r = 0; r < 16; ++r) { const int cr = (r & 3) + 8 * (r >> 2);
                    const float b0 = bp[59 - cr], b1 = bp[59 - cr - 32];
                    p0[r] = ((unsigned)(dq - cr) <= 128u) ? fmaf(p0[r], C2, b0) : -INFINITY;
                    p1[r] = ((unsigned)(dq - cr - 32) <= 128u) ? fmaf(p1[r], C2, b1) : -INFINITY; }
            } else {
#pragma unroll
                for (int r = 0; r < 16; ++r) { p0[r] *= C2; p1[r] *= C2; }
            }
            float pmax = p0[0];
#pragma unroll
            for (int r = 1; r < 16; ++r) pmax = fmaxf(pmax, p0[r]);
#pragma unroll
            for (int r = 0; r < 16; ++r) pmax = fmaxf(pmax, p1[r]);
            { auto rr = __builtin_amdgcn_permlane32_swap(__float_as_uint(pmax), __float_as_uint(pmax), false, false); pmax = fmaxf(__uint_as_float(rr[0]), __uint_as_float(rr[1])); }
            const float mn = fmaxf(m_run, pmax), alpha = __builtin_amdgcn_exp2f(m_run - mn); m_run = mn;
            float ps = 0.f;
#pragma unroll
            for (int r = 0; r < 16; ++r) { p0[r] = __builtin_amdgcn_exp2f(p0[r] - mn); p1[r] = __builtin_amdgcn_exp2f(p1[r] - mn); ps += p0[r] + p1[r]; }
            { auto rr = __builtin_amdgcn_permlane32_swap(__float_as_uint(ps), __float_as_uint(ps), false, false); ps = __uint_as_float(rr[0]) + __uint_as_float(rr[1]); }
            l_run = l_run * alpha + ps;
            if (__any(alpha < 1.f)) { if (hi == 0) wsf[r32] = alpha; asm volatile("s_waitcnt lgkmcnt(0)" ::: "memory");
#pragma unroll
                for (int r = 0; r < 16; ++r) { const float a = wsf[crow(r, hi)];
#pragma unroll
                    for (int d_ = 0; d_ < 4; ++d_) o[d_][r] *= a; }
                asm volatile("s_waitcnt lgkmcnt(0)" ::: "memory"); }
            bf16x8 pa0, pa1, pa2, pa3;
#define PK4(P, B_, OUT) do { unsigned a0 = cvtpk(P[B_ + 0], P[B_ + 1]), a1 = cvtpk(P[B_ + 2], P[B_ + 3]); unsigned b0 = cvtpk(P[B_ + 4], P[B_ + 5]), b1 = cvtpk(P[B_ + 6], P[B_ + 7]); \
        auto r0 = __builtin_amdgcn_permlane32_swap(a0, b0, false, false); auto r1 = __builtin_amdgcn_permlane32_swap(a1, b1, false, false); \
        u32x4 w = {r0[0], r1[0], r0[1], r1[1]}; OUT = *reinterpret_cast<bf16x8*>(&w); } while (0)
            PK4(p0, 0, pa0); PK4(p0, 8, pa1); PK4(p1, 0, pa2); PK4(p1, 8, pa3);
#undef PK4
            SBAR();
            pv_tile(o, vbl + buf * SHM_V, pa0, pa1, pa2, pa3);
        }
        if (t + 1 < NT) SWRITE(buf ^ 1);
        __syncthreads();
    }
#undef SLOAD
#undef SWRITE
    if (hi == 0) wsf[r32] = l_run; asm volatile("s_waitcnt lgkmcnt(0)" ::: "memory");
    float rli[16];
#pragma unroll
    for (int r = 0; r < 16; ++r) rli[r] = __builtin_amdgcn_rcpf(wsf[crow(r, hi)]);
#pragma unroll
    for (int r = 0; r < 16; ++r) { const int row = wid * 32 + crow(r, hi); bf16_t* op = Ob + (size_t)(obase + row * omul) * ostride;
#pragma unroll
        for (int d0 = 0; d0 < 4; ++d0) { const float v = o[d0][r] * rli[r]; const float vn = __shfl_xor(v, 1);
            if ((r32 & 1) == 0) *(unsigned*)(op + d0 * 32 + r32) = cvtpk(v, vn); } }
    if (BAND) { if (hi == 0) lse[(size_t)(obase + (wid * 32 + r32) * omul) * 4] = (m_run + __log2f(l_run)) * LN2; }
    __syncthreads();
}
#undef KSWZ
#undef SBAR

__device__ __forceinline__ void attn_phase(const Ctx& c, int half, PG8_LAS unsigned char* lds_u, int tid, int bid, int nblk) {
    asm volatile("" : "+v"(tid));
    PG8_LAS char* lds = (PG8_LAS char*)lds_u;
    constexpr int QB = S / 256, NUA = BH * 3 * 4 * QB, NUC = BH * 4 * QB, NU = NUA + NUC;
    const bf16_t* P = wsp<bf16_t>(c, OFF_P);
    for (int u = bid; u < NU; u += nblk) {
        if (u < NUA) {
            const int j = u % QB, h = (u / QB) & 3, g = (u / (QB * 4)) % 3, bl = u / (QB * 12);
            const int r = dil_of(g), L = S / r, nqb = L / 256, cc = j / nqb, qb = j % nqb, q0 = qb * 256, base = bl * S + cc * L;
            { PG8_LAS float* bt = (PG8_LAS float*)(lds + LDS_BIAS); const float* bsrc = wsp<float>(c, OFF_SMALL) + SM_BIAS + (g * 4 + h) * 129;
              for (int i = tid; i < BIAS_N; i += 512) { const int uu = i - BIAS_PAD; bt[i] = (uu >= 0 && uu <= 128) ? bsrc[uu] * LOG2E : 0.f; } }
            const int klo = q0 >= 128 ? q0 - 128 : 0, NT = (q0 + 256 - klo) / 64;
            const bf16_t* Qp = P + (size_t)(base + q0) * NP + g * 1536 + h * 128; const bf16_t* Kp = P + (size_t)(base + klo) * NP + g * 1536 + 512 + h * 128;
            attn_unit<true>(lds, Qp, NP, Kp, Kp + 512, NP, NT, q0, klo, wsp<bf16_t>(c, OFF_PART) + (size_t)g * TH * WA + h * 128, WA, wsp<float>(c, OFF_LSE) + (size_t)g * TH * 4 + h,
                            bl * S + q0 * r + cc, r, tid);
        } else {
            const int v = u - NUA, j = v % QB, h = (v / QB) & 3, bl = v / (QB * 4), b = half * BH + bl, tl0 = bl * S + j * 256;
            const bf16_t* Qp = P + (size_t)tl0 * NP + COLS_A + COLS_B + h * 128; const bf16_t* Kp = wsp<bf16_t>(c, OFF_MEMKV) + (size_t)b * MEM * 1024 + h * 128;
            attn_unit<false>(lds, Qp, NP, Kp, Kp + 512, 1024, MEM / 64, 0, 0, (bf16_t*)c.out + (size_t)half * TH * OW + WA + WB + h * 128, OW, nullptr, tl0, 1, tid);
        }
    }
}
}
namespace rowops {
typedef float f32x4 __attribute__((ext_vector_type(4)));
typedef unsigned u32x2 __attribute__((ext_vector_type(2)));
typedef unsigned u32x4 __attribute__((ext_vector_type(4)));
__device__ __forceinline__ float wave_sum(float v) {
#pragma unroll
    for (int o = 1; o < 64; o <<= 1) v += __shfl_xor(v, o);
    return v;
}
__device__ __forceinline__ unsigned pk2(float lo, float hi) { return pg8::cvt_pk_bf16(lo, hi); }

constexpr int SM_WGT = 16384, SM_CS = SM_WGT + 48 * D, SM_BW = SM_CS + 64;
static_assert((SM_BW + 64) * 4 <= (int)MiB, "small region");
__device__ __forceinline__ void router_weights_prep(const Ctx& c, int tid, int bid, int nblk) {
    const int lane = tid & 63, gw = bid * 8 + (tid >> 6), NGW = nblk * 8; float* sm = wsp<float>(c, OFF_SMALL);
    for (int col = gw; col < 48; col += NGW) { float cs = 0.f, bw = 0.f;
        for (int i = lane; i < D; i += 64) { const float w = col < 4 ? c.w_rg[i * 4 + col] : (col < 36 ? c.w_re[i * 32 + col - 4] : 0.f); const float gwv = c.ln1_g[i] * w; sm[SM_WGT + col * D + i] = gwv; cs += gwv; bw += c.ln1_b[i] * w; }
        cs = wave_sum(cs); bw = wave_sum(bw);
        if (lane == 0) { sm[SM_CS + col] = cs; sm[SM_BW + col] = bw + (col < 4 ? c.b_rg[col] : (col < 36 ? c.b_re[col - 4] : 0.f)); } }
}
template <bool DRY> __device__ __forceinline__ void ln1_router_phase(const Ctx& c, PG8_LAS unsigned char* lds, int tid, int bid, int nblk) {
    asm volatile("" : "+v"(tid));
    const int lane = tid & 63, wid = tid >> 6, l15 = lane & 15, lq = lane >> 4, gw = bid * 8 + wid, NGW = nblk * 8;
    PG8_LAS int* lh = (PG8_LAS int*)lds; PG8_LAS int* asg = lh + 64; PG8_LAS float* lg = (PG8_LAS float*)(lds + 4096) + wid * (16 * 48);
    if (tid < 64) lh[tid] = 0;
    __syncthreads();
    float* H1 = wsp<float>(c, OFF_H1); bf16_t* X1B = wsp<bf16_t>(c, OFF_X1B); const float* sm = wsp<float>(c, OFF_SMALL);
    unsigned* cnt = wsp<unsigned>(c, OFF_CTL) + CW_CNT; int* list = wsp<int>(c, OFF_LIST); float* rw = wsp<float>(c, OFF_RW);
    int ngrp = 0;
    for (int g0 = gw * 16; g0 < T; g0 += NGW * 16, ++ngrp) {
        float my_mean = 0.f, my_rstd = 0.f;
#pragma unroll 4
        for (int r = 0; r < 16; ++r) { const f32x4* hp = (const f32x4*)(H1 + (size_t)(g0 + r) * D) + lane; f32x4 v[4]; float s = 0.f;
#pragma unroll
            for (int j = 0; j < 4; ++j) { v[j] = hp[64 * j]; s += (v[j][0] + v[j][1]) + (v[j][2] + v[j][3]); }
            const float mean = wave_sum(s) * (1.f / D); float s2 = 0.f;
#pragma unroll
            for (int j = 0; j < 4; ++j) { v[j] = v[j] - mean; s2 += (v[j][0] * v[j][0] + v[j][1] * v[j][1]) + (v[j][2] * v[j][2] + v[j][3] * v[j][3]); }
            const float rstd = 1.f / sqrtf(wave_sum(s2) * (1.f / D) + LN_EPS);
            if (lane == r) { my_mean = mean; my_rstd = rstd; } }
        f32x4 acc0 = {0.f, 0.f, 0.f, 0.f}, acc1 = acc0, acc2 = acc0;
        { const float* ap = H1 + (size_t)(g0 + l15) * D + 4 * lq; const float* bp = sm + SM_WGT + (size_t)l15 * D + 4 * lq;
#pragma unroll 4
          for (int st = 0; st < D / 16; ++st) { const f32x4 a = *(const f32x4*)(ap + 16 * st), b0 = *(const f32x4*)(bp + 16 * st), b1 = *(const f32x4*)(bp + 16 * D + 16 * st), b2 = *(const f32x4*)(bp + 32 * D + 16 * st);
#pragma unroll
              for (int j = 0; j < 4; ++j) { acc0 = __builtin_amdgcn_mfma_f32_16x16x4f32(a[j], b0[j], acc0, 0, 0, 0); acc1 = __builtin_amdgcn_mfma_f32_16x16x4f32(a[j], b1[j], acc1, 0, 0, 0); acc2 = __builtin_amdgcn_mfma_f32_16x16x4f32(a[j], b2[j], acc2, 0, 0, 0); } } }
#pragma unroll
        for (int i = 0; i < 4; ++i) { lg[(lq * 4 + i) * 48 + l15] = acc0[i]; lg[(lq * 4 + i) * 48 + 16 + l15] = acc1[i]; lg[(lq * 4 + i) * 48 + 32 + l15] = acc2[i]; }
        asm volatile("s_waitcnt lgkmcnt(0)" ::: "memory");
        if (lane < 16) { const PG8_LAS float* lr = lg + lane * 48; float gl[4], gm; int gs = 0;
#pragma unroll
            for (int g = 0; g < 4; ++g) gl[g] = my_rstd * (lr[g] - my_mean * sm[SM_CS + g]) + sm[SM_BW + g];
            gm = gl[0];
#pragma unroll
            for (int g = 1; g < 4; ++g) if (gl[g] > gm) { gm = gl[g]; gs = g; }
            const float gp = 1.f / (__expf(gl[0] - gm) + __expf(gl[1] - gm) + __expf(gl[2] - gm) + __expf(gl[3] - gm));
            float v0 = -INFINITY, v1 = -INFINITY; int i0 = 0, i1 = 0;
            for (int j = 0; j < 8; ++j) { const int col = 4 + gs * 8 + j; const float x = my_rstd * (lr[col] - my_mean * sm[SM_CS + col]) + sm[SM_BW + col];
                if (x > v0) { v1 = v0; i1 = i0; v0 = x; i0 = j; } else if (x > v1) { v1 = x; i1 = j; } }
            const float e1 = __expf(v1 - v0), w0 = gp / (1.f + e1), w1 = gp * e1 / (1.f + e1); const int ea = gs * 8 + i0, eb = gs * 8 + i1, row = g0 + lane;
            const int ra = __hip_atomic_fetch_add(lh + ea, 1, __ATOMIC_RELAXED, __HIP_MEMORY_SCOPE_WORKGROUP), rb = __hip_atomic_fetch_add(lh + eb, 1, __ATOMIC_RELAXED, __HIP_MEMORY_SCOPE_WORKGROUP);
            PG8_LAS int* a = asg + (wid * 16 + lane) * 4; a[0] = row; a[1] = ea | (ra << 8); a[2] = eb | (rb << 8);
            if (!DRY) { rw[row * 2] = w0; rw[row * 2 + 1] = w1; } }
        f32x4 gv[4], bv[4];
#pragma unroll
        for (int j = 0; j < 4; ++j) { gv[j] = *(const f32x4*)(c.ln1_g + 4 * lane + 256 * j); bv[j] = *(const f32x4*)(c.ln1_b + 4 * lane + 256 * j); }
#pragma unroll 4
        for (int r = 0; r < 16; ++r) { const float mean = __shfl(my_mean, r), rstd = __shfl(my_rstd, r); f32x4* hp = (f32x4*)(H1 + (size_t)(g0 + r) * D) + lane;
#pragma unroll
            for (int j = 0; j < 4; ++j) { const f32x4 v = (hp[64 * j] - mean) * rstd * gv[j] + bv[j]; if (!DRY) hp[64 * j] = v;
                u32x2 w; w.x = pk2(v[0], v[1]); w.y = pk2(v[2], v[3]); if (!DRY) *((u32x2*)(X1B + (size_t)(g0 + r) * D) + lane + 64 * j) = w; } }
    }
    __syncthreads();
    if (DRY) return;
    if (tid < 32) lh[32 + tid] = (int)atomicAdd(cnt + tid, (unsigned)lh[tid]);
    __syncthreads();
    if (lane < 16 && ngrp > 0) { const PG8_LAS int* a = asg + (wid * 16 + lane) * 4; const int row = a[0], xa = a[1], xb = a[2];
        list[(size_t)(xa & 255) * T + lh[32 + (xa & 255)] + (xa >> 8)] = row * 2; list[(size_t)(xb & 255) * T + lh[32 + (xb & 255)] + (xb >> 8)] = row * 2 + 1; }
    __syncthreads();
}
__device__ __forceinline__ void ln2_phase(const Ctx& c, int tid, int bid, int nblk) {
    asm volatile("" : "+v"(tid));
    const int lane = tid & 63, wid = tid >> 6, gw = bid * 8 + wid, NGW = nblk * 8;
    const float* X1 = wsp<float>(c, OFF_H1); const bf16_t* Y0 = wsp<bf16_t>(c, OFF_Y0); const bf16_t* Y1 = wsp<bf16_t>(c, OFF_Y1); const float* rw = wsp<float>(c, OFF_RW);
    f32x4 gv[4], bv[4];
#pragma unroll
    for (int j = 0; j < 4; ++j) { gv[j] = *(const f32x4*)(c.ln2_g + 4 * lane + 256 * j); bv[j] = *(const f32x4*)(c.ln2_b + 4 * lane + 256 * j); }
    for (int row = gw; row < T; row += NGW) {
        const f32x4* xp = (const f32x4*)(X1 + (size_t)row * D) + lane; const u32x2* y0p = (const u32x2*)(Y0 + (size_t)row * D) + lane; const u32x2* y1p = (const u32x2*)(Y1 + (size_t)row * D) + lane;
        const float w0 = rw[row * 2], w1 = rw[row * 2 + 1]; f32x4 v[4]; float s = 0.f;
#pragma unroll
        for (int j = 0; j < 4; ++j) { const f32x4 x = xp[64 * j]; const u32x2 a = y0p[64 * j], b = y1p[64 * j];
            v[j][0] = DN_ALPHA * x[0] + w0 * bflo(a.x) + w1 * bflo(b.x); v[j][1] = DN_ALPHA * x[1] + w0 * bfhi(a.x) + w1 * bfhi(b.x);
            v[j][2] = DN_ALPHA * x[2] + w0 * bflo(a.y) + w1 * bflo(b.y); v[j][3] = DN_ALPHA * x[3] + w0 * bfhi(a.y) + w1 * bfhi(b.y);
            s += (v[j][0] + v[j][1]) + (v[j][2] + v[j][3]); }
        const float mean = wave_sum(s) * (1.f / D); float s2 = 0.f;
#pragma unroll
        for (int j = 0; j < 4; ++j) { v[j] = v[j] - mean; s2 += (v[j][0] * v[j][0] + v[j][1] * v[j][1]) + (v[j][2] * v[j][2] + v[j][3] * v[j][3]); }
        const float rstd = 1.f / sqrtf(wave_sum(s2) * (1.f / D) + LN_EPS);
        f32x4* op = (f32x4*)(c.out + (size_t)row * D) + lane;
#pragma unroll
        for (int j = 0; j < 4; ++j) op[64 * j] = v[j] * rstd * gv[j] + bv[j];
    }
}
__device__ __forceinline__ void transpose_item(const float* W, int N, bf16_t* Wt, size_t ldo, PG8_LAS float* scr, int k0, int n0, int lane) {
#pragma unroll 8
    for (int i = 0; i < 32; ++i) { const int kk = 2 * i + (lane >> 5); scr[kk * 33 + (lane & 31)] = W[(size_t)(k0 + kk) * N + n0 + (lane & 31)]; }
    asm volatile("s_waitcnt lgkmcnt(0)" ::: "memory");
    const int ch = lane & 7;
#pragma unroll
    for (int j = 0; j < 4; ++j) { const int n = (lane >> 3) + 8 * j; const PG8_LAS float* s = scr + (8 * ch) * 33 + n;
        u32x4 o; o.x = pk2(s[0 * 33], s[1 * 33]); o.y = pk2(s[2 * 33], s[3 * 33]); o.z = pk2(s[4 * 33], s[5 * 33]); o.w = pk2(s[6 * 33], s[7 * 33]);
        *(u32x4*)(Wt + (size_t)n * ldo + k0 + 8 * ch) = o; }
    asm volatile("s_waitcnt lgkmcnt(0)" ::: "memory");
}
__device__ __forceinline__ void cvt_copy(const float* src, bf16_t* dst, long n, int tid, int bid, int nblk) {
    const long n8 = n / 8;
    for (long i = (long)bid * 512 + tid; i < n8; i += (long)nblk * 512) { const f32x4 a = *(const f32x4*)(src + i * 8), b = *(const f32x4*)(src + i * 8 + 4);
        u32x4 o; o.x = pk2(a[0], a[1]); o.y = pk2(a[2], a[3]); o.z = pk2(b[0], b[1]); o.w = pk2(b[2], b[3]); *(u32x4*)(dst + i * 8) = o; }
}
__device__ __forceinline__ void prologue_phase(const Ctx& c, PG8_LAS unsigned char* lds, int tid, int bid, int nblk) {
    asm volatile("" : "+v"(tid));
    const int lane = tid & 63, wid = tid >> 6, gw = bid * 8 + wid, NGW = nblk * 8;
    PG8_LAS float* scr = (PG8_LAS float*)(lds + wid * 16384);
    constexpr int I_IN = (D / 64) * (N_IN / 32), I_KV = (D / 64) * (1024 / 32), I_A = (WA / 64) * (D / 32), I_B = (WB / 64) * (D / 32), I_C = (WC / 64) * (D / 32), I_O = (D / 64) * (D / 32);
    constexpr int NIT = I_IN + I_KV + I_A + I_B + I_C + I_O;
    for (int it = gw; it < NIT; it += NGW) { int r = it;
        if (r < I_IN) { const int nb = N_IN / 32; transpose_item(c.w_in, N_IN, wsp<bf16_t>(c, WT_IN) + (size_t)(r % nb) * 32 * D, D, scr, (r / nb) * 64, (r % nb) * 32, lane); continue; } r -= I_IN;
        if (r < I_KV) { const int nb = 1024 / 32; transpose_item(c.w_kv, 1024, wsp<bf16_t>(c, WT_KV) + (size_t)(r % nb) * 32 * D, D, scr, (r / nb) * 64, (r % nb) * 32, lane); continue; } r -= I_KV;
        if (r < I_A) { const int nb = D / 32; transpose_item(c.w_a, D, wsp<bf16_t>(c, WT_A) + (size_t)(r % nb) * 32 * OW, OW, scr, (r / nb) * 64, (r % nb) * 32, lane); continue; } r -= I_A;
        if (r < I_B) { const int nb = D / 32; transpose_item(c.w_b, D, wsp<bf16_t>(c, WT_A) + WA + (size_t)(r % nb) * 32 * OW, OW, scr, (r / nb) * 64, (r % nb) * 32, lane); continue; } r -= I_B;
        if (r < I_C) { const int nb = D / 32; transpose_item(c.w_c, D, wsp<bf16_t>(c, WT_A) + WA + WB + (size_t)(r % nb) * 32 * OW, OW, scr, (r / nb) * 64, (r % nb) * 32, lane); continue; } r -= I_C;
        { const int nb = D / 32; transpose_item(c.w_out, D, wsp<bf16_t>(c, WT_OUT) + (size_t)(r % nb) * 32 * D, D, scr, (r / nb) * 64, (r % nb) * 32, lane); }
    }
    router_weights_prep(c, tid, bid, nblk);
    cvt_copy(c.x, wsp<bf16_t>(c, OFF_XB), (long)T * D, tid, bid, nblk);
    cvt_copy(c.mem, wsp<bf16_t>(c, OFF_MEMB), (long)NBATCH * MEM * D, tid, bid, nblk);
}
__device__ __forceinline__ void expert_weights_phase(const Ctx& c, PG8_LAS unsigned char* lds, int tid, int bid, int nblk) {
    asm volatile("" : "+v"(tid));
    const int lane = tid & 63, wid = tid >> 6, gw = bid * 8 + wid, NGW = nblk * 8;
    PG8_LAS float* scr = (PG8_LAS float*)(lds + wid * 16384);
    constexpr int I_G = (D / 64) * (DE / 32), I_D = (DE / 64) * (D / 32), PER_E = 2 * I_G + I_D;
    for (int it = gw; it < NE * PER_E; it += NGW) { const int e = it / PER_E; int r = it % PER_E;
        if (r < 2 * I_G) { const int up = r / I_G; r %= I_G; const int nb = DE / 32, n0 = (r % nb) * 32, k0 = (r / nb) * 64; const float* src = (up ? c.w_eu : c.w_eg) + (size_t)e * D * DE;
            transpose_item(src, DE, wsp<bf16_t>(c, OFF_WTGU) + ((size_t)e * 2 * DE + (n0 / 128) * 256 + up * 128 + n0 % 128) * D, D, scr, k0, n0, lane); }
        else { r -= 2 * I_G; const int nb = D / 32, n0 = (r % nb) * 32, k0 = (r / nb) * 64;
            transpose_item(c.w_ed + (size_t)e * DE * D, D, wsp<bf16_t>(c, OFF_WTDN) + ((size_t)e * D + n0) * DE, DE, scr, k0, n0, lane); }
    }
}
}
namespace hgrn {
typedef float f32x4 __attribute__((ext_vector_type(4)));
typedef unsigned u32x2 __attribute__((ext_vector_type(2)));
typedef unsigned u32x4 __attribute__((ext_vector_type(4)));
constexpr int QS = 272, SS = 144;
constexpr int L_QE = 0, L_KE = L_QE + 64 * QS, L_KDT = L_KE + 64 * QS, L_VT = L_KDT + 128 * SS, L_PM = L_VT + 128 * SS,     L_ST = L_PM + 64 * SS, L_F32 = L_ST + 128 * QS;
constexpr int F_QTOT = 0, F_DL = 512, F_ER = 640, F_SSQ = 768, F_LB = 1280, L_END = L_F32 + (1280 + 128) * 4;
static_assert(L_END <= 131072, "hgrn LDS");
__device__ __forceinline__ float fexp(float x) { return __expf(fminf(fmaxf(x, -80.f), 80.f)); }
__device__ __forceinline__ bf16x8 ldfrag(const PG8_LAS char* mat, int stride, int row, int ks, int lq) { return *(const PG8_LAS bf16x8*)(mat + row * stride + ks * 64 + lq * 16); }

struct Raw { bf16x8 f0, f1, q0, q1, v0, v1; unsigned short g[16]; };
template <bool FULL>
__device__ __forceinline__ void hg_load(Raw& R, const bf16_t* P, int row0, int h, int tid, int vcol, int lq) {
    const int et = tid >> 3, ec = (tid & 7) * 8, sr = tid >> 4, sc = (tid & 15) * 8;
    const bf16_t* fp = P + (size_t)(row0 + et) * NP + COLS_A + WB + h * 128 + ec; R.f0 = *(const bf16x8*)fp; R.f1 = *(const bf16x8*)(fp + 64);
    const bf16_t* vp = P + (size_t)(row0 + sr) * NP + COLS_A + 2 * WB + h * 128 + sc; R.v0 = *(const bf16x8*)vp; R.v1 = *(const bf16x8*)(vp + (size_t)32 * NP);
    if (FULL) { const bf16_t* qp = P + (size_t)(row0 + et) * NP + COLS_A + h * 128 + ec; R.q0 = *(const bf16x8*)qp; R.q1 = *(const bf16x8*)(qp + 64);
        const bf16_t* gp = P + (size_t)(row0 + lq * 4) * NP + COLS_A + 3 * WB + h * 128 + vcol;
#pragma unroll
        for (int mt = 0; mt < 4; ++mt)
#pragma unroll
            for (int i = 0; i < 4; ++i) R.g[mt * 4 + i] = gp[(size_t)(mt * 16 + i) * NP]; }
}
template <bool FULL>
__device__ __forceinline__ void hg_unit(const Ctx& c, int half, int bl, int h, int seg, PG8_LAS char* lds, int tid) {
    const int wid = __builtin_amdgcn_readfirstlane(tid >> 6), lane = tid & 63, l15 = lane & 15, lq = lane >> 4;
    const int ek = tid & 127, etq = tid >> 7;
    const int et = tid >> 3, ec = (tid & 7) * 8;
    const int sr = tid >> 4, sc = (tid & 15) * 8;
    const int bhl = bl * HB + h;
    const bf16_t* P = wsp<bf16_t>(c, OFF_P);
    PG8_LAS float* F = (PG8_LAS float*)(lds + L_F32); PG8_LAS float* LF = (PG8_LAS float*)(lds + L_ST);
    float* Shat = wsp<float>(c, OFF_HG) + ((size_t)bhl * NSEG + seg) * 128 * 128;
    const int vcol = wid * 16 + l15;
    if (tid < 128) F[F_LB + tid] = wsp<float>(c, OFF_SMALL)[SM_LB + h * 128 + tid];
    f32x4 Sacc[8];
#pragma unroll
    for (int kt = 0; kt < 8; ++kt) {
        if (FULL) {
#pragma unroll
            for (int i = 0; i < 4; ++i) Sacc[kt][i] = Shat[(size_t)(kt * 16 + lq * 4 + i) * 128 + vcol];
        } else Sacc[kt] = (f32x4){0.f, 0.f, 0.f, 0.f};
    }
    float dsum = 0.f;
    Raw R; hg_load<FULL>(R, P, bl * S + seg * 256, h, tid, vcol, lq);
    __syncthreads();
    for (int ch = 0; ch < 4; ++ch) {
        int row0 = bl * S + seg * 256 + ch * 64;
        asm volatile("" : "+s"(row0));
        { unsigned kw[8], qw[8];
#pragma unroll
          for (int hh = 0; hh < 2; ++hh) { const bf16x8 fr = hh ? R.f1 : R.f0; const bf16x8 qr = hh ? R.q1 : R.q0; f32x4 lfo[2];
#pragma unroll
              for (int j = 0; j < 8; ++j) { const float lb = F[F_LB + ec + hh * 64 + j]; const float f = lb + (1.f - lb) * pg8::fsigmoid(bf2f((bf16_t)fr[j])); lfo[j >> 2][j & 3] = __logf(f);
                  const unsigned kb = f2bf(1.f - f); if (j & 1) kw[hh * 4 + (j >> 1)] |= kb << 16; else kw[hh * 4 + (j >> 1)] = kb;
                  if (FULL) { const float q = bf2f((bf16_t)qr[j]); const unsigned qb = f2bf(q * pg8::fsigmoid(q)); if (j & 1) qw[hh * 4 + (j >> 1)] |= qb << 16; else qw[hh * 4 + (j >> 1)] = qb; } }
              *(PG8_LAS f32x4*)(LF + et * 128 + ec + hh * 64) = lfo[0]; *(PG8_LAS f32x4*)(LF + et * 128 + ec + hh * 64 + 4) = lfo[1]; }
          *(PG8_LAS u32x4*)(lds + L_KE + et * QS + ec * 2) = (u32x4){kw[0], kw[1], kw[2], kw[3]}; *(PG8_LAS u32x4*)(lds + L_KE + et * QS + ec * 2 + 128) = (u32x4){kw[4], kw[5], kw[6], kw[7]};
          if (FULL) { *(PG8_LAS u32x4*)(lds + L_QE + et * QS + ec * 2) = (u32x4){qw[0], qw[1], qw[2], qw[3]}; *(PG8_LAS u32x4*)(lds + L_QE + et * QS + ec * 2 + 128) = (u32x4){qw[4], qw[5], qw[6], qw[7]}; } }
        *(PG8_LAS bf16x8*)(lds + L_VT + sr * QS + sc * 2) = R.v0; *(PG8_LAS bf16x8*)(lds + L_VT + (sr + 32) * QS + sc * 2) = R.v1;
        unsigned short graw[16];
#pragma unroll
        for (int i = 0; i < 16; ++i) graw[i] = R.g[i];
        __syncthreads();
        float lf[16];
        { float run = 0.f;
#pragma unroll
          for (int j = 0; j < 16; ++j) { run += LF[(etq * 16 + j) * 128 + ek]; lf[j] = run; }
          F[F_QTOT + etq * 128 + ek] = run; }
        __syncthreads();
        { const float q0 = F[F_QTOT + ek], q1 = F[F_QTOT + 128 + ek], q2 = F[F_QTOT + 256 + ek], q3 = F[F_QTOT + 384 + ek];
          const float blast = (q0 + q1) + (q2 + q3), off = etq == 0 ? 0.f : (etq == 1 ? q0 : (etq == 2 ? q0 + q1 : (q0 + q1) + q2)), r = 0.5f * blast;
          if (etq == 0) { F[F_DL + ek] = fexp(blast); F[F_ER + ek] = fexp(r); dsum += blast; }
          unsigned kd[8];
#pragma unroll
          for (int j = 0; j < 16; ++j) { const float b = off + lf[j]; PG8_LAS bf16_t* kp = (PG8_LAS bf16_t*)(lds + L_KE + (etq * 16 + j) * QS + ek * 2); const float kfv = bf2f(*kp);
              const float kdv = kfv * fexp(blast - b);
              if (j & 1) kd[j >> 1] |= (unsigned)f2bf(kdv) << 16; else kd[j >> 1] = (unsigned)f2bf(kdv);
              if (FULL) { PG8_LAS bf16_t* qp = (PG8_LAS bf16_t*)(lds + L_QE + (etq * 16 + j) * QS + ek * 2); *qp = f2bf(bf2f(*qp) * fexp(b - r)); *kp = f2bf(kfv * fexp(r - b)); } }
          *(PG8_LAS u32x4*)(lds + L_KDT + ek * SS + etq * 32) = (u32x4){kd[0], kd[1], kd[2], kd[3]};
          *(PG8_LAS u32x4*)(lds + L_KDT + ek * SS + etq * 32 + 16) = (u32x4){kd[4], kd[5], kd[6], kd[7]}; }
        if (ch < 3) hg_load<FULL>(R, P, row0 + 64, h, tid, vcol, lq);
        __syncthreads();
        f32x4 oacc[4];
        if (FULL) {
#pragma unroll
            for (int kt = 0; kt < 8; ++kt) { const f32x4 er = *(const PG8_LAS f32x4*)(F + F_ER + kt * 16 + lq * 4);
                u32x2 w; w.x = pg8::cvt_pk_bf16(Sacc[kt][0] * er[0], Sacc[kt][1] * er[1]); w.y = pg8::cvt_pk_bf16(Sacc[kt][2] * er[2], Sacc[kt][3] * er[3]);
                *(PG8_LAS u32x2*)(lds + L_ST + vcol * QS + (kt * 16 + lq * 4) * 2) = w; }
            { const int tt = wid & 3;
#pragma unroll
              for (int sti = 0; sti < 2; ++sti) { const int st = 2 * (wid >> 2) + sti; f32x4 a = (f32x4){0.f, 0.f, 0.f, 0.f};
#pragma unroll
                  for (int ks = 0; ks < 4; ++ks) a = __builtin_amdgcn_mfma_f32_16x16x32_bf16(ldfrag(lds + L_KE, QS, st * 16 + l15, ks, lq), ldfrag(lds + L_QE, QS, tt * 16 + l15, ks, lq), a, 0, 0, 0);
                  const int t = tt * 16 + l15, s0 = st * 16 + lq * 4;
                  u32x2 w; w.x = pg8::cvt_pk_bf16(s0 <= t ? a[0] : 0.f, s0 + 1 <= t ? a[1] : 0.f); w.y = pg8::cvt_pk_bf16(s0 + 2 <= t ? a[2] : 0.f, s0 + 3 <= t ? a[3] : 0.f);
                  *(PG8_LAS u32x2*)(lds + L_PM + t * SS + s0 * 2) = w; } }
            __syncthreads();
        }
        bf16x8 vb0, vb1;
#pragma unroll
        for (int j = 0; j < 8; ++j) { vb0[j] = *(const PG8_LAS short*)(lds + L_VT + (lq * 8 + j) * QS + vcol * 2); vb1[j] = *(const PG8_LAS short*)(lds + L_VT + (32 + lq * 8 + j) * QS + vcol * 2); }
        if (FULL) {
            bf16x8 sb[4];
#pragma unroll
            for (int ks = 0; ks < 4; ++ks) sb[ks] = ldfrag(lds + L_ST, QS, vcol, ks, lq);
#pragma unroll
            for (int mt = 0; mt < 4; ++mt) { f32x4 a = (f32x4){0.f, 0.f, 0.f, 0.f};
#pragma unroll
                for (int ks = 0; ks < 4; ++ks) a = __builtin_amdgcn_mfma_f32_16x16x32_bf16(ldfrag(lds + L_QE, QS, mt * 16 + l15, ks, lq), sb[ks], a, 0, 0, 0);
                a = __builtin_amdgcn_mfma_f32_16x16x32_bf16(ldfrag(lds + L_PM, SS, mt * 16 + l15, 0, lq), vb0, a, 0, 0, 0);
                a = __builtin_amdgcn_mfma_f32_16x16x32_bf16(ldfrag(lds + L_PM, SS, mt * 16 + l15, 1, lq), vb1, a, 0, 0, 0);
                oacc[mt] = a; }
        }
#pragma unroll
        for (int kt = 0; kt < 8; ++kt) { const f32x4 dl = *(const PG8_LAS f32x4*)(F + F_DL + kt * 16 + lq * 4); f32x4 a = Sacc[kt] * dl;
            a = __builtin_amdgcn_mfma_f32_16x16x32_bf16(ldfrag(lds + L_KDT, SS, kt * 16 + l15, 0, lq), vb0, a, 0, 0, 0);
            a = __builtin_amdgcn_mfma_f32_16x16x32_bf16(ldfrag(lds + L_KDT, SS, kt * 16 + l15, 1, lq), vb1, a, 0, 0, 0);
            Sacc[kt] = a; }
        if (FULL) {
#pragma unroll
            for (int mt = 0; mt < 4; ++mt)
#pragma unroll
                for (int i = 0; i < 4; ++i) { float q = oacc[mt][i] * oacc[mt][i]; q += __shfl_xor(q, 1); q += __shfl_xor(q, 2); q += __shfl_xor(q, 4); q += __shfl_xor(q, 8);
                    if (l15 == 0) F[F_SSQ + (mt * 16 + lq * 4 + i) * 8 + wid] = q; }
            __syncthreads();
            const float ng = c.norm_g[h * 128 + vcol];
            bf16_t* op = (bf16_t*)c.out + ((size_t)half * TH + row0 + lq * 4) * OW + WA + h * 128 + vcol;
#pragma unroll
            for (int mt = 0; mt < 4; ++mt)
#pragma unroll
                for (int i = 0; i < 4; ++i) { const PG8_LAS f32x4* sp = (const PG8_LAS f32x4*)(F + F_SSQ + (mt * 16 + lq * 4 + i) * 8); const f32x4 s0 = sp[0], s1 = sp[1];
                    const float ss = ((s0[0] + s0[1]) + (s0[2] + s0[3])) + ((s1[0] + s1[1]) + (s1[2] + s1[3])); const float rs = 1.f / sqrtf(ss * (1.f / 128.f) + RMS_EPS);
                    const float g = bf2f(graw[mt * 4 + i]);
                    op[(size_t)(mt * 16 + i) * OW] = f2bf(oacc[mt][i] * rs * ng * (g * pg8::fsigmoid(g))); }
        }
        __syncthreads();
    }
    if (!FULL) {
#pragma unroll
        for (int kt = 0; kt < 8; ++kt)
#pragma unroll
            for (int i = 0; i < 4; ++i) Shat[(size_t)(kt * 16 + lq * 4 + i) * 128 + vcol] = Sacc[kt][i];
        if (etq == 0) wsp<float>(c, OFF_DSEG)[((size_t)bhl * NSEG + seg) * 128 + ek] = dsum;
    }
}
template <bool FULL>
__device__ __forceinline__ void hg_phase(const Ctx& c, int half, PG8_LAS unsigned char* lds_u, int tid, int bid, int nblk) {
    asm volatile("" : "+v"(tid));
    PG8_LAS char* lds = (PG8_LAS char*)lds_u;
    constexpr int NU = BH * HB * NSEG;
    for (int u = bid; u < NU; u += nblk) { const int seg = u % NSEG, bhl = u / NSEG; hg_unit<FULL>(c, half, bhl / HB, bhl % HB, seg, lds, tid); }
}
__device__ __forceinline__ void hg_scan_phase(const Ctx& c, int tid, int bid, int nblk) {
    asm volatile("" : "+v"(tid));
    constexpr long N = (long)BH * HB * 128 * 128;
    for (long idx = (long)bid * 512 + tid; idx < N; idx += (long)nblk * 512) { const int v = (int)(idx & 127), k = (int)((idx >> 7) & 127), bhl = (int)(idx >> 14);
        float* sp = wsp<float>(c, OFF_HG) + ((size_t)bhl * NSEG * 128 + k) * 128 + v; const float* dp = wsp<float>(c, OFF_DSEG) + (size_t)bhl * NSEG * 128 + k;
        float tmp[NSEG], dd[NSEG];
#pragma unroll
        for (int sg = 0; sg < NSEG; ++sg) { tmp[sg] = sp[(size_t)sg * 128 * 128]; dd[sg] = dp[sg * 128]; }
        float run = 0.f;
#pragma unroll
        for (int sg = 0; sg < NSEG; ++sg) { const float t = tmp[sg]; tmp[sg] = run; run = __expf(dd[sg]) * run + t; }
#pragma unroll
        for (int sg = 0; sg < NSEG; ++sg) sp[(size_t)sg * 128 * 128] = tmp[sg];
    }
}
__device__ __forceinline__ void comb_phase(const Ctx& c, int half, int tid, int bid, int nblk) {
    asm volatile("" : "+v"(tid));
    constexpr long N = (long)TH * WA / 8; const float* lse = wsp<float>(c, OFF_LSE); const bf16_t* part = wsp<bf16_t>(c, OFF_PART);
    for (long idx = (long)bid * 512 + tid; idx < N; idx += (long)nblk * 512) { const int c8 = (int)(idx % (WA / 8)), tl = (int)(idx / (WA / 8)), col = c8 * 8, h = col >> 7;
        const float l0 = lse[((size_t)0 * TH + tl) * 4 + h], l1 = lse[((size_t)1 * TH + tl) * 4 + h], l2 = lse[((size_t)2 * TH + tl) * 4 + h];
        const float mx = fmaxf(l0, fmaxf(l1, l2)), e0 = __expf(l0 - mx), e1 = __expf(l1 - mx), e2 = __expf(l2 - mx), inv = 1.f / (e0 + e1 + e2), w0 = e0 * inv, w1 = e1 * inv, w2 = e2 * inv;
        f32x4 a0, a1, b0, b1, c0, c1;
        pg8::unpack8(*(const u32x4*)(part + ((size_t)0 * TH + tl) * WA + col), a0, a1); pg8::unpack8(*(const u32x4*)(part + ((size_t)1 * TH + tl) * WA + col), b0, b1); pg8::unpack8(*(const u32x4*)(part + ((size_t)2 * TH + tl) * WA + col), c0, c1);
        *(u32x4*)((bf16_t*)c.out + ((size_t)half * TH + tl) * OW + col) = pg8::pack8(a0 * w0 + b0 * w1 + c0 * w2, a1 * w0 + b1 * w1 + c1 * w2); }
}
}
#define XB_TMO      128
#define XB_XCNT(j)  (256  + 64 * (j))
#define XB_XSUB(j)  (1280 + 64 * (j))
#define XB_XGEN(j)  (2304 + 64 * (j))
#define XB_TOP      3328
#define XB_TOPGEN   3392
#define XCD_BAR_WORDS 3456
#define XB_SPIN_CAP (1u << 18)
__device__ __forceinline__ unsigned xb_ld(unsigned* p)              { return __hip_atomic_load(p, __ATOMIC_RELAXED, __HIP_MEMORY_SCOPE_AGENT); }
__device__ __forceinline__ unsigned xb_add(unsigned* p, unsigned v) { return __hip_atomic_fetch_add(p, v, __ATOMIC_RELAXED, __HIP_MEMORY_SCOPE_AGENT); }
__device__ __forceinline__ unsigned xb_xcc_id() { return (unsigned)__builtin_amdgcn_s_getreg((3 << 11) | 20) & 0xFu; }
#define XB_SPIN(cond, bar) do { unsigned _sp = 0; while (cond) { __builtin_amdgcn_s_sleep(1); \
    if ((++_sp & 255u) == 0u) { if (xb_ld(&(bar)[XB_TMO])) break; if (_sp > XB_SPIN_CAP) { atomicAdd(&(bar)[XB_TMO], 1u); break; } } } } while (0)
struct XcdBarrier { unsigned* bar; unsigned x; volatile PG8_LAS unsigned* st; };
__device__ __forceinline__ XcdBarrier xcd_barrier_post(unsigned* bar, volatile PG8_LAS unsigned* st, int tid) {
    XcdBarrier b; b.bar = bar; b.x = xb_xcc_id(); b.st = st;
    if (tid == 0) (void)xb_add(&bar[XB_XCNT(b.x)], 1u);
    return b;
}
__device__ __forceinline__ void xcd_barrier_complete(unsigned* bar, unsigned x, unsigned& nloc, unsigned& nx) {
    const unsigned G = gridDim.x * gridDim.y * gridDim.z;
    unsigned sum, cnt, mine, sp = 0u;
    for (;;) {
        sum = 0u; cnt = 0u; mine = 0u;
#pragma unroll
        for (unsigned j = 0; j < 16; ++j) { const unsigned c = xb_ld(&bar[XB_XCNT(j)]); sum += c; cnt += (c > 0u) ? 1u : 0u; mine = (j == x) ? c : mine; }
        if (sum == G) break;
        __builtin_amdgcn_s_sleep(1);
        if ((++sp & 255u) == 0u) { if (xb_ld(&bar[XB_TMO])) break; if (sp > XB_SPIN_CAP) { atomicAdd(&bar[XB_TMO], 1u); break; } }
    }
    nloc = mine > 0u ? mine : 1u; nx = cnt > 0u ? cnt : 1u;
}
__device__ __forceinline__ void xcd_barrier(const XcdBarrier& b, int tid) {
    asm volatile("s_waitcnt vmcnt(0)" ::: "memory");
    __syncthreads();
    if (tid == 0) {
        unsigned* bar = b.bar;
        __builtin_amdgcn_s_waitcnt(0);
        unsigned nloc = b.st[0], nx = b.st[1];
        if (nloc == 0u) { xcd_barrier_complete(bar, b.x, nloc, nx); b.st[0] = nloc; b.st[1] = nx; }
        const unsigned old = xb_add(&bar[XB_XSUB(b.x)], 1u);
        const unsigned gen = old / nloc;
        if (old + 1u == (gen + 1u) * nloc) {
            __builtin_amdgcn_fence(__ATOMIC_RELEASE, "agent");
            asm volatile("s_waitcnt vmcnt(0)" ::: "memory");
            const unsigned og = xb_add(&bar[XB_TOP], 1u);
            const unsigned tg = og / nx;
            if (og + 1u == (tg + 1u) * nx) xb_add(&bar[XB_TOPGEN], 1u);
            else XB_SPIN(xb_ld(&bar[XB_TOPGEN]) == tg, bar);
            __builtin_amdgcn_fence(__ATOMIC_ACQUIRE, "agent");
            xb_add(&bar[XB_XGEN(b.x)], 1u);
            asm volatile("s_waitcnt vmcnt(0)" ::: "memory");
        } else {
            XB_SPIN(xb_ld(&bar[XB_XGEN(b.x)]) == gen, bar);
            __builtin_amdgcn_fence(__ATOMIC_ACQUIRE, "agent");
            asm volatile("s_waitcnt vmcnt(0)" ::: "memory");
        }
    }
    __syncthreads();
}
#include <hip/hip_cooperative_groups.h>
namespace cg = cooperative_groups;
constexpr int NTHR = 512, LDS_BYTES = 147456;

template <class F> __device__ __forceinline__ void dev_elems_(const F& f, long n, int tid, int bid, int nblk) {
    asm volatile("" : "+v"(tid));
    for (long i = (long)bid * NTHR + tid; i < n; i += (long)nblk * NTHR) f(i);
}
template <class G> __device__ __forceinline__ void dev_sgemm_(const G& g, int tid, int bid, int nblk) {
    asm volatile("" : "+v"(tid));
    const int M = g.M(); const int lane = tid & 63, wid = tid >> 6; constexpr int ntn = G::N / 64;
    const long ntiles = (long)(M / 16) * ntn;
    for (long tile = (long)bid * 8 + wid; tile < ntiles; tile += (long)nblk * 8) {
        const int tm = (int)(tile / ntn), tn = (int)(tile % ntn), r0 = tm * 16, c0 = tn * 64;
        f32x4 acc[G::NBP][4], carry[4];
#pragma unroll
        for (int j = 0; j < 4; ++j) { carry[j] = (f32x4){0.f, 0.f, 0.f, 0.f};
#pragma unroll
            for (int w = 0; w < G::NBP; ++w) acc[w][j] = (f32x4){0.f, 0.f, 0.f, 0.f}; }
#pragma unroll
        for (int seg = 0; seg < G::NSEGS; ++seg) {
            const bf16_t* ar = g.arow(seg, r0 + (lane & 15)) + 8 * (lane >> 4); const bf16_t* br[G::NBP][4];
#pragma unroll
            for (int w = 0; w < G::NBP; ++w)
#pragma unroll
                for (int j = 0; j < 4; ++j) br[w][j] = g.brow(seg, r0, c0 + 16 * j + (lane & 15), w) + 8 * (lane >> 4);
            const int K = g.K(seg);
            for (int k0 = 0; k0 < K; k0 += 32) { const bf16x8 a = *(const bf16x8*)(ar + k0);
#pragma unroll
                for (int w = 0; w < G::NBP; ++w)
#pragma unroll
                    for (int j = 0; j < 4; ++j) { const bf16x8 b = *(const bf16x8*)(br[w][j] + k0); acc[w][j] = __builtin_amdgcn_mfma_f32_16x16x32_bf16(a, b, acc[w][j], 0, 0, 0); } }
#pragma unroll
            for (int j = 0; j < 4; ++j)
#pragma unroll
                for (int i = 0; i < 4; ++i) { float a = acc[0][j][i], cr = carry[j][i]; g.between(seg, r0 + (lane >> 4) * 4 + i, c0 + 16 * j + (lane & 15), a, cr); acc[0][j][i] = a; carry[j][i] = cr; }
        }
#pragma unroll
        for (int j = 0; j < 4; ++j)
#pragma unroll
            for (int i = 0; i < 4; ++i) g.store(r0 + (lane >> 4) * 4 + i, c0 + 16 * j + (lane & 15), acc[0][j][i], G::NBP == 2 ? acc[G::NBP - 1][j][i] : carry[j][i]);
    }
}

struct E_hg3q { Ctx c; int half; static constexpr long n = (long)BH * HB * NSEG * 128 * 4;
    __device__ __forceinline__ void operator()(long idx) const { const int kq = (int)(idx & 3), v = (int)((idx >> 2) & 127); const long r = idx >> 9; const int seg = (int)(r % NSEG), bhl = (int)(r / NSEG), h = bhl % HB, bl = bhl / HB;
        const bf16_t* P = wsp<bf16_t>(c, OFF_P); float st[32];
#pragma unroll
        for (int k = 0; k < 32; ++k) st[k] = wsp<float>(c, OFF_HG)[(((size_t)bhl * NSEG + seg) * 128 + kq * 32 + k) * 128 + v];
        for (int s = 0; s < 256; ++s) { const int tl = bl * S + seg * 256 + s; const bf16_t* pr = P + (size_t)tl * NP; const float iv = bf2f(pr[COLS_A + 2 * WB + h * 128 + v]); float o = 0.f;
#pragma unroll
            for (int k = 0; k < 32; ++k) { const int kk = kq * 32 + k; const float f = hg_f(c, pr, h * 128 + kk); st[k] = f * st[k] + (1.f - f) * iv; o += siluf_(bf2f(pr[COLS_A + h * 128 + kk])) * st[k]; }
            o += __shfl_xor(o, 1); o += __shfl_xor(o, 2);
            if (kq == 0) ((bf16_t*)c.out)[((size_t)half * TH + tl) * OW + WA + h * 128 + v] = f2bf(o); } } };

typedef const __attribute__((address_space(4))) Ctx* CtxK;
#if defined(__HIP_DEVICE_COMPILE__)
__device__ __forceinline__ Ctx load_ctx() { CtxK p = (CtxK)__builtin_amdgcn_kernarg_segment_ptr(); asm volatile("" : "+s"(p)); return *p; }
#else
__device__ inline Ctx load_ctx() { return Ctx(); }
#endif
#define PH_BEGIN { const Ctx c = load_ctx(); const int tid = wid_s * 64 + pg8::lane_id_opaque(); int bid = blockIdx.x, nblk = gridDim.x; asm volatile("" : "+s"(bid), "+s"(nblk));
#define dev_elems(...) dev_elems_(__VA_ARGS__, tid, bid, nblk)
#define dev_sgemm(...) dev_sgemm_(__VA_ARGS__, tid, bid, nblk)
#define PH_END }
#ifndef DUP
#define DUP -1
#endif
#define GSYNC() do { xcd_barrier(xbar, tid_k); if (DUP == 20) xcd_barrier(xbar, tid_k); } while (0)
#define REP(k) for (int rep_ = 0; rep_ < ((DUP == (k)) ? 2 : 1); ++rep_)

__global__ void __launch_bounds__(NTHR) mega(Ctx c_arg) {
    extern __shared__ __attribute__((aligned(16))) unsigned char lds_raw[];
    PG8_LAS unsigned char* lds = (PG8_LAS unsigned char*)lds_raw;
    cg::grid_group grid = cg::this_grid();
    const int wid_s = __builtin_amdgcn_readfirstlane((int)threadIdx.x >> 6);
    volatile PG8_LAS unsigned* bst = (volatile PG8_LAS unsigned*)(lds + LDS_MISC);
    if (threadIdx.x == 0) { bst[0] = 0u; bst[1] = 0u; }
    __syncthreads();
    const XcdBarrier xbar = xcd_barrier_post(wsp<unsigned>(c_arg, OFF_CTL) + 4096, bst, (int)threadIdx.x);
#define tid_k (wid_s * 64 + pg8::lane_id_opaque())
    PH_BEGIN
    dev_elems(S0_small{c}, S0_small::n); REP(0) rowops::prologue_phase(c, lds, tid, bid, nblk);
    PH_END
    grid.sync();
#pragma unroll
    for (int half = 0; half < NHALF; ++half) {
        PH_BEGIN
        REP(1) fast_proj(c, half, lds, tid, bid, nblk);
        PH_END
        GSYNC();
        PH_BEGIN
        if (half == 0) fast_memkv(c, lds, tid, bid, nblk);
        REP(2) hgrn::hg_phase<false>(c, half, lds, tid, bid, nblk);
        PH_END
        GSYNC();
        PH_BEGIN
        hgrn::hg_scan_phase(c, tid, bid, nblk); REP(3) attn::attn_phase(c, half, lds, tid, bid, nblk);
        PH_END
        GSYNC();
        PH_BEGIN
        REP(4) hgrn::hg_phase<true>(c, half, lds, tid, bid, nblk); REP(12) hgrn::comb_phase(c, half, tid, bid, nblk);
        PH_END
        GSYNC();
    }
    PH_BEGIN
    REP(13) { rowops::expert_weights_phase(c, lds, tid, bid, nblk); __syncthreads(); } REP(5) fast_gates(c, lds, tid, bid, nblk);
    PH_END
    GSYNC();
    PH_BEGIN
    REP(6) fast_merge(c, lds, tid, bid, nblk);
    PH_END
    GSYNC();
    PH_BEGIN
    REP(7) fast_wout(c, lds, tid, bid, nblk);
    PH_END
    GSYNC();
    PH_BEGIN
    rowops::ln1_router_phase<false>(c, lds, tid, bid, nblk); if (DUP == 8) { __syncthreads(); rowops::ln1_router_phase<true>(c, lds, tid, bid, nblk); }
    PH_END
    GSYNC();
    PH_BEGIN
    REP(9) fast_moe1(c, lds, tid, bid, nblk);
    PH_END
    GSYNC();
    PH_BEGIN
    REP(10) fast_moe2(c, lds, tid, bid, nblk);
    PH_END
    GSYNC();
    PH_BEGIN
    REP(11) rowops::ln2_phase(c, tid, bid, nblk);
    PH_END
}

extern "C" void kernel_launch(void* const* d_in, const int* in_sizes, int n_in, void* d_out, int out_size, void* d_ws, size_t ws_size, hipStream_t stream) {
    if (n_in != 22 || in_sizes[0] != T * D || out_size != T * D || ws_size < WS_END) { fprintf(stderr, "kernel_launch: unexpected shapes / workspace (%zu < %zu)\n", ws_size, (size_t)WS_END); return; }
    static int grid_blocks = 0;
    if (!grid_blocks) {
        int dev = 0, cus = 0, per_cu = 0;
        hipGetDevice(&dev); hipDeviceGetAttribute(&cus, hipDeviceAttributeMultiprocessorCount, dev);
        hipFuncSetAttribute((const void*)mega, hipFuncAttributeMaxDynamicSharedMemorySize, LDS_BYTES);
        hipOccupancyMaxActiveBlocksPerMultiprocessor(&per_cu, (const void*)mega, NTHR, LDS_BYTES);
        if (per_cu < 1) { fprintf(stderr, "kernel_launch: occupancy query says %d blocks/CU\n", per_cu); per_cu = 1; }
        if (per_cu > 1) per_cu = 1;
        grid_blocks = cus * per_cu;
    }
    Ctx c = make_ctx(d_in, d_out, d_ws);
    hipMemsetAsync((char*)d_ws + OFF_CTL, 0, 65536, stream);
    void* args[] = {&c};
    hipError_t e = hipLaunchCooperativeKernel((const void*)mega, dim3(grid_blocks), dim3(NTHR), args, LDS_BYTES, stream);
    if (e != hipSuccess) fprintf(stderr, "cooperative launch failed: %s (grid %d)\n", hipGetErrorString(e), grid_blocks);
}
```

```cpp
#ifdef HOST_TEST
#include <cmath>
#include <cstdint>
#include <cstdio>
#include <cstring>
#define HD
#define GLOBAL
#else
#include <hip/hip_runtime.h>
#include <cstdint>
#include <cstdio>
#include <cstring>
#include <cmath>
#define HD __host__ __device__ __forceinline__
#endif

#ifndef CFG_D
#define CFG_D 1024
#define CFG_B 4
#define CFG_S 8192
#endif
typedef unsigned short bf16_t;
constexpr int D = CFG_D, NBATCH = CFG_B, S = CFG_S, T = NBATCH * S;
constexpr int NHALF = 2, TH = T / NHALF, BH = NBATCH / NHALF;
constexpr int WA = 512, HB = D / 128, WB = D, WC = 512;
constexpr int COLS_A = 4608, COLS_B = 4 * WB, COLS_C = 512, COLS_G = 3 * D;
constexpr int NP = COLS_A + COLS_B + COLS_C, N_IN = NP + COLS_G;
constexpr int NPB = NP - COLS_A;
constexpr int OW = WA + WB + WC;
constexpr int DE = D / 4, NE = 32, HBK = DE < 128 ? DE : 128;
constexpr int MEM = 256, NSEG = S / 256;
constexpr int MAXROWS = 2 * T + NE * 256;
constexpr float DN_ALPHA = 1.189207115002721f;
constexpr float LN_EPS = 1e-5f, RMS_EPS = 1e-6f;
constexpr float QK_SCALE = 0.08838834764831845f;

constexpr size_t MiB = 1u << 20;
constexpr size_t al(size_t x) { return (x + 4095) & ~(size_t)4095; }
constexpr size_t OFF_CTL = 0;
constexpr size_t OFF_SMALL = 1 * MiB;
constexpr size_t OFF_WT = 2 * MiB;
constexpr size_t WT_IN = OFF_WT, WT_KV = WT_IN + al((size_t)N_IN * D * 2), WT_A = WT_KV + al((size_t)1024 * D * 2),
                 WT_B = WT_A + al((size_t)D * WA * 2), WT_C = WT_B + al((size_t)D * WB * 2), WT_OUT = WT_C + al((size_t)D * WC * 2),
                 OFF_MEMB = WT_OUT + al((size_t)D * D * 2), OFF_MEMKV = OFF_MEMB + al((size_t)NBATCH * MEM * D * 2),
                 OFF_LIST = OFF_MEMKV + al((size_t)NBATCH * MEM * 1024 * 2), OFF_RW = OFF_LIST + al((size_t)NE * T * 4),
                 OFF_XB = OFF_RW + al((size_t)T * 2 * 4), OFF_P = OFF_XB + al((size_t)T * D * 2),
                 OFF_PART = OFF_P + al((size_t)TH * NP * 2), OFF_LSE = OFF_PART + al((size_t)3 * TH * WA * 2),
                 OFF_HG = OFF_LSE + al((size_t)3 * TH * 4 * 4), OFF_DSEG = OFF_HG + al((size_t)BH * HB * NSEG * 128 * 128 * 4),
                 WS_END = OFF_DSEG + al((size_t)BH * HB * NSEG * 128 * 4);
constexpr size_t OFF_PB = OFF_P + (size_t)TH * COLS_A * 2, PLANE = (size_t)TH * 128;
constexpr size_t OFF_GATES = OFF_P, OFF_H1 = OFF_P, OFF_X1B = OFF_P + al((size_t)T * D * 4),
                 OFF_WTGU = OFF_P + al((size_t)T * 3 * D * 2), OFF_WTDN = OFF_WTGU + al((size_t)NE * 2 * DE * D * 2),
                 OFF_HBUF = OFF_WTDN + al((size_t)NE * D * DE * 2), OFF_PEND = OFF_HBUF + al((size_t)MAXROWS * DE * 2);
constexpr size_t OFF_STATS = OFF_HG + 20 * MiB;
static_assert(OFF_PART + (size_t)T * D * 2 <= OFF_STATS && OFF_STATS + (size_t)16 * T * 8 <= OFF_DSEG, "stats inside the dead HG region, above y1");
constexpr size_t OFF_MERGED = OFF_PART, OFF_Y0 = OFF_XB, OFF_Y1 = OFF_PART;
static_assert(OFF_MERGED + (size_t)T * D * 2 <= OFF_STATS, "merged below the stats");
static_assert(OFF_X1B + (size_t)T * D * 2 <= OFF_WTGU, "x1b inside dead gates region");
static_assert(OFF_PEND <= OFF_PART, "P-region overlays fit");
static_assert(OFF_Y1 + (size_t)T * D * 2 <= WS_END, "y1 fits in part+hg region");
constexpr int CW_CNT = 0;
constexpr int SM_BIAS = 0, SM_LB = 2048, SM_BLK = 2048 + 4096;

HD float bf2f(bf16_t v) { union { unsigned u; float f; } c; c.u = (unsigned)v << 16; return c.f; }
HD bf16_t f2bf(float f) { union { unsigned u; float f; } c; c.f = f; unsigned u = c.u; return (bf16_t)((u + 0x7fffu + ((u >> 16) & 1u)) >> 16); }
HD float sigmoidf_(float x) { return 1.0f / (1.0f + expf(-x)); }
HD float siluf_(float x) { return x / (1.0f + expf(-x)); }
HD int dil_of(int g) { return g == 0 ? 1 : (g == 1 ? 4 : 16); }
HD int perm_row(int tl, int g) { const int r = dil_of(g), bl = tl / S, s = tl % S; return bl * S + (s % r) * (S / r) + s / r; }

struct Ctx {
    const float *x, *mem, *rel_bias, *lb_logits, *w_in, *w_kv, *norm_g, *w_a, *w_b, *w_c, *w_out, *ln1_g, *ln1_b, *w_rg, *b_rg, *w_re, *b_re, *w_eg, *w_eu, *w_ed, *ln2_g, *ln2_b;
    float* out; unsigned char* ws;
};
#ifdef HOST_TEST
static const unsigned char T5_BUCKET[3][129] = {
#else
__device__ const unsigned char T5_BUCKET[3][129] = {
#endif
{0,1,2,3,4,5,6,7,8,9,10,11,12,13,14,15,16,16,16,16,16,16,17,17,17,17,17,17,17,17,18,18,18,18,18,18,18,18,18,18,19,19,19,19,19,19,19,19,19,19,19,19,19,19,20,20,20,20,20,20,20,20,20,20,20,20,20,20,20,20,20,20,20,21,21,21,21,21,21,21,21,21,21,21,21,21,21,21,21,21,21,21,21,21,21,21,21,21,21,22,22,22,22,22,22,22,22,22,22,22,22,22,22,22,22,22,22,22,22,22,22,22,22,22,22,22,22,22,22},
{0,4,8,12,16,16,17,17,18,18,19,19,19,19,20,20,20,20,20,21,21,21,21,21,21,22,22,22,22,22,22,22,22,22,23,23,23,23,23,23,23,23,23,23,23,23,24,24,24,24,24,24,24,24,24,24,24,24,24,24,24,24,25,25,25,25,25,25,25,25,25,25,25,25,25,25,25,25,25,25,25,25,25,26,26,26,26,26,26,26,26,26,26,26,26,26,26,26,26,26,26,26,26,26,26,26,26,26,26,26,26,26,26,27,27,27,27,27,27,27,27,27,27,27,27,27,27,27,27},
{0,16,18,19,20,21,21,22,22,23,23,23,24,24,24,24,25,25,25,25,25,26,26,26,26,26,26,26,26,27,27,27,27,27,27,27,27,27,27,28,28,28,28,28,28,28,28,28,28,28,28,28,29,29,29,29,29,29,29,29,29,29,29,29,29,29,29,29,29,29,30,30,30,30,30,30,30,30,30,30,30,30,30,30,30,30,30,30,30,30,30,30,30,30,30,31,31,31,31,31,31,31,31,31,31,31,31,31,31,31,31,31,31,31,31,31,31,31,31,31,31,31,31,31,31,31,31,31,31}};
template <class Tp> HD Tp* wsp(const Ctx& c, size_t off) { return (Tp*)(c.ws + off); }

#ifdef HOST_TEST
static inline unsigned atomic_inc_u32(unsigned* p) { unsigned r;
#pragma omp atomic capture
    { r = *p; *p += 1; }
    return r; }
#else
__device__ __forceinline__ unsigned atomic_inc_u32(unsigned* p) { return atomicAdd(p, 1u); }
#endif

struct S0_xb { Ctx c; static constexpr long n = (long)T * D;
    HD void operator()(long i) const { wsp<bf16_t>(c, OFF_XB)[i] = f2bf(c.x[i]); } };
struct S0_memb { Ctx c; static constexpr long n = (long)NBATCH * MEM * D;
    HD void operator()(long i) const { wsp<bf16_t>(c, OFF_MEMB)[i] = f2bf(c.mem[i]); } };
struct S0_tr { const float* W; bf16_t* Wt; int K, N; long n; int ldo;
    HD void operator()(long i) const { const int k = (int)(i % K); const long nn = i / K; Wt[(size_t)nn * ldo + k] = f2bf(W[(size_t)k * N + nn]); } };
struct S0_gu { Ctx c; static constexpr long n = (long)NE * 2 * DE * D;
    HD void operator()(long i) const { const int k = (int)(i % D); const long r = i / D; const int j = (int)(r % (2 * DE)), e = (int)(r / (2 * DE));
        const int u = j / (2 * HBK), w = j % (2 * HBK), hid = u * HBK + w % HBK, up = w / HBK;
        const float* src = up ? c.w_eu : c.w_eg; wsp<bf16_t>(c, OFF_WTGU)[i] = f2bf(src[((size_t)e * D + k) * DE + hid]); } };
struct S0_dn { Ctx c; static constexpr long n = (long)NE * D * DE;
    HD void operator()(long i) const { const int k = (int)(i % DE); const long r = i / DE; const int col = (int)(r % D), e = (int)(r / D);
        wsp<bf16_t>(c, OFF_WTDN)[i] = f2bf(c.w_ed[((size_t)e * DE + k) * D + col]); } };
struct S0_small { Ctx c; static constexpr long n = 12 * 129 + WB + 64 + 512;
    HD void operator()(long i) const { float* sm = wsp<float>(c, OFF_SMALL);
        if (i < 12 * 129) { const int gh = (int)(i / 129), u = (int)(i % 129), g = gh / 4; sm[SM_BIAS + i] = c.rel_bias[T5_BUCKET[g][u] * 12 + gh]; }
        else if (i < 12 * 129 + WB) { const int ch = (int)(i - 12 * 129); sm[SM_LB + ch] = sigmoidf_(c.lb_logits[ch] - c.lb_logits[WB + ch]); }
        else { const int j = (int)(i - 12 * 129 - WB); wsp<unsigned>(c, OFF_CTL)[j < 64 ? j : 1024 + (j - 64)] = 0u; } } };

struct G_proj { Ctx c; int half; static constexpr int N = NP, NSEGS = 1, NBP = 1;
    HD int M() const { return TH; } HD int K(int) const { return D; }
    HD const bf16_t* arow(int, int row) const { return wsp<bf16_t>(c, OFF_XB) + ((size_t)half * TH + row) * D; }
    HD const bf16_t* brow(int, int, int col, int) const { return wsp<bf16_t>(c, WT_IN) + (size_t)col * D; }
    HD void between(int, int, int, float&, float&) const {}
    HD void store(int row, int col, float a, float) const { const int pr = col < COLS_A ? perm_row(row, col / 1536) : row; wsp<bf16_t>(c, OFF_P)[(size_t)pr * NP + col] = f2bf(a); } };
struct G_memkv { Ctx c; static constexpr int N = 1024, NSEGS = 1, NBP = 1;
    HD int M() const { return NBATCH * MEM; } HD int K(int) const { return D; }
    HD const bf16_t* arow(int, int row) const { return wsp<bf16_t>(c, OFF_MEMB) + (size_t)row * D; }
    HD const bf16_t* brow(int, int, int col, int) const { return wsp<bf16_t>(c, WT_KV) + (size_t)col * D; }
    HD void between(int, int, int, float&, float&) const {}
    HD void store(int row, int col, float a, float) const { wsp<bf16_t>(c, OFF_MEMKV)[(size_t)row * 1024 + col] = f2bf(a); } };
struct G_gates { Ctx c; static constexpr int N = 3 * D, NSEGS = 1, NBP = 1;
    HD int M() const { return T; } HD int K(int) const { return D; }
    HD const bf16_t* arow(int, int row) const { return wsp<bf16_t>(c, OFF_XB) + (size_t)row * D; }
    HD const bf16_t* brow(int, int, int col, int) const { return wsp<bf16_t>(c, WT_IN) + (size_t)(NP + col) * D; }
    HD void between(int, int, int, float&, float&) const {}
    HD void store(int row, int col, float a, float) const { wsp<bf16_t>(c, OFF_GATES)[((size_t)(col / D) * T + row) * D + col % D] = f2bf(sigmoidf_(a)); } };
struct G_merge { Ctx c; static constexpr int N = D, NSEGS = 3, NBP = 1;
    HD int M() const { return T; } HD int K(int s) const { return s == 1 ? WB : 512; }
    HD const bf16_t* arow(int s, int row) const { return (const bf16_t*)c.out + (size_t)row * OW + (s == 0 ? 0 : (s == 1 ? WA : WA + WB)); }
    HD const bf16_t* brow(int s, int, int col, int) const { return wsp<bf16_t>(c, WT_A) + (size_t)col * OW + (s == 0 ? 0 : (s == 1 ? WA : WA + WB)); }
    HD void between(int s, int row, int col, float& acc, float& carry) const { carry += bf2f(wsp<bf16_t>(c, OFF_GATES)[((size_t)s * T + row) * D + col]) * acc; acc = 0.f; }
    HD void store(int row, int col, float, float carry) const { wsp<bf16_t>(c, OFF_MERGED)[(size_t)row * D + col] = f2bf(carry); } };
struct G_wout { Ctx c; static constexpr int N = D, NSEGS = 1, NBP = 1;
    HD int M() const { return T; } HD int K(int) const { return D; }
    HD const bf16_t* arow(int, int row) const { return wsp<bf16_t>(c, OFF_MERGED) + (size_t)row * D; }
    HD const bf16_t* brow(int, int, int col, int) const { return wsp<bf16_t>(c, WT_OUT) + (size_t)col * D; }
    HD void between(int, int, int, float&, float&) const {}
    HD void store(int row, int col, float a, float) const { wsp<float>(c, OFF_H1)[(size_t)row * D + col] = DN_ALPHA * c.x[(size_t)row * D + col] + a; } };
struct MoeRow { int e, pos, valid, entry; };
HD MoeRow moe_row(const Ctx& c, int row) {
    const int* blk = wsp<int>(c, OFF_SMALL) + SM_BLK; const unsigned* cnt = wsp<unsigned>(c, OFF_CTL) + CW_CNT;
    MoeRow r; const int rb = row >> 8; r.e = blk[64 + rb]; r.pos = ((rb - blk[r.e]) << 8) + (row & 255); r.valid = r.pos < (int)cnt[r.e];
    r.entry = wsp<int>(c, OFF_LIST)[(size_t)r.e * T + (r.valid ? r.pos : 0)]; return r; }
HD int moe_rows_total(const Ctx& c) { return (wsp<int>(c, OFF_SMALL) + SM_BLK)[32] << 8; }
struct G_moe1 { Ctx c; static constexpr int N = DE, NSEGS = 1, NBP = 2;
    HD int M() const { return moe_rows_total(c); } HD int K(int) const { return D; }
    HD const bf16_t* arow(int, int row) const { const MoeRow r = moe_row(c, row); return wsp<bf16_t>(c, OFF_X1B) + (size_t)(r.entry >> 1) * D; }
    HD const bf16_t* brow(int, int row0, int col, int which) const { const int e = (wsp<int>(c, OFF_SMALL) + SM_BLK)[64 + (row0 >> 8)];
        return wsp<bf16_t>(c, OFF_WTGU) + ((size_t)e * 2 * DE + (col / HBK) * 2 * HBK + which * HBK + col % HBK) * D; }
    HD void between(int, int, int, float&, float&) const {}
    HD void store(int row, int col, float g, float u) const { wsp<bf16_t>(c, OFF_HBUF)[(size_t)row * DE + col] = f2bf(siluf_(g) * u); } };
struct G_moe2 { Ctx c; static constexpr int N = D, NSEGS = 1, NBP = 1;
    HD int M() const { return moe_rows_total(c); } HD int K(int) const { return DE; }
    HD const bf16_t* arow(int, int row) const { return wsp<bf16_t>(c, OFF_HBUF) + (size_t)row * DE; }
    HD const bf16_t* brow(int, int row0, int col, int) const { const int e = (wsp<int>(c, OFF_SMALL) + SM_BLK)[64 + (row0 >> 8)]; return wsp<bf16_t>(c, OFF_WTDN) + ((size_t)e * D + col) * DE; }
    HD void between(int, int, int, float&, float&) const {}
    HD void store(int row, int col, float a, float) const { const MoeRow r = moe_row(c, row); if (!r.valid) return;
        wsp<bf16_t>(c, (r.entry & 1) ? OFF_Y1 : OFF_Y0)[(size_t)(r.entry >> 1) * D + col] = f2bf(a); } };

struct u32x4_t { unsigned x, y, z, w; };
HD float bflo(unsigned u) { union { unsigned u; float f; } c; c.u = u << 16; return c.f; }
HD float bfhi(unsigned u) { union { unsigned u; float f; } c; c.u = u & 0xffff0000u; return c.f; }
HD float dot128(const bf16_t* a, const bf16_t* b) { float s = 0.f; const u32x4_t* pa = (const u32x4_t*)a; const u32x4_t* pb = (const u32x4_t*)b;
#ifndef HOST_TEST
#pragma unroll 4
#endif
    for (int d = 0; d < 16; ++d) { const u32x4_t ua = pa[d], ub = pb[d];
        s += bflo(ua.x) * bflo(ub.x) + bfhi(ua.x) * bfhi(ub.x) + bflo(ua.y) * bflo(ub.y) + bfhi(ua.y) * bfhi(ub.y) + bflo(ua.z) * bflo(ub.z) + bfhi(ua.z) * bfhi(ub.z) + bflo(ua.w) * bflo(ub.w) + bfhi(ua.w) * bfhi(ub.w); }
    return s; }
struct E_attnA { Ctx c; int half; static constexpr long n = (long)TH * 3 * 4 * 8;
    HD void operator()(long idx) const {
        const int p = (int)(idx & 7), h = (int)((idx >> 3) & 3); const long rest = idx >> 5; const int g = (int)(rest % 3), tl = (int)(rest / 3);
        const int r = dil_of(g), bl = tl / S, s = tl % S, cc = s % r, nq = s / r, L = S / r, base = bl * S + cc * L;
        const bf16_t* P = wsp<bf16_t>(c, OFF_P); const float* bias = wsp<float>(c, OFF_SMALL) + SM_BIAS + (g * 4 + h) * 129;
        const bf16_t* q = P + (size_t)(base + nq) * NP + g * 1536 + h * 128;
        float m = -INFINITY, l = 0.f, o[16];
#ifndef HOST_TEST
#pragma unroll
#endif
        for (int j = 0; j < 16; ++j) o[j] = 0.f;
        const int umax = nq < 128 ? nq : 128;
        for (int u = 0; u <= umax; ++u) {
            const bf16_t* kr = P + (size_t)(base + nq - u) * NP + g * 1536 + 512 + h * 128; const bf16_t* vr = kr + 512 + p * 16;
            const float sc = dot128(q, kr) * QK_SCALE + bias[u];
            const float mn = fmaxf(m, sc), a = expf(m - mn), pw = expf(sc - mn); l = l * a + pw; m = mn;
#ifndef HOST_TEST
#pragma unroll
#endif
            for (int j = 0; j < 16; ++j) o[j] = o[j] * a + pw * bf2f(vr[j]);
        }
        bf16_t* op = wsp<bf16_t>(c, OFF_PART) + ((size_t)g * TH + tl) * WA + h * 128 + p * 16; const float il = 1.f / l;
#ifndef HOST_TEST
#pragma unroll
#endif
        for (int j = 0; j < 16; ++j) op[j] = f2bf(o[j] * il);
        if (p == 0) wsp<float>(c, OFF_LSE)[((size_t)g * TH + tl) * 4 + h] = m + logf(l);
    } };
struct E_combA { Ctx c; int half; static constexpr long n = (long)TH * WA;
    HD void operator()(long idx) const { const int col = (int)(idx % WA), tl = (int)(idx / WA), h = col >> 7;
        const float* lse = wsp<float>(c, OFF_LSE); const bf16_t* part = wsp<bf16_t>(c, OFF_PART);
        const float l0 = lse[((size_t)0 * TH + tl) * 4 + h], l1 = lse[((size_t)1 * TH + tl) * 4 + h], l2 = lse[((size_t)2 * TH + tl) * 4 + h];
        const float mx = fmaxf(l0, fmaxf(l1, l2)), e0 = expf(l0 - mx), e1 = expf(l1 - mx), e2 = expf(l2 - mx), inv = 1.f / (e0 + e1 + e2);
        const float v = (e0 * bf2f(part[((size_t)0 * TH + tl) * WA + col]) + e1 * bf2f(part[((size_t)1 * TH + tl) * WA + col]) + e2 * bf2f(part[((size_t)2 * TH + tl) * WA + col])) * inv;
        ((bf16_t*)c.out)[((size_t)half * TH + tl) * OW + col] = f2bf(v); } };
struct E_attnC { Ctx c; int half; static constexpr long n = (long)TH * 4 * 8;
    HD void operator()(long idx) const { const int p = (int)(idx & 7), h = (int)((idx >> 3) & 3), tl = (int)(idx >> 5), b = half * BH + tl / S;
        const bf16_t* q = wsp<bf16_t>(c, OFF_P) + (size_t)tl * NP + COLS_A + COLS_B + h * 128; const bf16_t* kv = wsp<bf16_t>(c, OFF_MEMKV) + (size_t)b * MEM * 1024;
        float m = -INFINITY, l = 0.f, o[16];
#ifndef HOST_TEST
#pragma unroll
#endif
        for (int j = 0; j < 16; ++j) o[j] = 0.f;
        for (int k = 0; k < MEM; ++k) { const bf16_t* kr = kv + (size_t)k * 1024 + h * 128; const bf16_t* vr = kr + 512 + p * 16;
            const float sc = dot128(q, kr) * QK_SCALE; const float mn = fmaxf(m, sc), a = expf(m - mn), pw = expf(sc - mn); l = l * a + pw; m = mn;
#ifndef HOST_TEST
#pragma unroll
#endif
            for (int j = 0; j < 16; ++j) o[j] = o[j] * a + pw * bf2f(vr[j]); }
        bf16_t* op = (bf16_t*)c.out + ((size_t)half * TH + tl) * OW + WA + WB + h * 128 + p * 16; const float il = 1.f / l;
#ifndef HOST_TEST
#pragma unroll
#endif
        for (int j = 0; j < 16; ++j) op[j] = f2bf(o[j] * il); } };

HD float hg_f(const Ctx& c, const bf16_t* prow, int ch) { const float lb = wsp<float>(c, OFF_SMALL)[SM_LB + ch]; return lb + (1.f - lb) * sigmoidf_(bf2f(prow[COLS_A + WB + ch])); }
struct E_hg1 { Ctx c; int half; static constexpr long n = (long)BH * HB * NSEG * 128 * 128;
    HD void operator()(long idx) const { const int v = (int)(idx & 127), k = (int)((idx >> 7) & 127); const long r = idx >> 14; const int seg = (int)(r % NSEG), bhl = (int)(r / NSEG), h = bhl % HB, bl = bhl / HB;
        const bf16_t* P = wsp<bf16_t>(c, OFF_P); const int ch = h * 128 + k; float st = 0.f, dsum = 0.f;
        for (int s = 0; s < 256; ++s) { const bf16_t* pr = P + (size_t)(bl * S + seg * 256 + s) * NP; const float f = hg_f(c, pr, ch); st = f * st + (1.f - f) * bf2f(pr[COLS_A + 2 * WB + h * 128 + v]); dsum += logf(f); }
        wsp<float>(c, OFF_HG)[idx] = st; if (v == 0) wsp<float>(c, OFF_DSEG)[((size_t)bhl * NSEG + seg) * 128 + k] = dsum; } };
struct E_hg2 { Ctx c; static constexpr long n = (long)BH * HB * 128 * 128;
    HD void operator()(long idx) const { const int v = (int)(idx & 127), k = (int)((idx >> 7) & 127), bhl = (int)(idx >> 14); float run = 0.f;
        for (int seg = 0; seg < NSEG; ++seg) { float* p = wsp<float>(c, OFF_HG) + (((size_t)bhl * NSEG + seg) * 128 + k) * 128 + v; const float tmp = *p; *p = run;
            run = expf(wsp<float>(c, OFF_DSEG)[((size_t)bhl * NSEG + seg) * 128 + k]) * run + tmp; } } };
struct E_hg3 { Ctx c; int half; static constexpr long n = (long)BH * HB * NSEG * 128;
    HD void operator()(long idx) const { const int v = (int)(idx & 127); const long r = idx >> 7; const int seg = (int)(r % NSEG), bhl = (int)(r / NSEG), h = bhl % HB, bl = bhl / HB;
        const bf16_t* P = wsp<bf16_t>(c, OFF_P); float st[128];
#ifndef HOST_TEST
#pragma unroll
#endif
        for (int k = 0; k < 128; ++k) st[k] = wsp<float>(c, OFF_HG)[(((size_t)bhl * NSEG + seg) * 128 + k) * 128 + v];
        for (int s = 0; s < 256; ++s) { const int tl = bl * S + seg * 256 + s; const bf16_t* pr = P + (size_t)tl * NP; const float iv = bf2f(pr[COLS_A + 2 * WB + h * 128 + v]); float o = 0.f;
#ifndef HOST_TEST
#pragma unroll
#endif
            for (int k = 0; k < 128; ++k) { const float f = hg_f(c, pr, h * 128 + k); st[k] = f * st[k] + (1.f - f) * iv; o += siluf_(bf2f(pr[COLS_A + h * 128 + k])) * st[k]; }
            ((bf16_t*)c.out)[((size_t)half * TH + tl) * OW + WA + h * 128 + v] = f2bf(o); } } };
struct E_hgnorm { Ctx c; int half; static constexpr long n = (long)TH * HB;
    HD void operator()(long idx) const { const int h = (int)(idx % HB), tl = (int)(idx / HB); bf16_t* o = (bf16_t*)c.out + ((size_t)half * TH + tl) * OW + WA + h * 128;
        const bf16_t* pr = wsp<bf16_t>(c, OFF_P) + (size_t)tl * NP + COLS_A + 3 * WB + h * 128; float ss = 0.f;
        for (int v = 0; v < 128; ++v) { const float x = bf2f(o[v]); ss += x * x; }
        const float rs = 1.f / sqrtf(ss * (1.f / 128.f) + RMS_EPS);
        for (int v = 0; v < 128; ++v) o[v] = f2bf(bf2f(o[v]) * rs * c.norm_g[h * 128 + v] * siluf_(bf2f(pr[v]))); } };

struct E_ln1 { Ctx c; static constexpr long n = T;
    HD void operator()(long row) const { float* h1 = wsp<float>(c, OFF_H1) + (size_t)row * D; bf16_t* xb1 = wsp<bf16_t>(c, OFF_X1B) + (size_t)row * D;
        float mu = 0.f; for (int i = 0; i < D; ++i) mu += h1[i]; mu *= (1.f / D);
        float var = 0.f; for (int i = 0; i < D; ++i) { const float d = h1[i] - mu; var += d * d; } var *= (1.f / D); const float rs = 1.f / sqrtf(var + LN_EPS);
        float gl0 = c.b_rg[0], gl1 = c.b_rg[1], gl2 = c.b_rg[2], gl3 = c.b_rg[3];
        for (int i = 0; i < D; ++i) { const float v = (h1[i] - mu) * rs * c.ln1_g[i] + c.ln1_b[i]; h1[i] = v; xb1[i] = f2bf(v);
            gl0 += v * c.w_rg[i * 4 + 0]; gl1 += v * c.w_rg[i * 4 + 1]; gl2 += v * c.w_rg[i * 4 + 2]; gl3 += v * c.w_rg[i * 4 + 3]; }
        int gs = 0; float gm = gl0; if (gl1 > gm) { gm = gl1; gs = 1; } if (gl2 > gm) { gm = gl2; gs = 2; } if (gl3 > gm) { gm = gl3; gs = 3; }
        const float gp = 1.f / (expf(gl0 - gm) + expf(gl1 - gm) + expf(gl2 - gm) + expf(gl3 - gm));
        float v0 = -INFINITY, v1 = -INFINITY; int i0 = 0, i1 = 0;
        for (int j = 0; j < 8; ++j) { float el = c.b_re[gs * 8 + j]; for (int i = 0; i < D; ++i) el += h1[i] * c.w_re[i * 32 + gs * 8 + j];
            if (el > v0) { v1 = v0; i1 = i0; v0 = el; i0 = j; } else if (el > v1) { v1 = el; i1 = j; } }
        const float e1 = expf(v1 - v0), w0 = gp / (1.f + e1), w1 = gp * e1 / (1.f + e1);
        unsigned* cnt = wsp<unsigned>(c, OFF_CTL) + CW_CNT; int* list = wsp<int>(c, OFF_LIST); float* rw = wsp<float>(c, OFF_RW);
        const int ea = gs * 8 + i0, eb = gs * 8 + i1;
        list[(size_t)ea * T + atomic_inc_u32(cnt + ea)] = (int)row * 2 + 0; list[(size_t)eb * T + atomic_inc_u32(cnt + eb)] = (int)row * 2 + 1;
        rw[row * 2 + 0] = w0; rw[row * 2 + 1] = w1; } };
struct E_blk { Ctx c; static constexpr long n = 1;
    HD void operator()(long) const { int* blk = wsp<int>(c, OFF_SMALL) + SM_BLK; const unsigned* cnt = wsp<unsigned>(c, OFF_CTL) + CW_CNT; int acc = 0;
        for (int e = 0; e < NE; ++e) { blk[e] = acc; const int nb = ((int)cnt[e] + 255) >> 8; for (int j = 0; j < nb; ++j) blk[64 + acc + j] = e; acc += nb; } blk[32] = acc; } };
struct E_ln2 { Ctx c; static constexpr long n = T;
    HD void operator()(long row) const { const float* x1 = wsp<float>(c, OFF_H1) + (size_t)row * D; const bf16_t* y0 = wsp<bf16_t>(c, OFF_Y0) + (size_t)row * D; const bf16_t* y1 = wsp<bf16_t>(c, OFF_Y1) + (size_t)row * D;
        const float w0 = wsp<float>(c, OFF_RW)[row * 2], w1 = wsp<float>(c, OFF_RW)[row * 2 + 1]; float* o = c.out + (size_t)row * D;
        float mu = 0.f; for (int i = 0; i < D; ++i) { const float v = DN_ALPHA * x1[i] + w0 * bf2f(y0[i]) + w1 * bf2f(y1[i]); mu += v; } mu *= (1.f / D);
        float var = 0.f; for (int i = 0; i < D; ++i) { const float v = DN_ALPHA * x1[i] + w0 * bf2f(y0[i]) + w1 * bf2f(y1[i]) - mu; var += v * v; } var *= (1.f / D); const float rs = 1.f / sqrtf(var + LN_EPS);
        for (int i = 0; i < D; ++i) { const float v = DN_ALPHA * x1[i] + w0 * bf2f(y0[i]) + w1 * bf2f(y1[i]); o[i] = (v - mu) * rs * c.ln2_g[i] + c.ln2_b[i]; } } };
typedef short bf16x8 __attribute__((ext_vector_type(8)));
typedef float f32x4 __attribute__((ext_vector_type(4)));

template <class F> __global__ void __launch_bounds__(256) k_elems(F f, long n) {
    for (long i = (long)blockIdx.x * 256 + threadIdx.x; i < n; i += (long)gridDim.x * 256) f(i);
}
template <class F> __global__ void __launch_bounds__(64) k_elems64(F f, long n) {
    for (long i = (long)blockIdx.x * 64 + threadIdx.x; i < n; i += (long)gridDim.x * 64) f(i);
}
template <class G> __global__ void __launch_bounds__(256) k_sgemm(G g) {
    const int M = g.M(); const int lane = threadIdx.x & 63, wid = threadIdx.x >> 6; constexpr int ntn = G::N / 64;
    const long ntiles = (long)(M / 64) * ntn;
    for (long tile = blockIdx.x; tile < ntiles; tile += gridDim.x) {
        const int tm = (int)(tile / ntn), tn = (int)(tile % ntn), r0 = tm * 64 + wid * 16, c0 = tn * 64;
        f32x4 acc[G::NBP][4], carry[4];
#pragma unroll
        for (int j = 0; j < 4; ++j) { carry[j] = (f32x4){0.f, 0.f, 0.f, 0.f};
#pragma unroll
            for (int w = 0; w < G::NBP; ++w) acc[w][j] = (f32x4){0.f, 0.f, 0.f, 0.f}; }
#pragma unroll
        for (int seg = 0; seg < G::NSEGS; ++seg) {
            const bf16_t* ar = g.arow(seg, r0 + (lane & 15)) + 8 * (lane >> 4); const bf16_t* br[G::NBP][4];
#pragma unroll
            for (int w = 0; w < G::NBP; ++w)
#pragma unroll
                for (int j = 0; j < 4; ++j) br[w][j] = g.brow(seg, r0, c0 + 16 * j + (lane & 15), w) + 8 * (lane >> 4);
            const int K = g.K(seg);
            for (int k0 = 0; k0 < K; k0 += 32) { const bf16x8 a = *(const bf16x8*)(ar + k0);
#pragma unroll
                for (int w = 0; w < G::NBP; ++w)
#pragma unroll
                    for (int j = 0; j < 4; ++j) { const bf16x8 b = *(const bf16x8*)(br[w][j] + k0); acc[w][j] = __builtin_amdgcn_mfma_f32_16x16x32_bf16(a, b, acc[w][j], 0, 0, 0); } }
#pragma unroll
            for (int j = 0; j < 4; ++j)
#pragma unroll
                for (int i = 0; i < 4; ++i) { float a = acc[0][j][i], cr = carry[j][i]; g.between(seg, r0 + (lane >> 4) * 4 + i, c0 + 16 * j + (lane & 15), a, cr); acc[0][j][i] = a; carry[j][i] = cr; }
        }
#pragma unroll
        for (int j = 0; j < 4; ++j)
#pragma unroll
            for (int i = 0; i < 4; ++i) g.store(r0 + (lane >> 4) * 4 + i, c0 + 16 * j + (lane & 15), acc[0][j][i], G::NBP == 2 ? acc[G::NBP - 1][j][i] : carry[j][i]);
    }
}
template <class F> static void launch_elems(const F& f, long n, hipStream_t st) { long nb = (n + 255) / 256; if (nb > 32768) nb = 32768; if (nb < 1) nb = 1; hipLaunchKernelGGL(k_elems<F>, dim3((unsigned)nb), dim3(256), 0, st, f, n); }
template <class F> static void launch_elems64(const F& f, long n, hipStream_t st) { long nb = (n + 63) / 64; if (nb > 65536) nb = 65536; hipLaunchKernelGGL(k_elems64<F>, dim3((unsigned)nb), dim3(64), 0, st, f, n); }
template <class G> static void launch_sgemm(const G& g, hipStream_t st) { hipLaunchKernelGGL(k_sgemm<G>, dim3(4096), dim3(256), 0, st, g); }

static Ctx make_ctx(void* const* d_in, void* d_out, void* d_ws) {
    Ctx c; memset(&c, 0, sizeof(c)); const float** ip = (const float**)&c; for (int i = 0; i < 22; ++i) ip[i] = (const float*)d_in[i];
    c.out = (float*)d_out; c.ws = (unsigned char*)d_ws; return c;
}
static void v1_stage0(Ctx c, hipStream_t st) {
    launch_elems(S0_xb{c}, S0_xb::n, st); launch_elems(S0_memb{c}, S0_memb::n, st); launch_elems(S0_small{c}, S0_small::n, st);
    launch_elems(S0_tr{c.w_in, wsp<bf16_t>(c, WT_IN), D, N_IN, (long)D * N_IN, D}, (long)D * N_IN, st);
    launch_elems(S0_tr{c.w_kv, wsp<bf16_t>(c, WT_KV), D, 1024, (long)D * 1024, D}, (long)D * 1024, st);
    launch_elems(S0_tr{c.w_a, wsp<bf16_t>(c, WT_A), WA, D, (long)D * WA, OW}, (long)D * WA, st);
    launch_elems(S0_tr{c.w_b, wsp<bf16_t>(c, WT_A) + WA, WB, D, (long)D * WB, OW}, (long)D * WB, st);
    launch_elems(S0_tr{c.w_c, wsp<bf16_t>(c, WT_A) + WA + WB, WC, D, (long)D * WC, OW}, (long)D * WC, st);
    launch_elems(S0_tr{c.w_out, wsp<bf16_t>(c, WT_OUT), D, D, (long)D * D, D}, (long)D * D, st);
}
static void v1_proj(Ctx c, int half, hipStream_t st) { if (half == 0) launch_sgemm(G_memkv{c}, st); launch_sgemm(G_proj{c, half}, st); }
static void v1_mixers(Ctx c, int half, hipStream_t st) {
    launch_elems(E_hg1{c, half}, E_hg1::n, st); launch_elems(E_hg2{c}, E_hg2::n, st);
    launch_elems(E_attnA{c, half}, E_attnA::n, st); launch_elems(E_attnC{c, half}, E_attnC::n, st);
    launch_elems64(E_hg3{c, half}, E_hg3::n, st); launch_elems(E_hgnorm{c, half}, E_hgnorm::n, st); launch_elems(E_combA{c, half}, E_combA::n, st);
}
static void v1_expw(Ctx c, hipStream_t st) { launch_elems(S0_gu{c}, S0_gu::n, st); launch_elems(S0_dn{c}, S0_dn::n, st); }
static void v1_gates(Ctx c, hipStream_t st) { launch_sgemm(G_gates{c}, st); }
static void v1_merge(Ctx c, hipStream_t st) { launch_sgemm(G_merge{c}, st); }
static void v1_wout(Ctx c, hipStream_t st) { launch_sgemm(G_wout{c}, st); }
static void v1_ln1(Ctx c, hipStream_t st) { launch_elems(E_ln1{c}, E_ln1::n, st); launch_elems(E_blk{c}, 1, st); }
static void v1_moe1(Ctx c, hipStream_t st) { launch_sgemm(G_moe1{c}, st); }
static void v1_moe2(Ctx c, hipStream_t st) { launch_sgemm(G_moe2{c}, st); }
static void v1_ln2(Ctx c, hipStream_t st) { launch_elems(E_ln2{c}, E_ln2::n, st); }
#ifndef PG8_LAS
#define PG8_LAS __attribute__((address_space(3)))
#endif
#define XB_TMO      128
#define XB_XCNT(j)  (256  + 64 * (j))
#define XB_XSUB(j)  (1280 + 64 * (j))
#define XB_XGEN(j)  (2304 + 64 * (j))
#define XB_TOP      3328
#define XB_TOPGEN   3392
#define XCD_BAR_WORDS 3456
#define XB_SPIN_CAP (1u << 18)
__device__ __forceinline__ unsigned xb_ld(unsigned* p)              { return __hip_atomic_load(p, __ATOMIC_RELAXED, __HIP_MEMORY_SCOPE_AGENT); }
__device__ __forceinline__ unsigned xb_add(unsigned* p, unsigned v) { return __hip_atomic_fetch_add(p, v, __ATOMIC_RELAXED, __HIP_MEMORY_SCOPE_AGENT); }
__device__ __forceinline__ unsigned xb_xcc_id() { return (unsigned)__builtin_amdgcn_s_getreg((3 << 11) | 20) & 0xFu; }
#define XB_SPIN(cond, bar) do { unsigned _sp = 0; while (cond) { __builtin_amdgcn_s_sleep(1); \
    if ((++_sp & 255u) == 0u) { if (xb_ld(&(bar)[XB_TMO])) break; if (_sp > XB_SPIN_CAP) { atomicAdd(&(bar)[XB_TMO], 1u); break; } } } } while (0)
struct XcdBarrier { unsigned* bar; unsigned x; volatile PG8_LAS unsigned* st; };
__device__ __forceinline__ XcdBarrier xcd_barrier_post(unsigned* bar, volatile PG8_LAS unsigned* st, bool t0) {
    XcdBarrier b; b.bar = bar; b.x = xb_xcc_id(); b.st = st;
    if (t0) (void)xb_add(&bar[XB_XCNT(b.x)], 1u);
    return b;
}
__device__ __forceinline__ void xcd_barrier_complete(unsigned* bar, unsigned x, unsigned& nloc, unsigned& nx) {
    const unsigned G = gridDim.x * gridDim.y * gridDim.z;
    unsigned sum, cnt, mine, sp = 0u;
    for (;;) {
        sum = 0u; cnt = 0u; mine = 0u;
#pragma unroll
        for (unsigned j = 0; j < 16; ++j) { const unsigned c = xb_ld(&bar[XB_XCNT(j)]); sum += c; cnt += (c > 0u) ? 1u : 0u; mine = (j == x) ? c : mine; }
        if (sum == G) break;
        __builtin_amdgcn_s_sleep(1);
        if ((++sp & 255u) == 0u) { if (xb_ld(&bar[XB_TMO])) break; if (sp > XB_SPIN_CAP) { atomicAdd(&bar[XB_TMO], 1u); break; } }
    }
    nloc = mine > 0u ? mine : 1u; nx = cnt > 0u ? cnt : 1u;
}
__device__ __forceinline__ void xcd_arrive(const XcdBarrier& b, bool t0) {
    asm volatile("s_waitcnt vmcnt(0)" ::: "memory");
    __syncthreads();
    if (t0) {
        unsigned* bar = b.bar;
        __builtin_amdgcn_s_waitcnt(0);
        unsigned nloc = b.st[0], nx = b.st[1];
        if (nloc == 0u) { xcd_barrier_complete(bar, b.x, nloc, nx); b.st[0] = nloc; b.st[1] = nx; }
        const unsigned old = xb_add(&bar[XB_XSUB(b.x)], 1u);
        const unsigned gen = old / nloc;
        if (old + 1u == (gen + 1u) * nloc) {
            __builtin_amdgcn_fence(__ATOMIC_RELEASE, "agent");
            asm volatile("s_waitcnt vmcnt(0)" ::: "memory");
            const unsigned og = xb_add(&bar[XB_TOP], 1u);
            const unsigned tg = og / nx;
            if (og + 1u == (tg + 1u) * nx) xb_add(&bar[XB_TOPGEN], 1u);
            b.st[2] = 1u; b.st[3] = tg;
        } else { b.st[2] = 2u; b.st[3] = gen; }
    }
}
__device__ __forceinline__ void xcd_wait(const XcdBarrier& b, bool t0) {
    if (t0) {
        unsigned* bar = b.bar; const unsigned role = b.st[2], g = b.st[3];
        if (role == 1u) { XB_SPIN(xb_ld(&bar[XB_TOPGEN]) == g, bar);
            __builtin_amdgcn_fence(__ATOMIC_ACQUIRE, "agent");
            xb_add(&bar[XB_XGEN(b.x)], 1u);
            asm volatile("s_waitcnt vmcnt(0)" ::: "memory");
        } else { XB_SPIN(xb_ld(&bar[XB_XGEN(b.x)]) == g, bar);
            __builtin_amdgcn_fence(__ATOMIC_ACQUIRE, "agent");
            asm volatile("s_waitcnt vmcnt(0)" ::: "memory"); }
        b.st[2] = 0u;
    }
    __syncthreads();
}
__device__ __forceinline__ void xcd_barrier(const XcdBarrier& b, bool t0) {
    asm volatile("s_waitcnt vmcnt(0)" ::: "memory");
    __syncthreads();
    if (t0) {
        unsigned* bar = b.bar;
        __builtin_amdgcn_s_waitcnt(0);
        unsigned nloc = b.st[0], nx = b.st[1];
        if (nloc == 0u) { xcd_barrier_complete(bar, b.x, nloc, nx); b.st[0] = nloc; b.st[1] = nx; }
        const unsigned old = xb_add(&bar[XB_XSUB(b.x)], 1u);
        const unsigned gen = old / nloc;
        if (old + 1u == (gen + 1u) * nloc) {
            __builtin_amdgcn_fence(__ATOMIC_RELEASE, "agent");
            asm volatile("s_waitcnt vmcnt(0)" ::: "memory");
            const unsigned og = xb_add(&bar[XB_TOP], 1u);
            const unsigned tg = og / nx;
            if (og + 1u == (tg + 1u) * nx) xb_add(&bar[XB_TOPGEN], 1u);
            else XB_SPIN(xb_ld(&bar[XB_TOPGEN]) == tg, bar);
            __builtin_amdgcn_fence(__ATOMIC_ACQUIRE, "agent");
            xb_add(&bar[XB_XGEN(b.x)], 1u);
            asm volatile("s_waitcnt vmcnt(0)" ::: "memory");
        } else {
            XB_SPIN(xb_ld(&bar[XB_XGEN(b.x)]) == gen, bar);
            __builtin_amdgcn_fence(__ATOMIC_ACQUIRE, "agent");
            asm volatile("s_waitcnt vmcnt(0)" ::: "memory");
        }
    }
    __syncthreads();
}
namespace pg8 {
typedef unsigned u32x4 __attribute__((ext_vector_type(4)));
constexpr int BM = 256, BK = 64, HALF = 128, HTB = HALF * BK * 2, STAGE_BYTES = 8 * HTB, NXCD = 8, WGM = 4;
__host__ __device__ __forceinline__ int lds_byte(int r, int c) { const int st = (r >> 4) * 2 + (c >> 5), rr = r & 15, cc = c & 31, ob = rr * 64 + cc * 2; return st * 1024 + (ob ^ (((ob >> 9) & 1) << 5)); }
__host__ __device__ __forceinline__ void stage_rc(int b, int& R, int& C) { const int st = b / 1024, sb = b % 1024, swz = sb ^ (((sb >> 9) & 1) << 5); R = (st >> 1) * 16 + swz / 64; C = (st & 1) * 32 + (swz % 64) / 2; }
__host__ __device__ __forceinline__ int perm32(int rho) { const int n = rho >> 4, i = rho & 15; return 8 * (i >> 2) + 4 * n + (i & 3); }
__device__ __forceinline__ unsigned cvt_pk_bf16(float lo, float hi) { unsigned r; asm volatile("v_cvt_pk_bf16_f32 %0, %1, %2" : "=v"(r) : "v"(lo), "v"(hi)); return r; }

__device__ __forceinline__ int lane_id_opaque() { int l; asm volatile("v_mbcnt_lo_u32_b32 %0, -1, 0\n\tv_mbcnt_hi_u32_b32 %0, -1, %0" : "=v"(l)); return l; }
struct Unit { const char* A; const char* B; int nt, pm, pn, tag, half; };
__device__ __forceinline__ void tile_of(int L, int nM, int nN, int& pm, int& pn) {
    const int nwg = nM * nN; int wgid = L; { const int q = nwg / NXCD, r = nwg % NXCD, xcd = wgid % NXCD, off = wgid / NXCD; wgid = (xcd < r ? xcd * (q + 1) : r * (q + 1) + (xcd - r) * q) + off; }
    const int nig = WGM * nN, gid = wgid / nig, fm = gid * WGM, gsz = (nM - fm) < WGM ? (nM - fm) : WGM;
    pm = fm + ((wgid % nig) % gsz); pn = (wgid % nig) / gsz;
}
template <class Epi, class Sched>
__device__ __forceinline__ void gemm_phase(PG8_LAS unsigned char* lds, const Sched& S, const Epi& E, int tid) {
    constexpr bool GA = Sched::GATHER;
    asm volatile("" : "+v"(tid));
    const int wid = __builtin_amdgcn_readfirstlane(tid >> 6), lane = tid & 63, wr = wid >> 2, wc = wid & 3, fr = lane & 15, fq = lane >> 4;
    const unsigned lda = S.lda, ldb = S.ldb;
    int sR[2]; unsigned voffA[2], voffB[2];
#pragma unroll
    for (int i = 0; i < 2; ++i) { int R, C; stage_rc(tid * 16 + i * 8192, R, C); sR[i] = R; const int Rb = Epi::PERM ? ((R & ~31) + perm32(R & 31)) : R;
        voffA[i] = (GA ? 0u : (unsigned)R * lda) + (unsigned)C * 2u; voffB[i] = (unsigned)Rb * ldb + (unsigned)C * 2u; }
    const size_t kstep = (size_t)(BK * 2), hstepA = (size_t)HALF * lda, hstepB = (size_t)HALF * ldb;
    const unsigned ldsw = (unsigned)wid * 1024u;
    const int aoff = lds_byte(wr * 64 + fr, fq * 8), boff = lds_byte(wc * 32 + fr, fq * 8);
#define PG8_SA(b, h) (((b) * 2 + (h)) * HTB)
#define PG8_SB(b, h) ((4 + (b) * 2 + (h)) * HTB)
#define PG8_STAGE(bufoff, gbase, voff) do { const char* gb_ = (const char*)(gbase); asm volatile("" : "+s"(gb_));     \
        _Pragma("unroll") for (int _i = 0; _i < 2; ++_i) \
        __builtin_amdgcn_global_load_lds((const unsigned*)(gb_ + (voff)[_i]), (PG8_LAS unsigned*)(lds + (bufoff) + ldsw + _i * 8192), 16, 0, 0); } while (0)
#define PG8_STAGE_A(bufoff, gbase, h, tk) do { if constexpr (GA) { unsigned _o[2]; _Pragma("unroll") for (int _i = 0; _i < 2; ++_i) _o[_i] = (((tk)[_i] >> (16 * (h))) & 0xffffu) * lda + voffA[_i]; PG8_STAGE(bufoff, gbase, _o); } \
        else { PG8_STAGE(bufoff, (gbase) + (h) * hstepA, voffA); } } while (0)
#define PG8_LDA(dst, b, h) do { _Pragma("unroll") for (int m = 0; m < 4; ++m) _Pragma("unroll") for (int k = 0; k < 2; ++k) dst[m][k] = *(const PG8_LAS bf16x8*)(lds + PG8_SA(b, h) + aoff + m * 2048 + k * 1024); } while (0)
#define PG8_LDB(dst, b, h) do { _Pragma("unroll") for (int n = 0; n < 2; ++n) _Pragma("unroll") for (int k = 0; k < 2; ++k) dst[n][k] = *(const PG8_LAS bf16x8*)(lds + PG8_SB(b, h) + boff + n * 2048 + k * 1024); } while (0)
#define PG8_MMA(ai, bj, At, Bt) do { __builtin_amdgcn_s_setprio(1); _Pragma("unroll") for (int m = 0; m < 4; ++m) _Pragma("unroll") for (int n = 0; n < 2; ++n) _Pragma("unroll") for (int k = 0; k < 2; ++k) \
        acc[ai][bj][m][n] = __builtin_amdgcn_mfma_f32_16x16x32_bf16(Bt[n][k], At[m][k], acc[ai][bj][m][n], 0, 0, 0); __builtin_amdgcn_s_setprio(0); } while (0)
#define PG8_WAIT_V(n) asm volatile("s_waitcnt vmcnt(" #n ")" ::: "memory")
#define PG8_WAIT_L(n) asm volatile("s_waitcnt lgkmcnt(" #n ")" ::: "memory")
#define PG8_BAR __builtin_amdgcn_s_barrier()
#define PG8_SCHED __builtin_amdgcn_sched_barrier(0)
#define PG8_TOKS(u, tk) do { if constexpr (GA) { const int t_ = wid * 64 + lane_id_opaque();     \
        _Pragma("unroll") for (int _i = 0; _i < 2; ++_i) { int R_, C_; stage_rc(t_ * 16 + _i * 8192, R_, C_); tk[_i] = S.a_row(u, R_) | (S.a_row(u, R_ + HALF) << 16); } } } while (0)
    Unit cur, nxt; int ui = 0;
    if (!S.next(0, cur)) { if (S.pend.bar) xcd_wait(S.pend, tid == 0); return; }
    f32x4 acc[2][2][4][2];
#pragma unroll
    for (int a = 0; a < 2; ++a)
#pragma unroll
        for (int b = 0; b < 2; ++b)
#pragma unroll
            for (int m = 0; m < 4; ++m)
#pragma unroll
                for (int n = 0; n < 2; ++n) acc[a][b][m][n] = (f32x4){0.f, 0.f, 0.f, 0.f};
    bf16x8 At[4][2], B0[2][2], B1[2][2];
    unsigned ctk[2] = {0u, 0u}, ntk[2] = {0u, 0u};
    S.a_ready(cur, wid);
    PG8_TOKS(cur, ctk);
    const char* cA = cur.A; const char* cB = cur.B;
    PG8_STAGE(PG8_SB(0, 0), cB, voffB); PG8_STAGE(PG8_SB(0, 1), cB + hstepB, voffB); PG8_STAGE_A(PG8_SA(0, 0), cA, 0, ctk); PG8_STAGE_A(PG8_SA(0, 1), cA, 1, ctk);
    if (wr == 1) PG8_BAR;
    PG8_WAIT_V(2); PG8_BAR;
    PG8_STAGE(PG8_SB(1, 0), cB + kstep, voffB); PG8_STAGE_A(PG8_SA(1, 0), cA + kstep, 0, ctk); PG8_STAGE(PG8_SB(1, 1), cB + hstepB + kstep, voffB);
    PG8_WAIT_V(6); PG8_BAR;
    for (;;) {
        const bool has_next = S.next(ui + 1, nxt);
        const char* nA = cA; const char* nB = cB;
        if constexpr (GA) { ntk[0] = ctk[0]; ntk[1] = ctk[1]; }
        if (has_next) { nA = nxt.A; nB = nxt.B; PG8_TOKS(nxt, ntk); }
        const int nt = cur.nt; bool full = true; if constexpr (Sched::HALF_UNITS) full = (cur.half == 0);
#define PG8_TRIP(a1, a2, b2, tk2) do { const char* a3 = (a2) + kstep; const char* b3 = (b2) + kstep; \
            PG8_LDB(B0, 0, 0); PG8_LDB(B1, 0, 1); PG8_SCHED; PG8_LDA(At, 0, 0); PG8_STAGE_A(PG8_SA(1, 1), a1, 1, ctk); \
            PG8_WAIT_V(8); PG8_WAIT_L(0); PG8_BAR; PG8_MMA(0, 0, At, B0); PG8_MMA(0, 1, At, B1); PG8_BAR; PG8_SCHED; \
            if (full) PG8_LDA(At, 0, 1); PG8_STAGE(PG8_SB(0, 0), b2, voffB); PG8_STAGE(PG8_SB(0, 1), (b2) + hstepB, voffB); PG8_STAGE_A(PG8_SA(0, 0), a2, 0, tk2); \
            PG8_WAIT_V(8); PG8_WAIT_L(0); PG8_BAR; if (full) { PG8_MMA(1, 0, At, B0); PG8_MMA(1, 1, At, B1); } PG8_BAR; PG8_SCHED; \
            PG8_LDB(B0, 1, 0); PG8_LDB(B1, 1, 1); PG8_SCHED; PG8_LDA(At, 1, 0); PG8_STAGE_A(PG8_SA(0, 1), a2, 1, tk2); \
            PG8_WAIT_V(8); PG8_WAIT_L(0); PG8_BAR; PG8_MMA(0, 0, At, B0); PG8_MMA(0, 1, At, B1); PG8_BAR; PG8_SCHED; \
            if (full) PG8_LDA(At, 1, 1); PG8_STAGE(PG8_SB(1, 0), b3, voffB); PG8_STAGE(PG8_SB(1, 1), b3 + hstepB, voffB); PG8_STAGE_A(PG8_SA(1, 0), a3, 0, tk2); \
            PG8_WAIT_V(8); PG8_WAIT_L(0); PG8_BAR; if (full) { PG8_MMA(1, 0, At, B0); PG8_MMA(1, 1, At, B1); } PG8_BAR; PG8_SCHED; } while (0)
        for (int t = 0; t < nt - 2; t += 2) { const char* a1 = cA + (size_t)(t + 1) * kstep; const char* a2 = cA + (size_t)(t + 2) * kstep; const char* b2 = cB + (size_t)(t + 2) * kstep;
            PG8_TRIP(a1, a2, b2, ctk); }
        if (has_next) S.a_ready(nxt, wid);
        { const char* a1 = cA + (size_t)(nt - 1) * kstep; PG8_TRIP(a1, nA, nB, ntk); }
#undef PG8_TRIP
        if (wr == 0) PG8_BAR;
        if (ui == 0 && S.pend.bar) xcd_wait(S.pend, wid == 0 && lane_id_opaque() == 0);
        { const int el = lane_id_opaque(); E(acc, cur, wr, wc, el & 15, el >> 4); }
        S.done(cur);
        if (!has_next) break;
        cur = nxt; cA = nA; cB = nB;
        if constexpr (GA) { ctk[0] = ntk[0]; ctk[1] = ntk[1]; }
        ++ui;
        if (wr == 1) PG8_BAR;
    }
    PG8_WAIT_V(0);
    PG8_BAR;
#undef PG8_SA
#undef PG8_SB
#undef PG8_STAGE
#undef PG8_STAGE_A
#undef PG8_LDA
#undef PG8_LDB
#undef PG8_MMA
#undef PG8_WAIT_V
#undef PG8_WAIT_L
#undef PG8_BAR
#undef PG8_SCHED
#undef PG8_TOKS
}
}
namespace pg8 {
#define ZERO_ACC() do { _Pragma("unroll") for (int a_ = 0; a_ < 2; ++a_) _Pragma("unroll") for (int b_ = 0; b_ < 2; ++b_) _Pragma("unroll") for (int m_ = 0; m_ < 4; ++m_) _Pragma("unroll") for (int n_ = 0; n_ < 2; ++n_) acc[a_][b_][m_][n_] = (f32x4){0.f, 0.f, 0.f, 0.f}; } while (0)
typedef f32x4 (&AccRef)[2][2][4][2];
typedef float f32x2 __attribute__((ext_vector_type(2)));
__device__ __forceinline__ u32x4 pack8(f32x4 v0, f32x4 v1) { u32x4 w; w.x = cvt_pk_bf16(v0[0], v0[1]); w.y = cvt_pk_bf16(v0[2], v0[3]); w.z = cvt_pk_bf16(v1[0], v1[1]); w.w = cvt_pk_bf16(v1[2], v1[3]); return w; }
__device__ __forceinline__ void unpack8(u32x4 w, f32x4& v0, f32x4& v1) { v0 = (f32x4){bflo(w.x), bfhi(w.x), bflo(w.y), bfhi(w.y)}; v1 = (f32x4){bflo(w.z), bfhi(w.z), bflo(w.w), bfhi(w.w)}; }
__device__ __forceinline__ float fsigmoid(float x) { return __builtin_amdgcn_rcpf(1.f + __expf(-x)); }

struct SchedGrid {
    static constexpr bool GATHER = false, HALF_UNITS = false; unsigned lda, ldb; XcdBarrier pend = {nullptr, 0u, nullptr};
    int nM, nN, G, c, nt; const char *A0, *B0;
    __device__ __forceinline__ bool next(int i, Unit& u) const { const long L = (long)i * G + c; if (L >= (long)nM * nN) return false;
        int pm, pn; tile_of((int)L, nM, nN, pm, pn); u.pm = pm; u.pn = pn; u.tag = 0; u.half = 0; u.nt = nt;
        u.A = A0 + (size_t)pm * BM * lda; u.B = B0 + (size_t)pn * BM * ldb; return true; }
    __device__ __forceinline__ void a_ready(const Unit&, int) const {}
    __device__ __forceinline__ void done(const Unit&) const {}
};
struct SchedMerge {
    static constexpr bool GATHER = false, HALF_UNITS = false; unsigned lda, ldb; XcdBarrier pend = {nullptr, 0u, nullptr};
    int nM, nN, G, c; const char *A0, *B0;
    __device__ __forceinline__ bool next(int i, Unit& u) const { const int r = i / 3, s = i - r * 3; const long L = (long)r * G + c; if (L >= (long)nM * nN) return false;
        int pm, pn; tile_of((int)L, nM, nN, pm, pn); u.pm = pm; u.pn = pn; u.tag = s; u.half = 0; u.nt = (s == 1 ? WB : WA) / BK;
        const size_t so = (size_t)((s > 0 ? WA : 0) + (s > 1 ? WB : 0)) * 2;
        u.A = A0 + (size_t)pm * BM * lda + so; u.B = B0 + (size_t)pn * BM * ldb + so; return true; }
    __device__ __forceinline__ void a_ready(const Unit&, int) const {}
    __device__ __forceinline__ void done(const Unit&) const {}
};
#define ROWS_BEGIN(off0) { unsigned ro_ = (off0); _Pragma("unroll") for (int ai = 0; ai < 2; ++ai) { _Pragma("unroll") for (int m = 0; m < 4; ++m) {
#define ROWS_END(step16) ro_ += (m == 3 ? 5u : 1u) * (step16); asm volatile("" : "+v"(ro_) :: "memory"); } } }
struct EpiProj { static constexpr bool PERM = true; bf16_t* P;
    __device__ __forceinline__ void operator()(AccRef acc, const Unit& u, int wr, int wc, int fr, int fq) const {
        const bool pl = u.pn < 18; const int g = pl ? u.pn / 6 : -1; const int r0 = u.pm * BM + wr * 64 + fr; const int pr0 = pl ? perm_row(r0, g) : r0;
        const unsigned rstride = pl ? 256u : (unsigned)(NPB * 2), bjoff = pl ? (unsigned)(PLANE * 2) : (unsigned)(HALF * 2);
        const unsigned step16 = (unsigned)(16 >> (g <= 0 ? 0 : 2 * g)) * rstride;
        const unsigned off0 = pl ? (unsigned)(2 * u.pn) * (unsigned)(PLANE * 2) + (unsigned)pr0 * 256u + (unsigned)(wc * 32 + 8 * fq) * 2u
                                 : (unsigned)(TH * COLS_A * 2) + (unsigned)r0 * (unsigned)(NPB * 2) + (unsigned)(u.pn * BM - COLS_A + wc * 32 + 8 * fq) * 2u;
        char* base0 = (char*)P; char* base1 = base0 + bjoff;
        ROWS_BEGIN(off0)
            *(u32x4*)(base0 + ro_) = pack8(acc[ai][0][m][0], acc[ai][0][m][1]); *(u32x4*)(base1 + ro_) = pack8(acc[ai][1][m][0], acc[ai][1][m][1]);
        ROWS_END(step16)
        ZERO_ACC(); } };
#if DUP >= 30
struct EpiProjProbe { static constexpr bool PERM = true; bf16_t* P; bool st;
    __device__ __forceinline__ void operator()(AccRef acc, const Unit& u, int wr, int wc, int fr, int fq) const {
        const int g = u.pn < 18 ? u.pn / 6 : -1; const int col0 = u.pn * BM + wc * 32 + 8 * fq; const int r0 = u.pm * BM + wr * 64 + fr;
        const int pr0 = g >= 0 ? perm_row(r0, g) : r0; const unsigned step16 = (unsigned)(16 >> (g <= 0 ? 0 : 2 * g)) * (NP * 2);
        char* base = (char*)P;
        if (st) {
        ROWS_BEGIN((unsigned)pr0 * (NP * 2) + (unsigned)col0 * 2)
#pragma unroll
            for (int bj = 0; bj < 2; ++bj) *(u32x4*)(base + ro_ + bj * (HALF * 2)) = pack8(acc[ai][bj][m][0], acc[ai][bj][m][1]);
        ROWS_END(step16)
        }
        ZERO_ACC(); } };
#endif
struct EpiGates { static constexpr bool PERM = true; bf16_t* Gt;
    __device__ __forceinline__ void operator()(AccRef acc, const Unit& u, int wr, int wc, int fr, int fq) const {
        const int pl = u.pn / (D / BM), col0 = (u.pn % (D / BM)) * BM + wc * 32 + 8 * fq, r0 = u.pm * BM + wr * 64 + fr; char* base = (char*)Gt + (size_t)pl * T * D * 2;
        ROWS_BEGIN((unsigned)r0 * (D * 2) + (unsigned)col0 * 2)
#pragma unroll
            for (int bj = 0; bj < 2; ++bj) { f32x4 v0 = acc[ai][bj][m][0], v1 = acc[ai][bj][m][1];
#pragma unroll
                for (int e = 0; e < 4; ++e) { v0[e] = fsigmoid(v0[e]); v1[e] = fsigmoid(v1[e]); }
                *(u32x4*)(base + ro_ + bj * (HALF * 2)) = pack8(v0, v1); }
        ROWS_END(16u * D * 2)
        ZERO_ACC(); } };
struct EpiMerge { static constexpr bool PERM = true; const bf16_t* Gt; bf16_t* Mg;
    __device__ __forceinline__ void operator()(AccRef acc, const Unit& u, int wr, int wc, int fr, int fq) const {
        const int s = u.tag; const int col0 = u.pn * BM + wc * 32 + 8 * fq, r0 = u.pm * BM + wr * 64 + fr; const char* gbase = (const char*)Gt + (size_t)s * T * D * 2; char* mbase = (char*)Mg;
        const unsigned o0 = (unsigned)r0 * (D * 2) + (unsigned)col0 * 2;
#pragma unroll
        for (int ai = 0; ai < 2; ++ai) {
            u32x4 ga[4][2], gb[4][2];
#pragma unroll
            for (int m = 0; m < 4; ++m)
#pragma unroll
                for (int bj = 0; bj < 2; ++bj) { const unsigned o = o0 + (unsigned)(ai * HALF + m * 16) * (D * 2) + bj * (HALF * 2); ga[m][bj] = *(const u32x4*)(gbase + o); if (s < 2) gb[m][bj] = *(const u32x4*)(gbase + (size_t)T * D * 2 + o); }
#pragma unroll
            for (int m = 0; m < 4; ++m)
#pragma unroll
                for (int bj = 0; bj < 2; ++bj) { f32x4 g0, g1; unpack8(ga[m][bj], g0, g1);
                    if (s < 2) { f32x4 h0, h1; unpack8(gb[m][bj], h0, h1);
#pragma unroll
                        for (int e = 0; e < 4; ++e) { g0[e] *= __builtin_amdgcn_rcpf(fmaxf(h0[e], 1e-20f)); g1[e] *= __builtin_amdgcn_rcpf(fmaxf(h1[e], 1e-20f)); } }
                    acc[ai][bj][m][0] *= g0; acc[ai][bj][m][1] *= g1;
                    if (s == 2) *(u32x4*)(mbase + o0 + (unsigned)(ai * HALF + m * 16) * (D * 2) + bj * (HALF * 2)) = pack8(acc[ai][bj][m][0], acc[ai][bj][m][1]); }
            asm volatile("" ::: "memory"); }
        if (s == 2) ZERO_ACC(); } };
struct EpiWout { static constexpr bool PERM = true; const bf16_t* XB; bf16_t* H1; float* ST;
    __device__ __forceinline__ void operator()(AccRef acc, const Unit& u, int wr, int wc, int fr, int fq) const {
        const int col0 = u.pn * BM + wc * 32 + 8 * fq, r0 = u.pm * BM + wr * 64 + fr; const char* xb_ = (const char*)XB; char* hb_ = (char*)H1;
        const unsigned o0 = (unsigned)r0 * (D * 2) + (unsigned)col0 * 2;
        float* stp = ST + ((size_t)(u.pn * 4 + wc) * T + r0) * 2;
#pragma unroll
        for (int ai = 0; ai < 2; ++ai) {
            u32x4 xv[4][2];
#pragma unroll
            for (int m = 0; m < 4; ++m)
#pragma unroll
                for (int bj = 0; bj < 2; ++bj) xv[m][bj] = *(const u32x4*)(xb_ + o0 + (unsigned)(ai * HALF + m * 16) * (D * 2) + bj * (HALF * 2));
            float s1[4], s2[4];
#pragma unroll
            for (int m = 0; m < 4; ++m) { s1[m] = 0.f; s2[m] = 0.f;
#pragma unroll
                for (int bj = 0; bj < 2; ++bj) { f32x4 x0, x1; unpack8(xv[m][bj], x0, x1); const f32x4 h0 = x0 * DN_ALPHA + acc[ai][bj][m][0], h1 = x1 * DN_ALPHA + acc[ai][bj][m][1];
                    *(u32x4*)(hb_ + o0 + (unsigned)(ai * HALF + m * 16) * (D * 2) + bj * (HALF * 2)) = pack8(h0, h1);
                    s1[m] += ((h0[0] + h0[1]) + (h0[2] + h0[3])) + ((h1[0] + h1[1]) + (h1[2] + h1[3]));
                    s2[m] += ((h0[0] * h0[0] + h0[1] * h0[1]) + (h0[2] * h0[2] + h0[3] * h0[3])) + ((h1[0] * h1[0] + h1[1] * h1[1]) + (h1[2] * h1[2] + h1[3] * h1[3])); } }
#pragma unroll
            for (int m = 0; m < 4; ++m) { s1[m] += __shfl_xor(s1[m], 16); s2[m] += __shfl_xor(s2[m], 16); s1[m] += __shfl_xor(s1[m], 32); s2[m] += __shfl_xor(s2[m], 32);
                if (fq == 0) { f32x2 o; o[0] = s1[m]; o[1] = s2[m]; *(f32x2*)(stp + (size_t)(ai * HALF + m * 16) * 2) = o; } }
            asm volatile("" ::: "memory"); }
        ZERO_ACC(); } };
template <bool GA> struct SchedMoe {
    static constexpr bool GATHER = GA, HALF_UNITS = true; unsigned lda, ldb; XcdBarrier pend = {nullptr, 0u, nullptr};
    int G, c, ncol, nt; const PG8_LAS int* blk; const int* list; const unsigned* cnt; const char* A; const char* B; size_t b_estride, b_pnstride; unsigned* hcnt;
    __device__ __forceinline__ bool next(int i, Unit& u) const { const long L = (long)i * G + c; const int nblk = __builtin_amdgcn_readfirstlane(blk[32]); if (L >= (long)nblk * ncol) return false;
        const int ent = __builtin_amdgcn_readfirstlane(blk[640 + (int)(L / ncol)]), rb = ent & 0xffff, pn = (int)(L % ncol), e = __builtin_amdgcn_readfirstlane(blk[64 + rb]); u.pm = rb; u.pn = pn; u.tag = e; u.half = ent >> 16; u.nt = nt;
        u.A = GA ? A : A + (size_t)rb * BM * lda; u.B = B + (size_t)e * b_estride + (size_t)pn * b_pnstride; return true; }
    __device__ __forceinline__ unsigned a_row(const Unit& u, int row) const {
        const int e = u.tag, pos = ((u.pm - __builtin_amdgcn_readfirstlane(blk[e])) << 8) + row; const int entry = list[(size_t)e * T + (pos < __builtin_amdgcn_readfirstlane((int)cnt[e]) ? pos : 0)]; return (unsigned)(entry >> 1); }
    __device__ __forceinline__ void a_ready(const Unit&, int) const {}
    __device__ __forceinline__ void done(const Unit&) const {}
};
struct EpiMoe1 { static constexpr bool PERM = true; bf16_t* Hb;
    __device__ __forceinline__ void operator()(AccRef acc, const Unit& u, int wr, int wc, int fr, int fq) const {
        const int col0 = u.pn * HALF + wc * 32 + 8 * fq, r0 = u.pm * BM + wr * 64 + fr; char* base = (char*)Hb;
        ROWS_BEGIN((unsigned)r0 * (DE * 2) + (unsigned)col0 * 2)
            f32x4 v0 = acc[ai][0][m][0], v1 = acc[ai][0][m][1];
#pragma unroll
            for (int e = 0; e < 4; ++e) { v0[e] = v0[e] * fsigmoid(v0[e]) * acc[ai][1][m][0][e]; v1[e] = v1[e] * fsigmoid(v1[e]) * acc[ai][1][m][1][e]; }
            *(u32x4*)(base + ro_) = pack8(v0, v1);
        ROWS_END(16u * DE * 2)
        ZERO_ACC(); } };
struct EpiMoe2 { static constexpr bool PERM = true; const PG8_LAS int* blk; const int* list; const unsigned* cnt; bf16_t* Y0; bf16_t* Y1;
    __device__ __forceinline__ void operator()(AccRef acc, const Unit& u, int wr, int wc, int fr, int fq) const {
        const int e = u.tag, col0 = u.pn * BM + wc * 32 + 8 * fq, pbase = ((u.pm - __builtin_amdgcn_readfirstlane(blk[e])) << 8) + wr * 64 + fr, n_e = __builtin_amdgcn_readfirstlane((int)cnt[e]); const int* le = list + (size_t)e * T;
        int ent[2][4];
#pragma unroll
        for (int ai = 0; ai < 2; ++ai)
#pragma unroll
            for (int m = 0; m < 4; ++m) { const int pos = pbase + ai * HALF + m * 16; ent[ai][m] = pos < n_e ? le[pos] : -1; }
#pragma unroll
        for (int ai = 0; ai < 2; ++ai)
#pragma unroll
            for (int m = 0; m < 4; ++m) { const int entry = ent[ai][m];
                if (entry >= 0) { bf16_t* rowp = ((entry & 1) ? Y1 : Y0) + (size_t)(entry >> 1) * D + col0;
#pragma unroll
                    for (int bj = 0; bj < 2; ++bj) *(u32x4*)(rowp + bj * HALF) = pack8(acc[ai][bj][m][0], acc[ai][bj][m][1]); } }
        ZERO_ACC(); } };
#undef ROWS_BEGIN
#undef ROWS_END
#undef ZERO_ACC
}

__device__ __forceinline__ void fast_proj(const Ctx& c, int half, PG8_LAS unsigned char* lds, int tid, int bid, int nblk, const XcdBarrier pend = XcdBarrier{nullptr, 0u, nullptr}) {
    pg8::SchedGrid S; S.pend = pend; S.nM = TH / 256; S.nN = NP / 256; S.G = nblk; S.c = bid; S.nt = D / 64; S.lda = D * 2; S.ldb = D * 2;
    S.A0 = (const char*)(wsp<bf16_t>(c, OFF_XB) + (size_t)half * TH * D); S.B0 = (const char*)wsp<bf16_t>(c, WT_IN);
    pg8::EpiProj E{wsp<bf16_t>(c, OFF_P)}; pg8::gemm_phase(lds, S, E, tid);
}
#if DUP >= 30
struct SchedSame_ {
    static constexpr bool GATHER = false, HALF_UNITS = false; unsigned lda, ldb; XcdBarrier pend = {nullptr, 0u, nullptr};
    int nM, nN, G, c, nt, nu; const char *A0, *B0;
    __device__ __forceinline__ bool next(int i, pg8::Unit& u) const { if (i >= nu) return false;
        int pm, pn; pg8::tile_of(c, nM, nN, pm, pn); u.pm = pm; u.pn = pn; u.tag = 0; u.half = 0; u.nt = nt;
        u.A = A0 + (size_t)pm * 256 * lda; u.B = B0 + (size_t)pn * 256 * ldb; return true; }
    __device__ __forceinline__ void a_ready(const pg8::Unit&, int) const {}
    __device__ __forceinline__ void done(const pg8::Unit&) const {}
};
__device__ __forceinline__ void fast_proj_probe(const Ctx& c, int half, PG8_LAS unsigned char* lds, int tid, int bid, int nblk) {
    constexpr int MODE = DUP - 30;
    pg8::SchedGrid S; S.nM = TH / 256; S.nN = NP / 256; S.G = nblk; S.c = bid; S.nt = (MODE == 11 ? 8 : D / 64); S.lda = D * 2; S.ldb = D * 2;
    S.A0 = (const char*)(wsp<bf16_t>(c, OFF_XB) + (size_t)half * TH * D); S.B0 = (const char*)wsp<bf16_t>(c, WT_IN);
    bool st = (MODE == 0 || (MODE >= 5 && MODE < 10)) ? true : MODE == 3 ? (((bid >> 3) & 1) == 0) : MODE == 4 ? ((bid & 1) == 0) : (c.ws == nullptr);
    if (MODE == 13) st = (c.ws != nullptr);
    if (MODE >= 5 && MODE < 10 && ((bid >> 3) & 1)) { const unsigned long long t0 = __builtin_amdgcn_s_memrealtime(); while (__builtin_amdgcn_s_memrealtime() - t0 < (unsigned long long)(MODE == 5 ? 1400 : 700)) __builtin_amdgcn_s_sleep(4); }
    pg8::EpiProjProbe E{wsp<bf16_t>(c, OFF_P), st};
    if (MODE == 12 || MODE == 13) { SchedSame_ Q; Q.nM = S.nM; Q.nN = S.nN; Q.G = nblk; Q.c = bid; Q.nt = D / 64; Q.nu = 9; Q.lda = S.lda; Q.ldb = S.ldb; Q.A0 = S.A0; Q.B0 = S.B0; pg8::gemm_phase(lds, Q, E, tid); }
    else pg8::gemm_phase(lds, S, E, tid);
}
#endif
struct EpiPlain { static constexpr bool PERM = true; bf16_t* O; int ldc;
    __device__ __forceinline__ void operator()(pg8::AccRef acc, const pg8::Unit& u, int wr, int wc, int fr, int fq) const {
        const int col0 = u.pn * 256 + wc * 32 + 8 * fq, r0 = u.pm * 256 + wr * 64 + fr; char* base = (char*)O; unsigned ro = (unsigned)r0 * (unsigned)(ldc * 2) + (unsigned)col0 * 2;
#pragma unroll
        for (int ai = 0; ai < 2; ++ai)
#pragma unroll
            for (int m = 0; m < 4; ++m) {
#pragma unroll
                for (int bj = 0; bj < 2; ++bj) { *(pg8::u32x4*)(base + ro + bj * 256) = pg8::pack8(acc[ai][bj][m][0], acc[ai][bj][m][1]); acc[ai][bj][m][0] = (f32x4){0.f, 0.f, 0.f, 0.f}; acc[ai][bj][m][1] = (f32x4){0.f, 0.f, 0.f, 0.f}; }
                ro += (m == 3 ? 5u : 1u) * 16u * (unsigned)(ldc * 2); asm volatile("" : "+v"(ro) :: "memory"); } } };
__device__ __forceinline__ void fast_memkv(const Ctx& c, PG8_LAS unsigned char* lds, int tid, int bid, int nblk) {
    pg8::SchedGrid S; S.nM = NBATCH * MEM / 256; S.nN = 1024 / 256; S.G = nblk; S.c = bid; S.nt = D / 64; S.lda = D * 2; S.ldb = D * 2;
    S.A0 = (const char*)wsp<bf16_t>(c, OFF_MEMB); S.B0 = (const char*)wsp<bf16_t>(c, WT_KV);
    EpiPlain E{wsp<bf16_t>(c, OFF_MEMKV), 1024}; pg8::gemm_phase(lds, S, E, tid);
}
__device__ __forceinline__ void fast_gates(const Ctx& c, PG8_LAS unsigned char* lds, int tid, int bid, int nblk, const XcdBarrier pend = XcdBarrier{nullptr, 0u, nullptr}) {
    pg8::SchedGrid S; S.pend = pend; S.nM = T / 256; S.nN = 3 * D / 256; S.G = nblk; S.c = bid; S.nt = D / 64; S.lda = D * 2; S.ldb = D * 2;
    S.A0 = (const char*)wsp<bf16_t>(c, OFF_XB); S.B0 = (const char*)(wsp<bf16_t>(c, WT_IN) + (size_t)NP * D);
    pg8::EpiGates E{wsp<bf16_t>(c, OFF_GATES)}; pg8::gemm_phase(lds, S, E, tid);
}
__device__ __forceinline__ void fast_merge(const Ctx& c, PG8_LAS unsigned char* lds, int tid, int bid, int nblk, const XcdBarrier pend = XcdBarrier{nullptr, 0u, nullptr}) {
    pg8::SchedMerge S; S.pend = pend; S.nM = T / 256; S.nN = D / 256; S.G = nblk; S.c = bid; S.lda = OW * 2; S.ldb = OW * 2;
    S.A0 = (const char*)c.out; S.B0 = (const char*)wsp<bf16_t>(c, WT_A);
    pg8::EpiMerge E{wsp<bf16_t>(c, OFF_GATES), wsp<bf16_t>(c, OFF_MERGED)}; pg8::gemm_phase(lds, S, E, tid);
}
__device__ __forceinline__ void fast_wout(const Ctx& c, PG8_LAS unsigned char* lds, int tid, int bid, int nblk) {
    pg8::SchedGrid S; S.nM = T / 256; S.nN = D / 256; S.G = nblk; S.c = bid; S.nt = D / 64; S.lda = D * 2; S.ldb = D * 2;
    S.A0 = (const char*)wsp<bf16_t>(c, OFF_MERGED); S.B0 = (const char*)wsp<bf16_t>(c, WT_OUT);
    pg8::EpiWout E{wsp<bf16_t>(c, OFF_XB), wsp<bf16_t>(c, OFF_H1), wsp<float>(c, OFF_STATS)}; pg8::gemm_phase(lds, S, E, tid);
}
constexpr int LDS_MISC = 141312, LDS_BLK = LDS_MISC + 1024;
__device__ __forceinline__ const PG8_LAS int* build_blk_table(const Ctx& c, PG8_LAS unsigned char* lds, int tid) {
    PG8_LAS int* blk = (PG8_LAS int*)(lds + LDS_BLK); const unsigned* cnt = wsp<unsigned>(c, OFF_CTL) + CW_CNT;
    if (tid < 32) blk[512 + tid] = ((int)cnt[tid] + 255) >> 8;
    __syncthreads();
    if (tid == 0) { int acc = 0; for (int e = 0; e < NE; ++e) { blk[e] = acc; acc += blk[512 + e]; } blk[32] = acc; }
    __syncthreads();
    if (tid == 0) { int nl = 0; for (int e = 0; e < NE; ++e) { const int rem = (int)cnt[e] - (blk[512 + e] - 1) * 256; blk[576 + e] = nl | ((blk[512 + e] > 0 && rem <= 128) ? 0x10000 : 0); nl += (blk[512 + e] > 0 && rem <= 128) ? 1 : 0; } blk[33] = nl; }
    __syncthreads();
    { const int total = blk[32], nl = blk[33]; for (int rb = tid; rb < total; rb += 512) { int e = 0;
#pragma unroll 1
        for (int j = 1; j < NE; ++j) if (blk[j] <= rb) e = j;
        blk[64 + rb] = e;
        const int lp = blk[576 + e] & 0xffff; const bool light = (blk[576 + e] >> 16) && rb == blk[e] + blk[512 + e] - 1;
        blk[640 + (light ? total - nl + lp : rb - lp)] = rb | (light ? 0x10000 : 0); } }
    __syncthreads();
    return blk;
}
__device__ __forceinline__ void fast_moe1(const Ctx& c, PG8_LAS unsigned char* lds, int tid, int bid, int nblk) {
    pg8::SchedMoe<true> S; S.G = nblk; S.c = bid; S.ncol = 2; S.nt = D / 64; S.blk = build_blk_table(c, lds, tid); S.list = wsp<int>(c, OFF_LIST); S.cnt = wsp<unsigned>(c, OFF_CTL) + CW_CNT;
    S.A = (const char*)wsp<bf16_t>(c, OFF_X1B); S.B = (const char*)wsp<bf16_t>(c, OFF_WTGU); S.b_estride = (size_t)2 * DE * D * 2; S.b_pnstride = (size_t)256 * D * 2; S.lda = D * 2; S.ldb = D * 2; S.hcnt = wsp<unsigned>(c, OFF_CTL) + 1024;
    pg8::EpiMoe1 E{wsp<bf16_t>(c, OFF_HBUF)}; pg8::gemm_phase(lds, S, E, tid);
}
__device__ __forceinline__ void fast_moe2(const Ctx& c, PG8_LAS unsigned char* lds, int tid, int bid, int nblk) {
    pg8::SchedMoe<false> S; S.G = nblk; S.c = bid; S.ncol = D / 256; S.nt = DE / 64; S.blk = build_blk_table(c, lds, tid); S.list = wsp<int>(c, OFF_LIST); S.cnt = wsp<unsigned>(c, OFF_CTL) + CW_CNT;
    S.A = (const char*)wsp<bf16_t>(c, OFF_HBUF); S.B = (const char*)wsp<bf16_t>(c, OFF_WTDN); S.b_estride = (size_t)D * DE * 2; S.b_pnstride = (size_t)256 * DE * 2; S.lda = DE * 2; S.ldb = DE * 2; S.hcnt = wsp<unsigned>(c, OFF_CTL) + 1024;
    pg8::EpiMoe2 E{S.blk, S.list, S.cnt, wsp<bf16_t>(c, OFF_Y0), wsp<bf16_t>(c, OFF_Y1)}; pg8::gemm_phase(lds, S, E, tid);
}
namespace attn {
typedef short s16x4 __attribute__((ext_vector_type(4)));
typedef float f32x16 __attribute__((ext_vector_type(16)));
typedef unsigned u32x4 __attribute__((ext_vector_type(4)));
constexpr int KVBLK = 64, DH = 128, SHM_V = KVBLK * DH * 2, SHM_K = KVBLK * DH * 2;
constexpr int LDS_V = 0, LDS_K = 2 * SHM_V, LDS_WS = LDS_K + 2 * SHM_K, LDS_BIAS = LDS_WS + 8 * 64 * 4, BIAS_PAD = 96, BIAS_N = 129 + 2 * BIAS_PAD, LDS_END = LDS_BIAS + ((BIAS_N * 4 + 15) & ~15);
constexpr float LOG2E = 1.4426950408889634f, C2 = LOG2E * QK_SCALE, LN2 = 0.6931471805599453f;
#define KSWZ(row, colB) ((row) * 256 + ((colB) ^ (((row) & 7) << 4)))
#define SBAR() __builtin_amdgcn_sched_barrier(0)
__device__ __forceinline__ int v_st(int k, int c) { const int kk = (k & ~0xC) | ((k & 4) << 1) | ((k & 8) >> 1); return ((kk >> 3) * 4 + (c >> 5)) * 512 + ((kk & 7) * 32 + (c & 31)) * 2; }
__device__ __forceinline__ int v_rd_base(int lane) { return ((lane & 3) << 3) | (((lane >> 2) & 3) << 6) | (((lane >> 4) & 1) << 5) | (((lane >> 5) & 1) << 8); }
constexpr int v_rd_off(int d0, int ks, int half) { return d0 * 512 + ks * 4096 + half * 2048; }
__device__ __forceinline__ int crow(int r, int hi) { return (r & 3) + 8 * (r >> 2) + 4 * hi; }
__device__ __forceinline__ unsigned cvtpk(float lo, float hi) { unsigned r; asm volatile("v_cvt_pk_bf16_f32 %0, %1, %2" : "=v"(r) : "v"(lo), "v"(hi)); return r; }
__device__ __forceinline__ void qkt(f32x16& p0, f32x16& p1, const PG8_LAS char* kbuf, int r32, int hi, const bf16x8* qr) {
    p0 = f32x16{}; p1 = f32x16{};
    const PG8_LAS char* kb[4];
#pragma unroll
    for (int dd = 0; dd < 4; ++dd) kb[dd] = kbuf + KSWZ(r32, (dd * 16 + hi * 8) * 2);
#pragma unroll
    for (int d0 = 0; d0 < 8; ++d0) { const PG8_LAS char* a = kb[d0 & 3] + (d0 >> 2) * 128;
        const bf16x8 b0 = *(const PG8_LAS bf16x8*)(a);
        const bf16x8 b1 = *(const PG8_LAS bf16x8*)(a + 32 * 256);
        p0 = __builtin_amdgcn_mfma_f32_32x32x16_bf16(b0, qr[d0], p0, 0, 0, 0);
        p1 = __builtin_amdgcn_mfma_f32_32x32x16_bf16(b1, qr[d0], p1, 0, 0, 0); }
}
__device__ __forceinline__ void pv_tile(f32x16* o, int vb0, bf16x8 pa0, bf16x8 pa1, bf16x8 pa2, bf16x8 pa3) {
#define TRRD(dst, off) asm volatile("ds_read_b64_tr_b16 %0, %1 offset:%2" : "=&v"(dst) : "v"(vb0), "i"(off) : "memory")
#define PV_RD(S, d0) do { constexpr int b_ = v_rd_off(d0, 0, 0); TRRD(S##l0, b_); TRRD(S##h0, b_ + 2048); TRRD(S##l1, b_ + 4096); TRRD(S##h1, b_ + 6144); TRRD(S##l2, b_ + 8192); TRRD(S##h2, b_ + 10240); TRRD(S##l3, b_ + 12288); TRRD(S##h3, b_ + 14336); } while (0)
#define PV_MM(S, d0) do { \
        o[d0] = __builtin_amdgcn_mfma_f32_32x32x16_bf16((bf16x8){S##l0[0], S##l0[1], S##l0[2], S##l0[3], S##h0[0], S##h0[1], S##h0[2], S##h0[3]}, pa0, o[d0], 0, 0, 0); \
        o[d0] = __builtin_amdgcn_mfma_f32_32x32x16_bf16((bf16x8){S##l1[0], S##l1[1], S##l1[2], S##l1[3], S##h1[0], S##h1[1], S##h1[2], S##h1[3]}, pa1, o[d0], 0, 0, 0); \
        o[d0] = __builtin_amdgcn_mfma_f32_32x32x16_bf16((bf16x8){S##l2[0], S##l2[1], S##l2[2], S##l2[3], S##h2[0], S##h2[1], S##h2[2], S##h2[3]}, pa2, o[d0], 0, 0, 0); \
        o[d0] = __builtin_amdgcn_mfma_f32_32x32x16_bf16((bf16x8){S##l3[0], S##l3[1], S##l3[2], S##l3[3], S##h3[0], S##h3[1], S##h3[2], S##h3[3]}, pa3, o[d0], 0, 0, 0); } while (0)
    s16x4 Al0, Al1, Al2, Al3, Ah0, Ah1, Ah2, Ah3, Bl0, Bl1, Bl2, Bl3, Bh0, Bh1, Bh2, Bh3;
    PV_RD(A, 0);
    PV_RD(B, 1); asm volatile("s_waitcnt lgkmcnt(8)" ::: "memory"); SBAR(); PV_MM(A, 0); SBAR();
    PV_RD(A, 2); asm volatile("s_waitcnt lgkmcnt(8)" ::: "memory"); SBAR(); PV_MM(B, 1); SBAR();
    PV_RD(B, 3); asm volatile("s_waitcnt lgkmcnt(8)" ::: "memory"); SBAR(); PV_MM(A, 2); SBAR();
    asm volatile("s_waitcnt lgkmcnt(0)" ::: "memory"); SBAR(); PV_MM(B, 3);
#undef PV_RD
#undef PV_MM
#undef TRRD
}
__device__ __forceinline__ void store_o_rows(const f32x16* o, float rl, bf16_t* rowp, int hi) {
    char* base = (char*)rowp + hi * 16;
#pragma unroll
    for (int d0 = 0; d0 < 4; ++d0)
#pragma unroll
        for (int g = 0; g < 4; g += 2) {
            const unsigned ax = cvtpk(o[d0][4 * g] * rl, o[d0][4 * g + 1] * rl), ay = cvtpk(o[d0][4 * g + 2] * rl, o[d0][4 * g + 3] * rl);
            const unsigned bx = cvtpk(o[d0][4 * g + 4] * rl, o[d0][4 * g + 5] * rl), by = cvtpk(o[d0][4 * g + 6] * rl, o[d0][4 * g + 7] * rl);
            auto rx = __builtin_amdgcn_permlane32_swap(ax, bx, false, false); auto ry = __builtin_amdgcn_permlane32_swap(ay, by, false, false);
            *(u32x4*)(base + d0 * 64 + g * 16) = (u32x4){rx[0], ry[0], rx[1], ry[1]}; }
}
template <bool BAND>
__device__ __forceinline__ void attn_unit(PG8_LAS char* lds, const bf16_t* Q, size_t qs, const bf16_t* K, const bf16_t* V, size_t ks, int NT, int qpos0, int kpos0,
                                          bf16_t* Ob, size_t ostride, float* lse, int obase, int omul, int tid) {
    const int wid = __builtin_amdgcn_readfirstlane(tid >> 6), lane = tid & 63, r32 = lane & 31, hi = lane >> 5;
    PG8_LAS char* V_lds = lds + LDS_V; PG8_LAS char* K_lds = lds + LDS_K;
    PG8_LAS float* wsf = (PG8_LAS float*)(lds + LDS_WS) + wid * 64; const PG8_LAS float* bias = (const PG8_LAS float*)(lds + LDS_BIAS);
    const int sr = tid >> 4, sc = (tid & 15) * 8, vst0 = v_st(sr, sc), vst1 = v_st(32 + sr, sc), kws = KSWZ(sr, sc * 2);
    const int vbl = (int)(uintptr_t)V_lds + v_rd_base(lane);
    bf16x8 qr[8];
    { const bf16_t* qp = Q + (size_t)(wid * 32 + r32) * qs + hi * 8;
#pragma unroll
      for (int d0 = 0; d0 < 8; ++d0) qr[d0] = *(const bf16x8*)(qp + d0 * 16); }
    bf16x8 st_k0, st_k1, st_v0, st_v1;
#define SLOAD(t) do { const size_t ro_ = (size_t)((t) * KVBLK + sr) * ks + sc; st_k0 = *(const bf16x8*)(K + ro_); st_k1 = *(const bf16x8*)(K + ro_ + 32 * ks); st_v0 = *(const bf16x8*)(V + ro_); st_v1 = *(const bf16x8*)(V + ro_ + 32 * ks); } while (0)
#define SWRITE(bf) do { *(PG8_LAS bf16x8*)(K_lds + (bf) * SHM_K + kws) = st_k0; *(PG8_LAS bf16x8*)(K_lds + (bf) * SHM_K + kws + 32 * 256) = st_k1; \
                        *(PG8_LAS bf16x8*)(V_lds + (bf) * SHM_V + vst0) = st_v0; *(PG8_LAS bf16x8*)(V_lds + (bf) * SHM_V + vst1) = st_v1; } while (0)
    SLOAD(0); SWRITE(0);
    __syncthreads();
    float m_run = -1e30f, l_run = 0.f; f32x16 o[4] = {};
    const int qlo = qpos0 + wid * 32;
    for (int t = 0; t < NT; ++t) {
        const int buf = t & 1;
        if (t + 1 < NT) SLOAD(t + 1);
        const int kb = kpos0 + t * KVBLK;
        const bool act = !BAND || (kb <= qlo + 31 && kb + KVBLK - 1 >= qlo - 128);
        if (act) {
            f32x16 p0, p1;
            qkt(p0, p1, K_lds + buf * SHM_K, r32, hi, qr);
            if (BAND) {
                const int dq = qlo + r32 - kb - 4 * hi;
                const PG8_LAS float* bp = bias + (dq + BIAS_PAD - 59);
#pragma unroll
                for (int r = 0; r < 16; ++r) { const int cr = (r & 3) + 8 * (r >> 2);
                    const float b0 = bp[59 - cr], b1 = bp[59 - cr - 32];
                    p0[r] = ((unsigned)(dq - cr) <= 128u) ? fmaf(p0[r], C2, b0) : -INFINITY;
                    p1[r] = ((unsigned)(dq - cr - 32) <= 128u) ? fmaf(p1[r], C2, b1) : -INFINITY; }
            } else {
#pragma unroll
                for (int r = 0; r < 16; ++r) { p0[r] *= C2; p1[r] *= C2; }
            }
            float pmax = p0[0];
#pragma unroll
            for (int r = 1; r < 16; ++r) pmax = fmaxf(pmax, p0[r]);
#pragma unroll
            for (int r = 0; r < 16; ++r) pmax = fmaxf(pmax, p1[r]);
            { auto rr = __builtin_amdgcn_permlane32_swap(__float_as_uint(pmax), __float_as_uint(pmax), false, false); pmax = fmaxf(__uint_as_float(rr[0]), __uint_as_float(rr[1])); }
            const float mn = fmaxf(m_run, pmax), alpha = __builtin_amdgcn_exp2f(m_run - mn); m_run = mn;
            float ps = 0.f;
#pragma unroll
            for (int r = 0; r < 16; ++r) { p0[r] = __builtin_amdgcn_exp2f(p0[r] - mn); p1[r] = __builtin_amdgcn_exp2f(p1[r] - mn); ps += p0[r] + p1[r]; }
            { auto rr = __builtin_amdgcn_permlane32_swap(__float_as_uint(ps), __float_as_uint(ps), false, false); ps = __uint_as_float(rr[0]) + __uint_as_float(rr[1]); }
            l_run = l_run * alpha + ps;
            if (__any(alpha < 1.f)) {
#pragma unroll
                for (int r = 0; r < 16; ++r)
#pragma unroll
                    for (int d_ = 0; d_ < 4; ++d_) o[d_][r] *= alpha; }
            bf16x8 pa0, pa1, pa2, pa3;
#define PK4(P, B_, OUT) do { unsigned a0 = cvtpk(P[B_ + 0], P[B_ + 1]), a1 = cvtpk(P[B_ + 2], P[B_ + 3]); unsigned b0 = cvtpk(P[B_ + 4], P[B_ + 5]), b1 = cvtpk(P[B_ + 6], P[B_ + 7]); \
        auto r0 = __builtin_amdgcn_permlane32_swap(a0, b0, false, false); auto r1 = __builtin_amdgcn_permlane32_swap(a1, b1, false, false); \
        u32x4 w = {r0[0], r1[0], r0[1], r1[1]}; OUT = *reinterpret_cast<bf16x8*>(&w); } while (0)
            PK4(p0, 0, pa0); PK4(p0, 8, pa1); PK4(p1, 0, pa2); PK4(p1, 8, pa3);
#undef PK4
            SBAR();
            pv_tile(o, vbl + buf * SHM_V, pa0, pa1, pa2, pa3);
        }
        if (t + 1 < NT) SWRITE(buf ^ 1);
        __syncthreads();
    }
#undef SLOAD
#undef SWRITE
    store_o_rows(o, __builtin_amdgcn_rcpf(l_run), Ob + (size_t)(obase + (wid * 32 + r32) * omul) * ostride, hi);
    if (BAND) { if (hi == 0) lse[(size_t)(obase + (wid * 32 + r32) * omul) * 4] = (m_run + __log2f(l_run)) * LN2; }
    __syncthreads();
}
struct SubUnit { const bf16_t* Q; const bf16_t* K; bf16_t* Ob; float* lse; int qpos0, kpos0, krow_min, obase, omul; };
constexpr int P2_V = 0, P2_K = 4 * SHM_V, P2_WS = P2_K + 4 * SHM_K, P2_BIAS = P2_WS + 8 * 64 * 4, P2_END = P2_BIAS + 2 * ((BIAS_N * 4 + 15) & ~15);
static_assert(P2_END <= 141312, "attention pair LDS");
__device__ __forceinline__ void attn_pair(PG8_LAS char* lds, const SubUnit& U, size_t qs, size_t ks, size_t ostride, int tid) {
    const int wid = __builtin_amdgcn_readfirstlane(tid >> 6), sub = wid >> 2, w4 = wid & 3, lane = tid & 63, r32 = lane & 31, hi = lane >> 5, t256 = tid & 255;
    PG8_LAS char* V_lds = lds + P2_V + sub * 2 * SHM_V; PG8_LAS char* K_lds = lds + P2_K + sub * 2 * SHM_K;
    PG8_LAS float* wsf = (PG8_LAS float*)(lds + P2_WS) + wid * 64; const PG8_LAS float* bias = (const PG8_LAS float*)(lds + P2_BIAS + sub * ((BIAS_N * 4 + 15) & ~15));
    const int sr = t256 >> 4, sc = (t256 & 15) * 8;
    const int vbl = (int)(uintptr_t)V_lds + v_rd_base(lane);
    bf16x8 qr[8];
    { const bf16_t* qp = U.Q + (size_t)(w4 * 32 + r32) * qs + hi * 8;
#pragma unroll
      for (int d0 = 0; d0 < 8; ++d0) qr[d0] = *(const bf16x8*)(qp + d0 * 16); }
    bf16x8 stk[4], stv[4];
#define SLOAD2(t) do { _Pragma("unroll") for (int i_ = 0; i_ < 4; ++i_) { int rr_ = (t) * KVBLK + sr + 16 * i_; rr_ = rr_ < U.krow_min ? U.krow_min : rr_; const bf16_t* kp_ = U.K + (ptrdiff_t)rr_ * (ptrdiff_t)ks + sc; stk[i_] = *(const bf16x8*)kp_; stv[i_] = *(const bf16x8*)(kp_ + 4 * PLANE); } } while (0)
#define SWRITE2(bf) do { _Pragma("unroll") for (int i_ = 0; i_ < 4; ++i_) { *(PG8_LAS bf16x8*)(K_lds + (bf) * SHM_K + KSWZ(sr + 16 * i_, sc * 2)) = stk[i_]; *(PG8_LAS bf16x8*)(V_lds + (bf) * SHM_V + v_st(sr + 16 * i_, sc)) = stv[i_]; } } while (0)
    SLOAD2(0); SWRITE2(0);
    __syncthreads();
    float m_run = -1e30f, l_run = 0.f; f32x16 o[4] = {};
    const int qlo = U.qpos0 + w4 * 32;
    for (int t = 0; t < 4; ++t) {
        const int buf = t & 1;
        if (t + 1 < 4) SLOAD2(t + 1);
        const int kb = U.kpos0 + t * KVBLK;
        const bool act = kb >= 0 && kb <= qlo + 31 && kb + KVBLK - 1 >= qlo - 128;
        if (act) {
            f32x16 p0, p1;
            qkt(p0, p1, K_lds + buf * SHM_K, r32, hi, qr);
            { const int dq = qlo + r32 - kb - 4 * hi; const PG8_LAS float* bp = bias + (dq + BIAS_PAD - 59);
#pragma unroll
              for (int r = 0; r < 16; ++r) { const int cr = (r & 3) + 8 * (r >> 2); const float b0 = bp[59 - cr], b1 = bp[59 - cr - 32];
                  p0[r] = fmaf(p0[r], C2, b0); p1[r] = fmaf(p1[r], C2, b1); } }
            float pmax = p0[0];
#pragma unroll
            for (int r = 1; r < 16; ++r) pmax = fmaxf(pmax, p0[r]);
#pragma unroll
            for (int r = 0; r < 16; ++r) pmax = fmaxf(pmax, p1[r]);
            { auto rr = __builtin_amdgcn_permlane32_swap(__float_as_uint(pmax), __float_as_uint(pmax), false, false); pmax = fmaxf(__uint_as_float(rr[0]), __uint_as_float(rr[1])); }
            const float mn = fmaxf(m_run, pmax), alpha = __builtin_amdgcn_exp2f(m_run - mn); m_run = mn;
            float ps = 0.f;
#pragma unroll
            for (int r = 0; r < 16; ++r) { p0[r] = __builtin_amdgcn_exp2f(p0[r] - mn); p1[r] = __builtin_amdgcn_exp2f(p1[r] - mn); ps += p0[r] + p1[r]; }
            { auto rr = __builtin_amdgcn_permlane32_swap(__float_as_uint(ps), __float_as_uint(ps), false, false); ps = __uint_as_float(rr[0]) + __uint_as_float(rr[1]); }
            l_run = l_run * alpha + ps;
            if (__any(alpha < 1.f)) {
#pragma unroll
                for (int r = 0; r < 16; ++r)
#pragma unroll
                    for (int d_ = 0; d_ < 4; ++d_) o[d_][r] *= alpha; }
            bf16x8 pa0, pa1, pa2, pa3;
#define PK4(P, B_, OUT) do { unsigned a0 = cvtpk(P[B_ + 0], P[B_ + 1]), a1 = cvtpk(P[B_ + 2], P[B_ + 3]); unsigned b0 = cvtpk(P[B_ + 4], P[B_ + 5]), b1 = cvtpk(P[B_ + 6], P[B_ + 7]); \
        auto r0 = __builtin_amdgcn_permlane32_swap(a0, b0, false, false); auto r1 = __builtin_amdgcn_permlane32_swap(a1, b1, false, false); \
        u32x4 w = {r0[0], r1[0], r0[1], r1[1]}; OUT = *reinterpret_cast<bf16x8*>(&w); } while (0)
            PK4(p0, 0, pa0); PK4(p0, 8, pa1); PK4(p1, 0, pa2); PK4(p1, 8, pa3);
#undef PK4
            SBAR();
            pv_tile(o, vbl + buf * SHM_V, pa0, pa1, pa2, pa3);
        }
        if (t + 1 < 4) SWRITE2(buf ^ 1);
        __syncthreads();
    }
#undef SLOAD2
#undef SWRITE2
    store_o_rows(o, __builtin_amdgcn_rcpf(l_run), U.Ob + (size_t)(U.obase + (w4 * 32 + r32) * U.omul) * ostride, hi);
    if (hi == 0) U.lse[(size_t)(U.obase + (w4 * 32 + r32) * U.omul) * 4] = (m_run + __log2f(l_run)) * LN2;
    __syncthreads();
}

__device__ __forceinline__ SubUnit a_subunit(const Ctx& c, int su, PG8_LAS char* lds, int sub, int tid) {
    constexpr int SB = S / 128; const bf16_t* P = wsp<bf16_t>(c, OFF_P);
    const int j = su % SB, h = (su / SB) & 3, g = (su / (SB * 4)) % 3, bl = su / (SB * 12);
    const int r = dil_of(g), L = S / r, nsb = L / 128, cc = j / nsb, sb = j % nsb, q0 = sb * 128, base = bl * S + cc * L;
    { PG8_LAS float* bt = (PG8_LAS float*)(lds + P2_BIAS + sub * ((BIAS_N * 4 + 15) & ~15)); const float* bsrc = wsp<float>(c, OFF_SMALL) + SM_BIAS + (g * 4 + h) * 129;
      for (int i = tid & 255; i < BIAS_N; i += 256) { const int uu = i - BIAS_PAD; bt[i] = (uu >= 0 && uu <= 128) ? bsrc[uu] * LOG2E : -INFINITY; } }
    SubUnit U; U.Q = P + ((size_t)(g * 12 + h) * TH + base + q0) * 128; U.K = P + ((ptrdiff_t)((g * 12 + 4 + h) * TH + base + q0) - 128) * 128;
    U.qpos0 = q0; U.kpos0 = q0 - 128; U.krow_min = 128 - q0 > 0 ? 128 - q0 : 0; if (U.krow_min > 0 && base + q0 >= 128) U.krow_min = 0;
    U.Ob = wsp<bf16_t>(c, OFF_PART) + (size_t)g * TH * WA + h * 128; U.lse = wsp<float>(c, OFF_LSE) + (size_t)g * TH * 4 + h; U.obase = bl * S + q0 * r + cc; U.omul = r;
    return U;
}
__device__ __forceinline__ void attn_phase(const Ctx& c, int half, PG8_LAS unsigned char* lds_u, int tid, int bid, int nblk) {
    asm volatile("" : "+v"(tid));
    PG8_LAS char* lds = (PG8_LAS char*)lds_u;
    constexpr int QB = S / 256, NPA = BH * 3 * 4 * (S / 128) / 2, NUC = BH * 4 * QB, NU = NPA + NUC;
    const bf16_t* P = wsp<bf16_t>(c, OFF_P); const int sub = __builtin_amdgcn_readfirstlane(tid >> 8);
    const bool xcd_order = (nblk % 8 == 0) && (NPA % 8 == 0);
    const int per = xcd_order ? NPA / 8 : NPA, step = xcd_order ? nblk / 8 : nblk, first = xcd_order ? (bid >> 3) : bid, ubase = xcd_order ? (bid & 7) * per : 0;
    for (int k = first; k < per; k += step) { const int u = ubase + k;
        const SubUnit U = a_subunit(c, 2 * u + sub, lds, sub, tid); attn_pair(lds, U, 128, 128, WA, tid); }
    for (int v = bid; v < NUC; v += nblk) {
        const int j = v % QB, h = (v / QB) & 3, bl = v / (QB * 4), b = half * BH + bl, tl0 = bl * S + j * 256;
        const bf16_t* Qp = wsp<bf16_t>(c, OFF_PB) + (size_t)tl0 * NPB + COLS_B + h * 128; const bf16_t* Kp = wsp<bf16_t>(c, OFF_MEMKV) + (size_t)b * MEM * 1024 + h * 128;
        attn_unit<false>(lds, Qp, NPB, Kp, Kp + 512, 1024, MEM / 64, 0, 0, (bf16_t*)c.out + (size_t)half * TH * OW + WA + WB + h * 128, OW, nullptr, tl0, 1, tid);
    }
}
#undef KSWZ
#undef SBAR
}
namespace rowops {
typedef float f32x4 __attribute__((ext_vector_type(4)));
typedef unsigned u32x2 __attribute__((ext_vector_type(2)));
typedef float f32x2 __attribute__((ext_vector_type(2)));
typedef unsigned u32x4 __attribute__((ext_vector_type(4)));
__device__ __forceinline__ float wave_sum(float v) {
#pragma unroll
    for (int o = 1; o < 64; o <<= 1) v += __shfl_xor(v, o);
    return v;
}
__device__ __forceinline__ unsigned pk2(float lo, float hi) { return pg8::cvt_pk_bf16(lo, hi); }

constexpr int SM_WGT = 16384, SM_CS = SM_WGT + 48 * D, SM_BW = SM_CS + 64;
constexpr size_t SMB_WGH = 512 * 1024, SMB_WGL = SMB_WGH + (size_t)48 * D * 2;
static_assert((SM_BW + 64) * 4 <= (int)SMB_WGH && SMB_WGL + (size_t)48 * D * 2 <= MiB, "small region");
__device__ __forceinline__ void router_weights_prep(const Ctx& c, int tid, int bid, int nblk) {
    const int lane = tid & 63, gw = bid * 8 + (tid >> 6), NGW = nblk * 8; float* sm = wsp<float>(c, OFF_SMALL);
    for (int col = gw; col < 48; col += NGW) { float cs = 0.f, bw = 0.f;
        for (int i = lane; i < D; i += 64) { const float w = col < 4 ? c.w_rg[i * 4 + col] : (col < 36 ? c.w_re[i * 32 + col - 4] : 0.f); const float gwv = c.ln1_g[i] * w; sm[SM_WGT + col * D + i] = gwv; cs += gwv; bw += c.ln1_b[i] * w;
            const unsigned hi = pk2(gwv, 0.f) & 0xffffu; ((bf16_t*)((char*)sm + SMB_WGH))[col * D + i] = (bf16_t)hi; ((bf16_t*)((char*)sm + SMB_WGL))[col * D + i] = (bf16_t)(pk2(gwv - bflo(hi), 0.f) & 0xffffu); }
        cs = wave_sum(cs); bw = wave_sum(bw);
        if (lane == 0) { sm[SM_CS + col] = cs; sm[SM_BW + col] = bw + (col < 4 ? c.b_rg[col] : (col < 36 ? c.b_re[col - 4] : 0.f)); } }
}
template <bool DRY> __device__ __forceinline__ void ln1_router_phase(const Ctx& c, PG8_LAS unsigned char* lds, int tid, int bid, int nblk) {
    asm volatile("" : "+v"(tid));
    const int lane = tid & 63, wid = tid >> 6, l15 = lane & 15, lq = lane >> 4, gw = bid * 8 + wid, NGW = nblk * 8;
    PG8_LAS int* lh = (PG8_LAS int*)lds; PG8_LAS int* asg = lh + 64; PG8_LAS float* lg = (PG8_LAS float*)(lds + 4096) + wid * (16 * 48);
    PG8_LAS float* GB = (PG8_LAS float*)(lds + 132608);
    if (tid < 64) lh[tid] = 0;
    for (int i = tid; i < D / 4; i += 512) { *(PG8_LAS f32x4*)(GB + 4 * i) = *(const f32x4*)(c.ln1_g + 4 * i); *(PG8_LAS f32x4*)(GB + D + 4 * i) = *(const f32x4*)(c.ln1_b + 4 * i); }
    __syncthreads();
    const bf16_t* H1B = wsp<bf16_t>(c, OFF_H1); bf16_t* X1B = wsp<bf16_t>(c, OFF_X1B); const float* sm = wsp<float>(c, OFF_SMALL);
    unsigned* cnt = wsp<unsigned>(c, OFF_CTL) + CW_CNT; int* list = wsp<int>(c, OFF_LIST); float* rw = wsp<float>(c, OFF_RW);
    int ngrp = 0; const bool stage_w = (NGW * 16 == T) && D == 1024;
    for (int g0 = gw * 16; g0 < T; g0 += NGW * 16, ++ngrp) {
        float my_mean = 0.f, my_rstd = 0.f;
        if (lane < 16) { const f32x2* sp = (const f32x2*)wsp<float>(c, OFF_STATS) + (g0 + lane); float s = 0.f, s2 = 0.f;
#pragma unroll
            for (int k = 0; k < 16; ++k) { const f32x2 p = sp[(size_t)k * T]; s += p[0]; s2 += p[1]; }
            my_mean = s * (1.f / D); my_rstd = 1.f / sqrtf(fmaxf(s2 * (1.f / D) - my_mean * my_mean, 0.f) + LN_EPS); }
        const float rmean = __shfl(my_mean, l15), rrstd = __shfl(my_rstd, l15);
        f32x4 acc0 = {0.f, 0.f, 0.f, 0.f}, acc1 = acc0, acc2 = acc0;
        const PG8_LAS float* gbl = GB + 8 * lq; asm volatile("" : "+v"(gbl));
#define NORM_STORE(a_, col_) do { const f32x4 g_ = *(const PG8_LAS f32x4*)(GB + (col_)), b_ = *(const PG8_LAS f32x4*)(GB + D + (col_)); const f32x4 v_ = ((a_) - rmean) * rrstd * g_ + b_; \
            u32x2 w_; w_.x = pk2(v_[0], v_[1]); w_.y = pk2(v_[2], v_[3]); if (!DRY) *(u32x2*)(X1B + (size_t)(g0 + l15) * D + (col_)) = w_; } while (0)
        if (stage_w) {
            PG8_LAS bf16_t* WH = (PG8_LAS bf16_t*)(lds + 32768); constexpr int WLS = 520; PG8_LAS bf16_t* WLo = WH + 48 * WLS;
            const bf16_t* ap = H1B + (size_t)(g0 + l15) * D + 8 * lq; bf16_t* xp = X1B + (size_t)(g0 + l15) * D + 8 * lq;
            const char* wsrc = (const char*)sm + SMB_WGH;
            u32x4 av[2][16];
#pragma unroll
            for (int i = 0; i < 16; ++i) av[0][i] = *(const u32x4*)(ap + 32 * i);
#pragma unroll
            for (int kh = 0; kh < 2; ++kh) {
                __syncthreads();
                for (int i = tid; i < 2 * 48 * 64; i += 512) { const int hl = i / (48 * 64), r = i % (48 * 64), col = r >> 6, k8 = (r & 63) * 8;
                    *(PG8_LAS u32x4*)(WH + (hl * 48 + col) * WLS + k8) = *(const u32x4*)(wsrc + (size_t)hl * 48 * D * 2 + ((size_t)col * D + kh * 512 + k8) * 2); }
                __syncthreads();
                const PG8_LAS bf16_t* bp = WH + l15 * WLS + 8 * lq;
                if (kh == 0) {
#pragma unroll
                    for (int i = 0; i < 16; ++i) av[1][i] = *(const u32x4*)(ap + 512 + 32 * i); }
#pragma unroll
                for (int i = 0; i < 16; ++i) { if ((i & 1) == 0) __builtin_amdgcn_sched_barrier(0); const u32x4 ar = av[kh][i]; const int col = kh * 512 + 32 * i;
                    { f32x4 a0, a1; pg8::unpack8(ar, a0, a1);
                      const f32x4 g0_ = *(const PG8_LAS f32x4*)(gbl + col), g1_ = *(const PG8_LAS f32x4*)(gbl + col + 4), b0_ = *(const PG8_LAS f32x4*)(gbl + D + col), b1_ = *(const PG8_LAS f32x4*)(gbl + D + col + 4);
                      const f32x4 v0_ = (a0 - rmean) * rrstd * g0_ + b0_, v1_ = (a1 - rmean) * rrstd * g1_ + b1_;
                      u32x4 w_; w_.x = pk2(v0_[0], v0_[1]); w_.y = pk2(v0_[2], v0_[3]); w_.z = pk2(v1_[0], v1_[1]); w_.w = pk2(v1_[2], v1_[3]); if (!DRY) *(u32x4*)(xp + col) = w_; }
                    const bf16x8 ah = __builtin_bit_cast(bf16x8, ar); const int st = i;
                    const bf16x8 h0 = *(const PG8_LAS bf16x8*)(bp + 32 * st), h1 = *(const PG8_LAS bf16x8*)(bp + 16 * WLS + 32 * st), h2 = *(const PG8_LAS bf16x8*)(bp + 32 * WLS + 32 * st);
                    const bf16x8 l0 = *(const PG8_LAS bf16x8*)(bp + 48 * WLS + 32 * st), l1 = *(const PG8_LAS bf16x8*)(bp + 64 * WLS + 32 * st), l2 = *(const PG8_LAS bf16x8*)(bp + 80 * WLS + 32 * st);
                    acc0 = __builtin_amdgcn_mfma_f32_16x16x32_bf16(ah, h0, acc0, 0, 0, 0); acc1 = __builtin_amdgcn_mfma_f32_16x16x32_bf16(ah, h1, acc1, 0, 0, 0); acc2 = __builtin_amdgcn_mfma_f32_16x16x32_bf16(ah, h2, acc2, 0, 0, 0);
                    acc0 = __builtin_amdgcn_mfma_f32_16x16x32_bf16(ah, l0, acc0, 0, 0, 0); acc1 = __builtin_amdgcn_mfma_f32_16x16x32_bf16(ah, l1, acc1, 0, 0, 0); acc2 = __builtin_amdgcn_mfma_f32_16x16x32_bf16(ah, l2, acc2, 0, 0, 0); } }
        } else
        { const bf16_t* ap = H1B + (size_t)(g0 + l15) * D + 4 * lq; const float* bp = sm + SM_WGT + (size_t)l15 * D + 4 * lq;
#pragma unroll 4
          for (int st = 0; st < D / 16; ++st) { const u32x2 ar = *(const u32x2*)(ap + 16 * st); const f32x4 a = {bflo(ar.x), bfhi(ar.x), bflo(ar.y), bfhi(ar.y)}; NORM_STORE(a, 16 * st + 4 * lq);
              const f32x4 b0 = *(const f32x4*)(bp + 16 * st), b1 = *(const f32x4*)(bp + 16 * D + 16 * st), b2 = *(const f32x4*)(bp + 32 * D + 16 * st);
#pragma unroll
              for (int j = 0; j < 4; ++j) { acc0 = __builtin_amdgcn_mfma_f32_16x16x4f32(a[j], b0[j], acc0, 0, 0, 0); acc1 = __builtin_amdgcn_mfma_f32_16x16x4f32(a[j], b1[j], acc1, 0, 0, 0); acc2 = __builtin_amdgcn_mfma_f32_16x16x4f32(a[j], b2[j], acc2, 0, 0, 0); } } }
#pragma unroll
        for (int i = 0; i < 4; ++i) { lg[(lq * 4 + i) * 48 + l15] = acc0[i]; lg[(lq * 4 + i) * 48 + 16 + l15] = acc1[i]; lg[(lq * 4 + i) * 48 + 32 + l15] = acc2[i]; }
        asm volatile("s_waitcnt lgkmcnt(0)" ::: "memory");
        if (lane < 16) { const PG8_LAS float* lr = lg + lane * 48; float gl[4], gm; int gs = 0;
#pragma unroll
            for (int g = 0; g < 4; ++g) gl[g] = my_rstd * (lr[g] - my_mean * sm[SM_CS + g]) + sm[SM_BW + g];
            gm = gl[0];
#pragma unroll
            for (int g = 1; g < 4; ++g) if (gl[g] > gm) { gm = gl[g]; gs = g; }
            const float gp = 1.f / (__expf(gl[0] - gm) + __expf(gl[1] - gm) + __expf(gl[2] - gm) + __expf(gl[3] - gm));
            float v0 = -INFINITY, v1 = -INFINITY; int i0 = 0, i1 = 0;
            for (int j = 0; j < 8; ++j) { const int col = 4 + gs * 8 + j; const float x = my_rstd * (lr[col] - my_mean * sm[SM_CS + col]) + sm[SM_BW + col];
                if (x > v0) { v1 = v0; i1 = i0; v0 = x; i0 = j; } else if (x > v1) { v1 = x; i1 = j; } }
            const float e1 = __expf(v1 - v0), w0 = gp / (1.f + e1), w1 = gp * e1 / (1.f + e1); const int ea = gs * 8 + i0, eb = gs * 8 + i1, row = g0 + lane;
            const int ra = __hip_atomic_fetch_add(lh + ea, 1, __ATOMIC_RELAXED, __HIP_MEMORY_SCOPE_WORKGROUP), rb = __hip_atomic_fetch_add(lh + eb, 1, __ATOMIC_RELAXED, __HIP_MEMORY_SCOPE_WORKGROUP);
            PG8_LAS int* a = asg + (wid * 16 + lane) * 4; a[0] = row; a[1] = ea | (ra << 8); a[2] = eb | (rb << 8);
            if (!DRY) { rw[row * 2] = w0; rw[row * 2 + 1] = w1; } }
    }
#undef NORM_STORE
    __syncthreads();
    if (DRY) return;
    if (tid < 32) lh[32 + tid] = (int)atomicAdd(cnt + tid, (unsigned)lh[tid]);
    __syncthreads();
    if (lane < 16 && ngrp > 0) { const PG8_LAS int* a = asg + (wid * 16 + lane) * 4; const int row = a[0], xa = a[1], xb = a[2];
        list[(size_t)(xa & 255) * T + lh[32 + (xa & 255)] + (xa >> 8)] = row * 2; list[(size_t)(xb & 255) * T + lh[32 + (xb & 255)] + (xb >> 8)] = row * 2 + 1; }
    __syncthreads();
}
__device__ __forceinline__ void ln2_phase(const Ctx& c, int tid, int bid, int nblk, float oscale) {
    asm volatile("" : "+v"(tid));
    const int lane = tid & 63, wid = tid >> 6, gw = bid * 8 + wid, NGW = nblk * 8;
    const bf16_t* X1B = wsp<bf16_t>(c, OFF_X1B); const bf16_t* Y0 = wsp<bf16_t>(c, OFF_Y0); const bf16_t* Y1 = wsp<bf16_t>(c, OFF_Y1); const float* rw = wsp<float>(c, OFF_RW);
    f32x4 gv[4], bv[4];
#pragma unroll
    for (int j = 0; j < 4; ++j) { gv[j] = *(const f32x4*)(c.ln2_g + 4 * lane + 256 * j); bv[j] = *(const f32x4*)(c.ln2_b + 4 * lane + 256 * j); }
    for (int row0 = gw; row0 < T; row0 += 2 * NGW) {
        u32x2 xr[2][4], ya[2][4], yb[2][4]; float w0[2], w1[2]; int rows[2];
#pragma unroll
        for (int q = 0; q < 2; ++q) { const int row = row0 + q * NGW < T ? row0 + q * NGW : row0; rows[q] = row;
            const u32x2* xp = (const u32x2*)(X1B + (size_t)row * D) + lane; const u32x2* y0p = (const u32x2*)(Y0 + (size_t)row * D) + lane; const u32x2* y1p = (const u32x2*)(Y1 + (size_t)row * D) + lane;
            w0[q] = rw[row * 2]; w1[q] = rw[row * 2 + 1];
#pragma unroll
            for (int j = 0; j < 4; ++j) { xr[q][j] = xp[64 * j]; ya[q][j] = y0p[64 * j]; yb[q][j] = y1p[64 * j]; } }
#pragma unroll
        for (int q = 0; q < 2; ++q) { if (q == 1 && row0 + NGW >= T) break;
            f32x4 v[4]; float s = 0.f;
#pragma unroll
            for (int j = 0; j < 4; ++j) { const u32x2 x = xr[q][j], a = ya[q][j], b = yb[q][j];
                v[j][0] = DN_ALPHA * bflo(x.x) + w0[q] * bflo(a.x) + w1[q] * bflo(b.x); v[j][1] = DN_ALPHA * bfhi(x.x) + w0[q] * bfhi(a.x) + w1[q] * bfhi(b.x);
                v[j][2] = DN_ALPHA * bflo(x.y) + w0[q] * bflo(a.y) + w1[q] * bflo(b.y); v[j][3] = DN_ALPHA * bfhi(x.y) + w0[q] * bfhi(a.y) + w1[q] * bfhi(b.y);
                s += (v[j][0] + v[j][1]) + (v[j][2] + v[j][3]); }
            const float mean = wave_sum(s) * (1.f / D); float s2 = 0.f;
#pragma unroll
            for (int j = 0; j < 4; ++j) { v[j] = v[j] - mean; s2 += (v[j][0] * v[j][0] + v[j][1] * v[j][1]) + (v[j][2] * v[j][2] + v[j][3] * v[j][3]); }
            const float rstd = 1.f / sqrtf(wave_sum(s2) * (1.f / D) + LN_EPS);
            f32x4* op = (f32x4*)(c.out + (size_t)rows[q] * D) + lane;
#pragma unroll
            for (int j = 0; j < 4; ++j) op[64 * j] = (v[j] * rstd * gv[j] + bv[j]) * oscale; }
    }
}
struct TrItem { const float* W; int N; bf16_t* Wt; size_t ldo; int k0, n0; };
__device__ __forceinline__ void tr_fetch(const TrItem& t, int lane, f32x4 (&w)[8]) {
#pragma unroll
    for (int i = 0; i < 8; ++i) { const int kk = 8 * i + (lane >> 3), n4 = (lane & 7) * 4; w[i] = *(const f32x4*)(t.W + (size_t)(t.k0 + kk) * t.N + t.n0 + n4); }
}
__device__ __forceinline__ void tr_to_lds(const f32x4 (&w)[8], PG8_LAS float* scr, int lane) {
#pragma unroll
    for (int i = 0; i < 8; ++i) { const int kk = 8 * i + (lane >> 3), n4 = (lane & 7) * 4; scr[kk * 33 + n4] = w[i][0]; scr[kk * 33 + n4 + 1] = w[i][1]; scr[kk * 33 + n4 + 2] = w[i][2]; scr[kk * 33 + n4 + 3] = w[i][3]; }
}
__device__ __forceinline__ void tr_emit(const TrItem& t, const PG8_LAS float* scr, int lane) {
    const int ch = lane & 7;
#pragma unroll
    for (int j = 0; j < 4; ++j) { const int n = (lane >> 3) + 8 * j; const PG8_LAS float* s = scr + (8 * ch) * 33 + n;
        u32x4 o; o.x = pk2(s[0 * 33], s[1 * 33]); o.y = pk2(s[2 * 33], s[3 * 33]); o.z = pk2(s[4 * 33], s[5 * 33]); o.w = pk2(s[6 * 33], s[7 * 33]);
        *(u32x4*)(t.Wt + (size_t)n * t.ldo + t.k0 + 8 * ch) = o; }
}
template <class Dec> __device__ __forceinline__ void tr_loop(const Dec& dec, int nit, int gw, int NGW, PG8_LAS float* scr, int lane) {
    int it = gw; if (it >= nit) return;
    TrItem cur = dec(it); f32x4 w[8]; tr_fetch(cur, lane, w);
    for (;;) { tr_to_lds(w, scr, lane);
        const int nx = it + NGW; const bool has = nx < nit; TrItem nxt = cur;
        if (has) { nxt = dec(nx); tr_fetch(nxt, lane, w); }
        asm volatile("s_waitcnt lgkmcnt(0)" ::: "memory");
        tr_emit(cur, scr, lane);
        asm volatile("s_waitcnt lgkmcnt(0)" ::: "memory");
        if (!has) break;
        cur = nxt; it = nx; }
}
__device__ __forceinline__ void cvt_copy(const float* src, bf16_t* dst, long n, int tid, int bid, int nblk) {
    const long n8 = n / 8, stride = (long)nblk * 512; long i = (long)bid * 512 + tid;
    for (; i + 3 * stride < n8; i += 4 * stride) {
        f32x4 a[4], b[4];
#pragma unroll
        for (int j = 0; j < 4; ++j) { a[j] = __builtin_nontemporal_load((const f32x4*)(src + (i + j * stride) * 8)); b[j] = __builtin_nontemporal_load((const f32x4*)(src + (i + j * stride) * 8 + 4)); }
#pragma unroll
        for (int j = 0; j < 4; ++j) { u32x4 o; o.x = pk2(a[j][0], a[j][1]); o.y = pk2(a[j][2], a[j][3]); o.z = pk2(b[j][0], b[j][1]); o.w = pk2(b[j][2], b[j][3]); *(u32x4*)(dst + (i + j * stride) * 8) = o; } }
    for (; i < n8; i += stride) { const f32x4 a = *(const f32x4*)(src + i * 8), b = *(const f32x4*)(src + i * 8 + 4);
        u32x4 o; o.x = pk2(a[0], a[1]); o.y = pk2(a[2], a[3]); o.z = pk2(b[0], b[1]); o.w = pk2(b[2], b[3]); *(u32x4*)(dst + i * 8) = o; }
}
__device__ __forceinline__ void prologue_phase(const Ctx& c, PG8_LAS unsigned char* lds, int tid, int bid, int nblk) {
    asm volatile("" : "+v"(tid));
    const int lane = tid & 63, wid = tid >> 6, gw = bid * 8 + wid, NGW = nblk * 8;
    PG8_LAS float* scr = (PG8_LAS float*)(lds + wid * 16384);
    constexpr int I_IN = (D / 64) * (N_IN / 32), I_KV = (D / 64) * (1024 / 32), I_A = (WA / 64) * (D / 32), I_B = (WB / 64) * (D / 32), I_C = (WC / 64) * (D / 32), I_O = (D / 64) * (D / 32);
    constexpr int NIT = I_IN + I_KV + I_A + I_B + I_C + I_O;
    auto dec = [&](int it) { int r = it; TrItem t;
        if (r < I_IN) { const int nb = N_IN / 32; t = TrItem{c.w_in, N_IN, wsp<bf16_t>(c, WT_IN) + (size_t)(r % nb) * 32 * D, (size_t)D, (r / nb) * 64, (r % nb) * 32}; return t; } r -= I_IN;
        if (r < I_KV) { const int nb = 1024 / 32; t = TrItem{c.w_kv, 1024, wsp<bf16_t>(c, WT_KV) + (size_t)(r % nb) * 32 * D, (size_t)D, (r / nb) * 64, (r % nb) * 32}; return t; } r -= I_KV;
        if (r < I_A) { const int nb = D / 32; t = TrItem{c.w_a, D, wsp<bf16_t>(c, WT_A) + (size_t)(r % nb) * 32 * OW, (size_t)OW, (r / nb) * 64, (r % nb) * 32}; return t; } r -= I_A;
        if (r < I_B) { const int nb = D / 32; t = TrItem{c.w_b, D, wsp<bf16_t>(c, WT_A) + WA + (size_t)(r % nb) * 32 * OW, (size_t)OW, (r / nb) * 64, (r % nb) * 32}; return t; } r -= I_B;
        if (r < I_C) { const int nb = D / 32; t = TrItem{c.w_c, D, wsp<bf16_t>(c, WT_A) + WA + WB + (size_t)(r % nb) * 32 * OW, (size_t)OW, (r / nb) * 64, (r % nb) * 32}; return t; } r -= I_C;
        { const int nb = D / 32; t = TrItem{c.w_out, D, wsp<bf16_t>(c, WT_OUT) + (size_t)(r % nb) * 32 * D, (size_t)D, (r / nb) * 64, (r % nb) * 32}; return t; } };
    tr_loop(dec, NIT, gw, NGW, scr, lane);
    router_weights_prep(c, tid, bid, nblk);
    cvt_copy(c.x, wsp<bf16_t>(c, OFF_XB), (long)T * D, tid, bid, nblk);
    cvt_copy(c.mem, wsp<bf16_t>(c, OFF_MEMB), (long)NBATCH * MEM * D, tid, bid, nblk);
}
__device__ __forceinline__ void expert_weights_phase(const Ctx& c, PG8_LAS unsigned char* lds, int tid, int bid, int nblk) {
    asm volatile("" : "+v"(tid));
    const int lane = tid & 63, wid = tid >> 6, gw = bid * 8 + wid, NGW = nblk * 8;
    PG8_LAS float* scr = (PG8_LAS float*)(lds + wid * 16384);
    constexpr int I_G = (D / 64) * (DE / 32), I_D = (DE / 64) * (D / 32), PER_E = 2 * I_G + I_D;
    auto dec = [&](int it) { const int e = it / PER_E; int r = it % PER_E; TrItem t;
        if (r < 2 * I_G) { const int up = r / I_G; r %= I_G; const int nb = DE / 32, n0 = (r % nb) * 32, k0 = (r / nb) * 64; const float* src = (up ? c.w_eu : c.w_eg) + (size_t)e * D * DE;
            t = TrItem{src, DE, wsp<bf16_t>(c, OFF_WTGU) + ((size_t)e * 2 * DE + (n0 / 128) * 256 + up * 128 + n0 % 128) * D, (size_t)D, k0, n0}; return t; }
        r -= 2 * I_G; const int nb = D / 32, n0 = (r % nb) * 32, k0 = (r / nb) * 64;
        t = TrItem{c.w_ed + (size_t)e * DE * D, D, wsp<bf16_t>(c, OFF_WTDN) + ((size_t)e * D + n0) * DE, (size_t)DE, k0, n0}; return t; };
    tr_loop(dec, NE * PER_E, gw, NGW, scr, lane);
}
}
namespace hgrn {
typedef float f32x4 __attribute__((ext_vector_type(4)));
typedef unsigned u32x2 __attribute__((ext_vector_type(2)));
typedef unsigned u32x4 __attribute__((ext_vector_type(4)));
constexpr int QS = 272, SS = 144;
constexpr int L_QE = 0, L_KE = L_QE + 64 * QS, L_KDT = L_KE + 64 * QS, L_VT = L_KDT + 128 * SS, L_PM = L_VT + 128 * SS,     L_ST = L_PM + 64 * SS, L_F32 = L_ST + 128 * QS;
constexpr int F_QTOT = 0, F_DL = 512, F_ER = 640, F_SSQ = 768, F_LB = 1280, L_END = L_F32 + (1280 + 128) * 4;
static_assert(L_END <= 131072, "hgrn LDS");
__device__ __forceinline__ float fexp2(float x) { return __builtin_amdgcn_exp2f(__builtin_amdgcn_fmed3f(x, -100.f, 115.f)); }
__device__ __forceinline__ unsigned hbf(float x) { return pg8::cvt_pk_bf16(x, x); }
__device__ __forceinline__ bf16x8 ldfrag(const PG8_LAS char* mat, int stride, int row, int ks, int lq) { return *(const PG8_LAS bf16x8*)(mat + row * stride + ks * 64 + lq * 16); }

struct Raw { bf16x8 f0, f1, q0, q1, v0, v1; unsigned short g[16]; };
template <bool FULL>
__device__ __forceinline__ void hg_load(Raw& R, const bf16_t* P, int row0, int h, int tid, int vcol, int lq) {
    const int et = tid >> 3, ec = (tid & 7) * 8, sr = tid >> 4, sc = (tid & 15) * 8;
    const bf16_t* fp = P + (size_t)(row0 + et) * NPB + WB + h * 128 + ec; R.f0 = *(const bf16x8*)fp; R.f1 = *(const bf16x8*)(fp + 64);
    const bf16_t* vp = P + (size_t)(row0 + sr) * NPB + 2 * WB + h * 128 + sc; R.v0 = *(const bf16x8*)vp; R.v1 = *(const bf16x8*)(vp + (size_t)32 * NPB);
    if (FULL) { const bf16_t* qp = P + (size_t)(row0 + et) * NPB + h * 128 + ec; R.q0 = *(const bf16x8*)qp; R.q1 = *(const bf16x8*)(qp + 64);
        const bf16_t* gp = P + (size_t)(row0 + lq * 4) * NPB + 3 * WB + h * 128 + vcol;
#pragma unroll
        for (int mt = 0; mt < 4; ++mt)
#pragma unroll
            for (int i = 0; i < 4; ++i) R.g[mt * 4 + i] = gp[(size_t)(mt * 16 + i) * NPB]; }
}
template <bool FULL>
__device__ __forceinline__ void hg_unit(const Ctx& c, int half, int bl, int h, int seg, PG8_LAS char* lds, int tid, Raw& R, int nrow0, int nh) {
    const int wid = __builtin_amdgcn_readfirstlane(tid >> 6), lane = tid & 63, l15 = lane & 15, lq = lane >> 4;
    const int ek = tid & 127, etq = tid >> 7;
    const int et = tid >> 3, ec = (tid & 7) * 8;
    const int sr = tid >> 4, sc = (tid & 15) * 8;
    const int bhl = bl * HB + h;
    const bf16_t* P = wsp<bf16_t>(c, OFF_PB);
    PG8_LAS float* F = (PG8_LAS float*)(lds + L_F32); PG8_LAS float* LF = (PG8_LAS float*)(lds + L_ST);
    bf16_t* Shat = wsp<bf16_t>(c, OFF_HG) + ((size_t)bhl * NSEG + seg) * 128 * 128;
    const int vcol = wid * 16 + l15;
    if (tid < 128) F[F_LB + tid] = wsp<float>(c, OFF_SMALL)[SM_LB + h * 128 + tid];
    f32x4 Sacc[8];
#pragma unroll
    for (int kt = 0; kt < 8; ++kt) {
        if (FULL) {
#pragma unroll
            for (int i = 0; i < 4; ++i) Sacc[kt][i] = bf2f(Shat[(size_t)(kt * 16 + lq * 4 + i) * 128 + vcol]);
        } else Sacc[kt] = (f32x4){0.f, 0.f, 0.f, 0.f};
    }
    float dsum = 0.f;
    __syncthreads();
    for (int ch = 0; ch < 4; ++ch) {
        int row0 = bl * S + seg * 256 + ch * 64;
        asm volatile("" : "+s"(row0));
        { unsigned kw[8], qw[8];
#pragma unroll
          for (int hh = 0; hh < 2; ++hh) { const bf16x8 fr = hh ? R.f1 : R.f0; const bf16x8 qr = hh ? R.q1 : R.q0; f32x4 lfo[2];
#pragma unroll
              for (int j = 0; j < 8; j += 2) { float kf2[2], qs2[2];
#pragma unroll
                  for (int e = 0; e < 2; ++e) { const float lb = F[F_LB + ec + hh * 64 + j + e]; const float f = lb + (1.f - lb) * pg8::fsigmoid(bf2f((bf16_t)fr[j + e])); lfo[(j + e) >> 2][(j + e) & 3] = __builtin_amdgcn_logf(f); kf2[e] = 1.f - f;
                      if (FULL) { const float q = bf2f((bf16_t)qr[j + e]); qs2[e] = q * pg8::fsigmoid(q); } }
                  kw[hh * 4 + (j >> 1)] = pg8::cvt_pk_bf16(kf2[0], kf2[1]); if (FULL) qw[hh * 4 + (j >> 1)] = pg8::cvt_pk_bf16(qs2[0], qs2[1]); }
              *(PG8_LAS f32x4*)(LF + et * 128 + ec + hh * 64) = lfo[0]; *(PG8_LAS f32x4*)(LF + et * 128 + ec + hh * 64 + 4) = lfo[1]; }
          *(PG8_LAS u32x4*)(lds + L_KE + et * QS + ec * 2) = (u32x4){kw[0], kw[1], kw[2], kw[3]}; *(PG8_LAS u32x4*)(lds + L_KE + et * QS + ec * 2 + 128) = (u32x4){kw[4], kw[5], kw[6], kw[7]};
          if (FULL) { *(PG8_LAS u32x4*)(lds + L_QE + et * QS + ec * 2) = (u32x4){qw[0], qw[1], qw[2], qw[3]}; *(PG8_LAS u32x4*)(lds + L_QE + et * QS + ec * 2 + 128) = (u32x4){qw[4], qw[5], qw[6], qw[7]}; } }
        *(PG8_LAS bf16x8*)(lds + L_VT + sr * QS + sc * 2) = R.v0; *(PG8_LAS bf16x8*)(lds + L_VT + (sr + 32) * QS + sc * 2) = R.v1;
        unsigned short graw[16];
#pragma unroll
        for (int i = 0; i < 16; ++i) graw[i] = R.g[i];
        __syncthreads();
        float lf[16];
        { float run = 0.f;
#pragma unroll
          for (int j = 0; j < 16; ++j) { run += LF[(etq * 16 + j) * 128 + ek]; lf[j] = run; }
          F[F_QTOT + etq * 128 + ek] = run; }
        __syncthreads();
        { const float q0 = F[F_QTOT + ek], q1 = F[F_QTOT + 128 + ek], q2 = F[F_QTOT + 256 + ek], q3 = F[F_QTOT + 384 + ek];
          const float blast = (q0 + q1) + (q2 + q3), off = etq == 0 ? 0.f : (etq == 1 ? q0 : (etq == 2 ? q0 + q1 : (q0 + q1) + q2)), r = 0.5f * blast;
          const float er = fexp2(r);
          if (etq == 0) { F[F_DL + ek] = fexp2(blast); F[F_ER + ek] = er; dsum += blast; }
          unsigned kd[8];
#pragma unroll
          for (int j = 0; j < 16; j += 2) { float kdv[2];
#pragma unroll
              for (int e = 0; e < 2; ++e) { const float b = off + lf[j + e]; PG8_LAS bf16_t* kp = (PG8_LAS bf16_t*)(lds + L_KE + (etq * 16 + j + e) * QS + ek * 2); const float kfv = bf2f(*kp);
                  float E = 1.f, kev = 0.f;
                  if (FULL) { E = fexp2(b - r); kev = kfv * __builtin_amdgcn_rcpf(E); kdv[e] = kev * er; }
                  else kdv[e] = kfv * fexp2(blast - b);
                  if (FULL) { PG8_LAS bf16_t* qp = (PG8_LAS bf16_t*)(lds + L_QE + (etq * 16 + j + e) * QS + ek * 2); *qp = (bf16_t)hbf(bf2f(*qp) * E); *kp = (bf16_t)hbf(kev); } }
              kd[j >> 1] = pg8::cvt_pk_bf16(kdv[0], kdv[1]); }
          *(PG8_LAS u32x4*)(lds + L_KDT + ek * SS + etq * 32) = (u32x4){kd[0], kd[1], kd[2], kd[3]};
          *(PG8_LAS u32x4*)(lds + L_KDT + ek * SS + etq * 32 + 16) = (u32x4){kd[4], kd[5], kd[6], kd[7]}; }
        if (ch < 3) hg_load<FULL>(R, P, row0 + 64, h, tid, vcol, lq); else if (nrow0 >= 0) hg_load<FULL>(R, P, nrow0, nh, tid, vcol, lq);
        __syncthreads();
        f32x4 oacc[4];
        if (FULL) {
#pragma unroll
            for (int kt = 0; kt < 8; ++kt) { const f32x4 er = *(const PG8_LAS f32x4*)(F + F_ER + kt * 16 + lq * 4);
                u32x2 w; w.x = pg8::cvt_pk_bf16(Sacc[kt][0] * er[0], Sacc[kt][1] * er[1]); w.y = pg8::cvt_pk_bf16(Sacc[kt][2] * er[2], Sacc[kt][3] * er[3]);
                *(PG8_LAS u32x2*)(lds + L_ST + vcol * QS + (kt * 16 + lq * 4) * 2) = w; }
            { const int tt = wid & 3;
#pragma unroll
              for (int sti = 0; sti < 2; ++sti) { const int st = 2 * (wid >> 2) + sti; f32x4 a = (f32x4){0.f, 0.f, 0.f, 0.f};
#pragma unroll
                  for (int ks = 0; ks < 4; ++ks) a = __builtin_amdgcn_mfma_f32_16x16x32_bf16(ldfrag(lds + L_KE, QS, st * 16 + l15, ks, lq), ldfrag(lds + L_QE, QS, tt * 16 + l15, ks, lq), a, 0, 0, 0);
                  const int t = tt * 16 + l15, s0 = st * 16 + lq * 4;
                  u32x2 w; w.x = pg8::cvt_pk_bf16(s0 <= t ? a[0] : 0.f, s0 + 1 <= t ? a[1] : 0.f); w.y = pg8::cvt_pk_bf16(s0 + 2 <= t ? a[2] : 0.f, s0 + 3 <= t ? a[3] : 0.f);
                  *(PG8_LAS u32x2*)(lds + L_PM + t * SS + s0 * 2) = w; } }
            __syncthreads();
        }
        bf16x8 vb0, vb1;
#pragma unroll
        for (int j = 0; j < 8; ++j) { vb0[j] = *(const PG8_LAS short*)(lds + L_VT + (lq * 8 + j) * QS + vcol * 2); vb1[j] = *(const PG8_LAS short*)(lds + L_VT + (32 + lq * 8 + j) * QS + vcol * 2); }
        if (FULL) {
            bf16x8 sb[4];
#pragma unroll
            for (int ks = 0; ks < 4; ++ks) sb[ks] = ldfrag(lds + L_ST, QS, vcol, ks, lq);
#pragma unroll
            for (int mt = 0; mt < 4; ++mt) { f32x4 a = (f32x4){0.f, 0.f, 0.f, 0.f};
#pragma unroll
                for (int ks = 0; ks < 4; ++ks) a = __builtin_amdgcn_mfma_f32_16x16x32_bf16(ldfrag(lds + L_QE, QS, mt * 16 + l15, ks, lq), sb[ks], a, 0, 0, 0);
                a = __builtin_amdgcn_mfma_f32_16x16x32_bf16(ldfrag(lds + L_PM, SS, mt * 16 + l15, 0, lq), vb0, a, 0, 0, 0);
                a = __builtin_amdgcn_mfma_f32_16x16x32_bf16(ldfrag(lds + L_PM, SS, mt * 16 + l15, 1, lq), vb1, a, 0, 0, 0);
                oacc[mt] = a; }
        }
#pragma unroll
        for (int kt = 0; kt < 8; ++kt) { const f32x4 dl = *(const PG8_LAS f32x4*)(F + F_DL + kt * 16 + lq * 4); f32x4 a = Sacc[kt] * dl;
            a = __builtin_amdgcn_mfma_f32_16x16x32_bf16(ldfrag(lds + L_KDT, SS, kt * 16 + l15, 0, lq), vb0, a, 0, 0, 0);
            a = __builtin_amdgcn_mfma_f32_16x16x32_bf16(ldfrag(lds + L_KDT, SS, kt * 16 + l15, 1, lq), vb1, a, 0, 0, 0);
            Sacc[kt] = a; }
        if (FULL) {
#pragma unroll
            for (int mt = 0; mt < 4; ++mt)
#pragma unroll
                for (int i = 0; i < 4; ++i) { float q = oacc[mt][i] * oacc[mt][i];
#define DPP_SHR(n) q += __builtin_bit_cast(float, __builtin_amdgcn_update_dpp(0, __builtin_bit_cast(int, q), 0x110 + (n), 0xf, 0xf, true))
                    DPP_SHR(1); DPP_SHR(2); DPP_SHR(4); DPP_SHR(8);
#undef DPP_SHR
                    if (l15 == 15) F[F_SSQ + (mt * 16 + lq * 4 + i) * 8 + wid] = q; }
            __syncthreads();
            const float ng = c.norm_g[h * 128 + vcol];
            float rs_mine;
            { const PG8_LAS f32x4* sp = (const PG8_LAS f32x4*)(F + F_SSQ + ((l15 >> 2) * 16 + lq * 4 + (l15 & 3)) * 8); const f32x4 s0 = sp[0], s1 = sp[1];
              const float ss = ((s0[0] + s0[1]) + (s0[2] + s0[3])) + ((s1[0] + s1[1]) + (s1[2] + s1[3])); rs_mine = __builtin_amdgcn_rsqf(ss * (1.f / 128.f) + RMS_EPS); }
            bf16_t* op = (bf16_t*)c.out + ((size_t)half * TH + row0 + lq * 4) * OW + WA + h * 128 + vcol;
#pragma unroll
            for (int mt = 0; mt < 4; ++mt)
#pragma unroll
                for (int i = 0; i < 4; ++i) { const float rs = __shfl(rs_mine, (lane & 48) | (mt * 4 + i)); const float g = bf2f(graw[mt * 4 + i]);
                    op[(size_t)(mt * 16 + i) * OW] = (bf16_t)pg8::cvt_pk_bf16(oacc[mt][i] * rs * ng * (g * pg8::fsigmoid(g)), 0.f); }
        }
        __syncthreads();
    }
    if (!FULL) {
#pragma unroll
        for (int kt = 0; kt < 8; ++kt)
#pragma unroll
            for (int i = 0; i < 4; ++i) Shat[(size_t)(kt * 16 + lq * 4 + i) * 128 + vcol] = (bf16_t)hbf(Sacc[kt][i]);
        if (etq == 0) wsp<float>(c, OFF_DSEG)[((size_t)bhl * NSEG + seg) * 128 + ek] = dsum;
    }
}
template <bool FULL>
__device__ __forceinline__ void hg_phase(const Ctx& c, int half, PG8_LAS unsigned char* lds_u, int tid, int bid_in, int nblk_in, int nlight = 0) {
    asm volatile("" : "+v"(tid));
    PG8_LAS char* lds = (PG8_LAS char*)lds_u;
    constexpr int NU = BH * HB * NSEG;
    const int bid = bid_in < nlight ? bid_in : nlight + (bid_in - nlight), nblk = bid_in < nlight ? NU : nblk_in - nlight;
    const int wid = __builtin_amdgcn_readfirstlane(tid >> 6), lane = tid & 63, vcol = wid * 16 + (lane & 15), lq = lane >> 4;
    Raw R;
    if (bid < NU) { const int seg = bid % NSEG, bhl = bid / NSEG; hg_load<FULL>(R, wsp<bf16_t>(c, OFF_PB), (bhl / HB) * S + seg * 256, bhl % HB, tid, vcol, lq); }
    for (int u = bid; u < NU; u += nblk) { const int seg = u % NSEG, bhl = u / NSEG; const int un = u + nblk; int nrow0 = -1, nh = 0;
        if (un < NU) { const int sgn = un % NSEG, bn = un / NSEG; nrow0 = (bn / HB) * S + sgn * 256; nh = bn % HB; }
        hg_unit<FULL>(c, half, bhl / HB, bhl % HB, seg, lds, tid, R, nrow0, nh); }
}
__device__ __forceinline__ void hg_scan_phase(const Ctx& c, int tid, int bid, int nblk) {
    asm volatile("" : "+v"(tid));
    constexpr long N = (long)BH * HB * 128 * 64;
    for (long idx = (long)bid * 512 + tid; idx < N; idx += (long)nblk * 512) { const int v2 = (int)(idx & 63), k = (int)((idx >> 6) & 127), bhl = (int)(idx >> 13);
        unsigned* sp = (unsigned*)(wsp<bf16_t>(c, OFF_HG) + ((size_t)bhl * NSEG * 128 + k) * 128) + v2; const float* dp = wsp<float>(c, OFF_DSEG) + (size_t)bhl * NSEG * 128 + k;
        unsigned tmp[NSEG]; float dd[NSEG];
#pragma unroll
        for (int sg = 0; sg < NSEG; ++sg) { tmp[sg] = sp[(size_t)sg * 128 * 64]; dd[sg] = dp[sg * 128]; }
        float r0 = 0.f, r1 = 0.f;
#pragma unroll
        for (int sg = 0; sg < NSEG; ++sg) { const float t0 = bflo(tmp[sg]), t1 = bfhi(tmp[sg]), d = __builtin_amdgcn_exp2f(dd[sg]); tmp[sg] = pg8::cvt_pk_bf16(r0, r1); r0 = d * r0 + t0; r1 = d * r1 + t1; }
#pragma unroll
        for (int sg = 0; sg < NSEG; ++sg) sp[(size_t)sg * 128 * 64] = tmp[sg];
    }
}
__device__ __forceinline__ void comb_phase(const Ctx& c, int half, int tid, int bid, int nblk) {
    asm volatile("" : "+v"(tid));
    constexpr long N = (long)TH * WA / 8; const float* lse = wsp<float>(c, OFF_LSE); const bf16_t* part = wsp<bf16_t>(c, OFF_PART);
    const long stride = (long)nblk * 512;
    for (long idx0 = (long)bid * 512 + tid; idx0 < N; idx0 += 4 * stride) {
        u32x4 pa[4], pb[4], pc[4]; float l0[4], l1[4], l2[4];
#pragma unroll
        for (int j = 0; j < 4; ++j) { const long idx = idx0 + j * stride < N ? idx0 + j * stride : idx0; const int c8 = (int)(idx % (WA / 8)), tl = (int)(idx / (WA / 8)), col = c8 * 8, h = col >> 7;
            l0[j] = lse[((size_t)0 * TH + tl) * 4 + h]; l1[j] = lse[((size_t)1 * TH + tl) * 4 + h]; l2[j] = lse[((size_t)2 * TH + tl) * 4 + h];
            pa[j] = *(const u32x4*)(part + ((size_t)0 * TH + tl) * WA + col); pb[j] = *(const u32x4*)(part + ((size_t)1 * TH + tl) * WA + col); pc[j] = *(const u32x4*)(part + ((size_t)2 * TH + tl) * WA + col); }
#pragma unroll
        for (int j = 0; j < 4; ++j) { const long idx = idx0 + j * stride; if (idx < N) { const int c8 = (int)(idx % (WA / 8)), tl = (int)(idx / (WA / 8)), col = c8 * 8;
            const float mx = fmaxf(l0[j], fmaxf(l1[j], l2[j])), e0 = __expf(l0[j] - mx), e1 = __expf(l1[j] - mx), e2 = __expf(l2[j] - mx), inv = 1.f / (e0 + e1 + e2), w0 = e0 * inv, w1 = e1 * inv, w2 = e2 * inv;
            f32x4 a0, a1, b0, b1, c0, c1; pg8::unpack8(pa[j], a0, a1); pg8::unpack8(pb[j], b0, b1); pg8::unpack8(pc[j], c0, c1);
            *(u32x4*)((bf16_t*)c.out + ((size_t)half * TH + tl) * OW + col) = pg8::pack8(a0 * w0 + b0 * w1 + c0 * w2, a1 * w0 + b1 * w1 + c1 * w2); } }
    }
}
}
#include <hip/hip_cooperative_groups.h>
namespace cg = cooperative_groups;
constexpr int NTHR = 512, LDS_BYTES = 147456;

template <class F> __device__ __forceinline__ void dev_elems_(const F& f, long n, int tid, int bid, int nblk) {
    asm volatile("" : "+v"(tid));
    for (long i = (long)bid * NTHR + tid; i < n; i += (long)nblk * NTHR) f(i);
}
template <class G> __device__ __forceinline__ void dev_sgemm_(const G& g, int tid, int bid, int nblk) {
    asm volatile("" : "+v"(tid));
    const int M = g.M(); const int lane = tid & 63, wid = tid >> 6; constexpr int ntn = G::N / 64;
    const long ntiles = (long)(M / 16) * ntn;
    for (long tile = (long)bid * 8 + wid; tile < ntiles; tile += (long)nblk * 8) {
        const int tm = (int)(tile / ntn), tn = (int)(tile % ntn), r0 = tm * 16, c0 = tn * 64;
        f32x4 acc[G::NBP][4], carry[4];
#pragma unroll
        for (int j = 0; j < 4; ++j) { carry[j] = (f32x4){0.f, 0.f, 0.f, 0.f};
#pragma unroll
            for (int w = 0; w < G::NBP; ++w) acc[w][j] = (f32x4){0.f, 0.f, 0.f, 0.f}; }
#pragma unroll
        for (int seg = 0; seg < G::NSEGS; ++seg) {
            const bf16_t* ar = g.arow(seg, r0 + (lane & 15)) + 8 * (lane >> 4); const bf16_t* br[G::NBP][4];
#pragma unroll
            for (int w = 0; w < G::NBP; ++w)
#pragma unroll
                for (int j = 0; j < 4; ++j) br[w][j] = g.brow(seg, r0, c0 + 16 * j + (lane & 15), w) + 8 * (lane >> 4);
            const int K = g.K(seg);
            for (int k0 = 0; k0 < K; k0 += 32) { const bf16x8 a = *(const bf16x8*)(ar + k0);
#pragma unroll
                for (int w = 0; w < G::NBP; ++w)
#pragma unroll
                    for (int j = 0; j < 4; ++j) { const bf16x8 b = *(const bf16x8*)(br[w][j] + k0); acc[w][j] = __builtin_amdgcn_mfma_f32_16x16x32_bf16(a, b, acc[w][j], 0, 0, 0); } }
#pragma unroll
            for (int j = 0; j < 4; ++j)
#pragma unroll
                for (int i = 0; i < 4; ++i) { float a = acc[0][j][i], cr = carry[j][i]; g.between(seg, r0 + (lane >> 4) * 4 + i, c0 + 16 * j + (lane & 15), a, cr); acc[0][j][i] = a; carry[j][i] = cr; }
        }
#pragma unroll
        for (int j = 0; j < 4; ++j)
#pragma unroll
            for (int i = 0; i < 4; ++i) g.store(r0 + (lane >> 4) * 4 + i, c0 + 16 * j + (lane & 15), acc[0][j][i], G::NBP == 2 ? acc[G::NBP - 1][j][i] : carry[j][i]);
    }
}

struct E_hg3q { Ctx c; int half; static constexpr long n = (long)BH * HB * NSEG * 128 * 4;
    __device__ __forceinline__ void operator()(long idx) const { const int kq = (int)(idx & 3), v = (int)((idx >> 2) & 127); const long r = idx >> 9; const int seg = (int)(r % NSEG), bhl = (int)(r / NSEG), h = bhl % HB, bl = bhl / HB;
        const bf16_t* P = wsp<bf16_t>(c, OFF_P); float st[32];
#pragma unroll
        for (int k = 0; k < 32; ++k) st[k] = wsp<float>(c, OFF_HG)[(((size_t)bhl * NSEG + seg) * 128 + kq * 32 + k) * 128 + v];
        for (int s = 0; s < 256; ++s) { const int tl = bl * S + seg * 256 + s; const bf16_t* pr = P + (size_t)tl * NP; const float iv = bf2f(pr[COLS_A + 2 * WB + h * 128 + v]); float o = 0.f;
#pragma unroll
            for (int k = 0; k < 32; ++k) { const int kk = kq * 32 + k; const float f = hg_f(c, pr, h * 128 + kk); st[k] = f * st[k] + (1.f - f) * iv; o += siluf_(bf2f(pr[COLS_A + h * 128 + kk])) * st[k]; }
            o += __shfl_xor(o, 1); o += __shfl_xor(o, 2);
            if (kq == 0) ((bf16_t*)c.out)[((size_t)half * TH + tl) * OW + WA + h * 128 + v] = f2bf(o); } } };

typedef const __attribute__((address_space(4))) Ctx* CtxK;
#if defined(__HIP_DEVICE_COMPILE__)
__device__ __forceinline__ Ctx load_ctx() { CtxK p = (CtxK)__builtin_amdgcn_kernarg_segment_ptr(); asm volatile("" : "+s"(p)); return *p; }
#else
__device__ inline Ctx load_ctx() { return Ctx(); }
#endif
#define PH_BEGIN { const Ctx c = load_ctx(); const int tid = wid_s * 64 + pg8::lane_id_opaque(); int bid = blockIdx.x, nblk = gridDim.x; asm volatile("" : "+s"(bid), "+s"(nblk));
#define dev_elems(...) dev_elems_(__VA_ARGS__, tid, bid, nblk)
#define dev_sgemm(...) dev_sgemm_(__VA_ARGS__, tid, bid, nblk)
#define PH_END }
#ifndef DUP
#define DUP -1
#endif
#ifdef TPROBE
#define STAMP() do { if (blockIdx.x == 0 && threadIdx.x == 0) { unsigned long long* ts_ = (unsigned long long*)(c_arg.ws + OFF_CTL + 32768); ts_[nstamp] = __builtin_amdgcn_s_memrealtime(); } ++nstamp; } while (0)
#else
#define STAMP() do { } while (0)
#endif
#define GSYNC() do { xcd_barrier(xbar, tid_k == 0); if (DUP == 20) xcd_barrier(xbar, tid_k == 0); STAMP(); } while (0)
#define GARRIVE() xcd_arrive(xbar, tid_k == 0)
#define REP(k) for (int rep_ = 0; rep_ < ((DUP == (k)) ? 2 : 1); ++rep_)

__global__ void __launch_bounds__(NTHR) mega(Ctx c_arg) {
    extern __shared__ __attribute__((aligned(16))) unsigned char lds_raw[];
    PG8_LAS unsigned char* lds = (PG8_LAS unsigned char*)lds_raw;
    cg::grid_group grid = cg::this_grid();
    int nstamp = 0; (void)nstamp;
    const int wid_s = __builtin_amdgcn_readfirstlane((int)threadIdx.x >> 6);
    volatile PG8_LAS unsigned* bst = (volatile PG8_LAS unsigned*)(lds + LDS_MISC);
    if (threadIdx.x == 0) { bst[0] = 0u; bst[1] = 0u; }
    __syncthreads();
    if (blockIdx.x == 0) for (int i = threadIdx.x; i < XCD_BAR_WORDS; i += NTHR) (wsp<unsigned>(c_arg, OFF_CTL) + 4096)[i] = 0u;
#define tid_k (wid_s * 64 + pg8::lane_id_opaque())
    grid.sync();
    const XcdBarrier xbar = xcd_barrier_post(wsp<unsigned>(c_arg, OFF_CTL) + 4096, bst, threadIdx.x == 0);
    PH_BEGIN
    dev_elems(S0_small{c}, S0_small::n); REP(0) rowops::prologue_phase(c, lds, tid, bid, nblk);
    PH_END
    GSYNC();
#pragma unroll
    for (int half = 0; half < NHALF; ++half) {
        PH_BEGIN
        if (half == 0) fast_proj(c, half, lds, tid, bid, nblk); else fast_proj(c, half, lds, tid, bid, nblk, xbar);
        PH_END
#if DUP >= 30
        __syncthreads();
        PH_BEGIN
        fast_proj_probe(c, half, lds, tid, bid, nblk);
        PH_END
#endif
        GSYNC();
        PH_BEGIN
        if (half == 0) fast_memkv(c, lds, tid, bid, nblk);
        REP(2) hgrn::hg_phase<false>(c, half, lds, tid, bid, nblk, half == 0 ? 16 : 0);
        PH_END
        GSYNC();
        PH_BEGIN
        hgrn::hg_scan_phase(c, tid, bid, nblk); REP(3) attn::attn_phase(c, half, lds, tid, bid, nblk);
        PH_END
        GSYNC();
        PH_BEGIN
        REP(4) hgrn::hg_phase<true>(c, half, lds, tid, bid, nblk); REP(12) hgrn::comb_phase(c, half, tid, bid, nblk);
        PH_END
        GARRIVE();
    }
    PH_BEGIN
    fast_gates(c, lds, tid, bid, nblk, xbar); __syncthreads(); rowops::expert_weights_phase(c, lds, tid, bid, nblk);
    PH_END
    GARRIVE();
    PH_BEGIN
    fast_merge(c, lds, tid, bid, nblk, xbar);
    PH_END
    GSYNC();
    PH_BEGIN
    REP(7) fast_wout(c, lds, tid, bid, nblk);
    PH_END
    GSYNC();
    PH_BEGIN
    rowops::ln1_router_phase<false>(c, lds, tid, bid, nblk); if (DUP == 8) { __syncthreads(); rowops::ln1_router_phase<true>(c, lds, tid, bid, nblk); }
    PH_END
    GSYNC();
    PH_BEGIN
    REP(9) fast_moe1(c, lds, tid, bid, nblk);
    PH_END
    GSYNC();
    PH_BEGIN
    REP(10) fast_moe2(c, lds, tid, bid, nblk);
    PH_END
#ifdef TPROBE
    if (blockIdx.x == 0 && threadIdx.x == 0) { unsigned long long* ts_ = (unsigned long long*)(c_arg.ws + OFF_CTL + 32768); const unsigned long long now = __builtin_amdgcn_s_memrealtime();
        const float ticks = (TPROBE >= 100) ? (float)(now - ts_[0]) * 0.1f : (TPROBE == 15 ? (float)(now - ts_[15]) : (float)(ts_[TPROBE + 1] - ts_[TPROBE]));
        *(float*)(c_arg.ws + OFF_CTL + 32768 + 1024) = 1.f + sqrtf(ticks * 1e-6f); }
#endif
    GSYNC();
    PH_BEGIN
#ifdef TPROBE
    REP(11) rowops::ln2_phase(c, tid, bid, nblk, *(const float*)(c.ws + OFF_CTL + 32768 + 1024));
#else
    REP(11) rowops::ln2_phase(c, tid, bid, nblk, 1.f);
#endif
    PH_END
}

extern "C" void kernel_launch(void* const* d_in, const int* in_sizes, int n_in, void* d_out, int out_size, void* d_ws, size_t ws_size, hipStream_t stream) {
    if (n_in != 22 || in_sizes[0] != T * D || out_size != T * D || ws_size < WS_END) { fprintf(stderr, "kernel_launch: unexpected shapes / workspace (%zu < %zu)\n", ws_size, (size_t)WS_END); return; }
    static int grid_blocks = 0;
    if (!grid_blocks) {
        int dev = 0, cus = 0, per_cu = 0;
        hipGetDevice(&dev); hipDeviceGetAttribute(&cus, hipDeviceAttributeMultiprocessorCount, dev);
        hipFuncSetAttribute((const void*)mega, hipFuncAttributeMaxDynamicSharedMemorySize, LDS_BYTES);
        hipOccupancyMaxActiveBlocksPerMultiprocessor(&per_cu, (const void*)mega, NTHR, LDS_BYTES);
        if (per_cu < 1) { fprintf(stderr, "kernel_launch: occupancy query says %d blocks/CU\n", per_cu); per_cu = 1; }
        if (per_cu > 1) per_cu = 1;
        grid_blocks = cus * per_cu;
    }
    Ctx c = make_ctx(d_in, d_out, d_ws);
    void* args[] = {&c};
    hipError_t e = hipLaunchCooperativeKernel((const void*)mega, dim3(grid_blocks), dim3(NTHR), args, LDS_BYTES, stream);
    if (e != hipSuccess) fprintf(stderr, "cooperative launch failed: %s (grid %d)\n", hipGetErrorString(e), grid_blocks);
}
```

```cpp
#ifdef HOST_TEST
#include <cmath>
#include <cstdint>
#include <cstdio>
#include <cstring>
#define HD
#define GLOBAL
#else
#include <hip/hip_runtime.h>
#include <cstdint>
#include <cstdio>
#include <cstring>
#include <cmath>
#define HD __host__ __device__ __forceinline__
#endif

#ifndef CFG_D
#define CFG_D 1024
#define CFG_B 4
#define CFG_S 8192
#endif
typedef unsigned short bf16_t;
constexpr int D = CFG_D, NBATCH = CFG_B, S = CFG_S, T = NBATCH * S;
constexpr int NHALF = 2, TH = T / NHALF, BH = NBATCH / NHALF;
constexpr int WA = 512, HB = D / 128, WB = D, WC = 512;
constexpr int COLS_A = 4608, COLS_B = 4 * WB, COLS_C = 512, COLS_G = 3 * D;
constexpr int NP = COLS_A + COLS_B + COLS_C, N_IN = NP + COLS_G;
constexpr int NPB = NP - COLS_A;
constexpr int OW = WA + WB + WC;
constexpr int DE = D / 4, NE = 32, HBK = DE < 128 ? DE : 128;
constexpr int MEM = 256, NSEG = S / 256;
constexpr int MAXROWS = 2 * T + NE * 256;
constexpr float DN_ALPHA = 1.189207115002721f;
constexpr float LN_EPS = 1e-5f, RMS_EPS = 1e-6f;
constexpr float QK_SCALE = 0.08838834764831845f;

constexpr size_t MiB = 1u << 20;
constexpr size_t al(size_t x) { return (x + 4095) & ~(size_t)4095; }
constexpr size_t OFF_CTL = 0;
constexpr size_t OFF_SMALL = 1 * MiB;
constexpr size_t OFF_WT = 2 * MiB;
constexpr size_t WT_IN = OFF_WT, WT_KV = WT_IN + al((size_t)N_IN * D * 2), WT_A = WT_KV + al((size_t)1024 * D * 2),
                 WT_B = WT_A + al((size_t)D * WA * 2), WT_C = WT_B + al((size_t)D * WB * 2), WT_OUT = WT_C + al((size_t)D * WC * 2),
                 OFF_MEMB = WT_OUT + al((size_t)D * D * 2), OFF_MEMKV = OFF_MEMB + al((size_t)NBATCH * MEM * D * 2),
                 OFF_LIST = OFF_MEMKV + al((size_t)NBATCH * MEM * 1024 * 2), OFF_RW = OFF_LIST + al((size_t)NE * T * 4),
                 OFF_XB = OFF_RW + al((size_t)T * 2 * 4), OFF_P = OFF_XB + al((size_t)T * D * 2),
                 OFF_PART = OFF_P + al((size_t)TH * NP * 2), OFF_LSE = OFF_PART + al((size_t)3 * TH * WA * 2),
                 OFF_HG = OFF_LSE + al((size_t)3 * TH * 4 * 4), OFF_DSEG = OFF_HG + al((size_t)BH * HB * NSEG * 128 * 128 * 4),
                 WS_END = OFF_DSEG + al((size_t)BH * HB * NSEG * 128 * 4);
constexpr size_t OFF_PB = OFF_P + (size_t)TH * COLS_A * 2, PLANE = (size_t)TH * 128;
constexpr size_t OFF_GATES = OFF_P, OFF_H1 = OFF_P, OFF_X1B = OFF_P + al((size_t)T * D * 4),
                 OFF_WTGU = OFF_P + al((size_t)T * 3 * D * 2), OFF_WTDN = OFF_WTGU + al((size_t)NE * 2 * DE * D * 2),
                 OFF_HBUF = OFF_WTDN + al((size_t)NE * D * DE * 2), OFF_PEND = OFF_HBUF + al((size_t)MAXROWS * DE * 2);
constexpr size_t OFF_STATS = OFF_HG + 20 * MiB;
static_assert(OFF_PART + (size_t)T * D * 2 <= OFF_STATS && OFF_STATS + (size_t)16 * T * 8 <= OFF_DSEG, "stats inside the dead HG region, above y1");
constexpr size_t OFF_MERGED = OFF_PART, OFF_Y0 = OFF_XB, OFF_Y1 = OFF_PART;
static_assert(OFF_MERGED + (size_t)T * D * 2 <= OFF_STATS, "merged below the stats");
static_assert(OFF_X1B + (size_t)T * D * 2 <= OFF_WTGU, "x1b inside dead gates region");
static_assert(OFF_PEND <= OFF_PART, "P-region overlays fit");
static_assert(OFF_Y1 + (size_t)T * D * 2 <= WS_END, "y1 fits in part+hg region");
constexpr int CW_CNT = 0;
constexpr int SM_BIAS = 0, SM_LB = 2048, SM_BLK = 2048 + 4096;

HD float bf2f(bf16_t v) { union { unsigned u; float f; } c; c.u = (unsigned)v << 16; return c.f; }
HD bf16_t f2bf(float f) { union { unsigned u; float f; } c; c.f = f; unsigned u = c.u; return (bf16_t)((u + 0x7fffu + ((u >> 16) & 1u)) >> 16); }
HD float sigmoidf_(float x) { return 1.0f / (1.0f + expf(-x)); }
HD float siluf_(float x) { return x / (1.0f + expf(-x)); }
HD int dil_of(int g) { return g == 0 ? 1 : (g == 1 ? 4 : 16); }
HD int perm_row(int tl, int g) { const int r = dil_of(g), bl = tl / S, s = tl % S; return bl * S + (s % r) * (S / r) + s / r; }

struct Ctx {
    const float *x, *mem, *rel_bias, *lb_logits, *w_in, *w_kv, *norm_g, *w_a, *w_b, *w_c, *w_out, *ln1_g, *ln1_b, *w_rg, *b_rg, *w_re, *b_re, *w_eg, *w_eu, *w_ed, *ln2_g, *ln2_b;
    float* out; unsigned char* ws;
};
#ifdef HOST_TEST
static const unsigned char T5_BUCKET[3][129] = {
#else
__device__ const unsigned char T5_BUCKET[3][129] = {
#endif
{0,1,2,3,4,5,6,7,8,9,10,11,12,13,14,15,16,16,16,16,16,16,17,17,17,17,17,17,17,17,18,18,18,18,18,18,18,18,18,18,19,19,19,19,19,19,19,19,19,19,19,19,19,19,20,20,20,20,20,20,20,20,20,20,20,20,20,20,20,20,20,20,20,21,21,21,21,21,21,21,21,21,21,21,21,21,21,21,21,21,21,21,21,21,21,21,21,21,21,22,22,22,22,22,22,22,22,22,22,22,22,22,22,22,22,22,22,22,22,22,22,22,22,22,22,22,22,22,22},
{0,4,8,12,16,16,17,17,18,18,19,19,19,19,20,20,20,20,20,21,21,21,21,21,21,22,22,22,22,22,22,22,22,22,23,23,23,23,23,23,23,23,23,23,23,23,24,24,24,24,24,24,24,24,24,24,24,24,24,24,24,24,25,25,25,25,25,25,25,25,25,25,25,25,25,25,25,25,25,25,25,25,25,26,26,26,26,26,26,26,26,26,26,26,26,26,26,26,26,26,26,26,26,26,26,26,26,26,26,26,26,26,26,27,27,27,27,27,27,27,27,27,27,27,27,27,27,27,27},
{0,16,18,19,20,21,21,22,22,23,23,23,24,24,24,24,25,25,25,25,25,26,26,26,26,26,26,26,26,27,27,27,27,27,27,27,27,27,27,28,28,28,28,28,28,28,28,28,28,28,28,28,29,29,29,29,29,29,29,29,29,29,29,29,29,29,29,29,29,29,30,30,30,30,30,30,30,30,30,30,30,30,30,30,30,30,30,30,30,30,30,30,30,30,30,31,31,31,31,31,31,31,31,31,31,31,31,31,31,31,31,31,31,31,31,31,31,31,31,31,31,31,31,31,31,31,31,31,31}};
template <class Tp> HD Tp* wsp(const Ctx& c, size_t off) { return (Tp*)(c.ws + off); }

#ifdef HOST_TEST
static inline unsigned atomic_inc_u32(unsigned* p) { unsigned r;
#pragma omp atomic capture
    { r = *p; *p += 1; }
    return r; }
#else
__device__ __forceinline__ unsigned atomic_inc_u32(unsigned* p) { return atomicAdd(p, 1u); }
#endif

struct S0_xb { Ctx c; static constexpr long n = (long)T * D;
    HD void operator()(long i) const { wsp<bf16_t>(c, OFF_XB)[i] = f2bf(c.x[i]); } };
struct S0_memb { Ctx c; static constexpr long n = (long)NBATCH * MEM * D;
    HD void operator()(long i) const { wsp<bf16_t>(c, OFF_MEMB)[i] = f2bf(c.mem[i]); } };
struct S0_tr { const float* W; bf16_t* Wt; int K, N; long n; int ldo;
    HD void operator()(long i) const { const int k = (int)(i % K); const long nn = i / K; Wt[(size_t)nn * ldo + k] = f2bf(W[(size_t)k * N + nn]); } };
struct S0_gu { Ctx c; static constexpr long n = (long)NE * 2 * DE * D;
    HD void operator()(long i) const { const int k = (int)(i % D); const long r = i / D; const int j = (int)(r % (2 * DE)), e = (int)(r / (2 * DE));
        const int u = j / (2 * HBK), w = j % (2 * HBK), hid = u * HBK + w % HBK, up = w / HBK;
        const float* src = up ? c.w_eu : c.w_eg; wsp<bf16_t>(c, OFF_WTGU)[i] = f2bf(src[((size_t)e * D + k) * DE + hid]); } };
struct S0_dn { Ctx c; static constexpr long n = (long)NE * D * DE;
    HD void operator()(long i) const { const int k = (int)(i % DE); const long r = i / DE; const int col = (int)(r % D), e = (int)(r / D);
        wsp<bf16_t>(c, OFF_WTDN)[i] = f2bf(c.w_ed[((size_t)e * DE + k) * D + col]); } };
struct S0_small { Ctx c; static constexpr long n = 12 * 129 + WB + 64 + 512;
    HD void operator()(long i) const { float* sm = wsp<float>(c, OFF_SMALL);
        if (i < 12 * 129) { const int gh = (int)(i / 129), u = (int)(i % 129), g = gh / 4; sm[SM_BIAS + i] = c.rel_bias[T5_BUCKET[g][u] * 12 + gh]; }
        else if (i < 12 * 129 + WB) { const int ch = (int)(i - 12 * 129); sm[SM_LB + ch] = sigmoidf_(c.lb_logits[ch] - c.lb_logits[WB + ch]); }
        else { const int j = (int)(i - 12 * 129 - WB); wsp<unsigned>(c, OFF_CTL)[j < 64 ? j : 1024 + (j - 64)] = 0u; } } };

struct G_proj { Ctx c; int half; static constexpr int N = NP, NSEGS = 1, NBP = 1;
    HD int M() const { return TH; } HD int K(int) const { return D; }
    HD const bf16_t* arow(int, int row) const { return wsp<bf16_t>(c, OFF_XB) + ((size_t)half * TH + row) * D; }
    HD const bf16_t* brow(int, int, int col, int) const { return wsp<bf16_t>(c, WT_IN) + (size_t)col * D; }
    HD void between(int, int, int, float&, float&) const {}
    HD void store(int row, int col, float a, float) const { const int pr = col < COLS_A ? perm_row(row, col / 1536) : row; wsp<bf16_t>(c, OFF_P)[(size_t)pr * NP + col] = f2bf(a); } };
struct G_memkv { Ctx c; static constexpr int N = 1024, NSEGS = 1, NBP = 1;
    HD int M() const { return NBATCH * MEM; } HD int K(int) const { return D; }
    HD const bf16_t* arow(int, int row) const { return wsp<bf16_t>(c, OFF_MEMB) + (size_t)row * D; }
    HD const bf16_t* brow(int, int, int col, int) const { return wsp<bf16_t>(c, WT_KV) + (size_t)col * D; }
    HD void between(int, int, int, float&, float&) const {}
    HD void store(int row, int col, float a, float) const { wsp<bf16_t>(c, OFF_MEMKV)[(size_t)row * 1024 + col] = f2bf(a); } };
struct G_gates { Ctx c; static constexpr int N = 3 * D, NSEGS = 1, NBP = 1;
    HD int M() const { return T; } HD int K(int) const { return D; }
    HD const bf16_t* arow(int, int row) const { return wsp<bf16_t>(c, OFF_XB) + (size_t)row * D; }
    HD const bf16_t* brow(int, int, int col, int) const { return wsp<bf16_t>(c, WT_IN) + (size_t)(NP + col) * D; }
    HD void between(int, int, int, float&, float&) const {}
    HD void store(int row, int col, float a, float) const { wsp<bf16_t>(c, OFF_GATES)[((size_t)(col / D) * T + row) * D + col % D] = f2bf(sigmoidf_(a)); } };
struct G_merge { Ctx c; static constexpr int N = D, NSEGS = 3, NBP = 1;
    HD int M() const { return T; } HD int K(int s) const { return s == 1 ? WB : 512; }
    HD const bf16_t* arow(int s, int row) const { return (const bf16_t*)c.out + (size_t)row * OW + (s == 0 ? 0 : (s == 1 ? WA : WA + WB)); }
    HD const bf16_t* brow(int s, int, int col, int) const { return wsp<bf16_t>(c, WT_A) + (size_t)col * OW + (s == 0 ? 0 : (s == 1 ? WA : WA + WB)); }
    HD void between(int s, int row, int col, float& acc, float& carry) const { carry += bf2f(wsp<bf16_t>(c, OFF_GATES)[((size_t)s * T + row) * D + col]) * acc; acc = 0.f; }
    HD void store(int row, int col, float, float carry) const { wsp<bf16_t>(c, OFF_MERGED)[(size_t)row * D + col] = f2bf(carry); } };
struct G_wout { Ctx c; static constexpr int N = D, NSEGS = 1, NBP = 1;
    HD int M() const { return T; } HD int K(int) const { return D; }
    HD const bf16_t* arow(int, int row) const { return wsp<bf16_t>(c, OFF_MERGED) + (size_t)row * D; }
    HD const bf16_t* brow(int, int, int col, int) const { return wsp<bf16_t>(c, WT_OUT) + (size_t)col * D; }
    HD void between(int, int, int, float&, float&) const {}
    HD void store(int row, int col, float a, float) const { wsp<float>(c, OFF_H1)[(size_t)row * D + col] = DN_ALPHA * c.x[(size_t)row * D + col] + a; } };
struct MoeRow { int e, pos, valid, entry; };
HD MoeRow moe_row(const Ctx& c, int row) {
    const int* blk = wsp<int>(c, OFF_SMALL) + SM_BLK; const unsigned* cnt = wsp<unsigned>(c, OFF_CTL) + CW_CNT;
    MoeRow r; const int rb = row >> 8; r.e = blk[64 + rb]; r.pos = ((rb - blk[r.e]) << 8) + (row & 255); r.valid = r.pos < (int)cnt[r.e];
    r.entry = wsp<int>(c, OFF_LIST)[(size_t)r.e * T + (r.valid ? r.pos : 0)]; return r; }
HD int moe_rows_total(const Ctx& c) { return (wsp<int>(c, OFF_SMALL) + SM_BLK)[32] << 8; }
struct G_moe1 { Ctx c; static constexpr int N = DE, NSEGS = 1, NBP = 2;
    HD int M() const { return moe_rows_total(c); } HD int K(int) const { return D; }
    HD const bf16_t* arow(int, int row) const { const MoeRow r = moe_row(c, row); return wsp<bf16_t>(c, OFF_X1B) + (size_t)(r.entry >> 1) * D; }
    HD const bf16_t* brow(int, int row0, int col, int which) const { const int e = (wsp<int>(c, OFF_SMALL) + SM_BLK)[64 + (row0 >> 8)];
        return wsp<bf16_t>(c, OFF_WTGU) + ((size_t)e * 2 * DE + (col / HBK) * 2 * HBK + which * HBK + col % HBK) * D; }
    HD void between(int, int, int, float&, float&) const {}
    HD void store(int row, int col, float g, float u) const { wsp<bf16_t>(c, OFF_HBUF)[(size_t)row * DE + col] = f2bf(siluf_(g) * u); } };
struct G_moe2 { Ctx c; static constexpr int N = D, NSEGS = 1, NBP = 1;
    HD int M() const { return moe_rows_total(c); } HD int K(int) const { return DE; }
    HD const bf16_t* arow(int, int row) const { return wsp<bf16_t>(c, OFF_HBUF) + (size_t)row * DE; }
    HD const bf16_t* brow(int, int row0, int col, int) const { const int e = (wsp<int>(c, OFF_SMALL) + SM_BLK)[64 + (row0 >> 8)]; return wsp<bf16_t>(c, OFF_WTDN) + ((size_t)e * D + col) * DE; }
    HD void between(int, int, int, float&, float&) const {}
    HD void store(int row, int col, float a, float) const { const MoeRow r = moe_row(c, row); if (!r.valid) return;
        wsp<bf16_t>(c, (r.entry & 1) ? OFF_Y1 : OFF_Y0)[(size_t)(r.entry >> 1) * D + col] = f2bf(a); } };

struct u32x4_t { unsigned x, y, z, w; };
HD float bflo(unsigned u) { union { unsigned u; float f; } c; c.u = u << 16; return c.f; }
HD float bfhi(unsigned u) { union { unsigned u; float f; } c; c.u = u & 0xffff0000u; return c.f; }
HD float dot128(const bf16_t* a, const bf16_t* b) { float s = 0.f; const u32x4_t* pa = (const u32x4_t*)a; const u32x4_t* pb = (const u32x4_t*)b;
#ifndef HOST_TEST
#pragma unroll 4
#endif
    for (int d = 0; d < 16; ++d) { const u32x4_t ua = pa[d], ub = pb[d];
        s += bflo(ua.x) * bflo(ub.x) + bfhi(ua.x) * bfhi(ub.x) + bflo(ua.y) * bflo(ub.y) + bfhi(ua.y) * bfhi(ub.y) + bflo(ua.z) * bflo(ub.z) + bfhi(ua.z) * bfhi(ub.z) + bflo(ua.w) * bflo(ub.w) + bfhi(ua.w) * bfhi(ub.w); }
    return s; }
struct E_attnA { Ctx c; int half; static constexpr long n = (long)TH * 3 * 4 * 8;
    HD void operator()(long idx) const {
        const int p = (int)(idx & 7), h = (int)((idx >> 3) & 3); const long rest = idx >> 5; const int g = (int)(rest % 3), tl = (int)(rest / 3);
        const int r = dil_of(g), bl = tl / S, s = tl % S, cc = s % r, nq = s / r, L = S / r, base = bl * S + cc * L;
        const bf16_t* P = wsp<bf16_t>(c, OFF_P); const float* bias = wsp<float>(c, OFF_SMALL) + SM_BIAS + (g * 4 + h) * 129;
        const bf16_t* q = P + (size_t)(base + nq) * NP + g * 1536 + h * 128;
        float m = -INFINITY, l = 0.f, o[16];
#ifndef HOST_TEST
#pragma unroll
#endif
        for (int j = 0; j < 16; ++j) o[j] = 0.f;
        const int umax = nq < 128 ? nq : 128;
        for (int u = 0; u <= umax; ++u) {
            const bf16_t* kr = P + (size_t)(base + nq - u) * NP + g * 1536 + 512 + h * 128; const bf16_t* vr = kr + 512 + p * 16;
            const float sc = dot128(q, kr) * QK_SCALE + bias[u];
            const float mn = fmaxf(m, sc), a = expf(m - mn), pw = expf(sc - mn); l = l * a + pw; m = mn;
#ifndef HOST_TEST
#pragma unroll
#endif
            for (int j = 0; j < 16; ++j) o[j] = o[j] * a + pw * bf2f(vr[j]);
        }
        bf16_t* op = wsp<bf16_t>(c, OFF_PART) + ((size_t)g * TH + tl) * WA + h * 128 + p * 16; const float il = 1.f / l;
#ifndef HOST_TEST
#pragma unroll
#endif
        for (int j = 0; j < 16; ++j) op[j] = f2bf(o[j] * il);
        if (p == 0) wsp<float>(c, OFF_LSE)[((size_t)g * TH + tl) * 4 + h] = m + logf(l);
    } };
struct E_combA { Ctx c; int half; static constexpr long n = (long)TH * WA;
    HD void operator()(long idx) const { const int col = (int)(idx % WA), tl = (int)(idx / WA), h = col >> 7;
        const float* lse = wsp<float>(c, OFF_LSE); const bf16_t* part = wsp<bf16_t>(c, OFF_PART);
        const float l0 = lse[((size_t)0 * TH + tl) * 4 + h], l1 = lse[((size_t)1 * TH + tl) * 4 + h], l2 = lse[((size_t)2 * TH + tl) * 4 + h];
        const float mx = fmaxf(l0, fmaxf(l1, l2)), e0 = expf(l0 - mx), e1 = expf(l1 - mx), e2 = expf(l2 - mx), inv = 1.f / (e0 + e1 + e2);
        const float v = (e0 * bf2f(part[((size_t)0 * TH + tl) * WA + col]) + e1 * bf2f(part[((size_t)1 * TH + tl) * WA + col]) + e2 * bf2f(part[((size_t)2 * TH + tl) * WA + col])) * inv;
        ((bf16_t*)c.out)[((size_t)half * TH + tl) * OW + col] = f2bf(v); } };
struct E_attnC { Ctx c; int half; static constexpr long n = (long)TH * 4 * 8;
    HD void operator()(long idx) const { const int p = (int)(idx & 7), h = (int)((idx >> 3) & 3), tl = (int)(idx >> 5), b = half * BH + tl / S;
        const bf16_t* q = wsp<bf16_t>(c, OFF_P) + (size_t)tl * NP + COLS_A + COLS_B + h * 128; const bf16_t* kv = wsp<bf16_t>(c, OFF_MEMKV) + (size_t)b * MEM * 1024;
        float m = -INFINITY, l = 0.f, o[16];
#ifndef HOST_TEST
#pragma unroll
#endif
        for (int j = 0; j < 16; ++j) o[j] = 0.f;
        for (int k = 0; k < MEM; ++k) { const bf16_t* kr = kv + (size_t)k * 1024 + h * 128; const bf16_t* vr = kr + 512 + p * 16;
            const float sc = dot128(q, kr) * QK_SCALE; const float mn = fmaxf(m, sc), a = expf(m - mn), pw = expf(sc - mn); l = l * a + pw; m = mn;
#ifndef HOST_TEST
#pragma unroll
#endif
            for (int j = 0; j < 16; ++j) o[j] = o[j] * a + pw * bf2f(vr[j]); }
        bf16_t* op = (bf16_t*)c.out + ((size_t)half * TH + tl) * OW + WA + WB + h * 128 + p * 16; const float il = 1.f / l;
#ifndef HOST_TEST
#pragma unroll
#endif
        for (int j = 0; j < 16; ++j) op[j] = f2bf(o[j] * il); } };

HD float hg_f(const Ctx& c, const bf16_t* prow, int ch) { const float lb = wsp<float>(c, OFF_SMALL)[SM_LB + ch]; return lb + (1.f - lb) * sigmoidf_(bf2f(prow[COLS_A + WB + ch])); }
struct E_hg1 { Ctx c; int half; static constexpr long n = (long)BH * HB * NSEG * 128 * 128;
    HD void operator()(long idx) const { const int v = (int)(idx & 127), k = (int)((idx >> 7) & 127); const long r = idx >> 14; const int seg = (int)(r % NSEG), bhl = (int)(r / NSEG), h = bhl % HB, bl = bhl / HB;
        const bf16_t* P = wsp<bf16_t>(c, OFF_P); const int ch = h * 128 + k; float st = 0.f, dsum = 0.f;
        for (int s = 0; s < 256; ++s) { const bf16_t* pr = P + (size_t)(bl * S + seg * 256 + s) * NP; const float f = hg_f(c, pr, ch); st = f * st + (1.f - f) * bf2f(pr[COLS_A + 2 * WB + h * 128 + v]); dsum += logf(f); }
        wsp<float>(c, OFF_HG)[idx] = st; if (v == 0) wsp<float>(c, OFF_DSEG)[((size_t)bhl * NSEG + seg) * 128 + k] = dsum; } };
struct E_hg2 { Ctx c; static constexpr long n = (long)BH * HB * 128 * 128;
    HD void operator()(long idx) const { const int v = (int)(idx & 127), k = (int)((idx >> 7) & 127), bhl = (int)(idx >> 14); float run = 0.f;
        for (int seg = 0; seg < NSEG; ++seg) { float* p = wsp<float>(c, OFF_HG) + (((size_t)bhl * NSEG + seg) * 128 + k) * 128 + v; const float tmp = *p; *p = run;
            run = expf(wsp<float>(c, OFF_DSEG)[((size_t)bhl * NSEG + seg) * 128 + k]) * run + tmp; } } };
struct E_hg3 { Ctx c; int half; static constexpr long n = (long)BH * HB * NSEG * 128;
    HD void operator()(long idx) const { const int v = (int)(idx & 127); const long r = idx >> 7; const int seg = (int)(r % NSEG), bhl = (int)(r / NSEG), h = bhl % HB, bl = bhl / HB;
        const bf16_t* P = wsp<bf16_t>(c, OFF_P); float st[128];
#ifndef HOST_TEST
#pragma unroll
#endif
        for (int k = 0; k < 128; ++k) st[k] = wsp<float>(c, OFF_HG)[(((size_t)bhl * NSEG + seg) * 128 + k) * 128 + v];
        for (int s = 0; s < 256; ++s) { const int tl = bl * S + seg * 256 + s; const bf16_t* pr = P + (size_t)tl * NP; const float iv = bf2f(pr[COLS_A + 2 * WB + h * 128 + v]); float o = 0.f;
#ifndef HOST_TEST
#pragma unroll
#endif
            for (int k = 0; k < 128; ++k) { const float f = hg_f(c, pr, h * 128 + k); st[k] = f * st[k] + (1.f - f) * iv; o += siluf_(bf2f(pr[COLS_A + h * 128 + k])) * st[k]; }
            ((bf16_t*)c.out)[((size_t)half * TH + tl) * OW + WA + h * 128 + v] = f2bf(o); } } };
struct E_hgnorm { Ctx c; int half; static constexpr long n = (long)TH * HB;
    HD void operator()(long idx) const { const int h = (int)(idx % HB), tl = (int)(idx / HB); bf16_t* o = (bf16_t*)c.out + ((size_t)half * TH + tl) * OW + WA + h * 128;
        const bf16_t* pr = wsp<bf16_t>(c, OFF_P) + (size_t)tl * NP + COLS_A + 3 * WB + h * 128; float ss = 0.f;
        for (int v = 0; v < 128; ++v) { const float x = bf2f(o[v]); ss += x * x; }
        const float rs = 1.f / sqrtf(ss * (1.f / 128.f) + RMS_EPS);
        for (int v = 0; v < 128; ++v) o[v] = f2bf(bf2f(o[v]) * rs * c.norm_g[h * 128 + v] * siluf_(bf2f(pr[v]))); } };

struct E_ln1 { Ctx c; static constexpr long n = T;
    HD void operator()(long row) const { float* h1 = wsp<float>(c, OFF_H1) + (size_t)row * D; bf16_t* xb1 = wsp<bf16_t>(c, OFF_X1B) + (size_t)row * D;
        float mu = 0.f; for (int i = 0; i < D; ++i) mu += h1[i]; mu *= (1.f / D);
        float var = 0.f; for (int i = 0; i < D; ++i) { const float d = h1[i] - mu; var += d * d; } var *= (1.f / D); const float rs = 1.f / sqrtf(var + LN_EPS);
        float gl0 = c.b_rg[0], gl1 = c.b_rg[1], gl2 = c.b_rg[2], gl3 = c.b_rg[3];
        for (int i = 0; i < D; ++i) { const float v = (h1[i] - mu) * rs * c.ln1_g[i] + c.ln1_b[i]; h1[i] = v; xb1[i] = f2bf(v);
            gl0 += v * c.w_rg[i * 4 + 0]; gl1 += v * c.w_rg[i * 4 + 1]; gl2 += v * c.w_rg[i * 4 + 2]; gl3 += v * c.w_rg[i * 4 + 3]; }
        int gs = 0; float gm = gl0; if (gl1 > gm) { gm = gl1; gs = 1; } if (gl2 > gm) { gm = gl2; gs = 2; } if (gl3 > gm) { gm = gl3; gs = 3; }
        const float gp = 1.f / (expf(gl0 - gm) + expf(gl1 - gm) + expf(gl2 - gm) + expf(gl3 - gm));
        float v0 = -INFINITY, v1 = -INFINITY; int i0 = 0, i1 = 0;
        for (int j = 0; j < 8; ++j) { float el = c.b_re[gs * 8 + j]; for (int i = 0; i < D; ++i) el += h1[i] * c.w_re[i * 32 + gs * 8 + j];
            if (el > v0) { v1 = v0; i1 = i0; v0 = el; i0 = j; } else if (el > v1) { v1 = el; i1 = j; } }
        const float e1 = expf(v1 - v0), w0 = gp / (1.f + e1), w1 = gp * e1 / (1.f + e1);
        unsigned* cnt = wsp<unsigned>(c, OFF_CTL) + CW_CNT; int* list = wsp<int>(c, OFF_LIST); float* rw = wsp<float>(c, OFF_RW);
        const int ea = gs * 8 + i0, eb = gs * 8 + i1;
        list[(size_t)ea * T + atomic_inc_u32(cnt + ea)] = (int)row * 2 + 0; list[(size_t)eb * T + atomic_inc_u32(cnt + eb)] = (int)row * 2 + 1;
        rw[row * 2 + 0] = w0; rw[row * 2 + 1] = w1; } };
struct E_blk { Ctx c; static constexpr long n = 1;
    HD void operator()(long) const { int* blk = wsp<int>(c, OFF_SMALL) + SM_BLK; const unsigned* cnt = wsp<unsigned>(c, OFF_CTL) + CW_CNT; int acc = 0;
        for (int e = 0; e < NE; ++e) { blk[e] = acc; const int nb = ((int)cnt[e] + 255) >> 8; for (int j = 0; j < nb; ++j) blk[64 + acc + j] = e; acc += nb; } blk[32] = acc; } };
struct E_ln2 { Ctx c; static constexpr long n = T;
    HD void operator()(long row) const { const float* x1 = wsp<float>(c, OFF_H1) + (size_t)row * D; const bf16_t* y0 = wsp<bf16_t>(c, OFF_Y0) + (size_t)row * D; const bf16_t* y1 = wsp<bf16_t>(c, OFF_Y1) + (size_t)row * D;
        const float w0 = wsp<float>(c, OFF_RW)[row * 2], w1 = wsp<float>(c, OFF_RW)[row * 2 + 1]; float* o = c.out + (size_t)row * D;
        float mu = 0.f; for (int i = 0; i < D; ++i) { const float v = DN_ALPHA * x1[i] + w0 * bf2f(y0[i]) + w1 * bf2f(y1[i]); mu += v; } mu *= (1.f / D);
        float var = 0.f; for (int i = 0; i < D; ++i) { const float v = DN_ALPHA * x1[i] + w0 * bf2f(y0[i]) + w1 * bf2f(y1[i]) - mu; var += v * v; } var *= (1.f / D); const float rs = 1.f / sqrtf(var + LN_EPS);
        for (int i = 0; i < D; ++i) { const float v = DN_ALPHA * x1[i] + w0 * bf2f(y0[i]) + w1 * bf2f(y1[i]); o[i] = (v - mu) * rs * c.ln2_g[i] + c.ln2_b[i]; } } };
typedef short bf16x8 __attribute__((ext_vector_type(8)));
typedef float f32x4 __attribute__((ext_vector_type(4)));

template <class F> __global__ void __launch_bounds__(256) k_elems(F f, long n) {
    for (long i = (long)blockIdx.x * 256 + threadIdx.x; i < n; i += (long)gridDim.x * 256) f(i);
}
template <class F> __global__ void __launch_bounds__(64) k_elems64(F f, long n) {
    for (long i = (long)blockIdx.x * 64 + threadIdx.x; i < n; i += (long)gridDim.x * 64) f(i);
}
template <class G> __global__ void __launch_bounds__(256) k_sgemm(G g) {
    const int M = g.M(); const int lane = threadIdx.x & 63, wid = threadIdx.x >> 6; constexpr int ntn = G::N / 64;
    const long ntiles = (long)(M / 64) * ntn;
    for (long tile = blockIdx.x; tile < ntiles; tile += gridDim.x) {
        const int tm = (int)(tile / ntn), tn = (int)(tile % ntn), r0 = tm * 64 + wid * 16, c0 = tn * 64;
        f32x4 acc[G::NBP][4], carry[4];
#pragma unroll
        for (int j = 0; j < 4; ++j) { carry[j] = (f32x4){0.f, 0.f, 0.f, 0.f};
#pragma unroll
            for (int w = 0; w < G::NBP; ++w) acc[w][j] = (f32x4){0.f, 0.f, 0.f, 0.f}; }
#pragma unroll
        for (int seg = 0; seg < G::NSEGS; ++seg) {
            const bf16_t* ar = g.arow(seg, r0 + (lane & 15)) + 8 * (lane >> 4); const bf16_t* br[G::NBP][4];
#pragma unroll
            for (int w = 0; w < G::NBP; ++w)
#pragma unroll
                for (int j = 0; j < 4; ++j) br[w][j] = g.brow(seg, r0, c0 + 16 * j + (lane & 15), w) + 8 * (lane >> 4);
            const int K = g.K(seg);
            for (int k0 = 0; k0 < K; k0 += 32) { const bf16x8 a = *(const bf16x8*)(ar + k0);
#pragma unroll
                for (int w = 0; w < G::NBP; ++w)
#pragma unroll
                    for (int j = 0; j < 4; ++j) { const bf16x8 b = *(const bf16x8*)(br[w][j] + k0); acc[w][j] = __builtin_amdgcn_mfma_f32_16x16x32_bf16(a, b, acc[w][j], 0, 0, 0); } }
#pragma unroll
            for (int j = 0; j < 4; ++j)
#pragma unroll
                for (int i = 0; i < 4; ++i) { float a = acc[0][j][i], cr = carry[j][i]; g.between(seg, r0 + (lane >> 4) * 4 + i, c0 + 16 * j + (lane & 15), a, cr); acc[0][j][i] = a; carry[j][i] = cr; }
        }
#pragma unroll
        for (int j = 0; j < 4; ++j)
#pragma unroll
            for (int i = 0; i < 4; ++i) g.store(r0 + (lane >> 4) * 4 + i, c0 + 16 * j + (lane & 15), acc[0][j][i], G::NBP == 2 ? acc[G::NBP - 1][j][i] : carry[j][i]);
    }
}
template <class F> static void launch_elems(const F& f, long n, hipStream_t st) { long nb = (n + 255) / 256; if (nb > 32768) nb = 32768; if (nb < 1) nb = 1; hipLaunchKernelGGL(k_elems<F>, dim3((unsigned)nb), dim3(256), 0, st, f, n); }
template <class F> static void launch_elems64(const F& f, long n, hipStream_t st) { long nb = (n + 63) / 64; if (nb > 65536) nb = 65536; hipLaunchKernelGGL(k_elems64<F>, dim3((unsigned)nb), dim3(64), 0, st, f, n); }
template <class G> static void launch_sgemm(const G& g, hipStream_t st) { hipLaunchKernelGGL(k_sgemm<G>, dim3(4096), dim3(256), 0, st, g); }

static Ctx make_ctx(void* const* d_in, void* d_out, void* d_ws) {
    Ctx c; memset(&c, 0, sizeof(c)); const float** ip = (const float**)&c; for (int i = 0; i < 22; ++i) ip[i] = (const float*)d_in[i];
    c.out = (float*)d_out; c.ws = (unsigned char*)d_ws; return c;
}
static void v1_stage0(Ctx c, hipStream_t st) {
    launch_elems(S0_xb{c}, S0_xb::n, st); launch_elems(S0_memb{c}, S0_memb::n, st); launch_elems(S0_small{c}, S0_small::n, st);
    launch_elems(S0_tr{c.w_in, wsp<bf16_t>(c, WT_IN), D, N_IN, (long)D * N_IN, D}, (long)D * N_IN, st);
    launch_elems(S0_tr{c.w_kv, wsp<bf16_t>(c, WT_KV), D, 1024, (long)D * 1024, D}, (long)D * 1024, st);
    launch_elems(S0_tr{c.w_a, wsp<bf16_t>(c, WT_A), WA, D, (long)D * WA, OW}, (long)D * WA, st);
    launch_elems(S0_tr{c.w_b, wsp<bf16_t>(c, WT_A) + WA, WB, D, (long)D * WB, OW}, (long)D * WB, st);
    launch_elems(S0_tr{c.w_c, wsp<bf16_t>(c, WT_A) + WA + WB, WC, D, (long)D * WC, OW}, (long)D * WC, st);
    launch_elems(S0_tr{c.w_out, wsp<bf16_t>(c, WT_OUT), D, D, (long)D * D, D}, (long)D * D, st);
}
static void v1_proj(Ctx c, int half, hipStream_t st) { if (half == 0) launch_sgemm(G_memkv{c}, st); launch_sgemm(G_proj{c, half}, st); }
static void v1_mixers(Ctx c, int half, hipStream_t st) {
    launch_elems(E_hg1{c, half}, E_hg1::n, st); launch_elems(E_hg2{c}, E_hg2::n, st);
    launch_elems(E_attnA{c, half}, E_attnA::n, st); launch_elems(E_attnC{c, half}, E_attnC::n, st);
    launch_elems64(E_hg3{c, half}, E_hg3::n, st); launch_elems(E_hgnorm{c, half}, E_hgnorm::n, st); launch_elems(E_combA{c, half}, E_combA::n, st);
}
static void v1_expw(Ctx c, hipStream_t st) { launch_elems(S0_gu{c}, S0_gu::n, st); launch_elems(S0_dn{c}, S0_dn::n, st); }
static void v1_gates(Ctx c, hipStream_t st) { launch_sgemm(G_gates{c}, st); }
static void v1_merge(Ctx c, hipStream_t st) { launch_sgemm(G_merge{c}, st); }
static void v1_wout(Ctx c, hipStream_t st) { launch_sgemm(G_wout{c}, st); }
static void v1_ln1(Ctx c, hipStream_t st) { launch_elems(E_ln1{c}, E_ln1::n, st); launch_elems(E_blk{c}, 1, st); }
static void v1_moe1(Ctx c, hipStream_t st) { launch_sgemm(G_moe1{c}, st); }
static void v1_moe2(Ctx c, hipStream_t st) { launch_sgemm(G_moe2{c}, st); }
static void v1_ln2(Ctx c, hipStream_t st) { launch_elems(E_ln2{c}, E_ln2::n, st); }
#ifndef PG8_LAS
#define PG8_LAS __attribute__((address_space(3)))
#endif
#define XB_TMO      128
#define XB_XCNT(j)  (256  + 64 * (j))
#define XB_XSUB(j)  (1280 + 64 * (j))
#define XB_XGEN(j)  (2304 + 64 * (j))
#define XB_TOP      3328
#define XB_TOPGEN   3392
#define XCD_BAR_WORDS 3456
#define XB_SPIN_CAP (1u << 18)
__device__ __forceinline__ unsigned xb_ld(unsigned* p)              { return __hip_atomic_load(p, __ATOMIC_RELAXED, __HIP_MEMORY_SCOPE_AGENT); }
__device__ __forceinline__ unsigned xb_add(unsigned* p, unsigned v) { return __hip_atomic_fetch_add(p, v, __ATOMIC_RELAXED, __HIP_MEMORY_SCOPE_AGENT); }
__device__ __forceinline__ unsigned xb_xcc_id() { return (unsigned)__builtin_amdgcn_s_getreg((3 << 11) | 20) & 0xFu; }
#define XB_SPIN(cond, bar) do { unsigned _sp = 0; while (cond) { __builtin_amdgcn_s_sleep(1); \
    if ((++_sp & 255u) == 0u) { if (xb_ld(&(bar)[XB_TMO])) break; if (_sp > XB_SPIN_CAP) { atomicAdd(&(bar)[XB_TMO], 1u); break; } } } } while (0)
struct XcdBarrier { unsigned* bar; unsigned x; volatile PG8_LAS unsigned* st; };
__device__ __forceinline__ XcdBarrier xcd_barrier_post(unsigned* bar, volatile PG8_LAS unsigned* st, bool t0) {
    XcdBarrier b; b.bar = bar; b.x = xb_xcc_id(); b.st = st;
    if (t0) (void)xb_add(&bar[XB_XCNT(b.x)], 1u);
    return b;
}
__device__ __forceinline__ void xcd_barrier_complete(unsigned* bar, unsigned x, unsigned& nloc, unsigned& nx) {
    const unsigned G = gridDim.x * gridDim.y * gridDim.z;
    unsigned sum, cnt, mine, sp = 0u;
    for (;;) {
        sum = 0u; cnt = 0u; mine = 0u;
#pragma unroll
        for (unsigned j = 0; j < 16; ++j) { const unsigned c = xb_ld(&bar[XB_XCNT(j)]); sum += c; cnt += (c > 0u) ? 1u : 0u; mine = (j == x) ? c : mine; }
        if (sum == G) break;
        __builtin_amdgcn_s_sleep(1);
        if ((++sp & 255u) == 0u) { if (xb_ld(&bar[XB_TMO])) break; if (sp > XB_SPIN_CAP) { atomicAdd(&bar[XB_TMO], 1u); break; } }
    }
    nloc = mine > 0u ? mine : 1u; nx = cnt > 0u ? cnt : 1u;
}
__device__ __forceinline__ void xcd_arrive(const XcdBarrier& b, bool t0) {
    asm volatile("s_waitcnt vmcnt(0)" ::: "memory");
    __syncthreads();
    if (t0) {
        unsigned* bar = b.bar;
        __builtin_amdgcn_s_waitcnt(0);
        unsigned nloc = b.st[0], nx = b.st[1];
        if (nloc == 0u) { xcd_barrier_complete(bar, b.x, nloc, nx); b.st[0] = nloc; b.st[1] = nx; }
        const unsigned old = xb_add(&bar[XB_XSUB(b.x)], 1u);
        const unsigned gen = old / nloc;
        if (old + 1u == (gen + 1u) * nloc) {
            __builtin_amdgcn_fence(__ATOMIC_RELEASE, "agent");
            asm volatile("s_waitcnt vmcnt(0)" ::: "memory");
            const unsigned og = xb_add(&bar[XB_TOP], 1u);
            const unsigned tg = og / nx;
            if (og + 1u == (tg + 1u) * nx) xb_add(&bar[XB_TOPGEN], 1u);
            b.st[2] = 1u; b.st[3] = tg;
        } else { b.st[2] = 2u; b.st[3] = gen; }
    }
}
__device__ __forceinline__ void xcd_wait(const XcdBarrier& b, bool t0) {
    if (t0) {
        unsigned* bar = b.bar; const unsigned role = b.st[2], g = b.st[3];
        if (role == 1u) { XB_SPIN(xb_ld(&bar[XB_TOPGEN]) == g, bar);
            __builtin_amdgcn_fence(__ATOMIC_ACQUIRE, "agent");
            xb_add(&bar[XB_XGEN(b.x)], 1u);
            asm volatile("s_waitcnt vmcnt(0)" ::: "memory");
        } else { XB_SPIN(xb_ld(&bar[XB_XGEN(b.x)]) == g, bar);
            __builtin_amdgcn_fence(__ATOMIC_ACQUIRE, "agent");
            asm volatile("s_waitcnt vmcnt(0)" ::: "memory"); }
        b.st[2] = 0u;
    }
    __syncthreads();
}
__device__ __forceinline__ void xcd_barrier(const XcdBarrier& b, bool t0) {
    asm volatile("s_waitcnt vmcnt(0)" ::: "memory");
    __syncthreads();
    if (t0) {
        unsigned* bar = b.bar;
        __builtin_amdgcn_s_waitcnt(0);
        unsigned nloc = b.st[0], nx = b.st[1];
        if (nloc == 0u) { xcd_barrier_complete(bar, b.x, nloc, nx); b.st[0] = nloc; b.st[1] = nx; }
        const unsigned old = xb_add(&bar[XB_XSUB(b.x)], 1u);
        const unsigned gen = old / nloc;
        if (old + 1u == (gen + 1u) * nloc) {
            __builtin_amdgcn_fence(__ATOMIC_RELEASE, "agent");
            asm volatile("s_waitcnt vmcnt(0)" ::: "memory");
            const unsigned og = xb_add(&bar[XB_TOP], 1u);
            const unsigned tg = og / nx;
            if (og + 1u == (tg + 1u) * nx) xb_add(&bar[XB_TOPGEN], 1u);
            else XB_SPIN(xb_ld(&bar[XB_TOPGEN]) == tg, bar);
            __builtin_amdgcn_fence(__ATOMIC_ACQUIRE, "agent");
            xb_add(&bar[XB_XGEN(b.x)], 1u);
            asm volatile("s_waitcnt vmcnt(0)" ::: "memory");
        } else {
            XB_SPIN(xb_ld(&bar[XB_XGEN(b.x)]) == gen, bar);
            __builtin_amdgcn_fence(__ATOMIC_ACQUIRE, "agent");
            asm volatile("s_waitcnt vmcnt(0)" ::: "memory");
        }
    }
    __syncthreads();
}
namespace pg8 {
typedef unsigned u32x4 __attribute__((ext_vector_type(4)));
constexpr int BM = 256, BK = 64, HALF = 128, HTB = HALF * BK * 2, STAGE_BYTES = 8 * HTB, NXCD = 8, WGM = 4;
__host__ __device__ __forceinline__ int lds_byte(int r, int c) { const int st = (r >> 4) * 2 + (c >> 5), rr = r & 15, cc = c & 31, ob = rr * 64 + cc * 2; return st * 1024 + (ob ^ (((ob >> 9) & 1) << 5)); }
__host__ __device__ __forceinline__ void stage_rc(int b, int& R, int& C) { const int st = b / 1024, sb = b % 1024, swz = sb ^ (((sb >> 9) & 1) << 5); R = (st >> 1) * 16 + swz / 64; C = (st & 1) * 32 + (swz % 64) / 2; }
__host__ __device__ __forceinline__ int perm32(int rho) { const int n = rho >> 4, i = rho & 15; return 8 * (i >> 2) + 4 * n + (i & 3); }
__device__ __forceinline__ unsigned cvt_pk_bf16(float lo, float hi) { unsigned r; asm volatile("v_cvt_pk_bf16_f32 %0, %1, %2" : "=v"(r) : "v"(lo), "v"(hi)); return r; }

__device__ __forceinline__ int lane_id_opaque() { int l; asm volatile("v_mbcnt_lo_u32_b32 %0, -1, 0\n\tv_mbcnt_hi_u32_b32 %0, -1, %0" : "=v"(l)); return l; }
struct Unit { const char* A; const char* B; int nt, pm, pn, tag, half; };
__device__ __forceinline__ void tile_of(int L, int nM, int nN, int& pm, int& pn) {
    const int nwg = nM * nN; int wgid = L; { const int q = nwg / NXCD, r = nwg % NXCD, xcd = wgid % NXCD, off = wgid / NXCD; wgid = (xcd < r ? xcd * (q + 1) : r * (q + 1) + (xcd - r) * q) + off; }
    const int nig = WGM * nN, gid = wgid / nig, fm = gid * WGM, gsz = (nM - fm) < WGM ? (nM - fm) : WGM;
    pm = fm + ((wgid % nig) % gsz); pn = (wgid % nig) / gsz;
}
template <class Epi, class Sched>
__device__ __forceinline__ void gemm_phase(PG8_LAS unsigned char* lds, const Sched& S, const Epi& E, int tid) {
    constexpr bool GA = Sched::GATHER;
    asm volatile("" : "+v"(tid));
    const int wid = __builtin_amdgcn_readfirstlane(tid >> 6), lane = tid & 63, wr = wid >> 2, wc = wid & 3, fr = lane & 15, fq = lane >> 4;
    const unsigned lda = S.lda, ldb = S.ldb;
    int sR[2]; unsigned voffA[2], voffB[2];
#pragma unroll
    for (int i = 0; i < 2; ++i) { int R, C; stage_rc(tid * 16 + i * 8192, R, C); sR[i] = R; const int Rb = Epi::PERM ? ((R & ~31) + perm32(R & 31)) : R;
        voffA[i] = (GA ? 0u : (unsigned)R * lda) + (unsigned)C * 2u; voffB[i] = (unsigned)Rb * ldb + (unsigned)C * 2u; }
    const size_t kstep = (size_t)(BK * 2), hstepA = (size_t)HALF * lda, hstepB = (size_t)HALF * ldb;
    const unsigned ldsw = (unsigned)wid * 1024u;
    const int aoff = lds_byte(wr * 64 + fr, fq * 8), boff = lds_byte(wc * 32 + fr, fq * 8);
#define PG8_SA(b, h) (((b) * 2 + (h)) * HTB)
#define PG8_SB(b, h) ((4 + (b) * 2 + (h)) * HTB)
#define PG8_STAGE(bufoff, gbase, voff) do { const char* gb_ = (const char*)(gbase); asm volatile("" : "+s"(gb_));     \
        _Pragma("unroll") for (int _i = 0; _i < 2; ++_i) \
        __builtin_amdgcn_global_load_lds((const unsigned*)(gb_ + (voff)[_i]), (PG8_LAS unsigned*)(lds + (bufoff) + ldsw + _i * 8192), 16, 0, 0); } while (0)
#define PG8_STAGE_A(bufoff, gbase, h, tk) do { if constexpr (GA) { unsigned _o[2]; _Pragma("unroll") for (int _i = 0; _i < 2; ++_i) _o[_i] = (((tk)[_i] >> (16 * (h))) & 0xffffu) * lda + voffA[_i]; PG8_STAGE(bufoff, gbase, _o); } \
        else { PG8_STAGE(bufoff, (gbase) + (h) * hstepA, voffA); } } while (0)
#define PG8_LDA(dst, b, h) do { _Pragma("unroll") for (int m = 0; m < 4; ++m) _Pragma("unroll") for (int k = 0; k < 2; ++k) dst[m][k] = *(const PG8_LAS bf16x8*)(lds + PG8_SA(b, h) + aoff + m * 2048 + k * 1024); } while (0)
#define PG8_LDB(dst, b, h) do { _Pragma("unroll") for (int n = 0; n < 2; ++n) _Pragma("unroll") for (int k = 0; k < 2; ++k) dst[n][k] = *(const PG8_LAS bf16x8*)(lds + PG8_SB(b, h) + boff + n * 2048 + k * 1024); } while (0)
#define PG8_MMA(ai, bj, At, Bt) do { __builtin_amdgcn_s_setprio(1); _Pragma("unroll") for (int m = 0; m < 4; ++m) _Pragma("unroll") for (int n = 0; n < 2; ++n) _Pragma("unroll") for (int k = 0; k < 2; ++k) \
        acc[ai][bj][m][n] = __builtin_amdgcn_mfma_f32_16x16x32_bf16(Bt[n][k], At[m][k], acc[ai][bj][m][n], 0, 0, 0); __builtin_amdgcn_s_setprio(0); } while (0)
#define PG8_WAIT_V(n) asm volatile("s_waitcnt vmcnt(" #n ")" ::: "memory")
#define PG8_WAIT_L(n) asm volatile("s_waitcnt lgkmcnt(" #n ")" ::: "memory")
#define PG8_BAR __builtin_amdgcn_s_barrier()
#define PG8_SCHED __builtin_amdgcn_sched_barrier(0)
#define PG8_TOKS(u, tk) do { if constexpr (GA) { const int t_ = wid * 64 + lane_id_opaque();     \
        _Pragma("unroll") for (int _i = 0; _i < 2; ++_i) { int R_, C_; stage_rc(t_ * 16 + _i * 8192, R_, C_); tk[_i] = S.a_row(u, R_) | (S.a_row(u, R_ + HALF) << 16); } } } while (0)
    Unit cur, nxt; int ui = 0;
    if (!S.next(0, cur)) { if (S.pend.bar) xcd_wait(S.pend, tid == 0); return; }
    f32x4 acc[2][2][4][2];
#pragma unroll
    for (int a = 0; a < 2; ++a)
#pragma unroll
        for (int b = 0; b < 2; ++b)
#pragma unroll
            for (int m = 0; m < 4; ++m)
#pragma unroll
                for (int n = 0; n < 2; ++n) acc[a][b][m][n] = (f32x4){0.f, 0.f, 0.f, 0.f};
    bf16x8 At[4][2], B0[2][2], B1[2][2];
    unsigned ctk[2] = {0u, 0u}, ntk[2] = {0u, 0u};
    S.a_ready(cur, wid);
    PG8_TOKS(cur, ctk);
    const char* cA = cur.A; const char* cB = cur.B;
    PG8_STAGE(PG8_SB(0, 0), cB, voffB); PG8_STAGE(PG8_SB(0, 1), cB + hstepB, voffB); PG8_STAGE_A(PG8_SA(0, 0), cA, 0, ctk); PG8_STAGE_A(PG8_SA(0, 1), cA, 1, ctk);
    if (wr == 1) PG8_BAR;
    PG8_WAIT_V(2); PG8_BAR;
    PG8_STAGE(PG8_SB(1, 0), cB + kstep, voffB); PG8_STAGE_A(PG8_SA(1, 0), cA + kstep, 0, ctk); PG8_STAGE(PG8_SB(1, 1), cB + hstepB + kstep, voffB);
    PG8_WAIT_V(6); PG8_BAR;
    for (;;) {
        const bool has_next = S.next(ui + 1, nxt);
        const char* nA = cA; const char* nB = cB;
        if constexpr (GA) { ntk[0] = ctk[0]; ntk[1] = ctk[1]; }
        if (has_next) { nA = nxt.A; nB = nxt.B; PG8_TOKS(nxt, ntk); }
        const int nt = cur.nt; bool full = true; if constexpr (Sched::HALF_UNITS) full = (cur.half == 0);
#define PG8_TRIP(a1, a2, b2, tk2) do { const char* a3 = (a2) + kstep; const char* b3 = (b2) + kstep; \
            PG8_LDB(B0, 0, 0); PG8_LDB(B1, 0, 1); PG8_SCHED; PG8_LDA(At, 0, 0); PG8_STAGE_A(PG8_SA(1, 1), a1, 1, ctk); \
            PG8_WAIT_V(8); PG8_WAIT_L(0); PG8_BAR; PG8_MMA(0, 0, At, B0); PG8_MMA(0, 1, At, B1); PG8_BAR; PG8_SCHED; \
            if (full) PG8_LDA(At, 0, 1); PG8_STAGE(PG8_SB(0, 0), b2, voffB); PG8_STAGE(PG8_SB(0, 1), (b2) + hstepB, voffB); PG8_STAGE_A(PG8_SA(0, 0), a2, 0, tk2); \
            PG8_WAIT_V(8); PG8_WAIT_L(0); PG8_BAR; if (full) { PG8_MMA(1, 0, At, B0); PG8_MMA(1, 1, At, B1); } PG8_BAR; PG8_SCHED; \
            PG8_LDB(B0, 1, 0); PG8_LDB(B1, 1, 1); PG8_SCHED; PG8_LDA(At, 1, 0); PG8_STAGE_A(PG8_SA(0, 1), a2, 1, tk2); \
            PG8_WAIT_V(8); PG8_WAIT_L(0); PG8_BAR; PG8_MMA(0, 0, At, B0); PG8_MMA(0, 1, At, B1); PG8_BAR; PG8_SCHED; \
            if (full) PG8_LDA(At, 1, 1); PG8_STAGE(PG8_SB(1, 0), b3, voffB); PG8_STAGE(PG8_SB(1, 1), b3 + hstepB, voffB); PG8_STAGE_A(PG8_SA(1, 0), a3, 0, tk2); \
            PG8_WAIT_V(8); PG8_WAIT_L(0); PG8_BAR; if (full) { PG8_MMA(1, 0, At, B0); PG8_MMA(1, 1, At, B1); } PG8_BAR; PG8_SCHED; } while (0)
        for (int t = 0; t < nt - 2; t += 2) { const char* a1 = cA + (size_t)(t + 1) * kstep; const char* a2 = cA + (size_t)(t + 2) * kstep; const char* b2 = cB + (size_t)(t + 2) * kstep;
            PG8_TRIP(a1, a2, b2, ctk); }
        if (has_next) S.a_ready(nxt, wid);
        { const char* a1 = cA + (size_t)(nt - 1) * kstep; PG8_TRIP(a1, nA, nB, ntk); }
#undef PG8_TRIP
        if (wr == 0) PG8_BAR;
        if (ui == 0 && S.pend.bar) xcd_wait(S.pend, wid == 0 && lane_id_opaque() == 0);
        { const int el = lane_id_opaque(); E(acc, cur, wr, wc, el & 15, el >> 4); }
        S.done(cur);
        if (!has_next) break;
        cur = nxt; cA = nA; cB = nB;
        if constexpr (GA) { ctk[0] = ntk[0]; ctk[1] = ntk[1]; }
        ++ui;
        if (wr == 1) PG8_BAR;
    }
    PG8_WAIT_V(0);
    PG8_BAR;
#undef PG8_SA
#undef PG8_SB
#undef PG8_STAGE
#undef PG8_STAGE_A
#undef PG8_LDA
#undef PG8_LDB
#undef PG8_MMA
#undef PG8_WAIT_V
#undef PG8_WAIT_L
#undef PG8_BAR
#undef PG8_SCHED
#undef PG8_TOKS
}
}
namespace pg8 {
#define ZERO_ACC() do { _Pragma("unroll") for (int a_ = 0; a_ < 2; ++a_) _Pragma("unroll") for (int b_ = 0; b_ < 2; ++b_) _Pragma("unroll") for (int m_ = 0; m_ < 4; ++m_) _Pragma("unroll") for (int n_ = 0; n_ < 2; ++n_) acc[a_][b_][m_][n_] = (f32x4){0.f, 0.f, 0.f, 0.f}; } while (0)
typedef f32x4 (&AccRef)[2][2][4][2];
typedef float f32x2 __attribute__((ext_vector_type(2)));
__device__ __forceinline__ u32x4 pack8(f32x4 v0, f32x4 v1) { u32x4 w; w.x = cvt_pk_bf16(v0[0], v0[1]); w.y = cvt_pk_bf16(v0[2], v0[3]); w.z = cvt_pk_bf16(v1[0], v1[1]); w.w = cvt_pk_bf16(v1[2], v1[3]); return w; }
__device__ __forceinline__ void unpack8(u32x4 w, f32x4& v0, f32x4& v1) { v0 = (f32x4){bflo(w.x), bfhi(w.x), bflo(w.y), bfhi(w.y)}; v1 = (f32x4){bflo(w.z), bfhi(w.z), bflo(w.w), bfhi(w.w)}; }
__device__ __forceinline__ float fsigmoid(float x) { return __builtin_amdgcn_rcpf(1.f + __expf(-x)); }

struct SchedGrid {
    static constexpr bool GATHER = false, HALF_UNITS = false; unsigned lda, ldb; XcdBarrier pend = {nullptr, 0u, nullptr};
    int nM, nN, G, c, nt; const char *A0, *B0;
    __device__ __forceinline__ bool next(int i, Unit& u) const { const long L = (long)i * G + c; if (L >= (long)nM * nN) return false;
        int pm, pn; tile_of((int)L, nM, nN, pm, pn); u.pm = pm; u.pn = pn; u.tag = 0; u.half = 0; u.nt = nt;
        u.A = A0 + (size_t)pm * BM * lda; u.B = B0 + (size_t)pn * BM * ldb; return true; }
    __device__ __forceinline__ void a_ready(const Unit&, int) const {}
    __device__ __forceinline__ void done(const Unit&) const {}
};
struct SchedMerge {
    static constexpr bool GATHER = false, HALF_UNITS = false; unsigned lda, ldb; XcdBarrier pend = {nullptr, 0u, nullptr};
    int nM, nN, G, c; const char *A0, *B0;
    __device__ __forceinline__ bool next(int i, Unit& u) const { const int r = i / 3, s = i - r * 3; const long L = (long)r * G + c; if (L >= (long)nM * nN) return false;
        int pm, pn; tile_of((int)L, nM, nN, pm, pn); u.pm = pm; u.pn = pn; u.tag = s; u.half = 0; u.nt = (s == 1 ? WB : WA) / BK;
        const size_t so = (size_t)((s > 0 ? WA : 0) + (s > 1 ? WB : 0)) * 2;
        u.A = A0 + (size_t)pm * BM * lda + so; u.B = B0 + (size_t)pn * BM * ldb + so; return true; }
    __device__ __forceinline__ void a_ready(const Unit&, int) const {}
    __device__ __forceinline__ void done(const Unit&) const {}
};
#define ROWS_BEGIN(off0) { unsigned ro_ = (off0); _Pragma("unroll") for (int ai = 0; ai < 2; ++ai) { _Pragma("unroll") for (int m = 0; m < 4; ++m) {
#define ROWS_END(step16) ro_ += (m == 3 ? 5u : 1u) * (step16); asm volatile("" : "+v"(ro_) :: "memory"); } } }
struct EpiProj { static constexpr bool PERM = true; bf16_t* P;
    __device__ __forceinline__ void operator()(AccRef acc, const Unit& u, int wr, int wc, int fr, int fq) const {
        const bool pl = u.pn < 18; const int g = pl ? u.pn / 6 : -1; const int r0 = u.pm * BM + wr * 64 + fr; const int pr0 = pl ? perm_row(r0, g) : r0;
        const unsigned rstride = pl ? 256u : (unsigned)(NPB * 2), bjoff = pl ? (unsigned)(PLANE * 2) : (unsigned)(HALF * 2);
        const unsigned step16 = (unsigned)(16 >> (g <= 0 ? 0 : 2 * g)) * rstride;
        const unsigned off0 = pl ? (unsigned)(2 * u.pn) * (unsigned)(PLANE * 2) + (unsigned)pr0 * 256u + (unsigned)(wc * 32 + 8 * fq) * 2u
                                 : (unsigned)(TH * COLS_A * 2) + (unsigned)r0 * (unsigned)(NPB * 2) + (unsigned)(u.pn * BM - COLS_A + wc * 32 + 8 * fq) * 2u;
        char* base0 = (char*)P; char* base1 = base0 + bjoff;
        ROWS_BEGIN(off0)
            *(u32x4*)(base0 + ro_) = pack8(acc[ai][0][m][0], acc[ai][0][m][1]); *(u32x4*)(base1 + ro_) = pack8(acc[ai][1][m][0], acc[ai][1][m][1]);
        ROWS_END(step16)
        ZERO_ACC(); } };
#if DUP >= 30
struct EpiProjProbe { static constexpr bool PERM = true; bf16_t* P; bool st;
    __device__ __forceinline__ void operator()(AccRef acc, const Unit& u, int wr, int wc, int fr, int fq) const {
        const int g = u.pn < 18 ? u.pn / 6 : -1; const int col0 = u.pn * BM + wc * 32 + 8 * fq; const int r0 = u.pm * BM + wr * 64 + fr;
        const int pr0 = g >= 0 ? perm_row(r0, g) : r0; const unsigned step16 = (unsigned)(16 >> (g <= 0 ? 0 : 2 * g)) * (NP * 2);
        char* base = (char*)P;
        if (st) {
        ROWS_BEGIN((unsigned)pr0 * (NP * 2) + (unsigned)col0 * 2)
#pragma unroll
            for (int bj = 0; bj < 2; ++bj) *(u32x4*)(base + ro_ + bj * (HALF * 2)) = pack8(acc[ai][bj][m][0], acc[ai][bj][m][1]);
        ROWS_END(step16)
        }
        ZERO_ACC(); } };
#endif
struct EpiGates { static constexpr bool PERM = true; bf16_t* Gt;
    __device__ __forceinline__ void operator()(AccRef acc, const Unit& u, int wr, int wc, int fr, int fq) const {
        const int pl = u.pn / (D / BM), col0 = (u.pn % (D / BM)) * BM + wc * 32 + 8 * fq, r0 = u.pm * BM + wr * 64 + fr; char* base = (char*)Gt + (size_t)pl * T * D * 2;
        ROWS_BEGIN((unsigned)r0 * (D * 2) + (unsigned)col0 * 2)
#pragma unroll
            for (int bj = 0; bj < 2; ++bj) { f32x4 v0 = acc[ai][bj][m][0], v1 = acc[ai][bj][m][1];
#pragma unroll
                for (int e = 0; e < 4; ++e) { v0[e] = fsigmoid(v0[e]); v1[e] = fsigmoid(v1[e]); }
                *(u32x4*)(base + ro_ + bj * (HALF * 2)) = pack8(v0, v1); }
        ROWS_END(16u * D * 2)
        ZERO_ACC(); } };
struct EpiMerge { static constexpr bool PERM = true; const bf16_t* Gt; bf16_t* Mg;
    __device__ __forceinline__ void operator()(AccRef acc, const Unit& u, int wr, int wc, int fr, int fq) const {
        const int s = u.tag; const int col0 = u.pn * BM + wc * 32 + 8 * fq, r0 = u.pm * BM + wr * 64 + fr; const char* gbase = (const char*)Gt + (size_t)s * T * D * 2; char* mbase = (char*)Mg;
        const unsigned o0 = (unsigned)r0 * (D * 2) + (unsigned)col0 * 2;
#pragma unroll
        for (int ai = 0; ai < 2; ++ai) {
            u32x4 ga[4][2], gb[4][2];
#pragma unroll
            for (int m = 0; m < 4; ++m)
#pragma unroll
                for (int bj = 0; bj < 2; ++bj) { const unsigned o = o0 + (unsigned)(ai * HALF + m * 16) * (D * 2) + bj * (HALF * 2); ga[m][bj] = *(const u32x4*)(gbase + o); if (s < 2) gb[m][bj] = *(const u32x4*)(gbase + (size_t)T * D * 2 + o); }
#pragma unroll
            for (int m = 0; m < 4; ++m)
#pragma unroll
                for (int bj = 0; bj < 2; ++bj) { f32x4 g0, g1; unpack8(ga[m][bj], g0, g1);
                    if (s < 2) { f32x4 h0, h1; unpack8(gb[m][bj], h0, h1);
#pragma unroll
                        for (int e = 0; e < 4; ++e) { g0[e] *= __builtin_amdgcn_rcpf(fmaxf(h0[e], 1e-20f)); g1[e] *= __builtin_amdgcn_rcpf(fmaxf(h1[e], 1e-20f)); } }
                    acc[ai][bj][m][0] *= g0; acc[ai][bj][m][1] *= g1;
                    if (s == 2) *(u32x4*)(mbase + o0 + (unsigned)(ai * HALF + m * 16) * (D * 2) + bj * (HALF * 2)) = pack8(acc[ai][bj][m][0], acc[ai][bj][m][1]); }
            asm volatile("" ::: "memory"); }
        if (s == 2) ZERO_ACC(); } };
struct EpiWout { static constexpr bool PERM = true; const bf16_t* XB; bf16_t* H1; float* ST;
    __device__ __forceinline__ void operator()(AccRef acc, const Unit& u, int wr, int wc, int fr, int fq) const {
        const int col0 = u.pn * BM + wc * 32 + 8 * fq, r0 = u.pm * BM + wr * 64 + fr; const char* xb_ = (const char*)XB; char* hb_ = (char*)H1;
        const unsigned o0 = (unsigned)r0 * (D * 2) + (unsigned)col0 * 2;
        float* stp = ST + ((size_t)(u.pn * 4 + wc) * T + r0) * 2;
#pragma unroll
        for (int ai = 0; ai < 2; ++ai) {
            u32x4 xv[4][2];
#pragma unroll
            for (int m = 0; m < 4; ++m)
#pragma unroll
                for (int bj = 0; bj < 2; ++bj) xv[m][bj] = *(const u32x4*)(xb_ + o0 + (unsigned)(ai * HALF + m * 16) * (D * 2) + bj * (HALF * 2));
            float s1[4], s2[4];
#pragma unroll
            for (int m = 0; m < 4; ++m) { s1[m] = 0.f; s2[m] = 0.f;
#pragma unroll
                for (int bj = 0; bj < 2; ++bj) { f32x4 x0, x1; unpack8(xv[m][bj], x0, x1); const f32x4 h0 = x0 * DN_ALPHA + acc[ai][bj][m][0], h1 = x1 * DN_ALPHA + acc[ai][bj][m][1];
                    *(u32x4*)(hb_ + o0 + (unsigned)(ai * HALF + m * 16) * (D * 2) + bj * (HALF * 2)) = pack8(h0, h1);
                    s1[m] += ((h0[0] + h0[1]) + (h0[2] + h0[3])) + ((h1[0] + h1[1]) + (h1[2] + h1[3]));
                    s2[m] += ((h0[0] * h0[0] + h0[1] * h0[1]) + (h0[2] * h0[2] + h0[3] * h0[3])) + ((h1[0] * h1[0] + h1[1] * h1[1]) + (h1[2] * h1[2] + h1[3] * h1[3])); } }
#pragma unroll
            for (int m = 0; m < 4; ++m) { s1[m] += __shfl_xor(s1[m], 16); s2[m] += __shfl_xor(s2[m], 16); s1[m] += __shfl_xor(s1[m], 32); s2[m] += __shfl_xor(s2[m], 32);
                if (fq == 0) { f32x2 o; o[0] = s1[m]; o[1] = s2[m]; *(f32x2*)(stp + (size_t)(ai * HALF + m * 16) * 2) = o; } }
            asm volatile("" ::: "memory"); }
        ZERO_ACC(); } };
template <bool GA> struct SchedMoe {
    static constexpr bool GATHER = GA, HALF_UNITS = true; unsigned lda, ldb; XcdBarrier pend = {nullptr, 0u, nullptr};
    int G, c, ncol, nt; const PG8_LAS int* blk; const int* list; const unsigned* cnt; const char* A; const char* B; size_t b_estride, b_pnstride; unsigned* hcnt;
    __device__ __forceinline__ bool next(int i, Unit& u) const { const long L = (long)i * G + c; const int nblk = __builtin_amdgcn_readfirstlane(blk[32]); if (L >= (long)nblk * ncol) return false;
        const int ent = __builtin_amdgcn_readfirstlane(blk[640 + (int)(L / ncol)]), rb = ent & 0xffff, pn = (int)(L % ncol), e = __builtin_amdgcn_readfirstlane(blk[64 + rb]); u.pm = rb; u.pn = pn; u.tag = e; u.half = ent >> 16; u.nt = nt;
        u.A = GA ? A : A + (size_t)rb * BM * lda; u.B = B + (size_t)e * b_estride + (size_t)pn * b_pnstride; return true; }
    __device__ __forceinline__ unsigned a_row(const Unit& u, int row) const {
        const int e = u.tag, pos = ((u.pm - __builtin_amdgcn_readfirstlane(blk[e])) << 8) + row; const int entry = list[(size_t)e * T + (pos < __builtin_amdgcn_readfirstlane((int)cnt[e]) ? pos : 0)]; return (unsigned)(entry >> 1); }
    __device__ __forceinline__ void a_ready(const Unit&, int) const {}
    __device__ __forceinline__ void done(const Unit&) const {}
};
struct EpiMoe1 { static constexpr bool PERM = true; bf16_t* Hb;
    __device__ __forceinline__ void operator()(AccRef acc, const Unit& u, int wr, int wc, int fr, int fq) const {
        const int col0 = u.pn * HALF + wc * 32 + 8 * fq, r0 = u.pm * BM + wr * 64 + fr; char* base = (char*)Hb;
        ROWS_BEGIN((unsigned)r0 * (DE * 2) + (unsigned)col0 * 2)
            f32x4 v0 = acc[ai][0][m][0], v1 = acc[ai][0][m][1];
#pragma unroll
            for (int e = 0; e < 4; ++e) { v0[e] = v0[e] * fsigmoid(v0[e]) * acc[ai][1][m][0][e]; v1[e] = v1[e] * fsigmoid(v1[e]) * acc[ai][1][m][1][e]; }
            *(u32x4*)(base + ro_) = pack8(v0, v1);
        ROWS_END(16u * DE * 2)
        ZERO_ACC(); } };
struct EpiMoe2 { static constexpr bool PERM = true; const PG8_LAS int* blk; const int* list; const unsigned* cnt; bf16_t* Y0; bf16_t* Y1;
    __device__ __forceinline__ void operator()(AccRef acc, const Unit& u, int wr, int wc, int fr, int fq) const {
        const int e = u.tag, col0 = u.pn * BM + wc * 32 + 8 * fq, pbase = ((u.pm - __builtin_amdgcn_readfirstlane(blk[e])) << 8) + wr * 64 + fr, n_e = __builtin_amdgcn_readfirstlane((int)cnt[e]); const int* le = list + (size_t)e * T;
        int ent[2][4];
#pragma unroll
        for (int ai = 0; ai < 2; ++ai)
#pragma unroll
            for (int m = 0; m < 4; ++m) { const int pos = pbase + ai * HALF + m * 16; ent[ai][m] = pos < n_e ? le[pos] : -1; }
#pragma unroll
        for (int ai = 0; ai < 2; ++ai)
#pragma unroll
            for (int m = 0; m < 4; ++m) { const int entry = ent[ai][m];
                if (entry >= 0) { bf16_t* rowp = ((entry & 1) ? Y1 : Y0) + (size_t)(entry >> 1) * D + col0;
#pragma unroll
                    for (int bj = 0; bj < 2; ++bj) *(u32x4*)(rowp + bj * HALF) = pack8(acc[ai][bj][m][0], acc[ai][bj][m][1]); } }
        ZERO_ACC(); } };
#undef ROWS_BEGIN
#undef ROWS_END
#undef ZERO_ACC
}

__device__ __forceinline__ void fast_proj(const Ctx& c, int half, PG8_LAS unsigned char* lds, int tid, int bid, int nblk, const XcdBarrier pend = XcdBarrier{nullptr, 0u, nullptr}) {
    pg8::SchedGrid S; S.pend = pend; S.nM = TH / 256; S.nN = NP / 256; S.G = nblk; S.c = bid; S.nt = D / 64; S.lda = D * 2; S.ldb = D * 2;
    S.A0 = (const char*)(wsp<bf16_t>(c, OFF_XB) + (size_t)half * TH * D); S.B0 = (const char*)wsp<bf16_t>(c, WT_IN);
    pg8::EpiProj E{wsp<bf16_t>(c, OFF_P)}; pg8::gemm_phase(lds, S, E, tid);
}
#if DUP >= 30
struct SchedSame_ {
    static constexpr bool GATHER = false, HALF_UNITS = false; unsigned lda, ldb; XcdBarrier pend = {nullptr, 0u, nullptr};
    int nM, nN, G, c, nt, nu; const char *A0, *B0;
    __device__ __forceinline__ bool next(int i, pg8::Unit& u) const { if (i >= nu) return false;
        int pm, pn; pg8::tile_of(c, nM, nN, pm, pn); u.pm = pm; u.pn = pn; u.tag = 0; u.half = 0; u.nt = nt;
        u.A = A0 + (size_t)pm * 256 * lda; u.B = B0 + (size_t)pn * 256 * ldb; return true; }
    __device__ __forceinline__ void a_ready(const pg8::Unit&, int) const {}
    __device__ __forceinline__ void done(const pg8::Unit&) const {}
};
__device__ __forceinline__ void fast_proj_probe(const Ctx& c, int half, PG8_LAS unsigned char* lds, int tid, int bid, int nblk) {
    constexpr int MODE = DUP - 30;
    pg8::SchedGrid S; S.nM = TH / 256; S.nN = NP / 256; S.G = nblk; S.c = bid; S.nt = (MODE == 11 ? 8 : D / 64); S.lda = D * 2; S.ldb = D * 2;
    S.A0 = (const char*)(wsp<bf16_t>(c, OFF_XB) + (size_t)half * TH * D); S.B0 = (const char*)wsp<bf16_t>(c, WT_IN);
    bool st = (MODE == 0 || (MODE >= 5 && MODE < 10)) ? true : MODE == 3 ? (((bid >> 3) & 1) == 0) : MODE == 4 ? ((bid & 1) == 0) : (c.ws == nullptr);
    if (MODE == 13) st = (c.ws != nullptr);
    if (MODE >= 5 && MODE < 10 && ((bid >> 3) & 1)) { const unsigned long long t0 = __builtin_amdgcn_s_memrealtime(); while (__builtin_amdgcn_s_memrealtime() - t0 < (unsigned long long)(MODE == 5 ? 1400 : 700)) __builtin_amdgcn_s_sleep(4); }
    pg8::EpiProjProbe E{wsp<bf16_t>(c, OFF_P), st};
    if (MODE == 12 || MODE == 13) { SchedSame_ Q; Q.nM = S.nM; Q.nN = S.nN; Q.G = nblk; Q.c = bid; Q.nt = D / 64; Q.nu = 9; Q.lda = S.lda; Q.ldb = S.ldb; Q.A0 = S.A0; Q.B0 = S.B0; pg8::gemm_phase(lds, Q, E, tid); }
    else pg8::gemm_phase(lds, S, E, tid);
}
#endif
struct EpiPlain { static constexpr bool PERM = true; bf16_t* O; int ldc;
    __device__ __forceinline__ void operator()(pg8::AccRef acc, const pg8::Unit& u, int wr, int wc, int fr, int fq) const {
        const int col0 = u.pn * 256 + wc * 32 + 8 * fq, r0 = u.pm * 256 + wr * 64 + fr; char* base = (char*)O; unsigned ro = (unsigned)r0 * (unsigned)(ldc * 2) + (unsigned)col0 * 2;
#pragma unroll
        for (int ai = 0; ai < 2; ++ai)
#pragma unroll
            for (int m = 0; m < 4; ++m) {
#pragma unroll
                for (int bj = 0; bj < 2; ++bj) { *(pg8::u32x4*)(base + ro + bj * 256) = pg8::pack8(acc[ai][bj][m][0], acc[ai][bj][m][1]); acc[ai][bj][m][0] = (f32x4){0.f, 0.f, 0.f, 0.f}; acc[ai][bj][m][1] = (f32x4){0.f, 0.f, 0.f, 0.f}; }
                ro += (m == 3 ? 5u : 1u) * 16u * (unsigned)(ldc * 2); asm volatile("" : "+v"(ro) :: "memory"); } } };
__device__ __forceinline__ void fast_memkv(const Ctx& c, PG8_LAS unsigned char* lds, int tid, int bid, int nblk) {
    pg8::SchedGrid S; S.nM = NBATCH * MEM / 256; S.nN = 1024 / 256; S.G = nblk; S.c = bid; S.nt = D / 64; S.lda = D * 2; S.ldb = D * 2;
    S.A0 = (const char*)wsp<bf16_t>(c, OFF_MEMB); S.B0 = (const char*)wsp<bf16_t>(c, WT_KV);
    EpiPlain E{wsp<bf16_t>(c, OFF_MEMKV), 1024}; pg8::gemm_phase(lds, S, E, tid);
}
__device__ __forceinline__ void fast_gates(const Ctx& c, PG8_LAS unsigned char* lds, int tid, int bid, int nblk, const XcdBarrier pend = XcdBarrier{nullptr, 0u, nullptr}) {
    pg8::SchedGrid S; S.pend = pend; S.nM = T / 256; S.nN = 3 * D / 256; S.G = nblk; S.c = bid; S.nt = D / 64; S.lda = D * 2; S.ldb = D * 2;
    S.A0 = (const char*)wsp<bf16_t>(c, OFF_XB); S.B0 = (const char*)(wsp<bf16_t>(c, WT_IN) + (size_t)NP * D);
    pg8::EpiGates E{wsp<bf16_t>(c, OFF_GATES)}; pg8::gemm_phase(lds, S, E, tid);
}
__device__ __forceinline__ void fast_merge(const Ctx& c, PG8_LAS unsigned char* lds, int tid, int bid, int nblk, const XcdBarrier pend = XcdBarrier{nullptr, 0u, nullptr}) {
    pg8::SchedMerge S; S.pend = pend; S.nM = T / 256; S.nN = D / 256; S.G = nblk; S.c = bid; S.lda = OW * 2; S.ldb = OW * 2;
    S.A0 = (const char*)c.out; S.B0 = (const char*)wsp<bf16_t>(c, WT_A);
    pg8::EpiMerge E{wsp<bf16_t>(c, OFF_GATES), wsp<bf16_t>(c, OFF_MERGED)}; pg8::gemm_phase(lds, S, E, tid);
}
__device__ __forceinline__ void fast_wout(const Ctx& c, PG8_LAS unsigned char* lds, int tid, int bid, int nblk) {
    pg8::SchedGrid S; S.nM = T / 256; S.nN = D / 256; S.G = nblk; S.c = bid; S.nt = D / 64; S.lda = D * 2; S.ldb = D * 2;
    S.A0 = (const char*)wsp<bf16_t>(c, OFF_MERGED); S.B0 = (const char*)wsp<bf16_t>(c, WT_OUT);
    pg8::EpiWout E{wsp<bf16_t>(c, OFF_XB), wsp<bf16_t>(c, OFF_H1), wsp<float>(c, OFF_STATS)}; pg8::gemm_phase(lds, S, E, tid);
}
constexpr int LDS_MISC = 141312, LDS_BLK = LDS_MISC + 1024;
__device__ __forceinline__ const PG8_LAS int* build_blk_table(const Ctx& c, PG8_LAS unsigned char* lds, int tid) {
    PG8_LAS int* blk = (PG8_LAS int*)(lds + LDS_BLK); const unsigned* cnt = wsp<unsigned>(c, OFF_CTL) + CW_CNT;
    if (tid < 32) blk[512 + tid] = ((int)cnt[tid] + 255) >> 8;
    __syncthreads();
    if (tid == 0) { int acc = 0; for (int e = 0; e < NE; ++e) { blk[e] = acc; acc += blk[512 + e]; } blk[32] = acc; }
    __syncthreads();
    if (tid == 0) { int nl = 0; for (int e = 0; e < NE; ++e) { const int rem = (int)cnt[e] - (blk[512 + e] - 1) * 256; blk[576 + e] = nl | ((blk[512 + e] > 0 && rem <= 128) ? 0x10000 : 0); nl += (blk[512 + e] > 0 && rem <= 128) ? 1 : 0; } blk[33] = nl; }
    __syncthreads();
    { const int total = blk[32], nl = blk[33]; for (int rb = tid; rb < total; rb += 512) { int e = 0;
#pragma unroll 1
        for (int j = 1; j < NE; ++j) if (blk[j] <= rb) e = j;
        blk[64 + rb] = e;
        const int lp = blk[576 + e] & 0xffff; const bool light = (blk[576 + e] >> 16) && rb == blk[e] + blk[512 + e] - 1;
        blk[640 + (light ? total - nl + lp : rb - lp)] = rb | (light ? 0x10000 : 0); } }
    __syncthreads();
    return blk;
}
__device__ __forceinline__ void fast_moe1(const Ctx& c, PG8_LAS unsigned char* lds, int tid, int bid, int nblk) {
    pg8::SchedMoe<true> S; S.G = nblk; S.c = bid; S.ncol = 2; S.nt = D / 64; S.blk = build_blk_table(c, lds, tid); S.list = wsp<int>(c, OFF_LIST); S.cnt = wsp<unsigned>(c, OFF_CTL) + CW_CNT;
    S.A = (const char*)wsp<bf16_t>(c, OFF_X1B); S.B = (const char*)wsp<bf16_t>(c, OFF_WTGU); S.b_estride = (size_t)2 * DE * D * 2; S.b_pnstride = (size_t)256 * D * 2; S.lda = D * 2; S.ldb = D * 2; S.hcnt = wsp<unsigned>(c, OFF_CTL) + 1024;
    pg8::EpiMoe1 E{wsp<bf16_t>(c, OFF_HBUF)}; pg8::gemm_phase(lds, S, E, tid);
}
__device__ __forceinline__ void fast_moe2(const Ctx& c, PG8_LAS unsigned char* lds, int tid, int bid, int nblk) {
    pg8::SchedMoe<false> S; S.G = nblk; S.c = bid; S.ncol = D / 256; S.nt = DE / 64; S.blk = build_blk_table(c, lds, tid); S.list = wsp<int>(c, OFF_LIST); S.cnt = wsp<unsigned>(c, OFF_CTL) + CW_CNT;
    S.A = (const char*)wsp<bf16_t>(c, OFF_HBUF); S.B = (const char*)wsp<bf16_t>(c, OFF_WTDN); S.b_estride = (size_t)D * DE * 2; S.b_pnstride = (size_t)256 * DE * 2; S.lda = DE * 2; S.ldb = DE * 2; S.hcnt = wsp<unsigned>(c, OFF_CTL) + 1024;
    pg8::EpiMoe2 E{S.blk, S.list, S.cnt, wsp<bf16_t>(c, OFF_Y0), wsp<bf16_t>(c, OFF_Y1)}; pg8::gemm_phase(lds, S, E, tid);
}
namespace attn {
typedef short s16x4 __attribute__((ext_vector_type(4)));
typedef float f32x16 __attribute__((ext_vector_type(16)));
typedef unsigned u32x4 __attribute__((ext_vector_type(4)));
constexpr int KVBLK = 64, DH = 128, SHM_V = KVBLK * DH * 2, SHM_K = KVBLK * DH * 2;
constexpr int LDS_V = 0, LDS_K = 2 * SHM_V, LDS_WS = LDS_K + 2 * SHM_K, LDS_BIAS = LDS_WS + 8 * 64 * 4, BIAS_PAD = 96, BIAS_N = 129 + 2 * BIAS_PAD, LDS_END = LDS_BIAS + ((BIAS_N * 4 + 15) & ~15);
constexpr float LOG2E = 1.4426950408889634f, C2 = LOG2E * QK_SCALE, LN2 = 0.6931471805599453f;
#define KSWZ(row, colB) ((row) * 256 + ((colB) ^ (((row) & 7) << 4)))
#define SBAR() __builtin_amdgcn_sched_barrier(0)
__device__ __forceinline__ int v_st(int k, int c) { const int kk = (k & ~0xC) | ((k & 4) << 1) | ((k & 8) >> 1); return ((kk >> 3) * 4 + (c >> 5)) * 512 + ((kk & 7) * 32 + (c & 31)) * 2; }
__device__ __forceinline__ int v_rd_base(int lane) { return ((lane & 3) << 3) | (((lane >> 2) & 3) << 6) | (((lane >> 4) & 1) << 5) | (((lane >> 5) & 1) << 8); }
constexpr int v_rd_off(int d0, int ks, int half) { return d0 * 512 + ks * 4096 + half * 2048; }
__device__ __forceinline__ int crow(int r, int hi) { return (r & 3) + 8 * (r >> 2) + 4 * hi; }
__device__ __forceinline__ unsigned cvtpk(float lo, float hi) { unsigned r; asm volatile("v_cvt_pk_bf16_f32 %0, %1, %2" : "=v"(r) : "v"(lo), "v"(hi)); return r; }
__device__ __forceinline__ void qkt(f32x16& p0, f32x16& p1, const PG8_LAS char* kbuf, int r32, int hi, const bf16x8* qr) {
    p0 = f32x16{}; p1 = f32x16{};
    const PG8_LAS char* kb[4];
#pragma unroll
    for (int dd = 0; dd < 4; ++dd) kb[dd] = kbuf + KSWZ(r32, (dd * 16 + hi * 8) * 2);
#pragma unroll
    for (int d0 = 0; d0 < 8; ++d0) { const PG8_LAS char* a = kb[d0 & 3] + (d0 >> 2) * 128;
        const bf16x8 b0 = *(const PG8_LAS bf16x8*)(a);
        const bf16x8 b1 = *(const PG8_LAS bf16x8*)(a + 32 * 256);
        p0 = __builtin_amdgcn_mfma_f32_32x32x16_bf16(b0, qr[d0], p0, 0, 0, 0);
        p1 = __builtin_amdgcn_mfma_f32_32x32x16_bf16(b1, qr[d0], p1, 0, 0, 0); }
}
__device__ __forceinline__ void pv_tile(f32x16* o, int vb0, bf16x8 pa0, bf16x8 pa1, bf16x8 pa2, bf16x8 pa3) {
#define TRRD(dst, off) asm volatile("ds_read_b64_tr_b16 %0, %1 offset:%2" : "=&v"(dst) : "v"(vb0), "i"(off) : "memory")
#define PV_RD(S, d0) do { constexpr int b_ = v_rd_off(d0, 0, 0); TRRD(S##l0, b_); TRRD(S##h0, b_ + 2048); TRRD(S##l1, b_ + 4096); TRRD(S##h1, b_ + 6144); TRRD(S##l2, b_ + 8192); TRRD(S##h2, b_ + 10240); TRRD(S##l3, b_ + 12288); TRRD(S##h3, b_ + 14336); } while (0)
#define PV_MM(S, d0) do { \
        o[d0] = __builtin_amdgcn_mfma_f32_32x32x16_bf16((bf16x8){S##l0[0], S##l0[1], S##l0[2], S##l0[3], S##h0[0], S##h0[1], S##h0[2], S##h0[3]}, pa0, o[d0], 0, 0, 0); \
        o[d0] = __builtin_amdgcn_mfma_f32_32x32x16_bf16((bf16x8){S##l1[0], S##l1[1], S##l1[2], S##l1[3], S##h1[0], S##h1[1], S##h1[2], S##h1[3]}, pa1, o[d0], 0, 0, 0); \
        o[d0] = __builtin_amdgcn_mfma_f32_32x32x16_bf16((bf16x8){S##l2[0], S##l2[1], S##l2[2], S##l2[3], S##h2[0], S##h2[1], S##h2[2], S##h2[3]}, pa2, o[d0], 0, 0, 0); \
        o[d0] = __builtin_amdgcn_mfma_f32_32x32x16_bf16((bf16x8){S##l3[0], S##l3[1], S##l3[2], S##l3[3], S##h3[0], S##h3[1], S##h3[2], S##h3[3]}, pa3, o[d0], 0, 0, 0); } while (0)
    s16x4 Al0, Al1, Al2, Al3, Ah0, Ah1, Ah2, Ah3, Bl0, Bl1, Bl2, Bl3, Bh0, Bh1, Bh2, Bh3;
    PV_RD(A, 0);
    PV_RD(B, 1); asm volatile("s_waitcnt lgkmcnt(8)" ::: "memory"); SBAR(); PV_MM(A, 0); SBAR();
    PV_RD(A, 2); asm volatile("s_waitcnt lgkmcnt(8)" ::: "memory"); SBAR(); PV_MM(B, 1); SBAR();
    PV_RD(B, 3); asm volatile("s_waitcnt lgkmcnt(8)" ::: "memory"); SBAR(); PV_MM(A, 2); SBAR();
    asm volatile("s_waitcnt lgkmcnt(0)" ::: "memory"); SBAR(); PV_MM(B, 3);
#undef PV_RD
#undef PV_MM
#undef TRRD
}
__device__ __forceinline__ void store_o_rows(const f32x16* o, float rl, bf16_t* rowp, int hi) {
    char* base = (char*)rowp + hi * 16;
#pragma unroll
    for (int d0 = 0; d0 < 4; ++d0)
#pragma unroll
        for (int g = 0; g < 4; g += 2) {
            const unsigned ax = cvtpk(o[d0][4 * g] * rl, o[d0][4 * g + 1] * rl), ay = cvtpk(o[d0][4 * g + 2] * rl, o[d0][4 * g + 3] * rl);
            const unsigned bx = cvtpk(o[d0][4 * g + 4] * rl, o[d0][4 * g + 5] * rl), by = cvtpk(o[d0][4 * g + 6] * rl, o[d0][4 * g + 7] * rl);
            auto rx = __builtin_amdgcn_permlane32_swap(ax, bx, false, false); auto ry = __builtin_amdgcn_permlane32_swap(ay, by, false, false);
            *(u32x4*)(base + d0 * 64 + g * 16) = (u32x4){rx[0], ry[0], rx[1], ry[1]}; }
}
template <bool BAND>
__device__ __forceinline__ void attn_unit(PG8_LAS char* lds, const bf16_t* Q, size_t qs, const bf16_t* K, const bf16_t* V, size_t ks, int NT, int qpos0, int kpos0,
                                          bf16_t* Ob, size_t ostride, float* lse, int obase, int omul, int tid) {
    const int wid = __builtin_amdgcn_readfirstlane(tid >> 6), lane = tid & 63, r32 = lane & 31, hi = lane >> 5;
    PG8_LAS char* V_lds = lds + LDS_V; PG8_LAS char* K_lds = lds + LDS_K;
    PG8_LAS float* wsf = (PG8_LAS float*)(lds + LDS_WS) + wid * 64; const PG8_LAS float* bias = (const PG8_LAS float*)(lds + LDS_BIAS);
    const int sr = tid >> 4, sc = (tid & 15) * 8, vst0 = v_st(sr, sc), vst1 = v_st(32 + sr, sc), kws = KSWZ(sr, sc * 2);
    const int vbl = (int)(uintptr_t)V_lds + v_rd_base(lane);
    bf16x8 qr[8];
    { const bf16_t* qp = Q + (size_t)(wid * 32 + r32) * qs + hi * 8;
#pragma unroll
      for (int d0 = 0; d0 < 8; ++d0) qr[d0] = *(const bf16x8*)(qp + d0 * 16); }
    bf16x8 st_k0, st_k1, st_v0, st_v1;
#define SLOAD(t) do { const size_t ro_ = (size_t)((t) * KVBLK + sr) * ks + sc; st_k0 = *(const bf16x8*)(K + ro_); st_k1 = *(const bf16x8*)(K + ro_ + 32 * ks); st_v0 = *(const bf16x8*)(V + ro_); st_v1 = *(const bf16x8*)(V + ro_ + 32 * ks); } while (0)
#define SWRITE(bf) do { *(PG8_LAS bf16x8*)(K_lds + (bf) * SHM_K + kws) = st_k0; *(PG8_LAS bf16x8*)(K_lds + (bf) * SHM_K + kws + 32 * 256) = st_k1; \
                        *(PG8_LAS bf16x8*)(V_lds + (bf) * SHM_V + vst0) = st_v0; *(PG8_LAS bf16x8*)(V_lds + (bf) * SHM_V + vst1) = st_v1; } while (0)
    SLOAD(0); SWRITE(0);
    __syncthreads();
    float m_run = -1e30f, l_run = 0.f; f32x16 o[4] = {};
    const int qlo = qpos0 + wid * 32;
    for (int t = 0; t < NT; ++t) {
        const int buf = t & 1;
        if (t + 1 < NT) SLOAD(t + 1);
        const int kb = kpos0 + t * KVBLK;
        const bool act = !BAND || (kb <= qlo + 31 && kb + KVBLK - 1 >= qlo - 128);
        if (act) {
            f32x16 p0, p1;
            qkt(p0, p1, K_lds + buf * SHM_K, r32, hi, qr);
            if (BAND) {
                const int dq = qlo + r32 - kb - 4 * hi;
                const PG8_LAS float* bp = bias + (dq + BIAS_PAD - 59);
#pragma unroll
                for (int r = 0; r < 16; ++r) { const int cr = (r & 3) + 8 * (r >> 2);
                    const float b0 = bp[59 - cr], b1 = bp[59 - cr - 32];
                    p0[r] = ((unsigned)(dq - cr) <= 128u) ? fmaf(p0[r], C2, b0) : -INFINITY;
                    p1[r] = ((unsigned)(dq - cr - 32) <= 128u) ? fmaf(p1[r], C2, b1) : -INFINITY; }
            } else {
#pragma unroll
                for (int r = 0; r < 16; ++r) { p0[r] *= C2; p1[r] *= C2; }
            }
            float pmax = p0[0];
#pragma unroll
            for (int r = 1; r < 16; ++r) pmax = fmaxf(pmax, p0[r]);
#pragma unroll
            for (int r = 0; r < 16; ++r) pmax = fmaxf(pmax, p1[r]);
            { auto rr = __builtin_amdgcn_permlane32_swap(__float_as_uint(pmax), __float_as_uint(pmax), false, false); pmax = fmaxf(__uint_as_float(rr[0]), __uint_as_float(rr[1])); }
            const float mn = fmaxf(m_run, pmax), alpha = __builtin_amdgcn_exp2f(m_run - mn); m_run = mn;
            float ps = 0.f;
#pragma unroll
            for (int r = 0; r < 16; ++r) { p0[r] = __builtin_amdgcn_exp2f(p0[r] - mn); p1[r] = __builtin_amdgcn_exp2f(p1[r] - mn); ps += p0[r] + p1[r]; }
            { auto rr = __builtin_amdgcn_permlane32_swap(__float_as_uint(ps), __float_as_uint(ps), false, false); ps = __uint_as_float(rr[0]) + __uint_as_float(rr[1]); }
            l_run = l_run * alpha + ps;
            if (__any(alpha < 1.f)) {
#pragma unroll
                for (int r = 0; r < 16; ++r)
#pragma unroll
                    for (int d_ = 0; d_ < 4; ++d_) o[d_][r] *= alpha; }
            bf16x8 pa0, pa1, pa2, pa3;
#define PK4(P, B_, OUT) do { unsigned a0 = cvtpk(P[B_ + 0], P[B_ + 1]), a1 = cvtpk(P[B_ + 2], P[B_ + 3]); unsigned b0 = cvtpk(P[B_ + 4], P[B_ + 5]), b1 = cvtpk(P[B_ + 6], P[B_ + 7]); \
        auto r0 = __builtin_amdgcn_permlane32_swap(a0, b0, false, false); auto r1 = __builtin_amdgcn_permlane32_swap(a1, b1, false, false); \
        u32x4 w = {r0[0], r1[0], r0[1], r1[1]}; OUT = *reinterpret_cast<bf16x8*>(&w); } while (0)
            PK4(p0, 0, pa0); PK4(p0, 8, pa1); PK4(p1, 0, pa2); PK4(p1, 8, pa3);
#undef PK4
            SBAR();
            pv_tile(o, vbl + buf * SHM_V, pa0, pa1, pa2, pa3);
        }
        if (t + 1 < NT) SWRITE(buf ^ 1);
        __syncthreads();
    }
#undef SLOAD
#undef SWRITE
    store_o_rows(o, __builtin_amdgcn_rcpf(l_run), Ob + (size_t)(obase + (wid * 32 + r32) * omul) * ostride, hi);
    if (BAND) { if (hi == 0) lse[(size_t)(obase + (wid * 32 + r32) * omul) * 4] = (m_run + __log2f(l_run)) * LN2; }
    __syncthreads();
}
struct SubUnit { const bf16_t* Q; const bf16_t* K; bf16_t* Ob; float* lse; const float* bsrc; int qpos0, kpos0, krow_min, obase, omul; };
constexpr int P2_V = 0, P2_K = 4 * SHM_V, P2_WS = P2_K + 4 * SHM_K, P2_BIAS = P2_WS + 8 * 64 * 4, P2_END = P2_BIAS + 2 * ((BIAS_N * 4 + 15) & ~15);
static_assert(P2_END <= 141312, "attention pair LDS");
template <class MakeUnit>
__device__ __forceinline__ void attn_pair_seq(PG8_LAS char* lds, const MakeUnit& mk, int u0, int ustep, int uend, size_t qs, size_t ks, size_t ostride, int tid) {
    if (u0 >= uend) return;
    const int wid = __builtin_amdgcn_readfirstlane(tid >> 6), sub = wid >> 2, w4 = wid & 3, lane = tid & 63, r32 = lane & 31, hi = lane >> 5, t256 = tid & 255;
    PG8_LAS char* V_lds = lds + P2_V + sub * 2 * SHM_V; PG8_LAS char* K_lds = lds + P2_K + sub * 2 * SHM_K;
    PG8_LAS float* bt = (PG8_LAS float*)(lds + P2_BIAS + sub * ((BIAS_N * 4 + 15) & ~15)); const PG8_LAS float* bias = bt;
    const int sr = t256 >> 4, sc = (t256 & 15) * 8;
    const int vbl = (int)(uintptr_t)V_lds + v_rd_base(lane);
    bf16x8 qr[8]; bf16x8 stk[4], stv[4]; float bn0 = 0.f, bn1 = 0.f;
#define QLOAD(UU) do { const bf16_t* qp_ = (UU).Q + (size_t)(w4 * 32 + r32) * qs + hi * 8; _Pragma("unroll") for (int d0 = 0; d0 < 8; ++d0) qr[d0] = *(const bf16x8*)(qp_ + d0 * 16); } while (0)
#define BLOAD(UU) do { const int u0_ = t256 - BIAS_PAD, u1_ = t256 + 256 - BIAS_PAD; bn0 = (u0_ >= 0 && u0_ <= 128) ? (UU).bsrc[u0_] * LOG2E : -INFINITY; bn1 = (t256 + 256 < BIAS_N && u1_ >= 0 && u1_ <= 128) ? (UU).bsrc[u1_] * LOG2E : -INFINITY; } while (0)
#define BWRITE() do { bt[t256] = bn0; if (t256 + 256 < BIAS_N) bt[t256 + 256] = bn1; } while (0)
#define SLOAD2(UU, t) do { _Pragma("unroll") for (int i_ = 0; i_ < 4; ++i_) { int rr_ = (t) * KVBLK + sr + 16 * i_; rr_ = rr_ < (UU).krow_min ? (UU).krow_min : rr_; const bf16_t* kp_ = (UU).K + (ptrdiff_t)rr_ * (ptrdiff_t)ks + sc; stk[i_] = *(const bf16x8*)kp_; stv[i_] = *(const bf16x8*)(kp_ + 4 * PLANE); } } while (0)
#define SWRITE2(bf) do { _Pragma("unroll") for (int i_ = 0; i_ < 4; ++i_) { *(PG8_LAS bf16x8*)(K_lds + (bf) * SHM_K + KSWZ(sr + 16 * i_, sc * 2)) = stk[i_]; *(PG8_LAS bf16x8*)(V_lds + (bf) * SHM_V + v_st(sr + 16 * i_, sc)) = stv[i_]; } } while (0)
    SubUnit U = mk(u0 * 2 + sub);
    QLOAD(U); BLOAD(U); SLOAD2(U, 0); BWRITE(); SWRITE2(0);
    __syncthreads();
    for (int u = u0; u < uend; u += ustep) {
        const bool has_next = u + ustep < uend;
        SubUnit N = U; if (has_next) N = mk((u + ustep) * 2 + sub);
        float m_run = -1e30f, l_run = 0.f; f32x16 o[4] = {};
        const int qlo = U.qpos0 + w4 * 32;
#pragma unroll
        for (int t = 0; t < 4; ++t) {
            const int buf = t & 1;
            if (t + 1 < 4) SLOAD2(U, t + 1); else if (has_next) { SLOAD2(N, 0); BLOAD(N); }
            const int kb = U.kpos0 + t * KVBLK;
            const bool act = kb >= 0 && kb <= qlo + 31 && kb + KVBLK - 1 >= qlo - 128;
            if (!act && t == 3 && has_next) QLOAD(N);
            if (act) {
                f32x16 p0, p1;
                qkt(p0, p1, K_lds + buf * SHM_K, r32, hi, qr);
                if (t == 3 && has_next) QLOAD(N);
                { const int dq = qlo + r32 - kb - 4 * hi; const PG8_LAS float* bp = bias + (dq + BIAS_PAD - 59);
#pragma unroll
                  for (int r = 0; r < 16; ++r) { const int cr = (r & 3) + 8 * (r >> 2); const float b0 = bp[59 - cr], b1 = bp[59 - cr - 32];
                      p0[r] = fmaf(p0[r], C2, b0); p1[r] = fmaf(p1[r], C2, b1); } }
                float pmax = p0[0];
#pragma unroll
                for (int r = 1; r < 16; ++r) pmax = fmaxf(pmax, p0[r]);
#pragma unroll
                for (int r = 0; r < 16; ++r) pmax = fmaxf(pmax, p1[r]);
                { auto rr = __builtin_amdgcn_permlane32_swap(__float_as_uint(pmax), __float_as_uint(pmax), false, false); pmax = fmaxf(__uint_as_float(rr[0]), __uint_as_float(rr[1])); }
                const float mn = fmaxf(m_run, pmax), alpha = __builtin_amdgcn_exp2f(m_run - mn); m_run = mn;
                float ps = 0.f;
#pragma unroll
                for (int r = 0; r < 16; ++r) { p0[r] = __builtin_amdgcn_exp2f(p0[r] - mn); p1[r] = __builtin_amdgcn_exp2f(p1[r] - mn); ps += p0[r] + p1[r]; }
                { auto rr = __builtin_amdgcn_permlane32_swap(__float_as_uint(ps), __float_as_uint(ps), false, false); ps = __uint_as_float(rr[0]) + __uint_as_float(rr[1]); }
                l_run = l_run * alpha + ps;
                if (__any(alpha < 1.f)) {
#pragma unroll
                    for (int r = 0; r < 16; ++r)
#pragma unroll
                        for (int d_ = 0; d_ < 4; ++d_) o[d_][r] *= alpha; }
                bf16x8 pa0, pa1, pa2, pa3;
#define PK4(P, B_, OUT) do { unsigned a0 = cvtpk(P[B_ + 0], P[B_ + 1]), a1 = cvtpk(P[B_ + 2], P[B_ + 3]); unsigned b0 = cvtpk(P[B_ + 4], P[B_ + 5]), b1 = cvtpk(P[B_ + 6], P[B_ + 7]); \
        auto r0 = __builtin_amdgcn_permlane32_swap(a0, b0, false, false); auto r1 = __builtin_amdgcn_permlane32_swap(a1, b1, false, false); \
        u32x4 w = {r0[0], r1[0], r0[1], r1[1]}; OUT = *reinterpret_cast<bf16x8*>(&w); } while (0)
                PK4(p0, 0, pa0); PK4(p0, 8, pa1); PK4(p1, 0, pa2); PK4(p1, 8, pa3);
#undef PK4
                SBAR();
                pv_tile(o, vbl + buf * SHM_V, pa0, pa1, pa2, pa3);
            }
            if (t + 1 < 4) SWRITE2(buf ^ 1); else if (has_next) SWRITE2(0);
            __syncthreads();
        }
        store_o_rows(o, __builtin_amdgcn_rcpf(l_run), U.Ob + (size_t)(U.obase + (w4 * 32 + r32) * U.omul) * ostride, hi);
        if (hi == 0) U.lse[(size_t)(U.obase + (w4 * 32 + r32) * U.omul) * 4] = (m_run + __log2f(l_run)) * LN2;
        if (has_next) BWRITE();
        __syncthreads();
        U = N;
    }
#undef QLOAD
#undef BLOAD
#undef BWRITE
#undef SLOAD2
#undef SWRITE2
}

__device__ __forceinline__ SubUnit a_subunit(const Ctx& c, int su) {
    constexpr int SB = S / 128; const bf16_t* P = wsp<bf16_t>(c, OFF_P);
    const int j = su % SB, h = (su / SB) & 3, g = (su / (SB * 4)) % 3, bl = su / (SB * 12);
    const int r = dil_of(g), L = S / r, nsb = L / 128, cc = j / nsb, sb = j % nsb, q0 = sb * 128, base = bl * S + cc * L;
    SubUnit U; U.bsrc = wsp<float>(c, OFF_SMALL) + SM_BIAS + (g * 4 + h) * 129;
    U.Q = P + ((size_t)(g * 12 + h) * TH + base + q0) * 128; U.K = P + ((ptrdiff_t)((g * 12 + 4 + h) * TH + base + q0) - 128) * 128;
    U.qpos0 = q0; U.kpos0 = q0 - 128; U.krow_min = 128 - q0 > 0 ? 128 - q0 : 0; if (U.krow_min > 0 && base + q0 >= 128) U.krow_min = 0;
    U.Ob = wsp<bf16_t>(c, OFF_PART) + (size_t)g * TH * WA + h * 128; U.lse = wsp<float>(c, OFF_LSE) + (size_t)g * TH * 4 + h; U.obase = bl * S + q0 * r + cc; U.omul = r;
    return U;
}
__device__ __forceinline__ void attn_phase(const Ctx& c, int half, PG8_LAS unsigned char* lds_u, int tid, int bid, int nblk) {
    asm volatile("" : "+v"(tid));
    PG8_LAS char* lds = (PG8_LAS char*)lds_u;
    constexpr int QB = S / 256, NPA = BH * 3 * 4 * (S / 128) / 2, NUC = BH * 4 * QB, NU = NPA + NUC;
    auto mk = [&](int su) { return a_subunit(c, su); };
    attn_pair_seq(lds, mk, bid, nblk, NPA, 128, 128, WA, tid);
    for (int v = bid; v < NUC; v += nblk) {
        const int j = v % QB, h = (v / QB) & 3, bl = v / (QB * 4), b = half * BH + bl, tl0 = bl * S + j * 256;
        const bf16_t* Qp = wsp<bf16_t>(c, OFF_PB) + (size_t)tl0 * NPB + COLS_B + h * 128; const bf16_t* Kp = wsp<bf16_t>(c, OFF_MEMKV) + (size_t)b * MEM * 1024 + h * 128;
        attn_unit<false>(lds, Qp, NPB, Kp, Kp + 512, 1024, MEM / 64, 0, 0, (bf16_t*)c.out + (size_t)half * TH * OW + WA + WB + h * 128, OW, nullptr, tl0, 1, tid);
    }
}
#undef KSWZ
#undef SBAR
}
namespace rowops {
typedef float f32x4 __attribute__((ext_vector_type(4)));
typedef unsigned u32x2 __attribute__((ext_vector_type(2)));
typedef float f32x2 __attribute__((ext_vector_type(2)));
typedef unsigned u32x4 __attribute__((ext_vector_type(4)));
__device__ __forceinline__ float wave_sum(float v) {
#pragma unroll
    for (int o = 1; o < 64; o <<= 1) v += __shfl_xor(v, o);
    return v;
}
__device__ __forceinline__ unsigned pk2(float lo, float hi) { return pg8::cvt_pk_bf16(lo, hi); }

constexpr int SM_WGT = 16384, SM_CS = SM_WGT + 48 * D, SM_BW = SM_CS + 64;
constexpr size_t SMB_WGH = 512 * 1024, SMB_WGL = SMB_WGH + (size_t)48 * D * 2;
static_assert((SM_BW + 64) * 4 <= (int)SMB_WGH && SMB_WGL + (size_t)48 * D * 2 <= MiB, "small region");
__device__ __forceinline__ void router_weights_prep(const Ctx& c, int tid, int bid, int nblk) {
    const int lane = tid & 63, gw = bid * 8 + (tid >> 6), NGW = nblk * 8; float* sm = wsp<float>(c, OFF_SMALL);
    for (int col = gw; col < 48; col += NGW) { float cs = 0.f, bw = 0.f;
        for (int i = lane; i < D; i += 64) { const float w = col < 4 ? c.w_rg[i * 4 + col] : (col < 36 ? c.w_re[i * 32 + col - 4] : 0.f); const float gwv = c.ln1_g[i] * w; sm[SM_WGT + col * D + i] = gwv; cs += gwv; bw += c.ln1_b[i] * w;
            const unsigned hi = pk2(gwv, 0.f) & 0xffffu; ((bf16_t*)((char*)sm + SMB_WGH))[col * D + i] = (bf16_t)hi; ((bf16_t*)((char*)sm + SMB_WGL))[col * D + i] = (bf16_t)(pk2(gwv - bflo(hi), 0.f) & 0xffffu); }
        cs = wave_sum(cs); bw = wave_sum(bw);
        if (lane == 0) { sm[SM_CS + col] = cs; sm[SM_BW + col] = bw + (col < 4 ? c.b_rg[col] : (col < 36 ? c.b_re[col - 4] : 0.f)); } }
}
template <bool DRY> __device__ __forceinline__ void ln1_router_phase(const Ctx& c, PG8_LAS unsigned char* lds, int tid, int bid, int nblk) {
    asm volatile("" : "+v"(tid));
    const int lane = tid & 63, wid = tid >> 6, l15 = lane & 15, lq = lane >> 4, gw = bid * 8 + wid, NGW = nblk * 8;
    PG8_LAS int* lh = (PG8_LAS int*)lds; PG8_LAS int* asg = lh + 64; PG8_LAS float* lg = (PG8_LAS float*)(lds + 4096) + wid * (16 * 48);
    PG8_LAS float* GB = (PG8_LAS float*)(lds + 132608);
    if (tid < 64) lh[tid] = 0;
    for (int i = tid; i < D / 4; i += 512) { *(PG8_LAS f32x4*)(GB + 4 * i) = *(const f32x4*)(c.ln1_g + 4 * i); *(PG8_LAS f32x4*)(GB + D + 4 * i) = *(const f32x4*)(c.ln1_b + 4 * i); }
    __syncthreads();
    const bf16_t* H1B = wsp<bf16_t>(c, OFF_H1); bf16_t* X1B = wsp<bf16_t>(c, OFF_X1B); const float* sm = wsp<float>(c, OFF_SMALL);
    unsigned* cnt = wsp<unsigned>(c, OFF_CTL) + CW_CNT; int* list = wsp<int>(c, OFF_LIST); float* rw = wsp<float>(c, OFF_RW);
    int ngrp = 0; const bool stage_w = (NGW * 16 == T) && D == 1024;
    for (int g0 = gw * 16; g0 < T; g0 += NGW * 16, ++ngrp) {
        float my_mean = 0.f, my_rstd = 0.f;
        if (lane < 16) { const f32x2* sp = (const f32x2*)wsp<float>(c, OFF_STATS) + (g0 + lane); float s = 0.f, s2 = 0.f;
#pragma unroll
            for (int k = 0; k < 16; ++k) { const f32x2 p = sp[(size_t)k * T]; s += p[0]; s2 += p[1]; }
            my_mean = s * (1.f / D); my_rstd = 1.f / sqrtf(fmaxf(s2 * (1.f / D) - my_mean * my_mean, 0.f) + LN_EPS); }
        const float rmean = __shfl(my_mean, l15), rrstd = __shfl(my_rstd, l15);
        f32x4 acc0 = {0.f, 0.f, 0.f, 0.f}, acc1 = acc0, acc2 = acc0;
        const PG8_LAS float* gbl = GB + 8 * lq; asm volatile("" : "+v"(gbl));
#define NORM_STORE(a_, col_) do { const f32x4 g_ = *(const PG8_LAS f32x4*)(GB + (col_)), b_ = *(const PG8_LAS f32x4*)(GB + D + (col_)); const f32x4 v_ = ((a_) - rmean) * rrstd * g_ + b_; \
            u32x2 w_; w_.x = pk2(v_[0], v_[1]); w_.y = pk2(v_[2], v_[3]); if (!DRY) *(u32x2*)(X1B + (size_t)(g0 + l15) * D + (col_)) = w_; } while (0)
        if (stage_w) {
            PG8_LAS bf16_t* WH = (PG8_LAS bf16_t*)(lds + 32768); constexpr int WLS = 520; PG8_LAS bf16_t* WLo = WH + 48 * WLS;
            const bf16_t* ap = H1B + (size_t)(g0 + l15) * D + 8 * lq; bf16_t* xp = X1B + (size_t)(g0 + l15) * D + 8 * lq;
            const char* wsrc = (const char*)sm + SMB_WGH;
            u32x4 av[2][16];
#pragma unroll
            for (int i = 0; i < 16; ++i) av[0][i] = *(const u32x4*)(ap + 32 * i);
#pragma unroll
            for (int kh = 0; kh < 2; ++kh) {
                __syncthreads();
                for (int i = tid; i < 2 * 48 * 64; i += 512) { const int hl = i / (48 * 64), r = i % (48 * 64), col = r >> 6, k8 = (r & 63) * 8;
                    *(PG8_LAS u32x4*)(WH + (hl * 48 + col) * WLS + k8) = *(const u32x4*)(wsrc + (size_t)hl * 48 * D * 2 + ((size_t)col * D + kh * 512 + k8) * 2); }
                __syncthreads();
                const PG8_LAS bf16_t* bp = WH + l15 * WLS + 8 * lq;
                if (kh == 0) {
#pragma unroll
                    for (int i = 0; i < 16; ++i) av[1][i] = *(const u32x4*)(ap + 512 + 32 * i); }
#pragma unroll
                for (int i = 0; i < 16; ++i) { if ((i & 1) == 0) __builtin_amdgcn_sched_barrier(0); const u32x4 ar = av[kh][i]; const int col = kh * 512 + 32 * i;
                    { f32x4 a0, a1; pg8::unpack8(ar, a0, a1);
                      const f32x4 g0_ = *(const PG8_LAS f32x4*)(gbl + col), g1_ = *(const PG8_LAS f32x4*)(gbl + col + 4), b0_ = *(const PG8_LAS f32x4*)(gbl + D + col), b1_ = *(const PG8_LAS f32x4*)(gbl + D + col + 4);
                      const f32x4 v0_ = (a0 - rmean) * rrstd * g0_ + b0_, v1_ = (a1 - rmean) * rrstd * g1_ + b1_;
                      u32x4 w_; w_.x = pk2(v0_[0], v0_[1]); w_.y = pk2(v0_[2], v0_[3]); w_.z = pk2(v1_[0], v1_[1]); w_.w = pk2(v1_[2], v1_[3]); if (!DRY) *(u32x4*)(xp + col) = w_; }
                    const bf16x8 ah = __builtin_bit_cast(bf16x8, ar); const int st = i;
                    const bf16x8 h0 = *(const PG8_LAS bf16x8*)(bp + 32 * st), h1 = *(const PG8_LAS bf16x8*)(bp + 16 * WLS + 32 * st), h2 = *(const PG8_LAS bf16x8*)(bp + 32 * WLS + 32 * st);
                    const bf16x8 l0 = *(const PG8_LAS bf16x8*)(bp + 48 * WLS + 32 * st), l1 = *(const PG8_LAS bf16x8*)(bp + 64 * WLS + 32 * st), l2 = *(const PG8_LAS bf16x8*)(bp + 80 * WLS + 32 * st);
                    acc0 = __builtin_amdgcn_mfma_f32_16x16x32_bf16(ah, h0, acc0, 0, 0, 0); acc1 = __builtin_amdgcn_mfma_f32_16x16x32_bf16(ah, h1, acc1, 0, 0, 0); acc2 = __builtin_amdgcn_mfma_f32_16x16x32_bf16(ah, h2, acc2, 0, 0, 0);
                    acc0 = __builtin_amdgcn_mfma_f32_16x16x32_bf16(ah, l0, acc0, 0, 0, 0); acc1 = __builtin_amdgcn_mfma_f32_16x16x32_bf16(ah, l1, acc1, 0, 0, 0); acc2 = __builtin_amdgcn_mfma_f32_16x16x32_bf16(ah, l2, acc2, 0, 0, 0); } }
        } else
        { const bf16_t* ap = H1B + (size_t)(g0 + l15) * D + 4 * lq; const float* bp = sm + SM_WGT + (size_t)l15 * D + 4 * lq;
#pragma unroll 4
          for (int st = 0; st < D / 16; ++st) { const u32x2 ar = *(const u32x2*)(ap + 16 * st); const f32x4 a = {bflo(ar.x), bfhi(ar.x), bflo(ar.y), bfhi(ar.y)}; NORM_STORE(a, 16 * st + 4 * lq);
              const f32x4 b0 = *(const f32x4*)(bp + 16 * st), b1 = *(const f32x4*)(bp + 16 * D + 16 * st), b2 = *(const f32x4*)(bp + 32 * D + 16 * st);
#pragma unroll
              for (int j = 0; j < 4; ++j) { acc0 = __builtin_amdgcn_mfma_f32_16x16x4f32(a[j], b0[j], acc0, 0, 0, 0); acc1 = __builtin_amdgcn_mfma_f32_16x16x4f32(a[j], b1[j], acc1, 0, 0, 0); acc2 = __builtin_amdgcn_mfma_f32_16x16x4f32(a[j], b2[j], acc2, 0, 0, 0); } } }
#pragma unroll
        for (int i = 0; i < 4; ++i) { lg[(lq * 4 + i) * 48 + l15] = acc0[i]; lg[(lq * 4 + i) * 48 + 16 + l15] = acc1[i]; lg[(lq * 4 + i) * 48 + 32 + l15] = acc2[i]; }
        asm volatile("s_waitcnt lgkmcnt(0)" ::: "memory");
        if (lane < 16) { const PG8_LAS float* lr = lg + lane * 48; float gl[4], gm; int gs = 0;
#pragma unroll
            for (int g = 0; g < 4; ++g) gl[g] = my_rstd * (lr[g] - my_mean * sm[SM_CS + g]) + sm[SM_BW + g];
            gm = gl[0];
#pragma unroll
            for (int g = 1; g < 4; ++g) if (gl[g] > gm) { gm = gl[g]; gs = g; }
            const float gp = 1.f / (__expf(gl[0] - gm) + __expf(gl[1] - gm) + __expf(gl[2] - gm) + __expf(gl[3] - gm));
            float v0 = -INFINITY, v1 = -INFINITY; int i0 = 0, i1 = 0;
            for (int j = 0; j < 8; ++j) { const int col = 4 + gs * 8 + j; const float x = my_rstd * (lr[col] - my_mean * sm[SM_CS + col]) + sm[SM_BW + col];
                if (x > v0) { v1 = v0; i1 = i0; v0 = x; i0 = j; } else if (x > v1) { v1 = x; i1 = j; } }
            const float e1 = __expf(v1 - v0), w0 = gp / (1.f + e1), w1 = gp * e1 / (1.f + e1); const int ea = gs * 8 + i0, eb = gs * 8 + i1, row = g0 + lane;
            const int ra = __hip_atomic_fetch_add(lh + ea, 1, __ATOMIC_RELAXED, __HIP_MEMORY_SCOPE_WORKGROUP), rb = __hip_atomic_fetch_add(lh + eb, 1, __ATOMIC_RELAXED, __HIP_MEMORY_SCOPE_WORKGROUP);
            PG8_LAS int* a = asg + (wid * 16 + lane) * 4; a[0] = row; a[1] = ea | (ra << 8); a[2] = eb | (rb << 8);
            if (!DRY) { rw[row * 2] = w0; rw[row * 2 + 1] = w1; } }
    }
#undef NORM_STORE
    __syncthreads();
    if (DRY) return;
    if (tid < 32) lh[32 + tid] = (int)atomicAdd(cnt + tid, (unsigned)lh[tid]);
    __syncthreads();
    if (lane < 16 && ngrp > 0) { const PG8_LAS int* a = asg + (wid * 16 + lane) * 4; const int row = a[0], xa = a[1], xb = a[2];
        list[(size_t)(xa & 255) * T + lh[32 + (xa & 255)] + (xa >> 8)] = row * 2; list[(size_t)(xb & 255) * T + lh[32 + (xb & 255)] + (xb >> 8)] = row * 2 + 1; }
    __syncthreads();
}
__device__ __forceinline__ void ln2_phase(const Ctx& c, int tid, int bid, int nblk, float oscale) {
    asm volatile("" : "+v"(tid));
    const int lane = tid & 63, wid = tid >> 6, gw = bid * 8 + wid, NGW = nblk * 8;
    const bf16_t* X1B = wsp<bf16_t>(c, OFF_X1B); const bf16_t* Y0 = wsp<bf16_t>(c, OFF_Y0); const bf16_t* Y1 = wsp<bf16_t>(c, OFF_Y1); const float* rw = wsp<float>(c, OFF_RW);
    f32x4 gv[4], bv[4];
#pragma unroll
    for (int j = 0; j < 4; ++j) { gv[j] = *(const f32x4*)(c.ln2_g + 4 * lane + 256 * j); bv[j] = *(const f32x4*)(c.ln2_b + 4 * lane + 256 * j); }
    for (int row0 = gw; row0 < T; row0 += 2 * NGW) {
        u32x2 xr[2][4], ya[2][4], yb[2][4]; float w0[2], w1[2]; int rows[2];
#pragma unroll
        for (int q = 0; q < 2; ++q) { const int row = row0 + q * NGW < T ? row0 + q * NGW : row0; rows[q] = row;
            const u32x2* xp = (const u32x2*)(X1B + (size_t)row * D) + lane; const u32x2* y0p = (const u32x2*)(Y0 + (size_t)row * D) + lane; const u32x2* y1p = (const u32x2*)(Y1 + (size_t)row * D) + lane;
            w0[q] = rw[row * 2]; w1[q] = rw[row * 2 + 1];
#pragma unroll
            for (int j = 0; j < 4; ++j) { xr[q][j] = xp[64 * j]; ya[q][j] = y0p[64 * j]; yb[q][j] = y1p[64 * j]; } }
#pragma unroll
        for (int q = 0; q < 2; ++q) { if (q == 1 && row0 + NGW >= T) break;
            f32x4 v[4]; float s = 0.f;
#pragma unroll
            for (int j = 0; j < 4; ++j) { const u32x2 x = xr[q][j], a = ya[q][j], b = yb[q][j];
                v[j][0] = DN_ALPHA * bflo(x.x) + w0[q] * bflo(a.x) + w1[q] * bflo(b.x); v[j][1] = DN_ALPHA * bfhi(x.x) + w0[q] * bfhi(a.x) + w1[q] * bfhi(b.x);
                v[j][2] = DN_ALPHA * bflo(x.y) + w0[q] * bflo(a.y) + w1[q] * bflo(b.y); v[j][3] = DN_ALPHA * bfhi(x.y) + w0[q] * bfhi(a.y) + w1[q] * bfhi(b.y);
                s += (v[j][0] + v[j][1]) + (v[j][2] + v[j][3]); }
            const float mean = wave_sum(s) * (1.f / D); float s2 = 0.f;
#pragma unroll
            for (int j = 0; j < 4; ++j) { v[j] = v[j] - mean; s2 += (v[j][0] * v[j][0] + v[j][1] * v[j][1]) + (v[j][2] * v[j][2] + v[j][3] * v[j][3]); }
            const float rstd = 1.f / sqrtf(wave_sum(s2) * (1.f / D) + LN_EPS);
            f32x4* op = (f32x4*)(c.out + (size_t)rows[q] * D) + lane;
#pragma unroll
            for (int j = 0; j < 4; ++j) op[64 * j] = (v[j] * rstd * gv[j] + bv[j]) * oscale; }
    }
}
struct TrItem { const float* W; int N; bf16_t* Wt; size_t ldo; int k0, n0; };
__device__ __forceinline__ void tr_fetch(const TrItem& t, int lane, f32x4 (&w)[8]) {
#pragma unroll
    for (int i = 0; i < 8; ++i) { const int kk = 8 * i + (lane >> 3), n4 = (lane & 7) * 4; w[i] = *(const f32x4*)(t.W + (size_t)(t.k0 + kk) * t.N + t.n0 + n4); }
}
__device__ __forceinline__ void tr_to_lds(const f32x4 (&w)[8], PG8_LAS float* scr, int lane) {
#pragma unroll
    for (int i = 0; i < 8; ++i) { const int kk = 8 * i + (lane >> 3), n4 = (lane & 7) * 4; scr[kk * 33 + n4] = w[i][0]; scr[kk * 33 + n4 + 1] = w[i][1]; scr[kk * 33 + n4 + 2] = w[i][2]; scr[kk * 33 + n4 + 3] = w[i][3]; }
}
__device__ __forceinline__ void tr_emit(const TrItem& t, const PG8_LAS float* scr, int lane) {
    const int ch = lane & 7;
#pragma unroll
    for (int j = 0; j < 4; ++j) { const int n = (lane >> 3) + 8 * j; const PG8_LAS float* s = scr + (8 * ch) * 33 + n;
        u32x4 o; o.x = pk2(s[0 * 33], s[1 * 33]); o.y = pk2(s[2 * 33], s[3 * 33]); o.z = pk2(s[4 * 33], s[5 * 33]); o.w = pk2(s[6 * 33], s[7 * 33]);
        *(u32x4*)(t.Wt + (size_t)n * t.ldo + t.k0 + 8 * ch) = o; }
}
template <class Dec> __device__ __forceinline__ void tr_loop(const Dec& dec, int nit, int gw, int NGW, PG8_LAS float* scr, int lane) {
    int it = gw; if (it >= nit) return;
    TrItem cur = dec(it); f32x4 w[8]; tr_fetch(cur, lane, w);
    for (;;) { tr_to_lds(w, scr, lane);
        const int nx = it + NGW; const bool has = nx < nit; TrItem nxt = cur;
        if (has) { nxt = dec(nx); tr_fetch(nxt, lane, w); }
        asm volatile("s_waitcnt lgkmcnt(0)" ::: "memory");
        tr_emit(cur, scr, lane);
        asm volatile("s_waitcnt lgkmcnt(0)" ::: "memory");
        if (!has) break;
        cur = nxt; it = nx; }
}
__device__ __forceinline__ void cvt_copy(const float* src, bf16_t* dst, long n, int tid, int bid, int nblk) {
    const long n8 = n / 8, stride = (long)nblk * 512; long i = (long)bid * 512 + tid;
    for (; i + 3 * stride < n8; i += 4 * stride) {
        f32x4 a[4], b[4];
#pragma unroll
        for (int j = 0; j < 4; ++j) { a[j] = __builtin_nontemporal_load((const f32x4*)(src + (i + j * stride) * 8)); b[j] = __builtin_nontemporal_load((const f32x4*)(src + (i + j * stride) * 8 + 4)); }
#pragma unroll
        for (int j = 0; j < 4; ++j) { u32x4 o; o.x = pk2(a[j][0], a[j][1]); o.y = pk2(a[j][2], a[j][3]); o.z = pk2(b[j][0], b[j][1]); o.w = pk2(b[j][2], b[j][3]); *(u32x4*)(dst + (i + j * stride) * 8) = o; } }
    for (; i < n8; i += stride) { const f32x4 a = *(const f32x4*)(src + i * 8), b = *(const f32x4*)(src + i * 8 + 4);
        u32x4 o; o.x = pk2(a[0], a[1]); o.y = pk2(a[2], a[3]); o.z = pk2(b[0], b[1]); o.w = pk2(b[2], b[3]); *(u32x4*)(dst + i * 8) = o; }
}
__device__ __forceinline__ void prologue_phase(const Ctx& c, PG8_LAS unsigned char* lds, int tid, int bid, int nblk) {
    asm volatile("" : "+v"(tid));
    const int lane = tid & 63, wid = tid >> 6, gw = bid * 8 + wid, NGW = nblk * 8;
    PG8_LAS float* scr = (PG8_LAS float*)(lds + wid * 16384);
    constexpr int I_IN = (D / 64) * (N_IN / 32), I_KV = (D / 64) * (1024 / 32), I_A = (WA / 64) * (D / 32), I_B = (WB / 64) * (D / 32), I_C = (WC / 64) * (D / 32), I_O = (D / 64) * (D / 32);
    constexpr int NIT = I_IN + I_KV + I_A + I_B + I_C + I_O;
    auto dec = [&](int it) { int r = it; TrItem t;
        if (r < I_IN) { const int nb = N_IN / 32; t = TrItem{c.w_in, N_IN, wsp<bf16_t>(c, WT_IN) + (size_t)(r % nb) * 32 * D, (size_t)D, (r / nb) * 64, (r % nb) * 32}; return t; } r -= I_IN;
        if (r < I_KV) { const int nb = 1024 / 32; t = TrItem{c.w_kv, 1024, wsp<bf16_t>(c, WT_KV) + (size_t)(r % nb) * 32 * D, (size_t)D, (r / nb) * 64, (r % nb) * 32}; return t; } r -= I_KV;
        if (r < I_A) { const int nb = D / 32; t = TrItem{c.w_a, D, wsp<bf16_t>(c, WT_A) + (size_t)(r % nb) * 32 * OW, (size_t)OW, (r / nb) * 64, (r % nb) * 32}; return t; } r -= I_A;
        if (r < I_B) { const int nb = D / 32; t = TrItem{c.w_b, D, wsp<bf16_t>(c, WT_A) + WA + (size_t)(r % nb) * 32 * OW, (size_t)OW, (r / nb) * 64, (r % nb) * 32}; return t; } r -= I_B;
        if (r < I_C) { const int nb = D / 32; t = TrItem{c.w_c, D, wsp<bf16_t>(c, WT_A) + WA + WB + (size_t)(r % nb) * 32 * OW, (size_t)OW, (r / nb) * 64, (r % nb) * 32}; return t; } r -= I_C;
        { const int nb = D / 32; t = TrItem{c.w_out, D, wsp<bf16_t>(c, WT_OUT) + (size_t)(r % nb) * 32 * D, (size_t)D, (r / nb) * 64, (r % nb) * 32}; return t; } };
    tr_loop(dec, NIT, gw, NGW, scr, lane);
    router_weights_prep(c, tid, bid, nblk);
    cvt_copy(c.x, wsp<bf16_t>(c, OFF_XB), (long)T * D, tid, bid, nblk);
    cvt_copy(c.mem, wsp<bf16_t>(c, OFF_MEMB), (long)NBATCH * MEM * D, tid, bid, nblk);
}
__device__ __forceinline__ void expert_weights_phase(const Ctx& c, PG8_LAS unsigned char* lds, int tid, int bid, int nblk) {
    asm volatile("" : "+v"(tid));
    const int lane = tid & 63, wid = tid >> 6, gw = bid * 8 + wid, NGW = nblk * 8;
    PG8_LAS float* scr = (PG8_LAS float*)(lds + wid * 16384);
    constexpr int I_G = (D / 64) * (DE / 32), I_D = (DE / 64) * (D / 32), PER_E = 2 * I_G + I_D;
    auto dec = [&](int it) { const int e = it / PER_E; int r = it % PER_E; TrItem t;
        if (r < 2 * I_G) { const int up = r / I_G; r %= I_G; const int nb = DE / 32, n0 = (r % nb) * 32, k0 = (r / nb) * 64; const float* src = (up ? c.w_eu : c.w_eg) + (size_t)e * D * DE;
            t = TrItem{src, DE, wsp<bf16_t>(c, OFF_WTGU) + ((size_t)e * 2 * DE + (n0 / 128) * 256 + up * 128 + n0 % 128) * D, (size_t)D, k0, n0}; return t; }
        r -= 2 * I_G; const int nb = D / 32, n0 = (r % nb) * 32, k0 = (r / nb) * 64;
        t = TrItem{c.w_ed + (size_t)e * DE * D, D, wsp<bf16_t>(c, OFF_WTDN) + ((size_t)e * D + n0) * DE, (size_t)DE, k0, n0}; return t; };
    tr_loop(dec, NE * PER_E, gw, NGW, scr, lane);
}
}
namespace hgrn {
typedef float f32x4 __attribute__((ext_vector_type(4)));
typedef unsigned u32x2 __attribute__((ext_vector_type(2)));
typedef unsigned u32x4 __attribute__((ext_vector_type(4)));
constexpr int QS = 272, SS = 144;
constexpr int L_QE = 0, L_KE = L_QE + 64 * QS, L_KDT = L_KE + 64 * QS, L_VT = L_KDT + 128 * SS, L_PM = L_VT + 128 * SS,     L_ST = L_PM + 64 * SS, L_F32 = L_ST + 128 * QS;
constexpr int F_QTOT = 0, F_DL = 512, F_ER = 640, F_SSQ = 768, F_LB = 1280, L_END = L_F32 + (1280 + 128) * 4;
static_assert(L_END <= 131072, "hgrn LDS");
__device__ __forceinline__ float fexp2(float x) { return __builtin_amdgcn_exp2f(__builtin_amdgcn_fmed3f(x, -100.f, 115.f)); }
__device__ __forceinline__ unsigned hbf(float x) { return pg8::cvt_pk_bf16(x, x); }
__device__ __forceinline__ bf16x8 ldfrag(const PG8_LAS char* mat, int stride, int row, int ks, int lq) { return *(const PG8_LAS bf16x8*)(mat + row * stride + ks * 64 + lq * 16); }

struct Raw { bf16x8 f0, f1, q0, q1, v0, v1; unsigned short g[16]; };
template <bool FULL>
__device__ __forceinline__ void hg_load(Raw& R, const bf16_t* P, int row0, int h, int tid, int vcol, int lq) {
    const int et = tid >> 3, ec = (tid & 7) * 8, sr = tid >> 4, sc = (tid & 15) * 8;
    const bf16_t* fp = P + (size_t)(row0 + et) * NPB + WB + h * 128 + ec; R.f0 = *(const bf16x8*)fp; R.f1 = *(const bf16x8*)(fp + 64);
    const bf16_t* vp = P + (size_t)(row0 + sr) * NPB + 2 * WB + h * 128 + sc; R.v0 = *(const bf16x8*)vp; R.v1 = *(const bf16x8*)(vp + (size_t)32 * NPB);
    if (FULL) { const bf16_t* qp = P + (size_t)(row0 + et) * NPB + h * 128 + ec; R.q0 = *(const bf16x8*)qp; R.q1 = *(const bf16x8*)(qp + 64);
        const bf16_t* gp = P + (size_t)(row0 + lq * 4) * NPB + 3 * WB + h * 128 + vcol;
#pragma unroll
        for (int mt = 0; mt < 4; ++mt)
#pragma unroll
            for (int i = 0; i < 4; ++i) R.g[mt * 4 + i] = gp[(size_t)(mt * 16 + i) * NPB]; }
}
template <bool FULL>
__device__ __forceinline__ void hg_unit(const Ctx& c, int half, int bl, int h, int seg, PG8_LAS char* lds, int tid, Raw& R, int nrow0, int nh) {
    const int wid = __builtin_amdgcn_readfirstlane(tid >> 6), lane = tid & 63, l15 = lane & 15, lq = lane >> 4;
    const int ek = tid & 127, etq = tid >> 7;
    const int et = tid >> 3, ec = (tid & 7) * 8;
    const int sr = tid >> 4, sc = (tid & 15) * 8;
    const int bhl = bl * HB + h;
    const bf16_t* P = wsp<bf16_t>(c, OFF_PB);
    PG8_LAS float* F = (PG8_LAS float*)(lds + L_F32); PG8_LAS float* LF = (PG8_LAS float*)(lds + L_ST);
    bf16_t* Shat = wsp<bf16_t>(c, OFF_HG) + ((size_t)bhl * NSEG + seg) * 128 * 128;
    const int vcol = wid * 16 + l15;
    if (tid < 128) F[F_LB + tid] = wsp<float>(c, OFF_SMALL)[SM_LB + h * 128 + tid];
    f32x4 Sacc[8];
#pragma unroll
    for (int kt = 0; kt < 8; ++kt) {
        if (FULL) {
#pragma unroll
            for (int i = 0; i < 4; ++i) Sacc[kt][i] = bf2f(Shat[(size_t)(kt * 16 + lq * 4 + i) * 128 + vcol]);
        } else Sacc[kt] = (f32x4){0.f, 0.f, 0.f, 0.f};
    }
    float dsum = 0.f;
    __syncthreads();
    for (int ch = 0; ch < 4; ++ch) {
        int row0 = bl * S + seg * 256 + ch * 64;
        asm volatile("" : "+s"(row0));
        { unsigned kw[8], qw[8];
#pragma unroll
          for (int hh = 0; hh < 2; ++hh) { const bf16x8 fr = hh ? R.f1 : R.f0; const bf16x8 qr = hh ? R.q1 : R.q0; f32x4 lfo[2];
#pragma unroll
              for (int j = 0; j < 8; j += 2) { float kf2[2], qs2[2];
#pragma unroll
                  for (int e = 0; e < 2; ++e) { const float lb = F[F_LB + ec + hh * 64 + j + e]; const float f = lb + (1.f - lb) * pg8::fsigmoid(bf2f((bf16_t)fr[j + e])); lfo[(j + e) >> 2][(j + e) & 3] = __builtin_amdgcn_logf(f); kf2[e] = 1.f - f;
                      if (FULL) { const float q = bf2f((bf16_t)qr[j + e]); qs2[e] = q * pg8::fsigmoid(q); } }
                  kw[hh * 4 + (j >> 1)] = pg8::cvt_pk_bf16(kf2[0], kf2[1]); if (FULL) qw[hh * 4 + (j >> 1)] = pg8::cvt_pk_bf16(qs2[0], qs2[1]); }
              *(PG8_LAS f32x4*)(LF + et * 128 + ec + hh * 64) = lfo[0]; *(PG8_LAS f32x4*)(LF + et * 128 + ec + hh * 64 + 4) = lfo[1]; }
          *(PG8_LAS u32x4*)(lds + L_KE + et * QS + ec * 2) = (u32x4){kw[0], kw[1], kw[2], kw[3]}; *(PG8_LAS u32x4*)(lds + L_KE + et * QS + ec * 2 + 128) = (u32x4){kw[4], kw[5], kw[6], kw[7]};
          if (FULL) { *(PG8_LAS u32x4*)(lds + L_QE + et * QS + ec * 2) = (u32x4){qw[0], qw[1], qw[2], qw[3]}; *(PG8_LAS u32x4*)(lds + L_QE + et * QS + ec * 2 + 128) = (u32x4){qw[4], qw[5], qw[6], qw[7]}; } }
        *(PG8_LAS bf16x8*)(lds + L_VT + sr * QS + sc * 2) = R.v0; *(PG8_LAS bf16x8*)(lds + L_VT + (sr + 32) * QS + sc * 2) = R.v1;
        unsigned short graw[16];
#pragma unroll
        for (int i = 0; i < 16; ++i) graw[i] = R.g[i];
        __syncthreads();
        float lf[16];
        { float run = 0.f;
#pragma unroll
          for (int j = 0; j < 16; ++j) { run += LF[(etq * 16 + j) * 128 + ek]; lf[j] = run; }
          F[F_QTOT + etq * 128 + ek] = run; }
        __syncthreads();
        { const float q0 = F[F_QTOT + ek], q1 = F[F_QTOT + 128 + ek], q2 = F[F_QTOT + 256 + ek], q3 = F[F_QTOT + 384 + ek];
          const float blast = (q0 + q1) + (q2 + q3), off = etq == 0 ? 0.f : (etq == 1 ? q0 : (etq == 2 ? q0 + q1 : (q0 + q1) + q2)), r = 0.5f * blast;
          const float er = fexp2(r);
          if (etq == 0) { F[F_DL + ek] = fexp2(blast); F[F_ER + ek] = er; dsum += blast; }
          unsigned kd[8];
#pragma unroll
          for (int j = 0; j < 16; j += 2) { float kdv[2];
#pragma unroll
              for (int e = 0; e < 2; ++e) { const float b = off + lf[j + e]; PG8_LAS bf16_t* kp = (PG8_LAS bf16_t*)(lds + L_KE + (etq * 16 + j + e) * QS + ek * 2); const float kfv = bf2f(*kp);
                  float E = 1.f, kev = 0.f;
                  if (FULL) { E = fexp2(b - r); kev = kfv * __builtin_amdgcn_rcpf(E); kdv[e] = kev * er; }
                  else kdv[e] = kfv * fexp2(blast - b);
                  if (FULL) { PG8_LAS bf16_t* qp = (PG8_LAS bf16_t*)(lds + L_QE + (etq * 16 + j + e) * QS + ek * 2); *qp = (bf16_t)hbf(bf2f(*qp) * E); *kp = (bf16_t)hbf(kev); } }
              kd[j >> 1] = pg8::cvt_pk_bf16(kdv[0], kdv[1]); }
          *(PG8_LAS u32x4*)(lds + L_KDT + ek * SS + etq * 32) = (u32x4){kd[0], kd[1], kd[2], kd[3]};
          *(PG8_LAS u32x4*)(lds + L_KDT + ek * SS + etq * 32 + 16) = (u32x4){kd[4], kd[5], kd[6], kd[7]}; }
        if (ch < 3) hg_load<FULL>(R, P, row0 + 64, h, tid, vcol, lq); else if (nrow0 >= 0) hg_load<FULL>(R, P, nrow0, nh, tid, vcol, lq);
        __syncthreads();
        f32x4 oacc[4];
        if (FULL) {
#pragma unroll
            for (int kt = 0; kt < 8; ++kt) { const f32x4 er = *(const PG8_LAS f32x4*)(F + F_ER + kt * 16 + lq * 4);
                u32x2 w; w.x = pg8::cvt_pk_bf16(Sacc[kt][0] * er[0], Sacc[kt][1] * er[1]); w.y = pg8::cvt_pk_bf16(Sacc[kt][2] * er[2], Sacc[kt][3] * er[3]);
                *(PG8_LAS u32x2*)(lds + L_ST + vcol * QS + (kt * 16 + lq * 4) * 2) = w; }
            { const int tt = wid & 3;
#pragma unroll
              for (int sti = 0; sti < 2; ++sti) { const int st = 2 * (wid >> 2) + sti; f32x4 a = (f32x4){0.f, 0.f, 0.f, 0.f};
#pragma unroll
                  for (int ks = 0; ks < 4; ++ks) a = __builtin_amdgcn_mfma_f32_16x16x32_bf16(ldfrag(lds + L_KE, QS, st * 16 + l15, ks, lq), ldfrag(lds + L_QE, QS, tt * 16 + l15, ks, lq), a, 0, 0, 0);
                  const int t = tt * 16 + l15, s0 = st * 16 + lq * 4;
                  u32x2 w; w.x = pg8::cvt_pk_bf16(s0 <= t ? a[0] : 0.f, s0 + 1 <= t ? a[1] : 0.f); w.y = pg8::cvt_pk_bf16(s0 + 2 <= t ? a[2] : 0.f, s0 + 3 <= t ? a[3] : 0.f);
                  *(PG8_LAS u32x2*)(lds + L_PM + t * SS + s0 * 2) = w; } }
            __syncthreads();
        }
        bf16x8 vb0, vb1;
#pragma unroll
        for (int j = 0; j < 8; ++j) { vb0[j] = *(const PG8_LAS short*)(lds + L_VT + (lq * 8 + j) * QS + vcol * 2); vb1[j] = *(const PG8_LAS short*)(lds + L_VT + (32 + lq * 8 + j) * QS + vcol * 2); }
        if (FULL) {
            bf16x8 sb[4];
#pragma unroll
            for (int ks = 0; ks < 4; ++ks) sb[ks] = ldfrag(lds + L_ST, QS, vcol, ks, lq);
#pragma unroll
            for (int mt = 0; mt < 4; ++mt) { f32x4 a = (f32x4){0.f, 0.f, 0.f, 0.f};
#pragma unroll
                for (int ks = 0; ks < 4; ++ks) a = __builtin_amdgcn_mfma_f32_16x16x32_bf16(ldfrag(lds + L_QE, QS, mt * 16 + l15, ks, lq), sb[ks], a, 0, 0, 0);
                a = __builtin_amdgcn_mfma_f32_16x16x32_bf16(ldfrag(lds + L_PM, SS, mt * 16 + l15, 0, lq), vb0, a, 0, 0, 0);
                a = __builtin_amdgcn_mfma_f32_16x16x32_bf16(ldfrag(lds + L_PM, SS, mt * 16 + l15, 1, lq), vb1, a, 0, 0, 0);
                oacc[mt] = a; }
        }
#pragma unroll
        for (int kt = 0; kt < 8; ++kt) { const f32x4 dl = *(const PG8_LAS f32x4*)(F + F_DL + kt * 16 + lq * 4); f32x4 a = Sacc[kt] * dl;
            a = __builtin_amdgcn_mfma_f32_16x16x32_bf16(ldfrag(lds + L_KDT, SS, kt * 16 + l15, 0, lq), vb0, a, 0, 0, 0);
            a = __builtin_amdgcn_mfma_f32_16x16x32_bf16(ldfrag(lds + L_KDT, SS, kt * 16 + l15, 1, lq), vb1, a, 0, 0, 0);
            Sacc[kt] = a; }
        if (FULL) {
#pragma unroll
            for (int mt = 0; mt < 4; ++mt)
#pragma unroll
                for (int i = 0; i < 4; ++i) { float q = oacc[mt][i] * oacc[mt][i];
#define DPP_SHR(n) q += __builtin_bit_cast(float, __builtin_amdgcn_update_dpp(0, __builtin_bit_cast(int, q), 0x110 + (n), 0xf, 0xf, true))
                    DPP_SHR(1); DPP_SHR(2); DPP_SHR(4); DPP_SHR(8);
#undef DPP_SHR
                    if (l15 == 15) F[F_SSQ + (mt * 16 + lq * 4 + i) * 8 + wid] = q; }
            __syncthreads();
            const float ng = c.norm_g[h * 128 + vcol];
            float rs_mine;
            { const PG8_LAS f32x4* sp = (const PG8_LAS f32x4*)(F + F_SSQ + ((l15 >> 2) * 16 + lq * 4 + (l15 & 3)) * 8); const f32x4 s0 = sp[0], s1 = sp[1];
              const float ss = ((s0[0] + s0[1]) + (s0[2] + s0[3])) + ((s1[0] + s1[1]) + (s1[2] + s1[3])); rs_mine = __builtin_amdgcn_rsqf(ss * (1.f / 128.f) + RMS_EPS); }
            bf16_t* op = (bf16_t*)c.out + ((size_t)half * TH + row0 + lq * 4) * OW + WA + h * 128 + vcol;
#pragma unroll
            for (int mt = 0; mt < 4; ++mt)
#pragma unroll
                for (int i = 0; i < 4; ++i) { const float rs = __shfl(rs_mine, (lane & 48) | (mt * 4 + i)); const float g = bf2f(graw[mt * 4 + i]);
                    op[(size_t)(mt * 16 + i) * OW] = (bf16_t)pg8::cvt_pk_bf16(oacc[mt][i] * rs * ng * (g * pg8::fsigmoid(g)), 0.f); }
        }
        __syncthreads();
    }
    if (!FULL) {
#pragma unroll
        for (int kt = 0; kt < 8; ++kt)
#pragma unroll
            for (int i = 0; i < 4; ++i) Shat[(size_t)(kt * 16 + lq * 4 + i) * 128 + vcol] = (bf16_t)hbf(Sacc[kt][i]);
        if (etq == 0) wsp<float>(c, OFF_DSEG)[((size_t)bhl * NSEG + seg) * 128 + ek] = dsum;
    }
}
template <bool FULL>
__device__ __forceinline__ void hg_phase(const Ctx& c, int half, PG8_LAS unsigned char* lds_u, int tid, int bid_in, int nblk_in, int nlight = 0) {
    asm volatile("" : "+v"(tid));
    PG8_LAS char* lds = (PG8_LAS char*)lds_u;
    constexpr int NU = BH * HB * NSEG;
    const int bid = bid_in < nlight ? bid_in : nlight + (bid_in - nlight), nblk = bid_in < nlight ? NU : nblk_in - nlight;
    const int wid = __builtin_amdgcn_readfirstlane(tid >> 6), lane = tid & 63, vcol = wid * 16 + (lane & 15), lq = lane >> 4;
    Raw R;
    if (bid < NU) { const int seg = bid % NSEG, bhl = bid / NSEG; hg_load<FULL>(R, wsp<bf16_t>(c, OFF_PB), (bhl / HB) * S + seg * 256, bhl % HB, tid, vcol, lq); }
    for (int u = bid; u < NU; u += nblk) { const int seg = u % NSEG, bhl = u / NSEG; const int un = u + nblk; int nrow0 = -1, nh = 0;
        if (un < NU) { const int sgn = un % NSEG, bn = un / NSEG; nrow0 = (bn / HB) * S + sgn * 256; nh = bn % HB; }
        hg_unit<FULL>(c, half, bhl / HB, bhl % HB, seg, lds, tid, R, nrow0, nh); }
}
__device__ __forceinline__ void hg_scan_phase(const Ctx& c, int tid, int bid, int nblk) {
    asm volatile("" : "+v"(tid));
    constexpr long N = (long)BH * HB * 128 * 64;
    for (long idx = (long)bid * 512 + tid; idx < N; idx += (long)nblk * 512) { const int v2 = (int)(idx & 63), k = (int)((idx >> 6) & 127), bhl = (int)(idx >> 13);
        unsigned* sp = (unsigned*)(wsp<bf16_t>(c, OFF_HG) + ((size_t)bhl * NSEG * 128 + k) * 128) + v2; const float* dp = wsp<float>(c, OFF_DSEG) + (size_t)bhl * NSEG * 128 + k;
        unsigned tmp[NSEG]; float dd[NSEG];
#pragma unroll
        for (int sg = 0; sg < NSEG; ++sg) { tmp[sg] = sp[(size_t)sg * 128 * 64]; dd[sg] = dp[sg * 128]; }
        float r0 = 0.f, r1 = 0.f;
#pragma unroll
        for (int sg = 0; sg < NSEG; ++sg) { const float t0 = bflo(tmp[sg]), t1 = bfhi(tmp[sg]), d = __builtin_amdgcn_exp2f(dd[sg]); tmp[sg] = pg8::cvt_pk_bf16(r0, r1); r0 = d * r0 + t0; r1 = d * r1 + t1; }
#pragma unroll
        for (int sg = 0; sg < NSEG; ++sg) sp[(size_t)sg * 128 * 64] = tmp[sg];
    }
}
__device__ __forceinline__ void comb_phase(const Ctx& c, int half, int tid, int bid, int nblk) {
    asm volatile("" : "+v"(tid));
    constexpr long N = (long)TH * WA / 8; const float* lse = wsp<float>(c, OFF_LSE); const bf16_t* part = wsp<bf16_t>(c, OFF_PART);
    const long stride = (long)nblk * 512;
    for (long idx0 = (long)bid * 512 + tid; idx0 < N; idx0 += 4 * stride) {
        u32x4 pa[4], pb[4], pc[4]; float l0[4], l1[4], l2[4];
#pragma unroll
        for (int j = 0; j < 4; ++j) { const long idx = idx0 + j * stride < N ? idx0 + j * stride : idx0; const int c8 = (int)(idx % (WA / 8)), tl = (int)(idx / (WA / 8)), col = c8 * 8, h = col >> 7;
            l0[j] = lse[((size_t)0 * TH + tl) * 4 + h]; l1[j] = lse[((size_t)1 * TH + tl) * 4 + h]; l2[j] = lse[((size_t)2 * TH + tl) * 4 + h];
            pa[j] = *(const u32x4*)(part + ((size_t)0 * TH + tl) * WA + col); pb[j] = *(const u32x4*)(part + ((size_t)1 * TH + tl) * WA + col); pc[j] = *(const u32x4*)(part + ((size_t)2 * TH + tl) * WA + col); }
#pragma unroll
        for (int j = 0; j < 4; ++j) { const long idx = idx0 + j * stride; if (idx < N) { const int c8 = (int)(idx % (WA / 8)), tl = (int)(idx / (WA / 8)), col = c8 * 8;
            const float mx = fmaxf(l0[j], fmaxf(l1[j], l2[j])), e0 = __expf(l0[j] - mx), e1 = __expf(l1[j] - mx), e2 = __expf(l2[j] - mx), inv = 1.f / (e0 + e1 + e2), w0 = e0 * inv, w1 = e1 * inv, w2 = e2 * inv;
            f32x4 a0, a1, b0, b1, c0, c1; pg8::unpack8(pa[j], a0, a1); pg8::unpack8(pb[j], b0, b1); pg8::unpack8(pc[j], c0, c1);
            *(u32x4*)((bf16_t*)c.out + ((size_t)half * TH + tl) * OW + col) = pg8::pack8(a0 * w0 + b0 * w1 + c0 * w2, a1 * w0 + b1 * w1 + c1 * w2); } }
    }
}
}
#include <hip/hip_cooperative_groups.h>
namespace cg = cooperative_groups;
constexpr int NTHR = 512, LDS_BYTES = 147456;

template <class F> __device__ __forceinline__ void dev_elems_(const F& f, long n, int tid, int bid, int nblk) {
    asm volatile("" : "+v"(tid));
    for (long i = (long)bid * NTHR + tid; i < n; i += (long)nblk * NTHR) f(i);
}
template <class G> __device__ __forceinline__ void dev_sgemm_(const G& g, int tid, int bid, int nblk) {
    asm volatile("" : "+v"(tid));
    const int M = g.M(); const int lane = tid & 63, wid = tid >> 6; constexpr int ntn = G::N / 64;
    const long ntiles = (long)(M / 16) * ntn;
    for (long tile = (long)bid * 8 + wid; tile < ntiles; tile += (long)nblk * 8) {
        const int tm = (int)(tile / ntn), tn = (int)(tile % ntn), r0 = tm * 16, c0 = tn * 64;
        f32x4 acc[G::NBP][4], carry[4];
#pragma unroll
        for (int j = 0; j < 4; ++j) { carry[j] = (f32x4){0.f, 0.f, 0.f, 0.f};
#pragma unroll
            for (int w = 0; w < G::NBP; ++w) acc[w][j] = (f32x4){0.f, 0.f, 0.f, 0.f}; }
#pragma unroll
        for (int seg = 0; seg < G::NSEGS; ++seg) {
            const bf16_t* ar = g.arow(seg, r0 + (lane & 15)) + 8 * (lane >> 4); const bf16_t* br[G::NBP][4];
#pragma unroll
            for (int w = 0; w < G::NBP; ++w)
#pragma unroll
                for (int j = 0; j < 4; ++j) br[w][j] = g.brow(seg, r0, c0 + 16 * j + (lane & 15), w) + 8 * (lane >> 4);
            const int K = g.K(seg);
            for (int k0 = 0; k0 < K; k0 += 32) { const bf16x8 a = *(const bf16x8*)(ar + k0);
#pragma unroll
                for (int w = 0; w < G::NBP; ++w)
#pragma unroll
                    for (int j = 0; j < 4; ++j) { const bf16x8 b = *(const bf16x8*)(br[w][j] + k0); acc[w][j] = __builtin_amdgcn_mfma_f32_16x16x32_bf16(a, b, acc[w][j], 0, 0, 0); } }
#pragma unroll
            for (int j = 0; j < 4; ++j)
#pragma unroll
                for (int i = 0; i < 4; ++i) { float a = acc[0][j][i], cr = carry[j][i]; g.between(seg, r0 + (lane >> 4) * 4 + i, c0 + 16 * j + (lane & 15), a, cr); acc[0][j][i] = a; carry[j][i] = cr; }
        }
#pragma unroll
        for (int j = 0; j < 4; ++j)
#pragma unroll
            for (int i = 0; i < 4; ++i) g.store(r0 + (lane >> 4) * 4 + i, c0 + 16 * j + (lane & 15), acc[0][j][i], G::NBP == 2 ? acc[G::NBP - 1][j][i] : carry[j][i]);
    }
}

struct E_hg3q { Ctx c; int half; static constexpr long n = (long)BH * HB * NSEG * 128 * 4;
    __device__ __forceinline__ void operator()(long idx) const { const int kq = (int)(idx & 3), v = (int)((idx >> 2) & 127); const long r = idx >> 9; const int seg = (int)(r % NSEG), bhl = (int)(r / NSEG), h = bhl % HB, bl = bhl / HB;
        const bf16_t* P = wsp<bf16_t>(c, OFF_P); float st[32];
#pragma unroll
        for (int k = 0; k < 32; ++k) st[k] = wsp<float>(c, OFF_HG)[(((size_t)bhl * NSEG + seg) * 128 + kq * 32 + k) * 128 + v];
        for (int s = 0; s < 256; ++s) { const int tl = bl * S + seg * 256 + s; const bf16_t* pr = P + (size_t)tl * NP; const float iv = bf2f(pr[COLS_A + 2 * WB + h * 128 + v]); float o = 0.f;
#pragma unroll
            for (int k = 0; k < 32; ++k) { const int kk = kq * 32 + k; const float f = hg_f(c, pr, h * 128 + kk); st[k] = f * st[k] + (1.f - f) * iv; o += siluf_(bf2f(pr[COLS_A + h * 128 + kk])) * st[k]; }
            o += __shfl_xor(o, 1); o += __shfl_xor(o, 2);
            if (kq == 0) ((bf16_t*)c.out)[((size_t)half * TH + tl) * OW + WA + h * 128 + v] = f2bf(o); } } };

typedef const __attribute__((address_space(4))) Ctx* CtxK;
#if defined(__HIP_DEVICE_COMPILE__)
__device__ __forceinline__ Ctx load_ctx() { CtxK p = (CtxK)__builtin_amdgcn_kernarg_segment_ptr(); asm volatile("" : "+s"(p)); return *p; }
#else
__device__ inline Ctx load_ctx() { return Ctx(); }
#endif
#define PH_BEGIN { const Ctx c = load_ctx(); const int tid = wid_s * 64 + pg8::lane_id_opaque(); int bid = blockIdx.x, nblk = gridDim.x; asm volatile("" : "+s"(bid), "+s"(nblk));
#define dev_elems(...) dev_elems_(__VA_ARGS__, tid, bid, nblk)
#define dev_sgemm(...) dev_sgemm_(__VA_ARGS__, tid, bid, nblk)
#define PH_END }
#ifndef DUP
#define DUP -1
#endif
#ifdef TPROBE
#define STAMP() do { if (blockIdx.x == 0 && threadIdx.x == 0) { unsigned long long* ts_ = (unsigned long long*)(c_arg.ws + OFF_CTL + 32768); ts_[nstamp] = __builtin_amdgcn_s_memrealtime(); } ++nstamp; } while (0)
#else
#define STAMP() do { } while (0)
#endif
#define GSYNC() do { xcd_barrier(xbar, tid_k == 0); if (DUP == 20) xcd_barrier(xbar, tid_k == 0); STAMP(); } while (0)
#define GARRIVE() xcd_arrive(xbar, tid_k == 0)
#define REP(k) for (int rep_ = 0; rep_ < ((DUP == (k)) ? 2 : 1); ++rep_)

__global__ void __launch_bounds__(NTHR) mega(Ctx c_arg) {
    extern __shared__ __attribute__((aligned(16))) unsigned char lds_raw[];
    PG8_LAS unsigned char* lds = (PG8_LAS unsigned char*)lds_raw;
    cg::grid_group grid = cg::this_grid();
    int nstamp = 0; (void)nstamp;
    const int wid_s = __builtin_amdgcn_readfirstlane((int)threadIdx.x >> 6);
    volatile PG8_LAS unsigned* bst = (volatile PG8_LAS unsigned*)(lds + LDS_MISC);
    if (threadIdx.x == 0) { bst[0] = 0u; bst[1] = 0u; }
    __syncthreads();
    if (blockIdx.x == 0) for (int i = threadIdx.x; i < XCD_BAR_WORDS; i += NTHR) (wsp<unsigned>(c_arg, OFF_CTL) + 4096)[i] = 0u;
#define tid_k (wid_s * 64 + pg8::lane_id_opaque())
    grid.sync();
    const XcdBarrier xbar = xcd_barrier_post(wsp<unsigned>(c_arg, OFF_CTL) + 4096, bst, threadIdx.x == 0);
    PH_BEGIN
    dev_elems(S0_small{c}, S0_small::n); REP(0) rowops::prologue_phase(c, lds, tid, bid, nblk);
    PH_END
    GSYNC();
#pragma unroll
    for (int half = 0; half < NHALF; ++half) {
        PH_BEGIN
        if (half == 0) fast_proj(c, half, lds, tid, bid, nblk); else fast_proj(c, half, lds, tid, bid, nblk, xbar);
        PH_END
#if DUP >= 30
        __syncthreads();
        PH_BEGIN
        fast_proj_probe(c, half, lds, tid, bid, nblk);
        PH_END
#endif
        GSYNC();
        PH_BEGIN
        if (half == 0) fast_memkv(c, lds, tid, bid, nblk);
        REP(2) hgrn::hg_phase<false>(c, half, lds, tid, bid, nblk, half == 0 ? 16 : 0);
        PH_END
        GSYNC();
        PH_BEGIN
        hgrn::hg_scan_phase(c, tid, bid, nblk); REP(3) attn::attn_phase(c, half, lds, tid, bid, nblk);
        PH_END
        GSYNC();
        PH_BEGIN
        REP(4) hgrn::hg_phase<true>(c, half, lds, tid, bid, nblk); REP(12) hgrn::comb_phase(c, half, tid, bid, nblk);
        PH_END
        GARRIVE();
    }
    PH_BEGIN
    fast_gates(c, lds, tid, bid, nblk, xbar); __syncthreads(); rowops::expert_weights_phase(c, lds, tid, bid, nblk);
    PH_END
    GARRIVE();
    PH_BEGIN
    fast_merge(c, lds, tid, bid, nblk, xbar);
    PH_END
    GSYNC();
    PH_BEGIN
    REP(7) fast_wout(c, lds, tid, bid, nblk);
    PH_END
    GSYNC();
    PH_BEGIN
    rowops::ln1_router_phase<false>(c, lds, tid, bid, nblk); if (DUP == 8) { __syncthreads(); rowops::ln1_router_phase<true>(c, lds, tid, bid, nblk); }
    PH_END
    GSYNC();
    PH_BEGIN
    REP(9) fast_moe1(c, lds, tid, bid, nblk);
    PH_END
    GSYNC();
    PH_BEGIN
    REP(10) fast_moe2(c, lds, tid, bid, nblk);
    PH_END
#ifdef TPROBE
    if (blockIdx.x == 0 && threadIdx.x == 0) { unsigned long long* ts_ = (unsigned long long*)(c_arg.ws + OFF_CTL + 32768); const unsigned long long now = __builtin_amdgcn_s_memrealtime();
        const float ticks = (TPROBE >= 100) ? (float)(now - ts_[0]) * 0.1f : (TPROBE == 15 ? (float)(now - ts_[15]) : (float)(ts_[TPROBE + 1] - ts_[TPROBE]));
        *(float*)(c_arg.ws + OFF_CTL + 32768 + 1024) = 1.f + sqrtf(ticks * 1e-6f); }
#endif
    GSYNC();
    PH_BEGIN
#ifdef TPROBE
    REP(11) rowops::ln2_phase(c, tid, bid, nblk, *(const float*)(c.ws + OFF_CTL + 32768 + 1024));
#else
    REP(11) rowops::ln2_phase(c, tid, bid, nblk, 1.f);
#endif
    PH_END
}

extern "C" void kernel_launch(void* const* d_in, const int* in_sizes, int n_in, void* d_out, int out_size, void* d_ws, size_t ws_size, hipStream_t stream) {
    if (n_in != 22 || in_sizes[0] != T * D || out_size != T * D || ws_size < WS_END) { fprintf(stderr, "kernel_launch: unexpected shapes / workspace (%zu < %zu)\n", ws_size, (size_t)WS_END); return; }
    static int grid_blocks = 0;
    if (!grid_blocks) {
        int dev = 0, cus = 0, per_cu = 0;
        hipGetDevice(&dev); hipDeviceGetAttribute(&cus, hipDeviceAttributeMultiprocessorCount, dev);
        hipFuncSetAttribute((const void*)mega, hipFuncAttributeMaxDynamicSharedMemorySize, LDS_BYTES);
        hipOccupancyMaxActiveBlocksPerMultiprocessor(&per_cu, (const void*)mega, NTHR, LDS_BYTES);
        if (per_cu < 1) { fprintf(stderr, "kernel_launch: occupancy query says %d blocks/CU\n", per_cu); per_cu = 1; }
        if (per_cu > 1) per_cu = 1;
        grid_blocks = cus * per_cu;
    }
    Ctx c = make_ctx(d_in, d_out, d_ws);
    void* args[] = {&c};
    hipError_t e = hipLaunchCooperativeKernel((const void*)mega, dim3(grid_blocks), dim3(NTHR), args, LDS_BYTES, stream);
    if (e != hipSuccess) fprintf(stderr, "cooperative launch failed: %s (grid %d)\n", hipGetErrorString(e), grid_blocks);
}
```
